# Optimizing an MI355X kernel written in HIP

```python
import math
import jax, jax.numpy as jnp
from jax import lax
import numpy as np

D_MODEL = 4096
BATCH = 2
SEQ = 8192
DEPTH = 2

N_MIXERS = 2
RMS_EPS = 1e-6

DILATED_GROUPS = ((128, 1), (512, 4), (2048, 16))
N_GROUPS = 3
ATTN_HEAD_DIM = 128
ATTN_HEADS_PER_GROUP = 16
ATTN_HEADS = N_GROUPS * ATTN_HEADS_PER_GROUP
ATTN_BLOCK = 128
NEG_INF = -1e30

NUM_BUCKETS = 32
MAX_EXACT = 16
REL_MAX_DISTANCE = 2048

HG_HEAD_DIM = 128
HG_HEADS = D_MODEL // HG_HEAD_DIM
HG_CHUNK = 64

D_FF = -(-8 * D_MODEL // (3 * 256)) * 256

kernel_name = 'hybrid_dilated_attn_hgrn2_swiglu'


def rms_norm(x, gain):
    xf = x.astype(jnp.float32)
    y = xf * lax.rsqrt(jnp.mean(xf * xf, axis=-1, keepdims=True) + RMS_EPS)
    return (y * gain.astype(jnp.float32)).astype(x.dtype)


def t5_causal_bucket(dist):
    dist = jnp.maximum(dist, 0)
    log_ratio = jnp.log(jnp.maximum(dist, 1).astype(jnp.float32) / MAX_EXACT) / math.log(REL_MAX_DISTANCE / MAX_EXACT)
    large = MAX_EXACT + (log_ratio * (NUM_BUCKETS - MAX_EXACT)).astype(jnp.int32)
    large = jnp.minimum(large, NUM_BUCKETS - 1)
    return jnp.where(dist < MAX_EXACT, dist, large)


def dilated_window_group(q, k, v, rel_bias_g, window, dilation):
    B, S, H, Dh = q.shape
    span = window // dilation
    n = S // dilation
    nb = -(-n // ATTN_BLOCK)
    n_pad = nb * ATTN_BLOCK

    def to_blocks(a):
        a = a.reshape(B, n, dilation, H, Dh).transpose(0, 3, 2, 1, 4)
        a = jnp.pad(a, ((0, 0), (0, 0), (0, 0), (0, n_pad - n), (0, 0)))
        return a.reshape(B, H, dilation, nb, ATTN_BLOCK, Dh)

    def with_prev(a):
        prev = jnp.pad(a, ((0, 0), (0, 0), (0, 0), (1, 0), (0, 0), (0, 0)))[:, :, :, :-1]
        return jnp.concatenate([prev, a], axis=-2)

    qb = to_blocks(q)
    kc = with_prev(to_blocks(k))
    vc = with_prev(to_blocks(v))

    qi = jnp.arange(ATTN_BLOCK)[:, None]
    ki = jnp.arange(2 * ATTN_BLOCK)[None, :]
    rel = qi - ki + ATTN_BLOCK
    band = (rel >= 0) & (rel <= span)
    valid = band[None] & ((jnp.arange(nb)[:, None, None] > 0) | (ki[None] >= ATTN_BLOCK))
    bias = rel_bias_g[t5_causal_bucket(rel * dilation)].astype(jnp.float32)
    bias = bias.transpose(2, 0, 1)[None, :, None, None]

    logits = jnp.einsum('bhrnqd,bhrnkd->bhrnqk', qb, kc, preferred_element_type=jnp.float32) * (Dh ** -0.5) + bias
    logits = jnp.where(valid, logits, NEG_INF)
    lse = jax.nn.logsumexp(logits, axis=-1)
    probs = jnp.exp(logits - lse[..., None])
    out = jnp.einsum('bhrnqk,bhrnkd->bhrnqd', probs.astype(v.dtype), vc, preferred_element_type=jnp.float32)
    out = out.reshape(B, H, dilation, n_pad, Dh)[:, :, :, :n].transpose(0, 3, 2, 1, 4).reshape(B, S, H, Dh)
    lse = lse.reshape(B, H, dilation, n_pad)[..., :n].transpose(0, 3, 2, 1).reshape(B, S, H)
    return out, lse


def dilated_attention_mixer(y, w_in, w_out, rel_bias):
    B, S, _ = y.shape
    proj = (y @ w_in).reshape(B, S, N_GROUPS, 3, ATTN_HEADS_PER_GROUP, ATTN_HEAD_DIM)
    outs, lses = [], []
    for g, (window, dilation) in enumerate(DILATED_GROUPS):
        cols = rel_bias[:, g * ATTN_HEADS_PER_GROUP:(g + 1) * ATTN_HEADS_PER_GROUP]
        o, l = dilated_window_group(proj[:, :, g, 0], proj[:, :, g, 1], proj[:, :, g, 2], cols, window, dilation)
        outs.append(o)
        lses.append(l)
    alpha = jax.nn.softmax(jnp.stack(lses), axis=0)
    merged = jnp.sum(alpha[..., None] * jnp.stack(outs), axis=0)
    return merged.reshape(B, S, ATTN_HEADS_PER_GROUP * ATTN_HEAD_DIM).astype(y.dtype) @ w_out


def hgrn2_chunk_recurrence(q, k, v, log_f):
    B, H, S, Dk = q.shape
    Dv = v.shape[-1]
    nc = S // HG_CHUNK
    mid = HG_CHUNK // 2

    def chunks(a):
        return a.reshape(B, H, nc, HG_CHUNK, a.shape[-1]).transpose(2, 0, 1, 3, 4)

    causal = jnp.tril(jnp.ones((HG_CHUNK, HG_CHUNK), dtype=bool))

    def step(state, inp):
        qc, kc, vc, gc = inp
        b = jnp.cumsum(gc, axis=-2)
        b_ref = b[..., mid - 1:mid, :]
        b_last = b[..., -1:, :]
        inter = jnp.einsum('bhtd,bhde->bhte', qc * jnp.exp(b), state)
        scores = jnp.einsum('bhtd,bhsd->bhts', qc * jnp.exp(b - b_ref), kc * jnp.exp(b_ref - b))
        intra = jnp.einsum('bhts,bhse->bhte', jnp.where(causal, scores, 0.0), vc)
        new_state = state * jnp.exp(b_last[..., 0, :])[..., None] + jnp.einsum('bhsd,bhse->bhde', kc * jnp.exp(b_last - b), vc)
        return new_state, inter + intra

    state0 = jnp.zeros((B, H, Dk, Dv), jnp.float32)
    _, out = lax.scan(step, state0, (chunks(q), chunks(k), chunks(v), chunks(log_f)))
    return out.transpose(1, 2, 0, 3, 4).reshape(B, H, S, Dv)


def hgrn2_mixer(y, w_in, lower_bound, out_gain, w_out):
    B, S, _ = y.shape
    proj = (y @ w_in).reshape(B, S, 4, HG_HEADS, HG_HEAD_DIM).astype(jnp.float32)
    q_raw, f_raw, i_raw, g_raw = proj[:, :, 0], proj[:, :, 1], proj[:, :, 2], proj[:, :, 3]
    lb = lower_bound.astype(jnp.float32).reshape(HG_HEADS, HG_HEAD_DIM)
    forget = lb + (1.0 - lb) * jax.nn.sigmoid(f_raw)
    log_f = jnp.log(forget)
    key = 1.0 - forget
    q = jax.nn.silu(q_raw) * (HG_HEAD_DIM ** -0.5)
    to_bhsd = lambda a: a.transpose(0, 2, 1, 3)
    o = hgrn2_chunk_recurrence(to_bhsd(q), to_bhsd(key), to_bhsd(i_raw), to_bhsd(log_f))
    o = rms_norm(o, out_gain).transpose(0, 2, 1, 3) * jax.nn.silu(g_raw)
    return o.reshape(B, S, HG_HEADS * HG_HEAD_DIM).astype(y.dtype) @ w_out


def swiglu_ffn(y, w_in, w_out):
    h = y @ w_in
    gate, up = h[..., :D_FF], h[..., D_FF:]
    return (jax.nn.silu(gate) * up) @ w_out


def setup_inputs(seed: int = 0) -> dict:
    key = jax.random.key(seed)
    ks = jax.random.split(key, 11)
    n_attn = (DEPTH + 1) // 2
    n_hg = DEPTH // 2
    attn_in_cols = N_GROUPS * 3 * ATTN_HEADS_PER_GROUP * ATTN_HEAD_DIM
    attn_out_rows = ATTN_HEADS_PER_GROUP * ATTN_HEAD_DIM
    hg_width = HG_HEADS * HG_HEAD_DIM

    def dense(k, shape, fan_in):
        return jax.random.normal(k, shape, jnp.float32) * (fan_in ** -0.5)

    return {
        'x': jax.random.normal(ks[0], (BATCH, SEQ, D_MODEL), jnp.float32),
        'norm_gains': 1.0 + 0.05 * jax.random.normal(ks[1], (DEPTH, 4, D_MODEL), jnp.float32),
        'rel_bias': 0.1 * jax.random.normal(ks[2], (NUM_BUCKETS, ATTN_HEADS), jnp.float32),
        'attn_w_in': dense(ks[3], (n_attn, D_MODEL, attn_in_cols), D_MODEL),
        'attn_w_out': dense(ks[4], (n_attn, attn_out_rows, D_MODEL), attn_out_rows),
        'hgrn_w_in': dense(ks[5], (n_hg, D_MODEL, 4 * hg_width), D_MODEL),
        'hgrn_lb_logits': 1.0 + 0.1 * jax.random.normal(ks[6], (DEPTH, hg_width), jnp.float32),
        'hgrn_out_gain': 1.0 + 0.05 * jax.random.normal(ks[7], (n_hg, HG_HEAD_DIM), jnp.float32),
        'hgrn_w_out': dense(ks[8], (n_hg, hg_width, D_MODEL), hg_width),
        'ffn_w_in': dense(ks[9], (DEPTH, D_MODEL, 2 * D_FF), D_MODEL),
        'ffn_w_out': dense(ks[10], (DEPTH, D_FF, D_MODEL), D_FF),
    }


def reference(x, norm_gains, rel_bias, attn_w_in, attn_w_out, hgrn_w_in, hgrn_lb_logits,
              hgrn_out_gain, hgrn_w_out, ffn_w_in, ffn_w_out):
    lb_probs = jax.nn.softmax(hgrn_lb_logits.astype(jnp.float32), axis=0)
    lower_bounds = jnp.cumsum(lb_probs, axis=0) - lb_probs[0]
    h = x
    for i in range(DEPTH):
        gains = norm_gains[i]
        y = rms_norm(h, gains[0])
        if i % N_MIXERS == 0:
            y = dilated_attention_mixer(y, attn_w_in[i // N_MIXERS], attn_w_out[i // N_MIXERS], rel_bias)
        else:
            y = hgrn2_mixer(y, hgrn_w_in[i // N_MIXERS], lower_bounds[i], hgrn_out_gain[i // N_MIXERS], hgrn_w_out[i // N_MIXERS])
        h = h + rms_norm(y, gains[1])
        y = swiglu_ffn(rms_norm(h, gains[2]), ffn_w_in[i], ffn_w_out[i])
        h = h + rms_norm(y, gains[3])
    return h
```

```cpp
#include <hip/hip_runtime.h>
#include <cstdio>
#include <cstdint>
#ifndef PG8_WGM
#define PG8_WGM 8
#endif
#ifndef MK_FFO_ROT
#define MK_FFO_ROT 1
#endif
namespace pg8 {
#define PG8_LAS __attribute__((address_space(3)))
typedef unsigned short bf16_t;
typedef short bf16x8 __attribute__((ext_vector_type(8)));
typedef float f32x4 __attribute__((ext_vector_type(4)));
typedef unsigned u32x4 __attribute__((ext_vector_type(4)));
constexpr int BM = 256, BK = 64, HALF = 128, HTB = HALF * BK * 2  , STAGE_BYTES = 8 * HTB, NXCD = 8, WGM = PG8_WGM;

__host__ __device__ __forceinline__ int lds_byte(int r, int c) { const int st = (r >> 4) * 2 + (c >> 5), rr = r & 15, cc = c & 31, ob = rr * 64 + cc * 2; return st * 1024 + (ob ^ (((ob >> 9) & 1) << 5)); }
__host__ __device__ __forceinline__ void stage_rc(int b, int& R, int& C) { const int st = b / 1024, sb = b % 1024, swz = sb ^ (((sb >> 9) & 1) << 5); R = (st >> 1) * 16 + swz / 64; C = (st & 1) * 32 + (swz % 64) / 2; }
__host__ __device__ __forceinline__ int perm32(int rho) { const int n = rho >> 4, i = rho & 15; return 8 * (i >> 2) + 4 * n + (i & 3); }

struct Unit { int pm, pn; };
struct Gemm { const bf16_t* A; const bf16_t* Bt; int M, N, K; };

struct StaticOrder {
    int nM, nN, nwg, G, c;
    __host__ __device__ void init(int M, int N, int G_, int c_) { nM = M / BM; nN = N / BM; nwg = nM * nN; G = G_; c = c_; }
    __host__ __device__ bool next(int i, Unit& u) const {
        const long L = (long)i * G + c; if (L >= nwg) return false;
        int wgid = (int)L; { const int q = nwg / NXCD, r = nwg % NXCD, xcd = wgid % NXCD, off = wgid / NXCD; wgid = (xcd < r ? xcd * (q + 1) : r * (q + 1) + (xcd - r) * q) + off; }
        const int nig = WGM * nN, gid = wgid / nig, fm = gid * WGM, gsz = (nM - fm) < WGM ? (nM - fm) : WGM;
        u.pm = fm + ((wgid % nig) % gsz); u.pn = (wgid % nig) / gsz; return true;
    }
    __device__ __forceinline__ void a_ready(const Unit&) const {}
    __device__ __forceinline__ void done(const Unit&) const {}
};

__device__ __forceinline__ unsigned cvt_pk_bf16(float lo, float hi) { unsigned r; asm volatile("v_cvt_pk_bf16_f32 %0, %1, %2" : "=v"(r) : "v"(lo), "v"(hi)); return r; }
typedef float f32x2 __attribute__((ext_vector_type(2)));
typedef int i32x4 __attribute__((ext_vector_type(4)));
template <bool I8> struct AccT { typedef f32x4 type; static __device__ __forceinline__ f32x4 zero() { return (f32x4){0.f, 0.f, 0.f, 0.f}; } };
template <> struct AccT<true> { typedef i32x4 type; static __device__ __forceinline__ i32x4 zero() { return (i32x4){0, 0, 0, 0}; } };
__device__ __forceinline__ f32x4 mma16(bf16x8 a, bf16x8 b, f32x4 c) { return __builtin_amdgcn_mfma_f32_16x16x32_bf16(a, b, c, 0, 0, 0); }
__device__ __forceinline__ i32x4 mma16(bf16x8 a, bf16x8 b, i32x4 c) { return __builtin_amdgcn_mfma_i32_16x16x64_i8(__builtin_bit_cast(i32x4, a), __builtin_bit_cast(i32x4, b), c, 0, 0, 0); }
__host__ __device__ __forceinline__ size_t tm_chunk_off(int r, int cb, int nt, bool perm) {
    const int p = r >> 8, rr = r & 255, half = rr >> 7; int R = rr & 127;
    if (perm) { const int x = R & 31; R = (R & ~31) + 16 * ((x >> 2) & 1) + 4 * (x >> 3) + (x & 3); }
    return ((size_t)(p * nt + (cb >> 7)) * 2 + half) * 16384 + (size_t)lds_byte(R, (cb & 127) >> 1) + (cb & 1);
}
#ifndef MK_ST_SC1
#define MK_ST_SC1 0
#endif
__device__ __forceinline__ void st16(void* p, u32x4 v) {
#if MK_ST_SC1
    asm volatile("global_store_dwordx4 %0, %1, off sc1\n\ts_nop 1" :: "v"(p), "v"(v) : "memory");
#else
    *(u32x4*)p = v;
#endif
}
__device__ __forceinline__ float silu_f(float x) { return x * __builtin_amdgcn_rcpf(1.0f + __expf(-x)); }
template <bool I8> struct EpiBf16T {
    static constexpr bool PERM = true, AFTER_DRAIN = false;
    bf16_t* O; int ldc; int split_cols; size_t split_stride; int dil; const float* sa; const float* sw;
    __device__ __forceinline__ void operator()(const typename AccT<I8>::type (&acc)[2][2][4][2], const Unit& u, int wr, int wc, int fr, int fq) const {
        const int row0 = u.pm * BM + wr * 64 + fr; int colt = u.pn * BM; bf16_t* base = O; int sh = 0;
        if (split_cols) { const int t = colt / split_cols; base += (size_t)t * split_stride; colt -= t * split_cols; if (dil) sh = 2 * (t / 3); }
        const int col0 = colt + wc * 32 + 8 * fq;
        f32x4 swv[2][2];
#pragma unroll
        for (int bj = 0; bj < 2; ++bj)
#pragma unroll
            for (int n = 0; n < 2; ++n) swv[bj][n] = I8 ? *(const f32x4*)(sw + u.pn * BM + wc * 32 + 8 * fq + bj * HALF + 4 * n) : (f32x4){1.f, 1.f, 1.f, 1.f};
#pragma unroll
        for (int ai = 0; ai < 2; ++ai)
#pragma unroll
            for (int m = 0; m < 4; ++m) { int r = row0 + ai * HALF + m * 16; const float sr = I8 ? sa[r] : 1.f;
                if (sh) { const int tt = r & 8191; r = (r & ~8191) + ((tt & ((1 << sh) - 1)) << (13 - sh)) + (tt >> sh); }
                bf16_t* rowp = base + (size_t)r * ldc + col0;
#pragma unroll
                for (int bj = 0; bj < 2; ++bj) { f32x4 v0, v1;
#pragma unroll
                    for (int j = 0; j < 4; ++j) { v0[j] = I8 ? (float)acc[ai][bj][m][0][j] * (sr * swv[bj][0][j]) : (float)acc[ai][bj][m][0][j]; v1[j] = I8 ? (float)acc[ai][bj][m][1][j] * (sr * swv[bj][1][j]) : (float)acc[ai][bj][m][1][j]; }
                    u32x4 w; w.x = cvt_pk_bf16(v0[0], v0[1]); w.y = cvt_pk_bf16(v0[2], v0[3]); w.z = cvt_pk_bf16(v1[0], v1[1]); w.w = cvt_pk_bf16(v1[2], v1[3]);
                    st16(rowp + bj * HALF, w); } }
    }
};
typedef EpiBf16T<false> EpiBf16;
struct EpiF32 {
    static constexpr bool PERM = false, AFTER_DRAIN = false;
    float* C; int ldc;
    __device__ __forceinline__ void operator()(const f32x4 (&acc)[2][2][4][2], const Unit& u, int wr, int wc, int fr, int fq) const {
        const int row0 = u.pm * BM + wr * 64 + fr, col0 = u.pn * BM + wc * 32 + 4 * fq;
#pragma unroll
        for (int ai = 0; ai < 2; ++ai)
#pragma unroll
            for (int m = 0; m < 4; ++m) { float* rowp = C + (size_t)(row0 + ai * HALF + m * 16) * ldc + col0;
#pragma unroll
                for (int bj = 0; bj < 2; ++bj)
#pragma unroll
                    for (int n = 0; n < 2; ++n) *(f32x4*)(rowp + bj * HALF + n * 16) = acc[ai][bj][m][n]; }
    }
};
struct EpiSwiGLU {
    static constexpr bool PERM = true, AFTER_DRAIN = false;
    bf16_t* O; int ldc;
    __device__ __forceinline__ void operator()(const f32x4 (&acc)[2][2][4][2], const Unit& u, int wr, int wc, int fr, int fq) const {
        const int row0 = u.pm * BM + wr * 64 + fr, col0 = u.pn * HALF + wc * 32 + 8 * fq;
#pragma unroll
        for (int ai = 0; ai < 2; ++ai)
#pragma unroll
            for (int m = 0; m < 4; ++m) { bf16_t* rowp = O + (size_t)(row0 + ai * HALF + m * 16) * ldc + col0;
                const f32x4 g0 = acc[ai][0][m][0], g1 = acc[ai][0][m][1], u0 = acc[ai][1][m][0], u1 = acc[ai][1][m][1];
                f32x4 v0, v1;
#pragma unroll
                for (int j = 0; j < 4; ++j) { v0[j] = silu_f(g0[j]) * u0[j]; v1[j] = silu_f(g1[j]) * u1[j]; }
                u32x4 w; w.x = cvt_pk_bf16(v0[0], v0[1]); w.y = cvt_pk_bf16(v0[2], v0[3]); w.z = cvt_pk_bf16(v1[0], v1[1]); w.w = cvt_pk_bf16(v1[2], v1[3]);
                st16(rowp, w); }
    }
};

template <bool I8> struct EpiHgrn {
    static constexpr bool PERM = true, AFTER_DRAIN = false;
    bf16_t* base; bf16_t* KH; const float* lb; const float* sa; const float* sw;
    __device__ __forceinline__ void operator()(const typename AccT<I8>::type (&acc)[2][2][4][2], const Unit& u, int wr, int wc, int fr, int fq) const {
        const int row0 = u.pm * BM + wr * 64 + fr, sec = u.pn >> 4, cs0 = (u.pn & 15) * BM + wc * 32 + 8 * fq;
        f32x4 lbv[2][2], swv[2][2];
#pragma unroll
        for (int bj = 0; bj < 2; ++bj)
#pragma unroll
            for (int n = 0; n < 2; ++n) { lbv[bj][n] = (sec == 1) ? *(const f32x4*)(lb + cs0 + bj * HALF + 4 * n) : (f32x4){0.f, 0.f, 0.f, 0.f};
                swv[bj][n] = I8 ? *(const f32x4*)(sw + u.pn * BM + wc * 32 + 8 * fq + bj * HALF + 4 * n) : (f32x4){1.f, 1.f, 1.f, 1.f}; }
        bf16_t* const hm = base + (size_t)sec * ((size_t)16384 * 4096);
#pragma unroll
        for (int ai = 0; ai < 2; ++ai)
#pragma unroll
            for (int m = 0; m < 4; ++m) { const int r = row0 + ai * HALF + m * 16, bb = r >> 13, tt = r & 8191; const float sr = I8 ? sa[r] : 1.f;
#pragma unroll
                for (int bj = 0; bj < 2; ++bj) { f32x4 v[2]; u32x4 w;
#pragma unroll
                    for (int n = 0; n < 2; ++n)
#pragma unroll
                        for (int j = 0; j < 4; ++j) v[n][j] = I8 ? (float)acc[ai][bj][m][n][j] * (sr * swv[bj][n][j]) : (float)acc[ai][bj][m][n][j];
                    const size_t hoff = ((size_t)(bb * 32 + (u.pn & 15) * 2 + bj) * 8192 + tt) * 128 + wc * 32 + 8 * fq;
                    if (sec == 1) { f32x4 kk[2];
#pragma unroll
                        for (int n = 0; n < 2; ++n)
#pragma unroll
                            for (int j = 0; j < 4; ++j) { const float fg = lbv[bj][n][j] + (1.f - lbv[bj][n][j]) * __builtin_amdgcn_rcpf(1.0f + __expf(-v[n][j])); kk[n][j] = 1.f - fg; v[n][j] = __logf(fg); }
                        u32x4 kw; kw.x = cvt_pk_bf16(kk[0][0], kk[0][1]); kw.y = cvt_pk_bf16(kk[0][2], kk[0][3]); kw.z = cvt_pk_bf16(kk[1][0], kk[1][1]); kw.w = cvt_pk_bf16(kk[1][2], kk[1][3]);
                        st16(KH + hoff, kw);
                    } else if (sec == 0) {
#pragma unroll
                        for (int n = 0; n < 2; ++n)
#pragma unroll
                            for (int j = 0; j < 4; ++j) v[n][j] = silu_f(v[n][j]) * 0.08838834764831845f;
                    } else if (sec == 3) {
#pragma unroll
                        for (int n = 0; n < 2; ++n)
#pragma unroll
                            for (int j = 0; j < 4; ++j) v[n][j] = silu_f(v[n][j]);
                    }
                    w.x = cvt_pk_bf16(v[0][0], v[0][1]); w.y = cvt_pk_bf16(v[0][2], v[0][3]); w.z = cvt_pk_bf16(v[1][0], v[1][1]); w.w = cvt_pk_bf16(v[1][2], v[1][3]);
                    st16(hm + ((sec == 3) ? ((size_t)r * 4096 + cs0 + bj * HALF) : hoff), w); } }
    }
};
struct EpiSwiGLU8 {
    static constexpr bool PERM = true, AFTER_DRAIN = false;
    bf16_t* O; int ldc; const float* sa; const float* sw; bf16_t* O2;
    __device__ __forceinline__ EpiSwiGLU8 alt() const { EpiSwiGLU8 e = *this; e.O = O2; return e; }
    __device__ __forceinline__ void operator()(const i32x4 (&acc)[2][2][4][2], const Unit& u, int wr, int wc, int fr, int fq) const {
        const int row0 = u.pm * BM + wr * 64 + fr, col0 = u.pn * HALF + wc * 32 + 8 * fq, brow0 = u.pn * BM + wc * 32 + 8 * fq;
        f32x4 sg[2], su[2];
#pragma unroll
        for (int n = 0; n < 2; ++n) { sg[n] = *(const f32x4*)(sw + brow0 + 4 * n); su[n] = *(const f32x4*)(sw + brow0 + HALF + 4 * n); }
#pragma unroll
        for (int ai = 0; ai < 2; ++ai)
#pragma unroll
            for (int m = 0; m < 4; ++m) { const int r = row0 + ai * HALF + m * 16; const float sr = sa[r]; bf16_t* rowp = O + (size_t)r * ldc + col0;
                f32x4 v[2];
#pragma unroll
                for (int n = 0; n < 2; ++n)
#pragma unroll
                    for (int j = 0; j < 4; ++j) { const float gt = (float)acc[ai][0][m][n][j] * (sr * sg[n][j]), up = (float)acc[ai][1][m][n][j] * (sr * su[n][j]); v[n][j] = silu_f(gt) * up; }
                u32x4 w; w.x = cvt_pk_bf16(v[0][0], v[0][1]); w.y = cvt_pk_bf16(v[0][2], v[0][3]); w.z = cvt_pk_bf16(v[1][0], v[1][1]); w.w = cvt_pk_bf16(v[1][2], v[1][3]);
                st16(rowp, w); }
    }
};

template <bool I8> struct EpiHgrn2 {
    static constexpr bool PERM = true, AFTER_DRAIN = false;
    bf16_t* base; bf16_t* KH; const float* lb; const float* sa; const float* sw;
    __device__ __forceinline__ void operator()(const typename AccT<I8>::type (&acc)[2][2][4][2], const Unit& u, int wr, int wc, int fr, int fq) const {
        typedef unsigned u32x2 __attribute__((ext_vector_type(2)));
        const int row0 = u.pm * BM + wr * 64 + fr, head = u.pn >> 1, ch0 = 64 * (u.pn & 1) + 16 * wc + 4 * fq;
        const f32x4 lbv = *(const f32x4*)(lb + head * 128 + ch0);
        f32x4 swv[2][2];
#pragma unroll
        for (int bj = 0; bj < 2; ++bj)
#pragma unroll
            for (int n = 0; n < 2; ++n) swv[bj][n] = I8 ? *(const f32x4*)(sw + u.pn * BM + wc * 32 + 8 * fq + bj * HALF + 4 * n) : (f32x4){1.f, 1.f, 1.f, 1.f};
        const size_t MD = (size_t)16384 * 4096;
#pragma unroll
        for (int ai = 0; ai < 2; ++ai)
#pragma unroll
            for (int m = 0; m < 4; ++m) { const int r = row0 + ai * HALF + m * 16, bb = r >> 13, tt = r & 8191; const float sr = I8 ? sa[r] : 1.f;
                f32x4 v[2][2];
#pragma unroll
                for (int bj = 0; bj < 2; ++bj)
#pragma unroll
                    for (int n = 0; n < 2; ++n)
#pragma unroll
                        for (int j = 0; j < 4; ++j) v[bj][n][j] = I8 ? (float)acc[ai][bj][m][n][j] * (sr * swv[bj][n][j]) : (float)acc[ai][bj][m][n][j];
                const size_t hoff = ((size_t)(bb * 32 + head) * 8192 + tt) * 128 + ch0;
                f32x4 qv, lf, kk, sg;
#pragma unroll
                for (int j = 0; j < 4; ++j) { qv[j] = silu_f(v[0][0][j]) * 0.08838834764831845f;
                    const float fg = lbv[j] + (1.f - lbv[j]) * __builtin_amdgcn_rcpf(1.0f + __expf(-v[0][1][j])); kk[j] = 1.f - fg; lf[j] = __logf(fg); sg[j] = silu_f(v[1][1][j]); }
                *(u32x2*)(base + hoff) = (u32x2){cvt_pk_bf16(qv[0], qv[1]), cvt_pk_bf16(qv[2], qv[3])};
                *(u32x2*)(base + MD + hoff) = (u32x2){cvt_pk_bf16(lf[0], lf[1]), cvt_pk_bf16(lf[2], lf[3])};
                *(u32x2*)(KH + hoff) = (u32x2){cvt_pk_bf16(kk[0], kk[1]), cvt_pk_bf16(kk[2], kk[3])};
                *(u32x2*)(base + 2 * MD + hoff) = (u32x2){cvt_pk_bf16(v[1][0][0], v[1][0][1]), cvt_pk_bf16(v[1][0][2], v[1][0][3])};
                *(u32x2*)(base + 3 * MD + (size_t)r * 4096 + head * 128 + ch0) = (u32x2){cvt_pk_bf16(sg[0], sg[1]), cvt_pk_bf16(sg[2], sg[3])}; }
    }
};

#define PG8_DPP_SHR(x, n) __builtin_bit_cast(float, __builtin_amdgcn_update_dpp(0, __builtin_bit_cast(int, (x)), 0x110 + (n), 0xf, 0xf, false))
#define PG8_DPP_PERM(x, ctrl) __builtin_bit_cast(float, __builtin_amdgcn_update_dpp(0, __builtin_bit_cast(int, (x)), (ctrl), 0xf, 0xf, true))
__device__ __forceinline__ float row_sum16(float x) { x += PG8_DPP_PERM(x, 0x140); x += PG8_DPP_PERM(x, 0x141); x += PG8_DPP_PERM(x, 0xB1); x += PG8_DPP_PERM(x, 0x4E); return x; }
__device__ __forceinline__ float row_scan16(float x) { x += PG8_DPP_SHR(x, 1); x += PG8_DPP_SHR(x, 2); x += PG8_DPP_SHR(x, 4); x += PG8_DPP_SHR(x, 8); return x; }
template <bool I8> struct EpiHgrn3 {
    static constexpr bool PERM = true, AFTER_DRAIN = false;
    bf16_t* QR; size_t dKR, dVH, dSG;     float* EL; float* DEC; float* ER; const float* lb; const float* sa; const float* sw;
    __device__ __forceinline__ void operator()(const typename AccT<I8>::type (&acc)[2][2][4][2], const Unit& u, int wr, int wc, int fr, int fq) const {
        typedef unsigned u32x2 __attribute__((ext_vector_type(2)));
        const int lane = fr + 16 * fq, row0 = u.pm * BM + wr * 64 + fr, head = u.pn >> 1, ch0 = 64 * (u.pn & 1) + 16 * wc + 4 * fq;
        const f32x4 lbv = *(const f32x4*)(lb + head * 128 + ch0);
        f32x4 swv[2][2];
#pragma unroll
        for (int bj = 0; bj < 2; ++bj)
#pragma unroll
            for (int n = 0; n < 2; ++n) swv[bj][n] = I8 ? *(const f32x4*)(sw + u.pn * BM + wc * 32 + 8 * fq + bj * HALF + 4 * n) : (f32x4){1.f, 1.f, 1.f, 1.f};
#pragma unroll
        for (int ai = 0; ai < 2; ++ai) {
            f32x4 qv[4], lf[4], kk[4];
#pragma unroll
            for (int m = 0; m < 4; ++m) { const int r = row0 + ai * HALF + m * 16, bb = r >> 13, tt = r & 8191; const float sr = I8 ? sa[r] : 1.f;
                f32x4 v[2][2];
#pragma unroll
                for (int bj = 0; bj < 2; ++bj)
#pragma unroll
                    for (int n = 0; n < 2; ++n) { if constexpr (I8) v[bj][n] = __builtin_convertvector(acc[ai][bj][m][n], f32x4) * (swv[bj][n] * sr); else v[bj][n] = acc[ai][bj][m][n]; }
#pragma unroll
                for (int j = 0; j < 4; ++j) { qv[m][j] = silu_f(v[0][0][j]) * 0.08838834764831845f;
                    const float fg = lbv[j] + (1.f - lbv[j]) * __builtin_amdgcn_rcpf(1.0f + __expf(-v[0][1][j])); kk[m][j] = 1.f - fg; lf[m][j] = __builtin_amdgcn_logf(fg) * 0.6931471805599453f; }
                { const u32x2 p0 = __builtin_amdgcn_permlane16_swap(cvt_pk_bf16(v[1][0][0], v[1][0][1]), cvt_pk_bf16(v[1][1][0], v[1][1][1]), false, false);
                  const u32x2 p1 = __builtin_amdgcn_permlane16_swap(cvt_pk_bf16(v[1][0][2], v[1][0][3]), cvt_pk_bf16(v[1][1][2], v[1][1][3]), false, false);
                  const size_t doff = (fq & 1) ? (dSG + (size_t)r * 4096 + head * 128 + (ch0 - 4)) : (dVH + ((size_t)(bb * 32 + head) * 8192 + tt) * 128 + ch0);
                  *(u32x4*)(QR + doff) = (u32x4){p0.x, p1.x, p0.y, p1.y}; } }
            f32x4 bb[4], run = (f32x4){0.f, 0.f, 0.f, 0.f}, bref = run;
#pragma unroll
            for (int m = 0; m < 4; ++m) { f32x4 inc, tot;
#pragma unroll
                for (int j = 0; j < 4; ++j) { inc[j] = row_scan16(lf[m][j]); tot[j] = __shfl(inc[j], lane | 15); }
                bb[m] = inc + run; run = run + tot; if (m == 1) bref = run; }
            const int rb = u.pm * BM + ai * HALF + wr * 64; const size_t cid = (size_t)((rb >> 13) * 32 + head) * 128 + ((rb & 8191) >> 6);
#pragma unroll
            for (int m = 0; m < 4; ++m) { f32x4 qr, kr;
#pragma unroll
                for (int j = 0; j < 4; ++j) { const float e1 = __expf(bb[m][j] - bref[j]); qr[j] = qv[m][j] * e1; kr[j] = kk[m][j] * __builtin_amdgcn_rcpf(e1); }
                const size_t off = cid * 8704 + (size_t)(16 * m + fr) * 136 + (ch0 & ~7);
                const u32x2 p0 = __builtin_amdgcn_permlane16_swap(cvt_pk_bf16(qr[0], qr[1]), cvt_pk_bf16(kr[0], kr[1]), false, false);
                const u32x2 p1 = __builtin_amdgcn_permlane16_swap(cvt_pk_bf16(qr[2], qr[3]), cvt_pk_bf16(kr[2], kr[3]), false, false);
                *(u32x4*)(QR + off + ((fq & 1) ? dKR : (size_t)0)) = (u32x4){p0.x, p1.x, p0.y, p1.y}; }
            if (fr == 0) { f32x4 el, dc, er;
#pragma unroll
                for (int j = 0; j < 4; ++j) { el[j] = __expf(run[j] - bref[j]); dc[j] = __expf(run[j]); er[j] = __expf(bref[j]); }
                *(f32x4*)(EL + cid * 128 + ch0) = el; *(f32x4*)(DEC + cid * 128 + ch0) = dc; *(f32x4*)(ER + cid * 128 + ch0) = er; }
        }
    }
};

struct EpiSwiGLU8R {
    static constexpr bool PERM = true, AFTER_DRAIN = false;
    bf16_t* O; int ldc; const float* sa; const float* sw; unsigned* rmax;
    __device__ __forceinline__ void operator()(const i32x4 (&acc)[2][2][4][2], const Unit& u, int wr, int wc, int fr, int fq) const {
        const int row0 = u.pm * BM + wr * 64 + fr, col0 = u.pn * HALF + wc * 32 + 8 * fq, brow0 = u.pn * BM + wc * 32 + 8 * fq;
        f32x4 sg[2], su[2];
#pragma unroll
        for (int n = 0; n < 2; ++n) { sg[n] = *(const f32x4*)(sw + brow0 + 4 * n); su[n] = *(const f32x4*)(sw + brow0 + HALF + 4 * n); }
#pragma unroll
        for (int ai = 0; ai < 2; ++ai)
#pragma unroll
            for (int m = 0; m < 4; ++m) { const int r = row0 + ai * HALF + m * 16; const float sr = sa[r], sru = MK_FFO_ROT ? sr * 0.17677669529663687f : sr; bf16_t* rowp = O + (size_t)r * ldc + col0;
                f32x2 X[4];
#pragma unroll
                for (int n = 0; n < 2; ++n)
#pragma unroll
                    for (int j = 0; j < 4; ++j) { const float gt = (float)acc[ai][0][m][n][j] * (sr * sg[n][j]), up = (float)acc[ai][1][m][n][j] * (sru * su[n][j]); X[2 * n + (j >> 1)][j & 1] = silu_f(gt) * up; }
#if MK_FFO_ROT
#pragma unroll
                for (int k = 0; k < 4; ++k) { const float a = X[k].x, b = X[k].y; X[k] = (f32x2){a + b, a - b}; }
                { f32x2 a = X[0], b = X[1]; X[0] = a + b; X[1] = a - b; a = X[2]; b = X[3]; X[2] = a + b; X[3] = a - b; }
                { f32x2 a = X[0], b = X[2]; X[0] = a + b; X[2] = a - b; a = X[1]; b = X[3]; X[1] = a + b; X[3] = a - b; }
                { float x0 = X[0].x, x1 = X[0].y, x2 = X[1].x, x3 = X[1].y, x4 = X[2].x, x5 = X[2].y, x6 = X[3].x, x7 = X[3].y;
                  asm volatile("v_nop\n\tv_nop\n\tv_permlane16_swap_b32 %0, %4\n\tv_permlane16_swap_b32 %1, %5\n\tv_permlane16_swap_b32 %2, %6\n\tv_permlane16_swap_b32 %3, %7\n\ts_nop 1"
                               : "+v"(x0), "+v"(x1), "+v"(x2), "+v"(x3), "+v"(x4), "+v"(x5), "+v"(x6), "+v"(x7));
                  { const f32x2 a = (f32x2){x0, x1}, b = (f32x2){x4, x5}, c = (f32x2){x2, x3}, d = (f32x2){x6, x7}; X[0] = a + b; X[2] = a - b; X[1] = c + d; X[3] = c - d; }
                  x0 = X[0].x; x1 = X[0].y; x2 = X[1].x; x3 = X[1].y; x4 = X[2].x; x5 = X[2].y; x6 = X[3].x; x7 = X[3].y;
                  asm volatile("v_nop\n\tv_nop\n\tv_permlane32_swap_b32 %0, %2\n\tv_permlane32_swap_b32 %1, %3\n\tv_permlane32_swap_b32 %4, %6\n\tv_permlane32_swap_b32 %5, %7\n\ts_nop 1"
                               : "+v"(x0), "+v"(x1), "+v"(x2), "+v"(x3), "+v"(x4), "+v"(x5), "+v"(x6), "+v"(x7));
                  { const f32x2 a = (f32x2){x0, x1}, b = (f32x2){x2, x3}, c = (f32x2){x4, x5}, d = (f32x2){x6, x7}; X[0] = a + b; X[1] = a - b; X[2] = c + d; X[3] = c - d; } }
#endif
                u32x4 w; w.x = cvt_pk_bf16(X[0].x, X[0].y); w.y = cvt_pk_bf16(X[1].x, X[1].y); w.z = cvt_pk_bf16(X[2].x, X[2].y); w.w = cvt_pk_bf16(X[3].x, X[3].y);
                st16(rowp, w);
                float am = fmaxf(fmaxf(fmaxf(fabsf(X[0].x), fabsf(X[0].y)), fmaxf(fabsf(X[1].x), fabsf(X[1].y))), fmaxf(fmaxf(fabsf(X[2].x), fabsf(X[2].y)), fmaxf(fabsf(X[3].x), fabsf(X[3].y))));
                am = fmaxf(am, __shfl_xor(am, 16)); am = fmaxf(am, __shfl_xor(am, 32));
                if (fq == 0) __hip_atomic_fetch_max(rmax + r, cvt_pk_bf16(am, am) << 16, __ATOMIC_RELAXED, __HIP_MEMORY_SCOPE_AGENT); }
    }
};
template <class Epi, class Sched, bool ALIGN_EPI = false, bool SP2 = false, bool I8 = false, int KREP = 1, int EREP = 1, bool TM = false, int TCH = 0, int LT = 0>
__device__ __forceinline__ void gemm_phase(PG8_LAS unsigned char* lds, const Gemm g, const Sched& S, const Epi& E) {
    const int tid = threadIdx.x, wid = __builtin_amdgcn_readfirstlane(tid >> 6), lane = tid & 63, wr = wid >> 2, wc = wid & 3, fr = lane & 15, fq = lane >> 4;
    const int K = g.K, nt = K / BK;
    unsigned voffA[2], voffB[2];
#pragma unroll
    for (int i = 0; i < 2; ++i) { int R, C; stage_rc(tid * 16 + i * 8192, R, C); const int Rb = Epi::PERM ? ((R & ~31) + perm32(R & 31)) : R;
        voffA[i] = TM ? (unsigned)(tid * 16 + i * 8192) : (unsigned)(R * K + C) * 2u; voffB[i] = TM ? (unsigned)(tid * 16 + i * 8192) : (unsigned)(Rb * K + C) * 2u; }
    const size_t kstep = TM ? (size_t)32768 : (size_t)(BK * 2);
    const size_t hstep = TM ? (size_t)16384 : (size_t)HALF * K * 2;
    const size_t tstep = TM ? (size_t)nt * 32768 : 2 * hstep;
    const unsigned ldsw = (unsigned)wid * 1024u;
    const int aoff = lds_byte(wr * 64 + fr, fq * 8), boff = lds_byte(wc * 32 + fr, fq * 8);
#define PG8_SA(b, h) (((b) * 2 + (h)) * HTB)
#define PG8_SB(b, h) ((4 + (b) * 2 + (h)) * HTB)
#define PG8_STAGE(bufoff, gbase, voff) do { _Pragma("unroll") for (int _i = 0; _i < 2; ++_i) \
        __builtin_amdgcn_global_load_lds((const unsigned*)((const char*)(gbase) + (voff)[_i]), (PG8_LAS unsigned*)(lds + (bufoff) + ldsw + _i * 8192), 16, 0, 0); } while (0)
#define PG8_LDA(dst, b, h) do { _Pragma("unroll") for (int m = 0; m < 4; ++m) _Pragma("unroll") for (int k = 0; k < 2; ++k) dst[m][k] = *(const PG8_LAS bf16x8*)(lds + PG8_SA(b, h) + aoff + m * 2048 + k * 1024); } while (0)
#define PG8_LDB(dst, b, h) do { _Pragma("unroll") for (int n = 0; n < 2; ++n) _Pragma("unroll") for (int k = 0; k < 2; ++k) dst[n][k] = *(const PG8_LAS bf16x8*)(lds + PG8_SB(b, h) + boff + n * 2048 + k * 1024); } while (0)
#ifndef PG8_PRIO
#define PG8_PRIO 1
#endif
#define PG8_MMA(ai, bj, At, Bt) do { if (PG8_PRIO) __builtin_amdgcn_s_setprio(PG8_PRIO); _Pragma("unroll") for (int m = 0; m < 4; ++m) _Pragma("unroll") for (int n = 0; n < 2; ++n) _Pragma("unroll") for (int k = 0; k < 2; ++k) \
        acc[ai][bj][m][n] = mma16(Bt[n][k], At[m][k], acc[ai][bj][m][n]); if (PG8_PRIO) __builtin_amdgcn_s_setprio(0); } while (0)
#define PG8_WAIT_V(n) asm volatile("s_waitcnt vmcnt(" #n ")" ::: "memory")
#define PG8_WAIT_L(n) asm volatile("s_waitcnt lgkmcnt(" #n ")" ::: "memory")
#define PG8_BAR __builtin_amdgcn_s_barrier()
#define PG8_SCHED __builtin_amdgcn_sched_barrier(0)
#define PG8_TOUCH(uidx) do { if constexpr (TCH > 0) { Unit tu_; if (S.next((uidx), tu_)) { const char* tb_ = (const char*)g.Bt + (size_t)tu_.pn * tstep; const unsigned sh_ = (unsigned)cur.pm & 63u; \
        for (int l_ = tid; l_ < nt * 4; l_ += 512) { const size_t o_ = TM ? ((size_t)sh_ * (size_t)(nt * 512) + (size_t)l_ * 128) : ((size_t)(4 * sh_ + l_ / nt) * (size_t)(nt * 128) + (size_t)(l_ % nt) * 128); \
            __builtin_amdgcn_global_load_lds((const unsigned*)(tb_ + o_), (PG8_LAS unsigned*)(lds + STAGE_BYTES + wid * 256), 4, 0, 0); } } } } while (0)
    const unsigned ltoff = (lane < 8) ? (unsigned)(wid * 1024 + lane * 128) : (unsigned)(wid * 512 + (lane - 8) * 128);
#define PG8_LTOUCH(abase, bbase) do { if constexpr (LT > 0) { if (lane < 12) { const char* tp_ = (lane < 8) ? ((abase) + ltA) : ((bbase) + ltB); \
        __builtin_amdgcn_global_load_lds((const unsigned*)(tp_ + ltoff), (PG8_LAS unsigned*)(lds + STAGE_BYTES + wid * 256), 4, 0, 0); } } } while (0)
#define PG8_WAIT_VS() do { if constexpr (LT > 0) PG8_WAIT_V(9); else PG8_WAIT_V(8); } while (0)
    Unit cur, nxt; int ui = 0;
    if (!S.next(0, cur)) return;
    typedef typename AccT<I8>::type acc_t;
    acc_t acc[2][2][4][2];
#pragma unroll
    for (int a = 0; a < 2; ++a)
#pragma unroll
        for (int b = 0; b < 2; ++b)
#pragma unroll
            for (int m = 0; m < 4; ++m)
#pragma unroll
                for (int n = 0; n < 2; ++n) acc[a][b][m][n] = AccT<I8>::zero();
    bf16x8 At[4][2], B0[2][2], B1[2][2];
    const char* cA = (const char*)g.A + (size_t)cur.pm * tstep; const char* cB = (const char*)g.Bt + (size_t)cur.pn * tstep;
    unsigned ltA = (unsigned)(cur.pn & 3) * 8192u, ltB = (unsigned)(cur.pm & 7) * 4096u;
    S.a_ready(cur);
    if constexpr (TCH > 0) { PG8_TOUCH(1); if constexpr (TCH > 1) PG8_TOUCH(2); }
    if constexpr (SP2) {
        PG8_STAGE(PG8_SB(0, 0), cB, voffB); PG8_STAGE(PG8_SB(0, 1), cB + hstep, voffB); PG8_STAGE(PG8_SA(0, 0), cA, voffA); PG8_STAGE(PG8_SA(0, 1), cA + hstep, voffA);
        if (wr == 1) PG8_BAR;
        PG8_WAIT_V(2); PG8_BAR;
        PG8_STAGE(PG8_SB(1, 0), cB + kstep, voffB); PG8_STAGE(PG8_SA(1, 0), cA + kstep, voffA); PG8_STAGE(PG8_SB(1, 1), cB + hstep + kstep, voffB);
        PG8_WAIT_V(6); PG8_BAR;
    } else {
        PG8_STAGE(PG8_SB(0, 0), cB, voffB); PG8_STAGE(PG8_SA(0, 0), cA, voffA); PG8_STAGE(PG8_SB(0, 1), cB + hstep, voffB); PG8_STAGE(PG8_SA(0, 1), cA + hstep, voffA);
        if (wr == 1) PG8_BAR;
        PG8_WAIT_V(4); PG8_BAR;
        PG8_STAGE(PG8_SB(1, 0), cB + kstep, voffB); PG8_STAGE(PG8_SA(1, 0), cA + kstep, voffA); PG8_STAGE(PG8_SB(1, 1), cB + hstep + kstep, voffB);
        PG8_WAIT_V(6); PG8_BAR;
    }
    for (;;) {
        const bool has_next = S.next(ui + 1, nxt);
        const char* nA = has_next ? (const char*)g.A + (size_t)nxt.pm * tstep : cA; const char* nB = has_next ? (const char*)g.Bt + (size_t)nxt.pn * tstep : cB;
        for (int krep = 0; krep < KREP; ++krep) {
        if (KREP > 1 && krep == KREP - 1 && krep > 0) {
_Pragma("unroll") for (int a = 0; a < 2; ++a) _Pragma("unroll") for (int b = 0; b < 2; ++b) _Pragma("unroll") for (int m = 0; m < 4; ++m) _Pragma("unroll") for (int n = 0; n < 2; ++n) acc[a][b][m][n] = AccT<I8>::zero(); }
        const char* nA2 = (krep == KREP - 1) ? nA : cA; const char* nB2 = (krep == KREP - 1) ? nB : cB;
        for (int t = 0; t < nt; t += 2) {
            const bool last = (t == nt - 2);
            const char* a1 = cA + (size_t)(t + 1) * kstep;
            const char* a2 = last ? nA2 : cA + (size_t)(t + 2) * kstep; const char* b2 = last ? nB2 : cB + (size_t)(t + 2) * kstep;
            const char* a3 = a2 + kstep; const char* b3 = b2 + kstep;
            const char *ta0 = cA, *tb0 = cB, *ta1 = cA, *tb1 = cB;
            if constexpr (LT > 0) { const int q0 = t + LT, q1 = t + 1 + LT;
                if (q0 < nt) { ta0 = cA + (size_t)q0 * kstep; tb0 = cB + (size_t)q0 * kstep; } else if (krep == KREP - 1 && has_next && q0 - nt < nt) { ta0 = nA + (size_t)(q0 - nt) * kstep; tb0 = nB + (size_t)(q0 - nt) * kstep; }
                if (q1 < nt) { ta1 = cA + (size_t)q1 * kstep; tb1 = cB + (size_t)q1 * kstep; } else if (krep == KREP - 1 && has_next && q1 - nt < nt) { ta1 = nA + (size_t)(q1 - nt) * kstep; tb1 = nB + (size_t)(q1 - nt) * kstep; } }
            if (last && has_next && krep == KREP - 1) S.a_ready(nxt);
            if constexpr (SP2) {
            PG8_LDB(B0, 0, 0); PG8_LDB(B1, 0, 1); PG8_SCHED; PG8_LDA(At, 0, 0); PG8_STAGE(PG8_SA(1, 1), a1 + hstep, voffA);
            PG8_WAIT_VS(); PG8_WAIT_L(0); PG8_BAR; PG8_MMA(0, 0, At, B0); PG8_MMA(0, 1, At, B1); PG8_BAR; PG8_SCHED;
            PG8_LDA(At, 0, 1); PG8_LTOUCH(ta0, tb0); PG8_STAGE(PG8_SB(0, 0), b2, voffB); PG8_STAGE(PG8_SB(0, 1), b2 + hstep, voffB); PG8_STAGE(PG8_SA(0, 0), a2, voffA);
            PG8_WAIT_VS(); PG8_WAIT_L(0); PG8_BAR; PG8_MMA(1, 0, At, B0); PG8_MMA(1, 1, At, B1); PG8_BAR; PG8_SCHED;
            PG8_LDB(B0, 1, 0); PG8_LDB(B1, 1, 1); PG8_SCHED; PG8_LDA(At, 1, 0); PG8_STAGE(PG8_SA(0, 1), a2 + hstep, voffA);
            PG8_WAIT_VS(); PG8_WAIT_L(0); PG8_BAR; PG8_MMA(0, 0, At, B0); PG8_MMA(0, 1, At, B1); PG8_BAR; PG8_SCHED;
            PG8_LDA(At, 1, 1); PG8_LTOUCH(ta1, tb1); PG8_STAGE(PG8_SB(1, 0), b3, voffB); PG8_STAGE(PG8_SB(1, 1), b3 + hstep, voffB); PG8_STAGE(PG8_SA(1, 0), a3, voffA);
            PG8_WAIT_VS(); PG8_WAIT_L(0); PG8_BAR; PG8_MMA(1, 0, At, B0); PG8_MMA(1, 1, At, B1); PG8_BAR; PG8_SCHED;
            } else {
            PG8_LDB(B0, 0, 0); PG8_SCHED; PG8_LDA(At, 0, 0); PG8_STAGE(PG8_SA(1, 1), a1 + hstep, voffA);
            PG8_WAIT_L(8); PG8_BAR; PG8_WAIT_L(0); PG8_MMA(0, 0, At, B0); PG8_BAR; PG8_SCHED;
            PG8_LDB(B1, 0, 1); PG8_STAGE(PG8_SB(0, 0), b2, voffB);
            PG8_BAR; PG8_WAIT_L(0); PG8_MMA(0, 1, At, B1); PG8_BAR;
            PG8_LDA(At, 0, 1); PG8_STAGE(PG8_SA(0, 0), a2, voffA);
            PG8_BAR; PG8_WAIT_L(0); PG8_MMA(1, 0, At, B0); PG8_BAR; PG8_SCHED;
            PG8_STAGE(PG8_SB(0, 1), b2 + hstep, voffB);
            PG8_WAIT_V(6); PG8_BAR; PG8_MMA(1, 1, At, B1); PG8_BAR;
            PG8_LDB(B0, 1, 0); PG8_SCHED; PG8_LDA(At, 1, 0); PG8_STAGE(PG8_SA(0, 1), a2 + hstep, voffA);
            PG8_WAIT_L(8); PG8_BAR; PG8_WAIT_L(0); PG8_MMA(0, 0, At, B0); PG8_BAR; PG8_SCHED;
            PG8_LDB(B1, 1, 1); PG8_STAGE(PG8_SB(1, 0), b3, voffB);
            PG8_BAR; PG8_WAIT_L(0); PG8_MMA(0, 1, At, B1); PG8_BAR;
            PG8_LDA(At, 1, 1); PG8_STAGE(PG8_SA(1, 0), a3, voffA);
            PG8_BAR; PG8_WAIT_L(0); PG8_MMA(1, 0, At, B0); PG8_BAR; PG8_SCHED;
            PG8_STAGE(PG8_SB(1, 1), b3 + hstep, voffB);
            PG8_WAIT_V(6); PG8_BAR; PG8_MMA(1, 1, At, B1); PG8_BAR;
            }
        }
        }
        if constexpr (ALIGN_EPI) { if (wr == 0) PG8_BAR; }
        if constexpr (!Epi::AFTER_DRAIN) { E(acc, cur, wr, wc, fr, fq); if constexpr (EREP > 1) { asm volatile("" ::: "memory"); E.alt()(acc, cur, wr, wc, fr, fq); } S.done(cur); PG8_TOUCH(ui + 1 + TCH); }
        if (!has_next) break;
#pragma unroll
        for (int a = 0; a < 2; ++a)
#pragma unroll
            for (int b = 0; b < 2; ++b)
#pragma unroll
                for (int m = 0; m < 4; ++m)
#pragma unroll
                    for (int n = 0; n < 2; ++n) acc[a][b][m][n] = AccT<I8>::zero();
        cur = nxt; cA = nA; cB = nB; ++ui; ltA = (unsigned)(cur.pn & 3) * 8192u; ltB = (unsigned)(cur.pm & 7) * 4096u;
        if constexpr (ALIGN_EPI) { if (wr == 1) PG8_BAR; }
    }
    PG8_WAIT_V(0);
    if constexpr (!ALIGN_EPI) { if (wr == 0) PG8_BAR; }
    PG8_BAR;
    if constexpr (Epi::AFTER_DRAIN) { E.fused(acc, cur, wr, wc, fr, fq, lds, wid, lane); S.done(cur); }
#undef PG8_TOUCH
#undef PG8_LTOUCH
#undef PG8_WAIT_VS
#undef PG8_SA
#undef PG8_SB
#undef PG8_STAGE
#undef PG8_LDA
#undef PG8_LDB
#undef PG8_MMA
#undef PG8_WAIT_V
#undef PG8_WAIT_L
#undef PG8_BAR
#undef PG8_SCHED
}
}
#ifndef PG8_SP2
#define PG8_SP2 true
#endif
#ifndef PG8_ALIGN
#define PG8_ALIGN true
#endif
constexpr int NWAVES = 8;
#ifndef MK_N_LAUNCHES
#define MK_N_LAUNCHES 1
#endif
#ifndef MK_HGRN_MFMA
#define MK_HGRN_MFMA 1
#endif
#ifndef MK_ATTN_MFMA
#define MK_ATTN_MFMA 1
#endif
constexpr bool HGRN_MFMA = MK_HGRN_MFMA, ATTN_MFMA = MK_ATTN_MFMA;
#ifndef MK_REP_GEMM
#define MK_REP_GEMM 1
#endif
#ifndef MK_REP_P0
#define MK_REP_P0 1
#endif
#ifndef MK_REP_ATT
#define MK_REP_ATT 1
#endif
#ifndef MK_REP_HG
#define MK_REP_HG 1
#endif
#ifndef MK_REP_NORM
#define MK_REP_NORM 1
#endif
constexpr int REP_GEMM = MK_REP_GEMM, REP_P0 = MK_REP_P0, REP_ATT = MK_REP_ATT, REP_HG = MK_REP_HG, REP_NORM = MK_REP_NORM;
#ifndef MK_FFN_I8
#define MK_FFN_I8 1
#endif
static_assert(MK_FFN_I8 == 1, "the workspace map overlays ACT on the bf16 FFN-in weight copies: int8 FFN path only");
#ifndef MK_HG_I8
#define MK_HG_I8 1
#endif
constexpr bool HG_I8 = MK_HG_I8;
#ifndef MK_ATT_I8
#define MK_ATT_I8 0
#endif
constexpr bool ATT_I8 = MK_ATT_I8;
constexpr bool FFN_I8 = MK_FFN_I8;
#ifndef MK_KREP_FFI
#define MK_KREP_FFI 1
#endif
#ifndef MK_EREP_FFI
#define MK_EREP_FFI 1
#endif
constexpr int EREP_FFI = MK_EREP_FFI;
#ifndef MK_REP_FFI
#define MK_REP_FFI 1
#endif
constexpr int REP_FFI = MK_REP_FFI;
constexpr int KREP_FFI = MK_KREP_FFI;
#ifndef MK_TM_FFI
#define MK_TM_FFI 1
#endif
constexpr bool TM_FFI = MK_TM_FFI;
#ifndef MK_TCH_FFI
#define MK_TCH_FFI 0
#endif
#ifndef MK_TCH_ALL
#define MK_TCH_ALL 0
#endif
constexpr int TCH_FFI = MK_TCH_FFI, TCH_ALL = MK_TCH_ALL;
#ifndef MK_LT_FFI
#define MK_LT_FFI 0
#endif
constexpr int LT_FFI = MK_LT_FFI;
#ifndef MK_HG_FUSE
#define MK_HG_FUSE 2
#endif
constexpr int HG_FUSE = MK_HG_FUSE;
#ifndef MK_REP_P8
#define MK_REP_P8 1
#endif
constexpr int REP_P8 = MK_REP_P8;
#ifndef MK_FFO_I8
#define MK_FFO_I8 1
#endif
#ifndef MK_FFO_ROT
#define MK_FFO_ROT 1
#endif
constexpr bool FFO_I8 = MK_FFO_I8;
#ifndef MK_REP_BAR
#define MK_REP_BAR 0
#endif
constexpr int REP_BAR = MK_REP_BAR;
#ifndef MK_NT_W
#define MK_NT_W 1
#endif
#if MK_NT_W
#define MK_LD_W(p) __builtin_nontemporal_load(p)
#else
#define MK_LD_W(p) (*(p))
#endif
#ifndef MK_P0_STRIP
#define MK_P0_STRIP 1
#endif
constexpr bool P0_STRIP = MK_P0_STRIP;
#ifndef MK_HGO_I8
#define MK_HGO_I8 1
#endif
constexpr bool HGO_I8 = MK_HGO_I8;
constexpr int NPH = 16;
constexpr int N_LAUNCHES = MK_N_LAUNCHES;
static_assert(N_LAUNCHES == 1 || N_LAUNCHES == NPH, "MK_N_LAUNCHES is 1 or NPH");

constexpr int BATCH = 2, SEQ = 8192, DM = 4096, M = BATCH * SEQ, DFF = 11008, NQKV = 18432, NHG = 16384, DATT = 2048, HD = 128;
constexpr float RMS_EPS = 1e-6f;
constexpr float QSCALE = 0.08838834764831845f;

constexpr size_t MiB = 1u << 20;
constexpr size_t WS_CTL = 0, CTL_ZERO_BYTES = 1 * MiB;
constexpr size_t WS_TAB = 1 * MiB;
constexpr size_t WS_WATTI = 2 * MiB, WS_WATTO = 146 * MiB, WS_WHGI = 162 * MiB, WS_WHGO = 290 * MiB;
constexpr size_t WS_WFFI = 322 * MiB, WFFI_STRIDE = 172 * MiB, WS_WFFO = 666 * MiB, WFFO_STRIDE = 86 * MiB;
constexpr size_t WS_XN = 838 * MiB;
constexpr size_t WS_Y = 966 * MiB;
constexpr size_t WS_ACT = 322 * MiB;
constexpr size_t WS_ACT_OLD = 1222 * MiB;
constexpr size_t WS_QKV = 1566 * MiB;
constexpr size_t WS_MRG = 2142 * MiB;
constexpr size_t WS_OG = 2206 * MiB;
constexpr size_t WS_END = 2334 * MiB;
constexpr size_t WS_SA = WS_TAB + 128 * 1024, WS_SW = WS_TAB + 256 * 1024;
constexpr size_t WS_W8 = 1222 * MiB, W8_STRIDE = 86 * MiB, WS_W8H = 1394 * MiB, WS_END3 = 2529 * MiB;
constexpr size_t WS_SWH = WS_SW + 4 * 2 * 2 * DFF, WS_SWA = WS_SWH + 4 * NHG, WS_W8A = 1458 * MiB;
static_assert(WS_W8A + (size_t)NQKV * DM <= WS_QKV && WS_SWA + 4 * NQKV <= WS_WATTI, "int8 maps");
constexpr size_t WS_HB = 2529 * MiB, WS_END4 = 2657 * MiB;
constexpr size_t WS_W8O = 2657 * MiB, W8O_STRIDE = 43 * MiB, WS_END5 = 2743 * MiB, WS_SWO = WS_TAB + 640 * 1024, WS_SA2 = WS_TAB + 704 * 1024, WS_ACT8 = WS_QKV, WS_RMAX = WS_CTL + 512 * 1024;
constexpr size_t WS_W8G = 1530 * MiB, WS_SWG = WS_TAB + 768 * 1024, WS_SA3 = WS_TAB + 800 * 1024;
static_assert(WS_W8G + (size_t)DM * DM <= WS_QKV && WS_SA3 + 4 * M <= WS_WATTI, "HGO_I8 maps");
constexpr int CW_TMO = 0, CW_CODE = 1;
constexpr int CW_BAR = 4096;
constexpr int RING_OFF = 0, RING_BYTES = 131072;
constexpr int LDSCTL_OFF = 150528, MISC_OFF = LDSCTL_OFF + 320;
constexpr int LDS_BYTES = 152576;
static_assert(MISC_OFF + 128 <= LDS_BYTES, "LDS map");

#define GAS __attribute__((address_space(1)))
#define LAS __attribute__((address_space(3)))
typedef unsigned short bf16;
typedef unsigned v4u __attribute__((ext_vector_type(4)));
typedef unsigned v2u __attribute__((ext_vector_type(2)));
typedef float f32x4 __attribute__((ext_vector_type(4)));
typedef short bf16x8 __attribute__((ext_vector_type(8)));
typedef GAS unsigned gu32;
typedef GAS unsigned long long gu64;
#define RLX_AGENT __ATOMIC_RELAXED, __HIP_MEMORY_SCOPE_AGENT
#define LDS_WAIT() asm volatile("s_waitcnt lgkmcnt(0)" ::: "memory")
#define VM_WAIT() asm volatile("s_waitcnt vmcnt(0)" ::: "memory")
__device__ __forceinline__ unsigned f2bf(float f) { unsigned u = __builtin_bit_cast(unsigned, f); return (u + 0x7fffu + ((u >> 16) & 1u)) >> 16; }
__device__ __forceinline__ unsigned pk2(float lo, float hi) { return f2bf(lo) | (f2bf(hi) << 16); }
__device__ __forceinline__ unsigned cvtpk(float lo, float hi) { return pg8::cvt_pk_bf16(lo, hi); }
__device__ __forceinline__ float bflo(unsigned w) { return __builtin_bit_cast(float, w << 16); }
__device__ __forceinline__ float bfhi(unsigned w) { return __builtin_bit_cast(float, w & 0xffff0000u); }
#define XB_TMO      128
#define XB_XCNT(j)  (256  + 64 * (j))
#define XB_XSUB(j)  (1280 + 64 * (j))
#define XB_XGEN(j)  (2304 + 64 * (j))
#define XB_TOP      3328
#define XB_TOPGEN   3392
#define XCD_BAR_WORDS 3456
#define XB_SPIN_CAP (1u << 18)

__device__ __forceinline__ unsigned xb_ld(unsigned* p)              { return __hip_atomic_load(p, __ATOMIC_RELAXED, __HIP_MEMORY_SCOPE_AGENT); }
__device__ __forceinline__ unsigned xb_add(unsigned* p, unsigned v) { return __hip_atomic_fetch_add(p, v, __ATOMIC_RELAXED, __HIP_MEMORY_SCOPE_AGENT); }
__device__ __forceinline__ unsigned xb_xcc_id() { return (unsigned)__builtin_amdgcn_s_getreg((3 << 11) | 20) & 0xFu; }
#define XB_SPIN(cond, bar) do { unsigned _sp = 0; while (cond) { __builtin_amdgcn_s_sleep(1); \
    if ((++_sp & 255u) == 0u) { if (xb_ld(&(bar)[XB_TMO])) break; if (_sp > XB_SPIN_CAP) { atomicAdd(&(bar)[XB_TMO], 1u); break; } } } } while (0)

struct XcdBarrier {
    unsigned* bar; unsigned x;
    volatile LAS unsigned* st;
};

__device__ __forceinline__ XcdBarrier xcd_barrier_post(unsigned* bar, volatile LAS unsigned* st) {
    XcdBarrier b; b.bar = bar; b.x = xb_xcc_id(); b.st = st;
    if (threadIdx.x == 0) (void)xb_add(&bar[XB_XCNT(b.x)], 1u);
    return b;
}
__device__ __forceinline__ void xcd_barrier_complete(unsigned* bar, unsigned x, unsigned& nloc, unsigned& nx) {
    const unsigned G = gridDim.x * gridDim.y * gridDim.z;
    unsigned sum, cnt, mine, sp = 0u;
    for (;;) {
        sum = 0u; cnt = 0u; mine = 0u;
#pragma unroll
        for (unsigned j = 0; j < 16; ++j) { const unsigned c = xb_ld(&bar[XB_XCNT(j)]); sum += c; cnt += (c > 0u) ? 1u : 0u; mine = (j == x) ? c : mine; }
        if (sum == G) break;
        __builtin_amdgcn_s_sleep(1);
        if ((++sp & 255u) == 0u) { if (xb_ld(&bar[XB_TMO])) break; if (sp > XB_SPIN_CAP) { atomicAdd(&bar[XB_TMO], 1u); break; } }
    }
    nloc = mine > 0u ? mine : 1u; nx = cnt > 0u ? cnt : 1u;
}

__device__ __forceinline__ void xcd_barrier(const XcdBarrier& b) {
    asm volatile("s_waitcnt vmcnt(0)" ::: "memory");
    __syncthreads();
    if (threadIdx.x == 0) {
        unsigned* bar = b.bar;
        __builtin_amdgcn_s_waitcnt(0);
        unsigned nloc = b.st[0], nx = b.st[1];
        if (nloc == 0u) { xcd_barrier_complete(bar, b.x, nloc, nx); b.st[0] = nloc; b.st[1] = nx; }
        const unsigned old = xb_add(&bar[XB_XSUB(b.x)], 1u);
        const unsigned gen = old / nloc;
        if (old + 1u == (gen + 1u) * nloc) {
            __builtin_amdgcn_fence(__ATOMIC_RELEASE, "agent");
            asm volatile("s_waitcnt vmcnt(0)" ::: "memory");
            const unsigned og = xb_add(&bar[XB_TOP], 1u);
            const unsigned tg = og / nx;
            if (og + 1u == (tg + 1u) * nx) xb_add(&bar[XB_TOPGEN], 1u);
            else XB_SPIN(xb_ld(&bar[XB_TOPGEN]) == tg, bar);
            __builtin_amdgcn_fence(__ATOMIC_ACQUIRE, "agent");
            xb_add(&bar[XB_XGEN(b.x)], 1u);
            asm volatile("s_waitcnt vmcnt(0)" ::: "memory");
        } else {
            XB_SPIN(xb_ld(&bar[XB_XGEN(b.x)]) == gen, bar);
            __builtin_amdgcn_fence(__ATOMIC_ACQUIRE, "agent");
            asm volatile("s_waitcnt vmcnt(0)" ::: "memory");
        }
    }
    __syncthreads();
}
struct Frame {
    LAS unsigned char* lds;
    volatile LAS unsigned* MISC;
    gu32* ctl;
    int tid, lane, wave;
    int vcu, G;
    const float *x, *gains, *rel_bias, *w_att_in, *w_att_out, *w_hg_in, *lb_logits, *hg_gain, *w_hg_out, *w_ff_in, *w_ff_out;
    float* out;
    unsigned char* ws;
};
__device__ __forceinline__ float wave_sum(float v) {
#pragma unroll
    for (int o = 1; o < 64; o <<= 1) v += __shfl_xor(v, o);
    return v;
}
__device__ __forceinline__ void p0_transpose_item(const float* W, int K, int N, bf16* WT, int mode, LAS float* scr, int item, int lane) {
    const int nblk = N / 32, kb = item / nblk, nb = item % nblk, k0 = 64 * kb, n0 = 32 * nb;
    int r0 = n0;
    if (mode == 1) { const int c = (n0 < DFF) ? n0 : n0 - DFF; r0 = 256 * (c >> 7) + (c & 127) + ((n0 < DFF) ? 0 : 128); }
#pragma unroll
    for (int i = 0; i < 32; ++i) { const int kk = 2 * i + (lane >> 5); scr[kk * 33 + (lane & 31)] = MK_LD_W(W + (size_t)(k0 + kk) * N + n0 + (lane & 31)); }
    LDS_WAIT(); asm volatile("" ::: "memory");
    const int c = lane & 7;
#pragma unroll
    for (int j = 0; j < 4; ++j) { const int n = (lane >> 3) + 8 * j; const LAS float* s = scr + (8 * c) * 33 + n;
        v4u o; o.x = pk2(s[0 * 33], s[1 * 33]); o.y = pk2(s[2 * 33], s[3 * 33]); o.z = pk2(s[4 * 33], s[5 * 33]); o.w = pk2(s[6 * 33], s[7 * 33]);
        int row = r0 + n;
        if (mode == 2) { const int col = n0 + n, s = col >> 12, cc = col & 4095, c64 = cc & 63; row = 256 * (cc >> 6) + 128 * (s >> 1) + 32 * (c64 >> 4) + 8 * ((c64 >> 2) & 3) + 4 * (s & 1) + (c64 & 3); }
        *(GAS v4u*)(WT + (size_t)row * K + k0 + 8 * c) = o; }
    LDS_WAIT(); asm volatile("" ::: "memory");
}
__device__ __forceinline__ int t5_bucket(int dist) {
    if (dist < 16) return dist;
    int large = 16 + (int)(log((double)dist / 16.0) / log(128.0) * 16.0);
    return large < 31 ? large : 31;
}
template <bool HAS_Y, int XNM, bool HIB = false, bool HOB = false>
__device__ __forceinline__ void norm_rows(Frame& F, const void* hin, const bf16* y, void* hout, bf16* xn, const float* ga, const float* gb, float* sa = nullptr) {
    const int gw = F.vcu * NWAVES + F.wave, NGW = F.G * NWAVES;
    for (int m = gw; m < M; m += NGW) {
        f32x4 h[16];
        if (HIB) { const GAS v2u* hr = (const GAS v2u*)((const bf16*)hin + (size_t)m * DM) + F.lane;
#pragma unroll
            for (int j = 0; j < 16; ++j) { const v2u hw = hr[64 * j]; h[j] = (f32x4){bflo(hw.x), bfhi(hw.x), bflo(hw.y), bfhi(hw.y)}; }
        } else { const GAS f32x4* hr = (const GAS f32x4*)((const float*)hin + (size_t)m * DM) + F.lane;
#pragma unroll
            for (int j = 0; j < 16; ++j) h[j] = hr[64 * j]; }
        if (HAS_Y) {
            const GAS v2u* yr = (const GAS v2u*)(y + (size_t)m * DM) + F.lane;
            f32x4 yv[16]; float ss = 0.f;
#pragma unroll
            for (int j = 0; j < 16; ++j) { const v2u yw = yr[64 * j]; yv[j] = (f32x4){bflo(yw.x), bfhi(yw.x), bflo(yw.y), bfhi(yw.y)}; ss += (yv[j].x * yv[j].x + yv[j].y * yv[j].y) + (yv[j].z * yv[j].z + yv[j].w * yv[j].w); }
            const float rstd = 1.f / sqrtf(wave_sum(ss) * (1.f / DM) + RMS_EPS);
            GAS f32x4* ho = (GAS f32x4*)((float*)hout + (size_t)m * DM) + F.lane; GAS v2u* hob = (GAS v2u*)((bf16*)hout + (size_t)m * DM) + F.lane;
#pragma unroll
            for (int j = 0; j < 16; ++j) { const f32x4 g = ((const GAS f32x4*)ga)[64 * j + F.lane]; h[j] = h[j] + yv[j] * rstd * g;
                if (HOB) { const v2u hw = (v2u){cvtpk(h[j].x, h[j].y), cvtpk(h[j].z, h[j].w)}; hob[64 * j] = hw; h[j] = (f32x4){bflo(hw.x), bfhi(hw.x), bflo(hw.y), bfhi(hw.y)}; }
                else ho[64 * j] = h[j]; }
        }
        if (XNM != 0) {
            float s2 = 0.f;
#pragma unroll
            for (int j = 0; j < 16; ++j) s2 += (h[j].x * h[j].x + h[j].y * h[j].y) + (h[j].z * h[j].z + h[j].w * h[j].w);
            const float r2 = 1.f / sqrtf(wave_sum(s2) * (1.f / DM) + RMS_EPS);
            if (XNM == 1) {
                GAS v2u* o8 = (GAS v2u*)(xn + (size_t)m * DM) + F.lane;
#pragma unroll
                for (int j = 0; j < 16; ++j) { const f32x4 g = ((const GAS f32x4*)gb)[64 * j + F.lane]; const f32x4 v = h[j] * r2 * g;
                    v2u w; w.x = pk2(v.x, v.y); w.y = pk2(v.z, v.w); o8[64 * j] = w; }
            } else {
                float am = 0.f;
#pragma unroll
                for (int j = 0; j < 16; ++j) { const f32x4 g = ((const GAS f32x4*)gb)[64 * j + F.lane]; h[j] = h[j] * r2 * g;
                    am = fmaxf(fmaxf(am, fmaxf(fabsf(h[j].x), fabsf(h[j].y))), fmaxf(fabsf(h[j].z), fabsf(h[j].w))); }
#pragma unroll
                for (int o = 1; o < 64; o <<= 1) am = fmaxf(am, __shfl_xor(am, o));
                am = fmaxf(am, 1e-20f);
                const float qs = 127.f / am;
                GAS unsigned char* o1 = (GAS unsigned char*)xn; GAS unsigned* o4 = (GAS unsigned*)(o1 + (size_t)m * DM) + F.lane;
#pragma unroll
                for (int j = 0; j < 16; ++j) { const int q0 = (int)rintf(h[j].x * qs), q1 = (int)rintf(h[j].y * qs), q2 = (int)rintf(h[j].z * qs), q3 = (int)rintf(h[j].w * qs);
                    const unsigned qw = (unsigned)(q0 & 255) | ((unsigned)(q1 & 255) << 8) | ((unsigned)(q2 & 255) << 16) | ((unsigned)q3 << 24);
                    if (XNM == 3) *(GAS unsigned*)(o1 + pg8::tm_chunk_off(m, 256 * j + 4 * F.lane, DM / 128, false)) = qw; else o4[64 * j] = qw; }
                if (F.lane == 0) sa[m] = am * (1.f / 127.f);
            }
        }
    }
}
template <bool TMW> __device__ __forceinline__ void p0_quant_rows(Frame& F, const bf16* WT, unsigned char* W8, float* sw, int rows) {
    const int gw = F.vcu * NWAVES + F.wave, NGW = F.G * NWAVES;
    for (int r = gw; r < rows; r += NGW) {
        const GAS v4u* src = (const GAS v4u*)(WT + (size_t)r * DM) + F.lane;
        v4u c[8]; float am = 0.f;
#pragma unroll
        for (int i = 0; i < 8; ++i) { c[i] = src[64 * i];
#pragma unroll
            for (int j = 0; j < 4; ++j) am = fmaxf(am, fmaxf(fabsf(bflo(c[i][j])), fabsf(bfhi(c[i][j])))); }
#pragma unroll
        for (int o = 1; o < 64; o <<= 1) am = fmaxf(am, __shfl_xor(am, o));
        am = fmaxf(am, 1e-30f);
        const float qs = 127.f / am;
        GAS v2u* dst = (GAS v2u*)(W8 + (size_t)r * DM) + F.lane;
#pragma unroll
        for (int i = 0; i < 8; ++i) { unsigned w[2];
#pragma unroll
            for (int hf = 0; hf < 2; ++hf) { const int q0 = (int)rintf(bflo(c[i][2 * hf]) * qs), q1 = (int)rintf(bfhi(c[i][2 * hf]) * qs), q2 = (int)rintf(bflo(c[i][2 * hf + 1]) * qs), q3 = (int)rintf(bfhi(c[i][2 * hf + 1]) * qs);
                w[hf] = (unsigned)(q0 & 255) | ((unsigned)(q1 & 255) << 8) | ((unsigned)(q2 & 255) << 16) | ((unsigned)q3 << 24); }
            if (TMW) *(GAS v2u*)(W8 + pg8::tm_chunk_off(r, 8 * (F.lane + 64 * i), DM / 128, true)) = (v2u){w[0], w[1]}; else dst[64 * i] = (v2u){w[0], w[1]}; }
        if (F.lane == 0) sw[r] = am * (1.f / 127.f);
    }
}
#define DPP_QUAD(x, ctrl) __builtin_bit_cast(float, __builtin_amdgcn_update_dpp(0, __builtin_bit_cast(int, (x)), (ctrl), 0xf, 0xf, true))
__device__ __forceinline__ void fwht8(float (&x)[8]) {
#pragma unroll
    for (int s = 1; s < 8; s <<= 1)
#pragma unroll
        for (int i = 0; i < 8; ++i) if (!(i & s)) { const float a = x[i], b = x[i + s]; x[i] = a + b; x[i + s] = a - b; }
}
__device__ __forceinline__ void fwht32_quad(float (&x)[8], int lane) {
    fwht8(x);
    const float s1 = (lane & 1) ? -1.f : 1.f, s2 = (lane & 2) ? -1.f : 1.f;
#pragma unroll
    for (int i = 0; i < 8; ++i) { const float p = DPP_QUAD(x[i], 0xB1); x[i] = p + s1 * x[i]; }
#pragma unroll
    for (int i = 0; i < 8; ++i) { const float p = DPP_QUAD(x[i], 0x4E); x[i] = (p + s2 * x[i]) * 0.17677669529663687f; }
}
template <int KL> __device__ __forceinline__ void p0_quant_wout(Frame& F, const bf16* WT, unsigned char* W8, float* sw) {
    const int gw = F.vcu * NWAVES + F.wave, NGW = F.G * NWAVES;
    constexpr int NCH = KL / 8, NI = (NCH + 63) / 64;
    for (int r = gw; r < DM; r += NGW) {
        const GAS v4u* src = (const GAS v4u*)(WT + (size_t)r * KL);
        v4u c[NI]; float am = 0.f;
#pragma unroll
        for (int i = 0; i < NI; ++i) { const int ch = F.lane + 64 * i; c[i] = (ch < NCH) ? src[ch] : (v4u){0u, 0u, 0u, 0u}; }
#pragma unroll
        for (int i = 0; i < NI; ++i) { float x[8];
#pragma unroll
            for (int j = 0; j < 4; ++j) { x[2 * j] = bflo(c[i][j]); x[2 * j + 1] = bfhi(c[i][j]); }
#if MK_FFO_ROT
            fwht32_quad(x, F.lane);
#endif
#pragma unroll
            for (int j = 0; j < 4; ++j) { c[i][j] = cvtpk(x[2 * j], x[2 * j + 1]); am = fmaxf(am, fmaxf(fabsf(bflo(c[i][j])), fabsf(bfhi(c[i][j])))); } }
#pragma unroll
        for (int o = 1; o < 64; o <<= 1) am = fmaxf(am, __shfl_xor(am, o));
        am = fmaxf(am, 1e-30f);
        const float qs = 127.f / am;
#pragma unroll
        for (int i = 0; i < NI; ++i) { const int ch = F.lane + 64 * i; unsigned w[2];
#pragma unroll
            for (int hf = 0; hf < 2; ++hf) { const int q0 = (int)rintf(bflo(c[i][2 * hf]) * qs), q1 = (int)rintf(bfhi(c[i][2 * hf]) * qs), q2 = (int)rintf(bflo(c[i][2 * hf + 1]) * qs), q3 = (int)rintf(bfhi(c[i][2 * hf + 1]) * qs);
                w[hf] = (unsigned)(q0 & 255) | ((unsigned)(q1 & 255) << 8) | ((unsigned)(q2 & 255) << 16) | ((unsigned)q3 << 24); }
            if (ch < NCH) *(GAS v2u*)(W8 + (size_t)r * KL + 8 * ch) = (v2u){w[0], w[1]}; }
        if (F.lane == 0) sw[r] = am * (1.f / 127.f);
    }
}
__device__ __forceinline__ void act_quant_rows(Frame& F, const bf16* ACTp, unsigned char* A8, const unsigned* rmax, float* sa2) {
    const int gw = F.vcu * NWAVES + F.wave, NGW = F.G * NWAVES;
    constexpr int NCH = DFF / 8, NI = (NCH + 63) / 64;
    for (int m = gw; m < M; m += NGW) {
        const float am = fmaxf(__builtin_bit_cast(float, rmax[m]), 1e-30f), qs = 127.f / am;
        const GAS v4u* src = (const GAS v4u*)(ACTp + (size_t)m * DFF);
#pragma unroll 11
        for (int i = 0; i < NI; ++i) { const int ch = F.lane + 64 * i; if (ch < NCH) { const v4u c = src[ch]; unsigned w[2];
#pragma unroll
            for (int hf = 0; hf < 2; ++hf) { const int q0 = (int)rintf(bflo(c[2 * hf]) * qs), q1 = (int)rintf(bfhi(c[2 * hf]) * qs), q2 = (int)rintf(bflo(c[2 * hf + 1]) * qs), q3 = (int)rintf(bfhi(c[2 * hf + 1]) * qs);
                w[hf] = (unsigned)(q0 & 255) | ((unsigned)(q1 & 255) << 8) | ((unsigned)(q2 & 255) << 16) | ((unsigned)q3 << 24); }
            *(GAS v2u*)(A8 + (size_t)m * DFF + 8 * ch) = (v2u){w[0], w[1]}; } }
        if (F.lane == 0) sa2[m] = am * (1.f / 127.f);
    }
}
constexpr int ST_PITCH = 8200, ST_K = 4096, ST_CM_OFF = RING_OFF + 16 * ST_PITCH;
__device__ __forceinline__ void strip_rot4(float (&v)[32]) {
#pragma unroll
    for (int g = 0; g < 4; ++g)
#pragma unroll
        for (int st = 1; st < 8; st <<= 1)
#pragma unroll
            for (int a = 0; a < 8; ++a) if (!(a & st)) { const float x = v[8 * g + a], y = v[8 * g + a + st]; v[8 * g + a] = x + y; v[8 * g + a + st] = x - y; }
#pragma unroll
    for (int g = 0; g < 4; ++g) {
        asm volatile("v_nop\n\tv_nop\n\tv_permlane16_swap_b32 %0, %1\n\tv_permlane16_swap_b32 %2, %3\n\tv_permlane16_swap_b32 %4, %5\n\tv_permlane16_swap_b32 %6, %7\n\ts_nop 1"
                     : "+v"(v[8 * g + 0]), "+v"(v[8 * g + 1]), "+v"(v[8 * g + 2]), "+v"(v[8 * g + 3]), "+v"(v[8 * g + 4]), "+v"(v[8 * g + 5]), "+v"(v[8 * g + 6]), "+v"(v[8 * g + 7]));
#pragma unroll
        for (int a = 0; a < 8; a += 2) { const float x = v[8 * g + a], y = v[8 * g + a + 1]; v[8 * g + a] = x + y; v[8 * g + a + 1] = x - y; }
        asm volatile("v_nop\n\tv_nop\n\tv_permlane32_swap_b32 %0, %2\n\tv_permlane32_swap_b32 %1, %3\n\tv_permlane32_swap_b32 %4, %6\n\tv_permlane32_swap_b32 %5, %7\n\ts_nop 1"
                     : "+v"(v[8 * g + 0]), "+v"(v[8 * g + 1]), "+v"(v[8 * g + 2]), "+v"(v[8 * g + 3]), "+v"(v[8 * g + 4]), "+v"(v[8 * g + 5]), "+v"(v[8 * g + 6]), "+v"(v[8 * g + 7]));
#pragma unroll
        for (int a = 0; a < 8; ++a) if (!(a & 2)) { const float x = v[8 * g + a], y = v[8 * g + a + 2]; v[8 * g + a] = x + y; v[8 * g + a + 2] = x - y; }
    }
}
__device__ __forceinline__ unsigned q8bits(float x, float qs) { return __builtin_bit_cast(unsigned, fmaf(x, qs, 12582912.f)) & 255u; }
constexpr size_t WS_FOMAX = WS_CTL + 256 * 1024, WS_FOCNT = WS_FOMAX + 32 * 1024;
__device__ __forceinline__ void strip_desc(const Frame& F, int s, const float*& p, int& N, int& kind, int& l, int& c0, int& b0, int& nb, int& cgl) {
    constexpr int S_FO = 3 * (DM / 16), S_FI = 2 * DFF / 16, S_HI = NHG / 16;
    int r = s; b0 = 0; nb = 32; cgl = 0;
    if (r < 2 * S_FO) { cgl = r / 3; const int part = r - 3 * cgl; l = cgl / (DM / 16); kind = 0; N = DM; p = F.w_ff_out + (size_t)l * DFF * DM; c0 = 16 * (cgl - l * (DM / 16));
        b0 = 29 * part; nb = (part == 2) ? 28 : 29; return; } r -= 2 * S_FO;
    if (r < 2 * S_FI) { l = r / S_FI; r -= l * S_FI; kind = 1; N = 2 * DFF; p = F.w_ff_in + (size_t)l * DM * 2 * DFF; c0 = 16 * r; return; } r -= 2 * S_FI;
    if (r < S_HI) { l = 0; kind = 2; N = NHG; p = F.w_hg_in; c0 = 16 * r; return; } r -= S_HI;
    l = 0; kind = 3; N = DM; p = F.w_hg_out; c0 = 16 * r;
}
template <int KL, int N, bool ROT, bool TMW, int MODE, bool SYNC3, bool PERMK>
__device__ __forceinline__ void p0_strip(Frame& F, float (&v)[32], const float* src, const float* nsrc, int nN, int c0, int b0, int nb, int cgl, unsigned char* W8, float* sw, int par) {
    LAS unsigned char* st = F.lds + RING_OFF;
    LAS float* cm = (LAS float*)(F.lds + ST_CM_OFF) + par * 128;
    const int n = F.lane & 15, kq = F.lane >> 4;
    float mx = 0.f;
#pragma unroll 1
    for (int blk = b0 + F.wave; blk < b0 + nb; blk += NWAVES) {
        float x[32];
#pragma unroll
        for (int i = 0; i < 32; ++i) x[i] = v[i];
        const bool last = blk + NWAVES >= b0 + nb;
        const float* q = last ? nsrc : src + (size_t)(128 * (blk + NWAVES)) * N;
        const size_t step = (size_t)4 * (last ? nN : N);
#pragma unroll
        for (int i = 0; i < 32; ++i) v[i] = MK_LD_W(q + i * step);
        if (ROT) strip_rot4(x);
        LAS unsigned short* d = (LAS unsigned short*)(st + n * ST_PITCH + 256 * (blk - b0)) + (!ROT ? kq : PERMK ? 4 * (kq >> 1) + 8 * (kq & 1) : 4 * kq);
#pragma unroll
        for (int i = 0; i < 32; i += 2) { const unsigned w = cvtpk(x[i], x[i + 1]); mx = fmaxf(mx, fmaxf(fabsf(x[i]), fabsf(x[i + 1])));
            const int r3 = (i >> 1) & 1, r4 = (i >> 2) & 1;
            if (ROT) *(LAS unsigned*)(d + 32 * (i >> 3) + (PERMK ? 2 * r4 + 16 * r3 : 2 * r3 + 16 * r4)) = w;
            else { d[4 * i] = (unsigned short)w; d[4 * i + 4] = (unsigned short)(w >> 16); } }
    }
    mx = fmaxf(mx, __shfl_xor(mx, 16)); mx = fmaxf(mx, __shfl_xor(mx, 32));
    if (F.lane < 16) cm[F.wave * 16 + n] = mx;
    __syncthreads();
    float am = 1e-30f;
#pragma unroll
    for (int w = 0; w < NWAVES; ++w) am = fmaxf(am, cm[w * 16 + n]);
    am = bflo(cvtpk(am, am));
    if (SYNC3) {
        unsigned* gmax = (unsigned*)(F.ws + WS_FOMAX) + cgl * 16; unsigned* cnt = (unsigned*)(F.ws + WS_FOCNT) + cgl;
        if (F.tid < 16) am = fmaxf(am, __builtin_bit_cast(float, __hip_atomic_fetch_max(gmax + n, __builtin_bit_cast(unsigned, am), __ATOMIC_RELAXED, __HIP_MEMORY_SCOPE_AGENT)));
        if (F.wave == 0) { asm volatile("s_waitcnt vmcnt(0)" ::: "memory");
            if (F.tid == 0) { (void)xb_add(cnt, 1u); unsigned sp = 0; while (xb_ld(cnt) < 3u && ++sp < (1u << 22)) __builtin_amdgcn_s_sleep(1); } }
        __syncthreads();
        am = fmaxf(am, __builtin_bit_cast(float, xb_ld(gmax + n)));
    }
    const float qs = 127.f / am;
    const int col = c0 + n; int R = col;
    if (MODE == 1) { const int c = (col < DFF) ? col : col - DFF; R = 256 * (c >> 7) + (c & 127) + ((col < DFF) ? 0 : 128); }
    if (MODE == 2) { const int s = col >> 12, cc = col & 4095, c64 = cc & 63; R = 256 * (cc >> 6) + 128 * (s >> 1) + 32 * (c64 >> 4) + 8 * ((c64 >> 2) & 3) + 4 * (s & 1) + (c64 & 3); }
#pragma unroll 2
    for (int t = 0; t < 8; ++t) {
        const int c = 4 * (F.wave + NWAVES * t) + kq;
        if (c < 8 * nb) {
            const LAS v2u* s2 = (const LAS v2u*)(st + n * ST_PITCH + 32 * c);
            unsigned w[4];
#pragma unroll
            for (int j = 0; j < 4; ++j) { const v2u u = s2[j];
                w[j] = q8bits(bflo(u.x), qs) | (q8bits(bfhi(u.x), qs) << 8) | (q8bits(bflo(u.y), qs) << 16) | (q8bits(bfhi(u.y), qs) << 24); }
            const int kb = 128 * b0 + 16 * c;
            if (TMW) *(GAS v4u*)(W8 + pg8::tm_chunk_off(R, kb, KL / 128, true)) = (v4u){w[0], w[1], w[2], w[3]};
            else *(GAS v4u*)(W8 + (size_t)R * KL + kb) = (v4u){w[0], w[1], w[2], w[3]};
        }
    }
    if (F.tid < 16 && b0 == 0) sw[R] = am * (ROT ? 0.17677669529663687f / 127.f : 1.f / 127.f);
    __syncthreads();
}
#ifndef MK_P0_DEFER
#define MK_P0_DEFER 0
#endif
constexpr int SX_FO = 3 * (DM / 16), SX_FI = 2 * DFF / 16, SX_HI = NHG / 16, SX_HO = DM / 16, SX_ALL = 2 * SX_FO + 2 * SX_FI + SX_HI + SX_HO;
constexpr int DEF_FI = MK_P0_DEFER ? 640 : 0, DEF_FO = MK_P0_DEFER ? 213 : 0;
static_assert(DEF_FI <= SX_FI && 3 * DEF_FO <= SX_FO, "deferred strip counts");
__device__ __forceinline__ int strip_full_index(int lst, int j) {
    if (lst == 1) return 2 * SX_FO + SX_FI + j;
    if (lst == 2) return SX_FO + j;
    if (j < SX_FO) return j;
    j -= SX_FO; if (j < SX_FO - 3 * DEF_FO) return SX_FO + 3 * DEF_FO + j;
    j -= SX_FO - 3 * DEF_FO; if (j < SX_FI) return 2 * SX_FO + j;
    j -= SX_FI; if (j < SX_FI - DEF_FI) return 2 * SX_FO + SX_FI + DEF_FI + j;
    j -= SX_FI - DEF_FI; return 2 * SX_FO + 2 * SX_FI + j;
}
template <int LST> __device__ __forceinline__ void run_strips(Frame& F, int j0, int jstep) {
    constexpr int CNT = LST == 0 ? SX_ALL - 3 * DEF_FO - DEF_FI : LST == 1 ? DEF_FI : 3 * DEF_FO;
    const int n = F.lane & 15, kq = F.lane >> 4;
    int j = j0, par = 0;
    if (j < 0 || j >= CNT) return;
    const float* p; int N, kind, l, c0, b0, nb, cgl;
    strip_desc(F, strip_full_index(LST, j), p, N, kind, l, c0, b0, nb, cgl);
    const float* src = p + (size_t)kq * N + c0 + n;
    float v[32];
    { const float* q = src + (size_t)(128 * (b0 + F.wave)) * N; const size_t step = (size_t)4 * N;
#pragma unroll
      for (int i = 0; i < 32; ++i) v[i] = MK_LD_W(q + i * step); }
#pragma unroll 1
    while (j < CNT) {
        const int jn = j + jstep;
        const float* pn; int Nn, kindn, ln, c0n, b0n, nbn, cgln;
        strip_desc(F, strip_full_index(LST, jn < CNT ? jn : j), pn, Nn, kindn, ln, c0n, b0n, nbn, cgln);
        const float* srcn = pn + (size_t)kq * Nn + c0n + n;
        const float* nsrc = srcn + (size_t)(128 * (b0n + F.wave)) * Nn;
        if (LST != 1 && kind == 0) p0_strip<DFF, DM, true, false, 0, true, true>(F, v, src, nsrc, Nn, c0, b0, nb, cgl, F.ws + WS_W8O + l * W8O_STRIDE, (float*)(F.ws + WS_SWO) + l * DM, par);
        else if (LST != 2 && kind == 1) p0_strip<DM, 2 * DFF, false, TM_FFI, 1, false, false>(F, v, src, nsrc, Nn, c0, 0, 32, 0, F.ws + WS_W8 + l * W8_STRIDE, (float*)(F.ws + WS_SW) + l * 2 * DFF, par);
        else if (LST == 0 && kind == 2) p0_strip<DM, NHG, false, false, 2, false, false>(F, v, src, nsrc, Nn, c0, 0, 32, 0, F.ws + WS_W8H, (float*)(F.ws + WS_SWH), par);
        else if (LST == 0) p0_strip<DM, DM, true, false, 0, false, false>(F, v, src, nsrc, Nn, c0, 0, 32, 0, F.ws + WS_W8G, (float*)(F.ws + WS_SWG), par);
        j = jn; src = srcn; kind = kindn; l = ln; c0 = c0n; b0 = b0n; nb = nbn; cgl = cgln; par ^= 1;
    }
    asm volatile("s_waitcnt vmcnt(0)" ::: "memory");
    __syncthreads();
}
template <int LST> __device__ __forceinline__ void run_deferred_strips(Frame& F, int units) {
    if ((LST == 1 ? DEF_FI : 3 * DEF_FO) == 0) return;
    const int rem = units % F.G, bx = (int)blockIdx.x;
    asm volatile("s_waitcnt vmcnt(0)" ::: "memory"); __syncthreads();
    run_strips<LST>(F, rem == 0 ? bx : bx - rem, rem == 0 ? F.G : F.G - rem);
}
__device__ __forceinline__ void p0_prologue(Frame& F) {
    LAS float* scr = (LAS float*)(F.lds + RING_OFF + F.wave * 16384);
    const int gw = F.vcu * NWAVES + F.wave, NGW = F.G * NWAVES;
    constexpr int I0 = (DM / 64) * (NQKV / 32), I1 = (DATT / 64) * (DM / 32), I2 = (DM / 64) * (NHG / 32), I3 = (DM / 64) * (DM / 32), I4 = (DM / 64) * (2 * DFF / 32), I6 = (DFF / 64) * (DM / 32);
    constexpr int NITEMS = P0_STRIP ? I0 + I1 : I0 + I1 + I2 + I3 + 2 * I4 + 2 * I6;
    if (P0_STRIP) run_strips<0>(F, F.vcu, F.G);
    for (int it = gw; it < NITEMS; it += NGW) {
        int r = it;
        if (r < I0) { p0_transpose_item(F.w_att_in, DM, NQKV, (bf16*)(F.ws + WS_WATTI), 0, scr, r, F.lane); continue; } r -= I0;
        if (r < I1) { p0_transpose_item(F.w_att_out, DATT, DM, (bf16*)(F.ws + WS_WATTO), 0, scr, r, F.lane); continue; } r -= I1;
        if (r < I2) { p0_transpose_item(F.w_hg_in, DM, NHG, (bf16*)(F.ws + WS_WHGI), HG_FUSE ? 2 : 0, scr, r, F.lane); continue; } r -= I2;
        if (r < I3) { p0_transpose_item(F.w_hg_out, DM, DM, (bf16*)(F.ws + WS_WHGO), 0, scr, r, F.lane); continue; } r -= I3;
        if (r < 2 * I4) { const int l = r / I4; p0_transpose_item(F.w_ff_in + (size_t)l * DM * 2 * DFF, DM, 2 * DFF, (bf16*)(F.ws + WS_WFFI + l * WFFI_STRIDE), 1, scr, r - l * I4, F.lane); continue; } r -= 2 * I4;
        { const int l = r / I6; p0_transpose_item(F.w_ff_out + (size_t)l * DFF * DM, DFF, DM, (bf16*)(F.ws + WS_WFFO + l * WFFO_STRIDE), 0, scr, r - l * I6, F.lane); }
    }
    float* BT = (float*)(F.ws + WS_TAB); float* LB = (float*)(F.ws + WS_TAB + 65536);
    const int gt = blockIdx.x * (NWAVES * 64) + F.tid, NT = F.G * NWAVES * 64;
    for (int idx = gt; idx < 3 * 16 * 129; idx += NT) { const int g = idx / (16 * 129), rem = idx - g * 16 * 129, h = rem / 129, j = rem - h * 129;
        BT[idx] = F.rel_bias[t5_bucket(j << (2 * g)) * 48 + g * 16 + h]; }
    for (int c = gt; c < DM; c += NT) { const float l0 = F.lb_logits[c], l1 = F.lb_logits[DM + c]; LB[c] = 1.f / (1.f + expf(l0 - l1)); }
    norm_rows<false, ATT_I8 ? 2 : 1>(F, F.x, nullptr, nullptr, (bf16*)(F.ws + WS_XN), nullptr, F.gains, (float*)(F.ws + WS_SA));
}
__device__ __forceinline__ void attn_naive(Frame& F) {
    const int gw = F.vcu * NWAVES + F.wave, NGW = F.G * NWAVES;
    const bf16* QKV = (const bf16*)(F.ws + WS_QKV); bf16* MRG = (bf16*)(F.ws + WS_MRG); const float* BT = (const float*)(F.ws + WS_TAB);
    for (int item = gw; item < M * 16; item += NGW) {
        const int m = item >> 4, h = item & 15, t = m & (SEQ - 1);
        float mx = -1e30f, l = 0.f, a0 = 0.f, a1 = 0.f;
#pragma unroll 1
        for (int g = 0; g < 3; ++g) {
            const int sh = 2 * g;
            const unsigned qw = *(const GAS unsigned*)(QKV + (size_t)m * NQKV + g * 6144 + h * 128 + 2 * F.lane);
            const float q0 = bflo(qw) * QSCALE, q1 = bfhi(qw) * QSCALE;
            const int jmax = (t >> sh) < 128 ? (t >> sh) : 128;
            const float* bt = BT + (g * 16 + h) * 129;
#pragma unroll 1
            for (int j0 = 0; j0 <= jmax; j0 += 8) {
                unsigned kw[8], vw[8]; float bs[8];
#pragma unroll
                for (int u = 0; u < 8; ++u) { const int jj = (j0 + u) <= jmax ? (j0 + u) : jmax; const bf16* rp = QKV + (size_t)(m - (jj << sh)) * NQKV + g * 6144 + h * 128 + 2 * F.lane;
                    kw[u] = *(const GAS unsigned*)(rp + 2048); vw[u] = *(const GAS unsigned*)(rp + 4096); bs[u] = bt[jj]; }
                float s[8]; float cm = -INFINITY;
#pragma unroll
                for (int u = 0; u < 8; ++u) { s[u] = wave_sum(q0 * bflo(kw[u]) + q1 * bfhi(kw[u])) + bs[u]; if (j0 + u > jmax) s[u] = -INFINITY; cm = fmaxf(cm, s[u]); }
                const float mn = fmaxf(mx, cm), sc = __expf(mx - mn); l *= sc; a0 *= sc; a1 *= sc; mx = mn;
#pragma unroll
                for (int u = 0; u < 8; ++u) { const float p = __expf(s[u] - mn); l += p; a0 += p * bflo(vw[u]); a1 += p * bfhi(vw[u]); }
            }
        }
        const float inv = 1.f / l;
        *(GAS unsigned*)(MRG + (size_t)m * DATT + h * 128 + 2 * F.lane) = pk2(a0 * inv, a1 * inv);
    }
}
__device__ __forceinline__ void hgrn_naive(Frame& F) {
    if (blockIdx.x >= 64) return;
    const int b = blockIdx.x >> 5, h = blockIdx.x & 31;
    const bf16* HP = (const bf16*)(F.ws + WS_QKV); float* ORAW = (float*)(F.ws + WS_ACT); const float* LB = (const float*)(F.ws + WS_TAB + 65536);
    LAS f32x4* PRM = (LAS f32x4*)(F.lds);
    LAS float* VV = (LAS float*)(F.lds + 32768);
    LAS float* OP = (LAS float*)(F.lds + 32768 + 8192);
    const int e = F.tid & 127, qd = F.tid >> 7, ps = F.tid >> 6, pl = F.tid & 63;
    const float lb0 = LB[h * 128 + 2 * pl], lb1 = LB[h * 128 + 2 * pl + 1];
    float S[32];
#pragma unroll
    for (int d = 0; d < 32; ++d) S[d] = 0.f;
    unsigned qw, fw, iw;
#define HG_LOAD(n) do { const bf16* bp = HP + (size_t)(b * SEQ + (n) * 8 + ps) * NHG + h * 128 + 2 * pl; qw = *(const GAS unsigned*)bp; fw = *(const GAS unsigned*)(bp + 4096); iw = *(const GAS unsigned*)(bp + 8192); } while (0)
#define HG_WRITE(buf) do { const float f0 = bflo(fw), f1 = bfhi(fw), r0 = bflo(qw), r1 = bfhi(qw); \
        const float g0 = lb0 + (1.f - lb0) / (1.f + __expf(-f0)), g1 = lb1 + (1.f - lb1) / (1.f + __expf(-f1)); \
        const int o = ((buf) * 8 + ps) * 128 + 2 * pl; \
        PRM[o] = (f32x4){g0, 1.f - g0, r0 / (1.f + __expf(-r0)) * QSCALE, 0.f}; PRM[o + 1] = (f32x4){g1, 1.f - g1, r1 / (1.f + __expf(-r1)) * QSCALE, 0.f}; \
        VV[o] = bflo(iw); VV[o + 1] = bfhi(iw); } while (0)
    HG_LOAD(0); HG_WRITE(0); __syncthreads();
#pragma unroll 1
    for (int n = 0; n < SEQ / 8; ++n) {
        const int buf = n & 1;
        if (n + 1 < SEQ / 8) HG_LOAD(n + 1);
#pragma unroll 1
        for (int st = 0; st < 8; ++st) {
            const float v = VV[(buf * 8 + st) * 128 + e]; float o = 0.f;
#pragma unroll
            for (int dd = 0; dd < 32; ++dd) { const f32x4 P = PRM[(buf * 8 + st) * 128 + qd * 32 + dd]; S[dd] = P.x * S[dd] + P.y * v; o += P.z * S[dd]; }
            OP[(st * 4 + qd) * 128 + e] = o;
        }
        if (n + 1 < SEQ / 8) HG_WRITE(buf ^ 1);
        __syncthreads();
#pragma unroll
        for (int r = 0; r < 2; ++r) { const int idx = F.tid + 512 * r, st = idx >> 7, ee = idx & 127;
            const float sum = (OP[(st * 4 + 0) * 128 + ee] + OP[(st * 4 + 1) * 128 + ee]) + (OP[(st * 4 + 2) * 128 + ee] + OP[(st * 4 + 3) * 128 + ee]);
            ORAW[(size_t)(b * SEQ + n * 8 + st) * DM + h * 128 + ee] = sum; }
        __syncthreads();
    }
#undef HG_LOAD
#undef HG_WRITE
}
__device__ __forceinline__ void hgrn_gate(Frame& F) {
    const int gw = F.vcu * NWAVES + F.wave, NGW = F.G * NWAVES;
    const float* ORAW = (const float*)(F.ws + WS_ACT); const bf16* HP = (const bf16*)(F.ws + WS_QKV); bf16* OG = (bf16*)(F.ws + WS_OG);
    const f32x4 gn = *(const GAS f32x4*)(F.hg_gain + 4 * (F.lane & 31));
    for (int m = gw; m < M; m += NGW) {
        const GAS f32x4* orow = (const GAS f32x4*)(ORAW + (size_t)m * DM) + F.lane;
        const GAS v2u* grow = (const GAS v2u*)(HP + (size_t)m * NHG + 3 * DM) + F.lane;
        GAS v2u* o8 = (GAS v2u*)(OG + (size_t)m * DM) + F.lane;
#pragma unroll 4
        for (int j = 0; j < 16; ++j) {
            const f32x4 o = orow[64 * j]; const v2u gw2 = grow[64 * j];
            float ss = (o.x * o.x + o.y * o.y) + (o.z * o.z + o.w * o.w);
#pragma unroll
            for (int k = 1; k < 32; k <<= 1) ss += __shfl_xor(ss, k);
            const float rstd = 1.f / sqrtf(ss * (1.f / HD) + RMS_EPS);
            const float g0 = bflo(gw2.x), g1 = bfhi(gw2.x), g2 = bflo(gw2.y), g3 = bfhi(gw2.y);
            v2u w; w.x = pk2(o.x * rstd * gn.x * (g0 / (1.f + __expf(-g0))), o.y * rstd * gn.y * (g1 / (1.f + __expf(-g1))));
            w.y = pk2(o.z * rstd * gn.z * (g2 / (1.f + __expf(-g2))), o.w * rstd * gn.w * (g3 / (1.f + __expf(-g3))));
            o8[64 * j] = w;
        }
    }
}
typedef short v4i16_t __attribute__((ext_vector_type(4)));
constexpr int AT_K = 0, AT_KP = 128 * 272, AT_V = 2 * AT_KP, AT_VP = 128 * 288, AT_BT = AT_V + 2 * AT_VP, AT_END = AT_BT + 1024;
static_assert(AT_END <= LDSCTL_OFF, "attention LDS map");
constexpr size_t WS_AO = 2334 * MiB, WS_LSE = 2526 * MiB, WS_END2 = 2529 * MiB;
__device__ __forceinline__ void attn_load_page(LAS unsigned char* L, int tid, const bf16* Kt, const bf16* Vt, int row0, int h, int slot) {
#pragma unroll
    for (int i = 0; i < 4; ++i) { const int chunk = tid + 512 * i, r = chunk >> 4, c = chunk & 15;
        const v4u kv = *(const GAS v4u*)(Kt + (size_t)(row0 + r) * 2048 + h * 128 + 8 * c); const v4u vv = *(const GAS v4u*)(Vt + (size_t)(row0 + r) * 2048 + h * 128 + 8 * c);
        *(LAS v4u*)(L + AT_K + slot * AT_KP + r * 272 + 16 * c) = kv; *(LAS v4u*)(L + AT_V + slot * AT_VP + r * 288 + 16 * c) = vv; }
}
__device__ __forceinline__ void attn_mfma(Frame& F) {
    const bf16* QKVp = (const bf16*)(F.ws + WS_QKV); bf16* AO = (bf16*)(F.ws + WS_AO); float* LSE = (float*)(F.ws + WS_LSE); const float* BT = (const float*)(F.ws + WS_TAB);
    LAS unsigned char* L = F.lds;
    const int w = F.wave, li = F.lane & 15, g4 = F.lane >> 4;
    const int per = (6144 + F.G - 1) / F.G, U0 = F.vcu * per, U1 = (U0 + per) < 6144 ? (U0 + per) : 6144;
    int prevU = -2;
    v4u pk[4], pv[4];
#define AT_DECODE(UU, gh_, qb_, g_, h_, q0_) const int gh_ = (UU) >> 7, qb_ = (UU) & 127, g_ = gh_ >> 4, h_ = gh_ & 15, q0_ = 128 * qb_
#define AT_PREFETCH(UU) do { AT_DECODE(UU, ghn, qbn, gn_, hn, q0n); (void)qbn; const bf16* Kn = QKVp + (size_t)(3 * gn_ + 1) * M * 2048; const bf16* Vn = Kn + (size_t)M * 2048; \
        _Pragma("unroll") for (int i = 0; i < 4; ++i) { const int chunk = F.tid + 512 * i, r = chunk >> 4, c = chunk & 15; \
            pk[i] = *(const GAS v4u*)(Kn + (size_t)(q0n + r) * 2048 + hn * 128 + 8 * c); pv[i] = *(const GAS v4u*)(Vn + (size_t)(q0n + r) * 2048 + hn * 128 + 8 * c); } \
        } while (0)
    if (U0 < U1) AT_PREFETCH(U0);
#pragma unroll 1
    for (int U = U0; U < U1; ++U) {
        const int gh = U >> 7, qb = U & 127, g = gh >> 4, h = gh & 15, sh = 2 * g, n = SEQ >> sh, q0 = 128 * qb, i0 = q0 & (n - 1);
        const bool first = (i0 == 0);
        const bf16* Qt = QKVp + (size_t)(3 * g) * M * 2048; const bf16* Kt = Qt + (size_t)M * 2048; const bf16* Vt = Kt + (size_t)M * 2048;
        __builtin_amdgcn_s_barrier(); asm volatile("" ::: "memory");
        if (U == U0 || qb == 0) { if (F.tid < 161) { const int rel = F.tid - 16; ((LAS float*)(L + AT_BT))[F.tid] = (rel >= 0 && rel <= 128) ? BT[gh * 129 + rel] : 0.f; } }
        if (first) { for (int i = F.tid; i < AT_VP / 16; i += NWAVES * 64) *(LAS v4u*)(L + AT_V + ((qb - 1) & 1) * AT_VP + 16 * i) = (v4u){0u, 0u, 0u, 0u}; }
        else if (prevU != U - 1) attn_load_page(L, F.tid, Kt, Vt, q0 - 128, h, (qb - 1) & 1);
#pragma unroll
        for (int i = 0; i < 4; ++i) { const int chunk = F.tid + 512 * i, r = chunk >> 4, c = chunk & 15;
            *(LAS v4u*)(L + AT_K + (qb & 1) * AT_KP + r * 272 + 16 * c) = pk[i]; *(LAS v4u*)(L + AT_V + (qb & 1) * AT_VP + r * 288 + 16 * c) = pv[i]; }
        prevU = U;
        bf16x8 qf[4];
        { const bf16* qp = Qt + (size_t)(q0 + 16 * w + li) * 2048 + h * 128 + 8 * g4;
#pragma unroll
          for (int ds = 0; ds < 4; ++ds) qf[ds] = *(const GAS bf16x8*)(qp + 32 * ds); }
        LDS_WAIT(); __builtin_amdgcn_s_barrier(); asm volatile("" ::: "memory");
        { const int Un = (U + 1 < U1) ? U + 1 : U; AT_PREFETCH(Un); }
        f32x4 sc[9];
#pragma unroll
        for (int blk = 0; blk < 9; ++blk) { const int kb = w + blk, slot = (qb - 1 + (kb >> 3)) & 1;
            const LAS unsigned char* kp = L + AT_K + slot * AT_KP + ((kb & 7) * 16 + li) * 272 + 16 * g4;
            f32x4 acc = (f32x4){0.f, 0.f, 0.f, 0.f};
#pragma unroll
            for (int ds = 0; ds < 4; ++ds) { const bf16x8 a = *(const LAS bf16x8*)(kp + 64 * ds); acc = __builtin_amdgcn_mfma_f32_16x16x32_bf16(a, qf[ds], acc, 0, 0, 0); }
            sc[blk] = acc; }
        const LAS float* bt = (const LAS float*)(L + AT_BT) + (16 + 128 + li - 4 * g4);
        const int ql = 16 * w + li, relmax = first ? (ql < 128 ? ql : 128) : 128;
        float mx = -INFINITY;
#pragma unroll
        for (int blk = 0; blk < 9; ++blk)
#pragma unroll
            for (int r = 0; r < 4; ++r) { const int rel = 128 + li - 16 * blk - 4 * g4 - r; const float bias = bt[-(16 * blk + r)];
                const float s = (rel >= 0 && rel <= relmax) ? sc[blk][r] * QSCALE + bias : -INFINITY; sc[blk][r] = s; mx = fmaxf(mx, s); }
        mx = fmaxf(mx, __shfl_xor(mx, 16)); mx = fmaxf(mx, __shfl_xor(mx, 32));
        float lsum = 0.f;
#pragma unroll
        for (int blk = 0; blk < 9; ++blk)
#pragma unroll
            for (int r = 0; r < 4; ++r) { const float p = __expf(sc[blk][r] - mx); sc[blk][r] = p; lsum += p; }
        lsum += __shfl_xor(lsum, 16); lsum += __shfl_xor(lsum, 32);
        f32x4 o[8];
#pragma unroll
        for (int db = 0; db < 8; ++db) o[db] = (f32x4){0.f, 0.f, 0.f, 0.f};
#pragma unroll
        for (int st = 0; st < 5; ++st) {
            const int ba = 2 * st, bb = (2 * st + 1) < 9 ? (2 * st + 1) : 8;
            v4u pw; pw.x = cvtpk(sc[ba][0], sc[ba][1]); pw.y = cvtpk(sc[ba][2], sc[ba][3]);
            if (2 * st + 1 < 9) { pw.z = cvtpk(sc[bb][0], sc[bb][1]); pw.w = cvtpk(sc[bb][2], sc[bb][3]); } else { pw.z = 0u; pw.w = 0u; }
            const bf16x8 pf = __builtin_bit_cast(bf16x8, pw);
            const int kba = w + ba, kbb = w + bb;
            const LAS unsigned char* va = L + AT_V + ((qb - 1 + (kba >> 3)) & 1) * AT_VP + ((kba & 7) * 16 + 4 * g4 + (li >> 2)) * 288 + 8 * (li & 3);
            const LAS unsigned char* vb = L + AT_V + ((qb - 1 + (kbb >> 3)) & 1) * AT_VP + ((kbb & 7) * 16 + 4 * g4 + (li >> 2)) * 288 + 8 * (li & 3);
#pragma unroll
            for (int db = 0; db < 8; ++db) {
                const v4i16_t lo = __builtin_amdgcn_ds_read_tr16_b64_v4i16((LAS v4i16_t*)(va + 32 * db)), hi = __builtin_amdgcn_ds_read_tr16_b64_v4i16((LAS v4i16_t*)(vb + 32 * db));
                const bf16x8 a = __builtin_shufflevector(lo, hi, 0, 1, 2, 3, 4, 5, 6, 7);
                o[db] = __builtin_amdgcn_mfma_f32_16x16x32_bf16(a, pf, o[db], 0, 0, 0); }
        }
        const float inv = 1.f / lsum;
        const size_t orow = (size_t)g * M + (size_t)(q0 + 16 * w + li);
        bf16* op = AO + orow * 2048 + h * 128 + 4 * g4;
#pragma unroll
        for (int db = 0; db < 8; ++db) *(GAS v2u*)(op + 16 * db) = (v2u){cvtpk(o[db][0] * inv, o[db][1] * inv), cvtpk(o[db][2] * inv, o[db][3] * inv)};
        if (g4 == 0) LSE[orow * 16 + h] = mx + __logf(lsum);
    }
#undef AT_PREFETCH
#undef AT_DECODE
}
__device__ __forceinline__ void attn_merge(Frame& F) {
    const int gw = F.vcu * NWAVES + F.wave, NGW = F.G * NWAVES;
    const bf16* AO = (const bf16*)(F.ws + WS_AO); const float* LSE = (const float*)(F.ws + WS_LSE); bf16* MRG = (bf16*)(F.ws + WS_MRG);
    for (int m = gw; m < M; m += NGW) {
        const int t = m & (SEQ - 1), bbase = m & ~(SEQ - 1);
        size_t rows[3];
#pragma unroll
        for (int g = 0; g < 3; ++g) { const int sh = 2 * g; rows[g] = (size_t)g * M + (size_t)(bbase + ((t & ((1 << sh) - 1)) << (13 - sh)) + (t >> sh)); }
#pragma unroll
        for (int k = 0; k < 4; ++k) {
            const int hd = (F.lane >> 4) + 4 * k, c = F.lane + 64 * k;
            const float l0 = LSE[rows[0] * 16 + hd], l1 = LSE[rows[1] * 16 + hd], l2 = LSE[rows[2] * 16 + hd];
            const float mx = fmaxf(l0, fmaxf(l1, l2)); float w0 = __expf(l0 - mx), w1 = __expf(l1 - mx), w2 = __expf(l2 - mx); const float inv = 1.f / (w0 + w1 + w2); w0 *= inv; w1 *= inv; w2 *= inv;
            const v4u a = *(const GAS v4u*)(AO + rows[0] * 2048 + 8 * c), b = *(const GAS v4u*)(AO + rows[1] * 2048 + 8 * c), d = *(const GAS v4u*)(AO + rows[2] * 2048 + 8 * c);
            v4u o;
#pragma unroll
            for (int j = 0; j < 4; ++j) o[j] = cvtpk(w0 * bflo(a[j]) + w1 * bflo(b[j]) + w2 * bflo(d[j]), w0 * bfhi(a[j]) + w1 * bfhi(b[j]) + w2 * bfhi(d[j]));
            *(GAS v4u*)(MRG + (size_t)m * DATT + 8 * c) = o;
        }
    }
}
typedef float f32x16 __attribute__((ext_vector_type(16)));
typedef short s16x4 __attribute__((ext_vector_type(4)));
constexpr int HG_QR = 0, HG_QD = 17408, HG_KR = 34816, HG_KRT = 52224, HG_VT = 70656, HG_ST0 = 75264, HG_ST1 = 83968, HG_SEG = 92672, HG_EL = 96768, HG_DEC = 97280, HG_END = 97792;
static_assert(HG_END <= RING_BYTES, "hgrn LDS map");
__device__ __forceinline__ void hgrn_mfma(Frame& F) {
    const bf16* HP = (const bf16*)(F.ws + WS_QKV); float* ORAW = (float*)(F.ws + WS_ACT); const float* LB = (const float*)(F.ws + WS_TAB + 65536);
    LAS unsigned char* L = F.lds;
    const int w = F.wave, cp = F.lane, l31 = F.lane & 31, hh = F.lane >> 5;
#pragma unroll 1
    for (int u = blockIdx.x; u < 256; u += F.G) {
        const int bh = u >> 2, e0 = (u & 3) * 32, b = bh >> 5, h = bh & 31;
        const float lb0 = LB[h * 128 + 2 * cp], lb1 = LB[h * 128 + 2 * cp + 1];
        const size_t rowbase = (size_t)b * SEQ;
        unsigned qraw[8], fraw[8], vraw[2];
#define HGM_LOAD(c) do { \
            _Pragma("unroll") for (int i = 0; i < 8; ++i) { const bf16* bp = HP + (rowbase + 64 * (c) + 8 * w + i) * NHG + h * 128 + 2 * cp; qraw[i] = *(const GAS unsigned*)bp; fraw[i] = *(const GAS unsigned*)(bp + 4096); } \
            _Pragma("unroll") for (int k = 0; k < 2; ++k) { const int vrow = (F.tid >> 4) + 32 * k; vraw[k] = *(const GAS unsigned*)(HP + (rowbase + 64 * (c) + vrow) * NHG + 8192 + h * 128 + e0 + 2 * (F.tid & 15)); } } while (0)
        f32x16 S;
#pragma unroll
        for (int i = 0; i < 16; ++i) S[i] = 0.f;
        for (int i = F.tid; i < 8704 / 4; i += NWAVES * 64) ((LAS unsigned*)(L + HG_ST0))[i] = 0u;
        HGM_LOAD(0);
#pragma unroll 1
        for (int c = 0; c < SEQ / 64; ++c) {
            float q[8][2], k[8][2], cs[8][2]; float run0 = 0.f, run1 = 0.f;
#pragma unroll
            for (int i = 0; i < 8; ++i) {
                const float f0 = bflo(fraw[i]), f1 = bfhi(fraw[i]), r0 = bflo(qraw[i]), r1 = bfhi(qraw[i]);
                const float g0 = lb0 + (1.f - lb0) * __builtin_amdgcn_rcpf(1.f + __expf(-f0)), g1 = lb1 + (1.f - lb1) * __builtin_amdgcn_rcpf(1.f + __expf(-f1));
                run0 += __logf(g0); run1 += __logf(g1); cs[i][0] = run0; cs[i][1] = run1;
                k[i][0] = 1.f - g0; k[i][1] = 1.f - g1;
                q[i][0] = r0 * __builtin_amdgcn_rcpf(1.f + __expf(-r0)) * QSCALE; q[i][1] = r1 * __builtin_amdgcn_rcpf(1.f + __expf(-r1)) * QSCALE;
            }
            { typedef float f32x2v __attribute__((ext_vector_type(2))); *(LAS f32x2v*)(L + HG_SEG + (w * 128 + 2 * cp) * 4) = (f32x2v){run0, run1}; }
            const unsigned v0 = vraw[0], v1 = vraw[1];
            LDS_WAIT(); __builtin_amdgcn_s_barrier(); asm volatile("" ::: "memory");
            float off0 = 0.f, off1 = 0.f, bref0 = 0.f, bref1 = 0.f, p0 = 0.f, p1 = 0.f;
#pragma unroll
            for (int s = 0; s < 8; ++s) { typedef float f32x2v __attribute__((ext_vector_type(2))); const f32x2v t = *(const LAS f32x2v*)(L + HG_SEG + (s * 128 + 2 * cp) * 4);
                if (s == w) { off0 = p0; off1 = p1; } p0 += t.x; p1 += t.y; if (s == 3) { bref0 = p0; bref1 = p1; } }
            const float er0 = __expf(bref0), er1 = __expf(bref1);
            unsigned krt0[4], krt1[4];
#pragma unroll
            for (int i = 0; i < 8; ++i) {
                const float e10 = __expf(cs[i][0] + off0 - bref0), e11 = __expf(cs[i][1] + off1 - bref1);
                const float qr0 = q[i][0] * e10, qr1 = q[i][1] * e11, kr0 = k[i][0] * __builtin_amdgcn_rcpf(e10), kr1 = k[i][1] * __builtin_amdgcn_rcpf(e11);
                const int ro = (8 * w + i) * 272 + 4 * cp;
                *(LAS unsigned*)(L + HG_QR + ro) = cvtpk(qr0, qr1);
                *(LAS unsigned*)(L + HG_QD + ro) = cvtpk(qr0 * er0, qr1 * er1);
                *(LAS unsigned*)(L + HG_KR + ro) = cvtpk(kr0, kr1);
                if (i & 1) { krt0[i >> 1] = cvtpk(k[i - 1][0] * __builtin_amdgcn_rcpf(__expf(cs[i - 1][0] + off0 - bref0)), kr0); krt1[i >> 1] = cvtpk(k[i - 1][1] * __builtin_amdgcn_rcpf(__expf(cs[i - 1][1] + off1 - bref1)), kr1); }
            }
            *(LAS v4u*)(L + HG_KRT + (2 * cp) * 144 + 16 * w) = (v4u){krt0[0], krt0[1], krt0[2], krt0[3]};
            *(LAS v4u*)(L + HG_KRT + (2 * cp + 1) * 144 + 16 * w) = (v4u){krt1[0], krt1[1], krt1[2], krt1[3]};
            if (w == 0) { typedef float f32x2v __attribute__((ext_vector_type(2)));
                *(LAS f32x2v*)(L + HG_EL + 8 * cp) = (f32x2v){__expf(p0 - bref0), __expf(p1 - bref1)}; *(LAS f32x2v*)(L + HG_DEC + 8 * cp) = (f32x2v){__expf(p0), __expf(p1)}; }
            { const int ee = 2 * (F.tid & 15), ss = F.tid >> 4;
                *(LAS unsigned short*)(L + HG_VT + ee * 144 + ss * 2) = (unsigned short)(v0 & 0xffffu); *(LAS unsigned short*)(L + HG_VT + (ee + 1) * 144 + ss * 2) = (unsigned short)(v0 >> 16);
                *(LAS unsigned short*)(L + HG_VT + ee * 144 + (ss + 32) * 2) = (unsigned short)(v1 & 0xffffu); *(LAS unsigned short*)(L + HG_VT + (ee + 1) * 144 + (ss + 32) * 2) = (unsigned short)(v1 >> 16); }
            if (c + 1 < SEQ / 64) HGM_LOAD(c + 1);
            LDS_WAIT(); __builtin_amdgcn_s_barrier(); asm volatile("" ::: "memory");
            const LAS unsigned char* stc = L + ((c & 1) ? HG_ST1 : HG_ST0);
            LAS unsigned char* stn = L + ((c & 1) ? HG_ST0 : HG_ST1);
            if (w < 2) {
                const int th = w;
                f32x16 Y;
#pragma unroll
                for (int i = 0; i < 16; ++i) Y[i] = 0.f;
#pragma unroll
                for (int kd = 0; kd < 8; ++kd) { const bf16x8 a = *(const LAS bf16x8*)(stc + l31 * 272 + (16 * kd + 8 * hh) * 2); const bf16x8 bq = *(const LAS bf16x8*)(L + HG_QD + (32 * th + l31) * 272 + (16 * kd + 8 * hh) * 2);
                    Y = __builtin_amdgcn_mfma_f32_32x32x16_bf16(a, bq, Y, 0, 0, 0); }
#pragma unroll
                for (int sb = 0; sb < 2; ++sb) { if (sb <= th) {
                    f32x16 X;
#pragma unroll
                    for (int i = 0; i < 16; ++i) X[i] = 0.f;
#pragma unroll
                    for (int kd = 0; kd < 8; ++kd) { const bf16x8 a = *(const LAS bf16x8*)(L + HG_KR + (32 * sb + l31) * 272 + (16 * kd + 8 * hh) * 2); const bf16x8 bq = *(const LAS bf16x8*)(L + HG_QR + (32 * th + l31) * 272 + (16 * kd + 8 * hh) * 2);
                        X = __builtin_amdgcn_mfma_f32_32x32x16_bf16(a, bq, X, 0, 0, 0); }
                    if (sb == th) {
#pragma unroll
                        for (int r = 0; r < 16; ++r) { const int s = (r & 3) + 8 * (r >> 2) + 4 * hh; if (s > l31) X[r] = 0.f; } }
#pragma unroll
                    for (int ks = 0; ks < 2; ++ks) {
                        const unsigned x0 = cvtpk(X[8 * ks + 0], X[8 * ks + 1]), x1 = cvtpk(X[8 * ks + 2], X[8 * ks + 3]), x2 = cvtpk(X[8 * ks + 4], X[8 * ks + 5]), x3 = cvtpk(X[8 * ks + 6], X[8 * ks + 7]);
                        const bf16x8 xb = __builtin_bit_cast(bf16x8, (v4u){x0, x1, x2, x3});
                        const v2u alo = *(const LAS v2u*)(L + HG_VT + l31 * 144 + (32 * sb + 16 * ks + 4 * hh) * 2), ahi = *(const LAS v2u*)(L + HG_VT + l31 * 144 + (32 * sb + 16 * ks + 8 + 4 * hh) * 2);
                        const bf16x8 a = __builtin_bit_cast(bf16x8, (v4u){alo.x, alo.y, ahi.x, ahi.y});
                        Y = __builtin_amdgcn_mfma_f32_32x32x16_bf16(a, xb, Y, 0, 0, 0); }
                } }
                float* orow = ORAW + (rowbase + 64 * c + 32 * th + l31) * DM + h * 128 + e0 + 4 * hh;
#pragma unroll
                for (int g = 0; g < 4; ++g) *(GAS f32x4*)(orow + 8 * g) = (f32x4){Y[4 * g], Y[4 * g + 1], Y[4 * g + 2], Y[4 * g + 3]};
            } else if (w >= 4) {
                const int dt = w - 4;
                f32x16 T;
#pragma unroll
                for (int i = 0; i < 16; ++i) T[i] = 0.f;
#pragma unroll
                for (int ks = 0; ks < 4; ++ks) { const bf16x8 a = *(const LAS bf16x8*)(L + HG_KRT + (32 * dt + l31) * 144 + (16 * ks + 8 * hh) * 2); const bf16x8 bv = *(const LAS bf16x8*)(L + HG_VT + l31 * 144 + (16 * ks + 8 * hh) * 2);
                    T = __builtin_amdgcn_mfma_f32_32x32x16_bf16(a, bv, T, 0, 0, 0); }
#pragma unroll
                for (int g = 0; g < 4; ++g) { const f32x4 dec = *(const LAS f32x4*)(L + HG_DEC + (32 * dt + 8 * g + 4 * hh) * 4), el = *(const LAS f32x4*)(L + HG_EL + (32 * dt + 8 * g + 4 * hh) * 4);
#pragma unroll
                    for (int i = 0; i < 4; ++i) S[4 * g + i] = dec[i] * S[4 * g + i] + el[i] * T[4 * g + i];
                    *(LAS v2u*)(stn + l31 * 272 + (32 * dt + 8 * g + 4 * hh) * 2) = (v2u){cvtpk(S[4 * g], S[4 * g + 1]), cvtpk(S[4 * g + 2], S[4 * g + 3])}; }
            }
        }
        LDS_WAIT(); __builtin_amdgcn_s_barrier(); asm volatile("" ::: "memory");
#undef HGM_LOAD
    }
}
__device__ __forceinline__ void hgrn_mfma2(Frame& F) {
    const bf16* QH = (const bf16*)(F.ws + WS_QKV); const bf16* FH = QH + (size_t)M * DM; const bf16* VH = FH + (size_t)M * DM; const bf16* KH = (const bf16*)(F.ws + WS_AO); bf16* ORAW = (bf16*)(F.ws + WS_ACT);
    LAS unsigned char* L = F.lds;
    const int w = F.wave, cp = F.lane, l31 = F.lane & 31, hh = F.lane >> 5, li = F.lane & 15, g4 = F.lane >> 4;
    typedef float f32x2v __attribute__((ext_vector_type(2)));
#pragma unroll 1
    for (int u = blockIdx.x; u < 256; u += F.G) {
        const int ux = u & 7, uy = u >> 3, bh = ux + 8 * (uy >> 2), e0 = (uy & 3) * 32, b = bh >> 5, h = bh & 31;
        const size_t rowbase = (size_t)b * SEQ;
        unsigned qn[8], fn[8], kn[8], vn[2];
        const bf16* pq = QH + ((size_t)bh * SEQ + 8 * w) * 128 + 2 * cp; const bf16* pf = FH + ((size_t)bh * SEQ + 8 * w) * 128 + 2 * cp; const bf16* pk = KH + ((size_t)bh * SEQ + 8 * w) * 128 + 2 * cp;
        const bf16* pv = VH + ((size_t)bh * SEQ + (F.tid >> 4)) * 128 + e0 + 2 * (F.tid & 15);
#define HG2_LOAD() do { \
            _Pragma("unroll") for (int i = 0; i < 8; ++i) { qn[i] = *(const GAS unsigned*)(pq + 128 * i); fn[i] = *(const GAS unsigned*)(pf + 128 * i); kn[i] = *(const GAS unsigned*)(pk + 128 * i); } \
            vn[0] = *(const GAS unsigned*)pv; vn[1] = *(const GAS unsigned*)(pv + 32 * 128); pq += 64 * 128; pf += 64 * 128; pk += 64 * 128; pv += 64 * 128; } while (0)
        f32x16 S;
#pragma unroll
        for (int i = 0; i < 16; ++i) S[i] = 0.f;
        for (int i = F.tid; i < 8704 / 4; i += NWAVES * 64) ((LAS unsigned*)(L + HG_ST0))[i] = 0u;
        HG2_LOAD();
#pragma unroll 1
        for (int c = 0; c < SEQ / 64; ++c) {
            float qf[8][2], kf[8][2], cs[8][2]; float run0 = 0.f, run1 = 0.f;
#pragma unroll
            for (int i = 0; i < 8; ++i) { qf[i][0] = bflo(qn[i]); qf[i][1] = bfhi(qn[i]); kf[i][0] = bflo(kn[i]); kf[i][1] = bfhi(kn[i]); run0 += bflo(fn[i]); run1 += bfhi(fn[i]); cs[i][0] = run0; cs[i][1] = run1; }
            const unsigned v0 = vn[0], v1 = vn[1];
            { const int back = (c + 1 < SEQ / 64) ? 0 : 64 * 128; pq -= back; pf -= back; pk -= back; pv -= back; }
            HG2_LOAD();
            *(LAS f32x2v*)(L + HG_SEG + (w * 128 + 2 * cp) * 4) = (f32x2v){run0, run1};
            LDS_WAIT(); __builtin_amdgcn_s_barrier(); asm volatile("" ::: "memory");
            float off0 = 0.f, off1 = 0.f, bref0 = 0.f, bref1 = 0.f, p0 = 0.f, p1 = 0.f;
#pragma unroll
            for (int s = 0; s < 8; ++s) { const f32x2v t = *(const LAS f32x2v*)(L + HG_SEG + (s * 128 + 2 * cp) * 4);
                if (s == w) { off0 = p0; off1 = p1; } p0 += t.x; p1 += t.y; if (s == 3) { bref0 = p0; bref1 = p1; } }
            const float er0 = __expf(bref0), er1 = __expf(bref1);
            off0 -= bref0; off1 -= bref1;
            float kr[8][2];
#pragma unroll
            for (int i = 0; i < 8; ++i) {
                const float e10 = __expf(cs[i][0] + off0), e11 = __expf(cs[i][1] + off1);
                const float qr0 = qf[i][0] * e10, qr1 = qf[i][1] * e11; kr[i][0] = kf[i][0] * __builtin_amdgcn_rcpf(e10); kr[i][1] = kf[i][1] * __builtin_amdgcn_rcpf(e11);
                const int ro = (8 * w + i) * 272 + 4 * cp;
                *(LAS unsigned*)(L + HG_QR + ro) = cvtpk(qr0, qr1);
                *(LAS unsigned*)(L + HG_QD + ro) = cvtpk(qr0 * er0, qr1 * er1);
                *(LAS unsigned*)(L + HG_KR + ro) = cvtpk(kr[i][0], kr[i][1]);
            }
            *(LAS v4u*)(L + HG_KRT + (2 * cp) * 144 + 16 * w) = (v4u){cvtpk(kr[0][0], kr[1][0]), cvtpk(kr[2][0], kr[3][0]), cvtpk(kr[4][0], kr[5][0]), cvtpk(kr[6][0], kr[7][0])};
            *(LAS v4u*)(L + HG_KRT + (2 * cp + 1) * 144 + 16 * w) = (v4u){cvtpk(kr[0][1], kr[1][1]), cvtpk(kr[2][1], kr[3][1]), cvtpk(kr[4][1], kr[5][1]), cvtpk(kr[6][1], kr[7][1])};
            if (w == 0) { *(LAS f32x2v*)(L + HG_EL + 8 * cp) = (f32x2v){__expf(p0 - bref0), __expf(p1 - bref1)}; *(LAS f32x2v*)(L + HG_DEC + 8 * cp) = (f32x2v){__expf(p0), __expf(p1)}; }
            { const int ee = 2 * (F.tid & 15), ss = F.tid >> 4;
                *(LAS unsigned short*)(L + HG_VT + ee * 144 + ss * 2) = (unsigned short)(v0 & 0xffffu); *(LAS unsigned short*)(L + HG_VT + (ee + 1) * 144 + ss * 2) = (unsigned short)(v0 >> 16);
                *(LAS unsigned short*)(L + HG_VT + ee * 144 + (ss + 32) * 2) = (unsigned short)(v1 & 0xffffu); *(LAS unsigned short*)(L + HG_VT + (ee + 1) * 144 + (ss + 32) * 2) = (unsigned short)(v1 >> 16); }
            LDS_WAIT(); __builtin_amdgcn_s_barrier(); asm volatile("" ::: "memory");
            const LAS unsigned char* stc = L + ((c & 1) ? HG_ST1 : HG_ST0);
            LAS unsigned char* stn = L + ((c & 1) ? HG_ST0 : HG_ST1);
            if (w < 4) {
                const int tq = w;
                f32x4 Y[2]; Y[0] = (f32x4){0.f, 0.f, 0.f, 0.f}; Y[1] = Y[0];
                bf16x8 bqr[4];
#pragma unroll
                for (int kd = 0; kd < 4; ++kd) { const bf16x8 bq = *(const LAS bf16x8*)(L + HG_QD + (16 * tq + li) * 272 + (32 * kd + 8 * g4) * 2); bqr[kd] = *(const LAS bf16x8*)(L + HG_QR + (16 * tq + li) * 272 + (32 * kd + 8 * g4) * 2);
#pragma unroll
                    for (int eb = 0; eb < 2; ++eb) { const bf16x8 a = *(const LAS bf16x8*)(stc + (16 * eb + li) * 272 + (32 * kd + 8 * g4) * 2); Y[eb] = __builtin_amdgcn_mfma_f32_16x16x32_bf16(a, bq, Y[eb], 0, 0, 0); } }
                f32x4 X[4];
#pragma unroll
                for (int sb = 0; sb < 4; ++sb) { f32x4 acc = (f32x4){0.f, 0.f, 0.f, 0.f};
                    if (sb <= tq) {
#pragma unroll
                        for (int kd = 0; kd < 4; ++kd) { const bf16x8 a = *(const LAS bf16x8*)(L + HG_KR + (16 * sb + li) * 272 + (32 * kd + 8 * g4) * 2); acc = __builtin_amdgcn_mfma_f32_16x16x32_bf16(a, bqr[kd], acc, 0, 0, 0); }
                        if (sb == tq) {
#pragma unroll
                            for (int r = 0; r < 4; ++r) if (4 * g4 + r > li) acc[r] = 0.f; } }
                    X[sb] = acc; }
#pragma unroll
                for (int pr = 0; pr < 2; ++pr) { if (2 * pr <= tq) {
                    const bf16x8 pf = __builtin_bit_cast(bf16x8, (v4u){cvtpk(X[2 * pr][0], X[2 * pr][1]), cvtpk(X[2 * pr][2], X[2 * pr][3]), cvtpk(X[2 * pr + 1][0], X[2 * pr + 1][1]), cvtpk(X[2 * pr + 1][2], X[2 * pr + 1][3])});
#pragma unroll
                    for (int eb = 0; eb < 2; ++eb) { const v2u alo = *(const LAS v2u*)(L + HG_VT + (16 * eb + li) * 144 + (32 * pr + 4 * g4) * 2), ahi = *(const LAS v2u*)(L + HG_VT + (16 * eb + li) * 144 + (32 * pr + 16 + 4 * g4) * 2);
                        const bf16x8 a = __builtin_bit_cast(bf16x8, (v4u){alo.x, alo.y, ahi.x, ahi.y}); Y[eb] = __builtin_amdgcn_mfma_f32_16x16x32_bf16(a, pf, Y[eb], 0, 0, 0); } } }
                bf16* orow = ORAW + (rowbase + 64 * c + 16 * tq + li) * DM + h * 128 + e0 + 4 * g4;
#pragma unroll
                for (int eb = 0; eb < 2; ++eb) *(GAS v2u*)(orow + 16 * eb) = (v2u){cvtpk(Y[eb][0], Y[eb][1]), cvtpk(Y[eb][2], Y[eb][3])};
            } else {
                const int dt = w - 4;
                f32x16 T;
#pragma unroll
                for (int i = 0; i < 16; ++i) T[i] = 0.f;
#pragma unroll
                for (int ks = 0; ks < 4; ++ks) { const bf16x8 a = *(const LAS bf16x8*)(L + HG_KRT + (32 * dt + l31) * 144 + (16 * ks + 8 * hh) * 2); const bf16x8 bv = *(const LAS bf16x8*)(L + HG_VT + l31 * 144 + (16 * ks + 8 * hh) * 2);
                    T = __builtin_amdgcn_mfma_f32_32x32x16_bf16(a, bv, T, 0, 0, 0); }
#pragma unroll
                for (int g = 0; g < 4; ++g) { const f32x4 dec = *(const LAS f32x4*)(L + HG_DEC + (32 * dt + 8 * g + 4 * hh) * 4), el = *(const LAS f32x4*)(L + HG_EL + (32 * dt + 8 * g + 4 * hh) * 4);
#pragma unroll
                    for (int i = 0; i < 4; ++i) S[4 * g + i] = dec[i] * S[4 * g + i] + el[i] * T[4 * g + i];
                    *(LAS v2u*)(stn + l31 * 272 + (32 * dt + 8 * g + 4 * hh) * 2) = (v2u){cvtpk(S[4 * g], S[4 * g + 1]), cvtpk(S[4 * g + 2], S[4 * g + 3])}; }
            }
        }
        LDS_WAIT(); __builtin_amdgcn_s_barrier(); asm volatile("" ::: "memory");
#undef HG2_LOAD
    }
}
__device__ __forceinline__ void hgrn_gate2(Frame& F) {
    const int gw = F.vcu * NWAVES + F.wave, NGW = F.G * NWAVES;
    const bf16* ORAW = (const bf16*)(F.ws + WS_ACT); const bf16* SG = (HG_FUSE == 2) ? (const bf16*)(F.ws + WS_AO) : (const bf16*)(F.ws + WS_QKV) + 3 * (size_t)M * DM; bf16* OG = (bf16*)(F.ws + WS_OG);
    const f32x4 gn = *(const GAS f32x4*)(F.hg_gain + 4 * (F.lane & 31));
    for (int m = gw; m < M; m += NGW) {
        const GAS v2u* orow = (const GAS v2u*)(ORAW + (size_t)m * DM) + F.lane;
        const GAS v2u* grow = (const GAS v2u*)(SG + (size_t)m * DM) + F.lane;
        GAS v2u* o8 = (GAS v2u*)(OG + (size_t)m * DM) + F.lane;
#pragma unroll 8
        for (int j = 0; j < 16; ++j) {
            const v2u ow = orow[64 * j], gw2 = grow[64 * j];
            const float o0 = bflo(ow.x), o1 = bfhi(ow.x), o2 = bflo(ow.y), o3 = bfhi(ow.y);
            float ss = (o0 * o0 + o1 * o1) + (o2 * o2 + o3 * o3);
#pragma unroll
            for (int k = 1; k < 32; k <<= 1) ss += __shfl_xor(ss, k);
            const float rstd = 1.f / sqrtf(ss * (1.f / HD) + RMS_EPS);
            float s0 = bflo(gw2.x), s1 = bfhi(gw2.x), s2 = bflo(gw2.y), s3 = bfhi(gw2.y);
            if (HG_FUSE == 2) { s0 *= __builtin_amdgcn_rcpf(1.f + __expf(-s0)); s1 *= __builtin_amdgcn_rcpf(1.f + __expf(-s1)); s2 *= __builtin_amdgcn_rcpf(1.f + __expf(-s2)); s3 *= __builtin_amdgcn_rcpf(1.f + __expf(-s3)); }
            v2u wv; wv.x = cvtpk(o0 * rstd * gn.x * s0, o1 * rstd * gn.y * s1); wv.y = cvtpk(o2 * rstd * gn.z * s2, o3 * rstd * gn.w * s3);
            o8[64 * j] = wv;
        }
    }
}

#define DPP_MOV(x, ctrl) __builtin_bit_cast(float, __builtin_amdgcn_update_dpp(0, __builtin_bit_cast(int, (x)), (ctrl), 0xf, 0xf, false))
__device__ __forceinline__ void hgrn_gate3(Frame& F) {
    const int gw = F.vcu * NWAVES + F.wave, NGW = F.G * NWAVES;
    const bf16* ORAW = (const bf16*)(F.ws + WS_ACT); const bf16* SG = (const bf16*)(F.ws + WS_AO); unsigned char* OG8 = (unsigned char*)(F.ws + WS_OG); float* sa3 = (float*)(F.ws + WS_SA3);
    const f32x4 gn = *(const GAS f32x4*)(F.hg_gain + 4 * (F.lane & 31));
    const float s1 = (F.lane & 1) ? -1.f : 1.f, s2 = (F.lane & 2) ? -1.f : 1.f, s4 = (F.lane & 4) ? -1.f : 1.f;
    for (int m = gw; m < M; m += NGW) {
        const GAS v2u* orow = (const GAS v2u*)(ORAW + (size_t)m * DM) + F.lane;
        const GAS v2u* grow = (const GAS v2u*)(SG + (size_t)m * DM) + F.lane;
        float v[16][4]; float am = 0.f;
#pragma unroll
        for (int j = 0; j < 16; ++j) {
            const v2u ow = orow[64 * j], gw2 = grow[64 * j];
            const float o0 = bflo(ow.x), o1 = bfhi(ow.x), o2 = bflo(ow.y), o3 = bfhi(ow.y);
            float ss = (o0 * o0 + o1 * o1) + (o2 * o2 + o3 * o3);
#pragma unroll
            for (int k = 1; k < 32; k <<= 1) ss += __shfl_xor(ss, k);
            const float rstd = 1.f / sqrtf(ss * (1.f / HD) + RMS_EPS);
            float g0 = bflo(gw2.x), g1 = bfhi(gw2.x), g2 = bflo(gw2.y), g3 = bfhi(gw2.y);
            g0 *= __builtin_amdgcn_rcpf(1.f + __expf(-g0)); g1 *= __builtin_amdgcn_rcpf(1.f + __expf(-g1)); g2 *= __builtin_amdgcn_rcpf(1.f + __expf(-g2)); g3 *= __builtin_amdgcn_rcpf(1.f + __expf(-g3));
            float x0 = o0 * rstd * gn.x * g0, x1 = o1 * rstd * gn.y * g1, x2 = o2 * rstd * gn.z * g2, x3 = o3 * rstd * gn.w * g3;
            { const unsigned a = cvtpk(x0, x1), b = cvtpk(x2, x3); x0 = bflo(a); x1 = bfhi(a); x2 = bflo(b); x3 = bfhi(b); }
            { const float a = x0 + x1, b = x0 - x1, c = x2 + x3, d = x2 - x3; x0 = a + c; x1 = b + d; x2 = a - c; x3 = b - d; }
            float x[4] = {x0, x1, x2, x3};
#pragma unroll
            for (int i = 0; i < 4; ++i) { const float p = DPP_QUAD(x[i], 0xB1); x[i] = p + s1 * x[i]; }
#pragma unroll
            for (int i = 0; i < 4; ++i) { const float p = DPP_QUAD(x[i], 0x4E); x[i] = p + s2 * x[i]; }
#pragma unroll
            for (int i = 0; i < 4; ++i) { const float pl = DPP_MOV(x[i], 0x104), pr = DPP_MOV(x[i], 0x114); const float p = (F.lane & 4) ? pr : pl; x[i] = (p + s4 * x[i]) * 0.17677669529663687f; }
#pragma unroll
            for (int i = 0; i < 4; ++i) { v[j][i] = x[i]; am = fmaxf(am, fabsf(x[i])); }
        }
#pragma unroll
        for (int o = 1; o < 64; o <<= 1) am = fmaxf(am, __shfl_xor(am, o));
        am = fmaxf(am, 1e-30f);
        const float qs = 127.f / am;
        GAS unsigned* o4 = (GAS unsigned*)(OG8 + (size_t)m * DM) + F.lane;
#pragma unroll
        for (int j = 0; j < 16; ++j) { const int q0 = (int)rintf(v[j][0] * qs), q1 = (int)rintf(v[j][1] * qs), q2 = (int)rintf(v[j][2] * qs), q3 = (int)rintf(v[j][3] * qs);
            o4[64 * j] = (unsigned)(q0 & 255) | ((unsigned)(q1 & 255) << 8) | ((unsigned)(q2 & 255) << 16) | ((unsigned)q3 << 24); }
        if (F.lane == 0) sa3[m] = am * (1.f / 127.f);
    }
}
constexpr int H4_OPB = 34816, H4_KR = 17408, H4_ED0 = 3 * H4_OPB, H4_EDB = 1536, H4_VS0 = H4_ED0 + 3 * H4_EDB, H4_VSB = 4096, H4_VT0 = H4_VS0 + 3 * H4_VSB, H4_VTB = 4608, H4_ST0 = H4_VT0 + 2 * H4_VTB, H4_STB = 8704, H4_END = H4_ST0 + 2 * H4_STB;
static_assert(H4_END <= LDSCTL_OFF, "hgrn4 LDS map");
constexpr size_t WS_H3QR = WS_QKV, WS_H3KR = WS_QKV + 136 * MiB, WS_H3VH = WS_QKV + 272 * MiB, WS_H3SG = WS_AO, WS_H3EL = WS_AO + 128 * MiB, WS_H3DEC = WS_AO + 132 * MiB, WS_H3ER = WS_AO + 136 * MiB;
static_assert(WS_H3VH + 128 * MiB <= WS_MRG && WS_H3ER + 4 * MiB + 512 <= WS_LSE, "hgrn4 workspace map");
__device__ __forceinline__ void hgrn_mfma3(Frame& F) {
    const char* TQR = (const char*)(F.ws + WS_H3QR); const char* TKR = (const char*)(F.ws + WS_H3KR);
    const bf16* VH = (const bf16*)(F.ws + WS_H3VH); const float* ELg = (const float*)(F.ws + WS_H3EL); const float* DECg = (const float*)(F.ws + WS_H3DEC); const float* ERg = (const float*)(F.ws + WS_H3ER);
    bf16* ORAW = (bf16*)(F.ws + WS_ACT);
    LAS unsigned char* L = F.lds;
    const int w = F.wave, li = F.lane & 15, g4 = F.lane >> 4;
#pragma unroll 1
    for (int u = blockIdx.x; u < 256; u += F.G) {
        const int ux = u & 7, uy = u >> 3, bh = ux + 8 * (uy >> 2), e0 = (uy & 3) * 32, b = bh >> 5, h = bh & 31;
        const size_t rowbase = (size_t)b * SEQ;
#define H4_DMA(cc, sl) do { const size_t cid_ = (size_t)bh * 128 + (cc); const size_t cidn_ = ((cc) + 1 < SEQ / 64) ? cid_ + 1 : cid_; LAS unsigned char* ob_ = L + (sl) * H4_OPB; LAS unsigned char* eb_ = L + H4_ED0 + (sl) * H4_EDB; \
            _Pragma("unroll") for (int i_ = 0; i_ < 5; ++i_) { const int k_ = 5 * w + i_; \
                if (k_ < 34) { const int t_ = (k_ >= 17) ? 1 : 0, q_ = k_ - 17 * t_; \
                    __builtin_amdgcn_global_load_lds((const unsigned*)((t_ ? TKR : TQR) + cid_ * 17408 + q_ * 1024 + F.lane * 16), (LAS unsigned*)(ob_ + t_ * H4_KR + q_ * 1024), 16, 0, 0); } \
                else { const int e_ = k_ - 34, ar_ = e_ >> 1; const float* sp_ = (ar_ == 0) ? (ELg + cid_ * 128) : (ar_ == 1) ? (DECg + cid_ * 128) : (ERg + cidn_ * 128); \
                    __builtin_amdgcn_global_load_lds((const unsigned*)(sp_ + (e_ & 1) * 64 + F.lane), (LAS unsigned*)(eb_ + ar_ * 512 + (e_ & 1) * 256), 4, 0, 0); } } \
            _Pragma("unroll") for (int i_ = 0; i_ < 2; ++i_) { const int p_ = 2 * w + i_; \
                __builtin_amdgcn_global_load_lds((const unsigned*)(VH + ((size_t)bh * SEQ + 64 * (cc) + 4 * p_ + (F.lane >> 4)) * 128 + e0 + 2 * (F.lane & 15)), (LAS unsigned*)(L + H4_VS0 + (sl) * H4_VSB + p_ * 256), 4, 0, 0); } } while (0)
        f32x4 S[2][2];
#pragma unroll
        for (int a = 0; a < 2; ++a)
#pragma unroll
            for (int c2 = 0; c2 < 2; ++c2) S[a][c2] = (f32x4){0.f, 0.f, 0.f, 0.f};
        for (int i = F.tid; i < H4_STB / 4; i += NWAVES * 64) ((LAS unsigned*)(L + H4_ST0))[i] = 0u;
        H4_DMA(0, 0); H4_DMA(1, 1);
        int sl = 0;
#pragma unroll 1
        for (int c = 0; c < SEQ / 64; ++c) {
            if (w < 4 && c >= 2) asm volatile("s_waitcnt vmcnt(11)" ::: "memory"); else asm volatile("s_waitcnt vmcnt(7)" ::: "memory");
            {
                const LAS unsigned char* vs = L + H4_VS0 + sl * H4_VSB; LAS unsigned char* vt = L + H4_VT0 + (c & 1) * H4_VTB;
                const int row = 8 * w + (F.lane >> 3), eq = 4 * (F.lane & 7);
                const v2u vv = *(const LAS v2u*)(vs + row * 64 + eq * 2);
                *(LAS unsigned short*)(vt + (eq + 0) * 144 + row * 2) = (unsigned short)(vv.x & 0xffffu); *(LAS unsigned short*)(vt + (eq + 1) * 144 + row * 2) = (unsigned short)(vv.x >> 16);
                *(LAS unsigned short*)(vt + (eq + 2) * 144 + row * 2) = (unsigned short)(vv.y & 0xffffu); *(LAS unsigned short*)(vt + (eq + 3) * 144 + row * 2) = (unsigned short)(vv.y >> 16); }
            LDS_WAIT(); __builtin_amdgcn_s_barrier(); asm volatile("" ::: "memory");
            { const int cn = (c + 2 < SEQ / 64) ? c + 2 : SEQ / 64 - 1; const int sn = (sl == 0) ? 2 : sl - 1;
              H4_DMA(cn, sn); }
            const LAS unsigned char* OB = L + sl * H4_OPB; const LAS unsigned char* VT = L + H4_VT0 + (c & 1) * H4_VTB;
            const LAS unsigned char* stc = L + H4_ST0 + (c & 1) * H4_STB;
            LAS unsigned char* stn = L + H4_ST0 + ((c + 1) & 1) * H4_STB;
            if (w < 4) {
                const int tq = w;
                f32x4 Y[2]; Y[0] = (f32x4){0.f, 0.f, 0.f, 0.f}; Y[1] = Y[0];
                bf16x8 bqr[4];
#pragma unroll
                for (int kd = 0; kd < 4; ++kd) { bqr[kd] = *(const LAS bf16x8*)(OB + (16 * tq + li) * 272 + (32 * kd + 8 * g4) * 2);
#pragma unroll
                    for (int eb = 0; eb < 2; ++eb) { const bf16x8 a = *(const LAS bf16x8*)(stc + (16 * eb + li) * 272 + (32 * kd + 8 * g4) * 2); Y[eb] = __builtin_amdgcn_mfma_f32_16x16x32_bf16(a, bqr[kd], Y[eb], 0, 0, 0); } }
                f32x4 X[4];
#pragma unroll
                for (int sb = 0; sb < 4; ++sb) { f32x4 acc = (f32x4){0.f, 0.f, 0.f, 0.f};
                    if (sb <= tq) {
#pragma unroll
                        for (int kd = 0; kd < 4; ++kd) { const bf16x8 a = *(const LAS bf16x8*)(OB + H4_KR + (16 * sb + li) * 272 + (32 * kd + 8 * g4) * 2); acc = __builtin_amdgcn_mfma_f32_16x16x32_bf16(a, bqr[kd], acc, 0, 0, 0); }
                        if (sb == tq) {
#pragma unroll
                            for (int r = 0; r < 4; ++r) if (4 * g4 + r > li) acc[r] = 0.f; } }
                    X[sb] = acc; }
#pragma unroll
                for (int pr = 0; pr < 2; ++pr) { if (2 * pr <= tq) {
                    const bf16x8 pf = __builtin_bit_cast(bf16x8, (v4u){cvtpk(X[2 * pr][0], X[2 * pr][1]), cvtpk(X[2 * pr][2], X[2 * pr][3]), cvtpk(X[2 * pr + 1][0], X[2 * pr + 1][1]), cvtpk(X[2 * pr + 1][2], X[2 * pr + 1][3])});
#pragma unroll
                    for (int eb = 0; eb < 2; ++eb) { const v2u alo = *(const LAS v2u*)(VT + (16 * eb + li) * 144 + (32 * pr + 4 * g4) * 2), ahi = *(const LAS v2u*)(VT + (16 * eb + li) * 144 + (32 * pr + 16 + 4 * g4) * 2);
                        const bf16x8 a = __builtin_bit_cast(bf16x8, (v4u){alo.x, alo.y, ahi.x, ahi.y}); Y[eb] = __builtin_amdgcn_mfma_f32_16x16x32_bf16(a, pf, Y[eb], 0, 0, 0); } } }
                bf16* orow = ORAW + (rowbase + 64 * c + 16 * tq + li) * DM + h * 128 + e0 + 4 * g4;
#pragma unroll
                for (int eb = 0; eb < 2; ++eb) *(GAS v2u*)(orow + 16 * eb) = (v2u){cvtpk(Y[eb][0], Y[eb][1]), cvtpk(Y[eb][2], Y[eb][3])};
            } else {
                const int dt = w - 4;
                const LAS float* ELs = (const LAS float*)(L + H4_ED0 + sl * H4_EDB); const LAS float* DECs = ELs + 128; const LAS float* ERs = ELs + 256;
#pragma unroll
                for (int dbl = 0; dbl < 2; ++dbl) { const int db = 2 * dt + dbl;
                    f32x4 T[2]; T[0] = (f32x4){0.f, 0.f, 0.f, 0.f}; T[1] = T[0];
#pragma unroll
                    for (int ks = 0; ks < 2; ++ks) {
                        const unsigned ka = (unsigned)(size_t)(OB + H4_KR + (32 * ks + 4 * g4 + (li >> 2)) * 272 + (16 * db + 4 * (li & 3)) * 2);
                        v2u lo, hi;
                        asm volatile("ds_read_b64_tr_b16 %0, %2\n\tds_read_b64_tr_b16 %1, %2 offset:4352\n\ts_waitcnt lgkmcnt(0)" : "=&v"(lo), "=&v"(hi) : "v"(ka) : "memory");
                        const bf16x8 a = __builtin_bit_cast(bf16x8, (v4u){lo.x, lo.y, hi.x, hi.y});
#pragma unroll
                        for (int eb = 0; eb < 2; ++eb) { const v2u blo = *(const LAS v2u*)(VT + (16 * eb + li) * 144 + (32 * ks + 4 * g4) * 2), bhi = *(const LAS v2u*)(VT + (16 * eb + li) * 144 + (32 * ks + 16 + 4 * g4) * 2);
                            const bf16x8 bv = __builtin_bit_cast(bf16x8, (v4u){blo.x, blo.y, bhi.x, bhi.y}); T[eb] = __builtin_amdgcn_mfma_f32_16x16x32_bf16(a, bv, T[eb], 0, 0, 0); } }
                    const f32x4 dec = *(const LAS f32x4*)(DECs + 16 * db + 4 * g4), el = *(const LAS f32x4*)(ELs + 16 * db + 4 * g4), er = *(const LAS f32x4*)(ERs + 16 * db + 4 * g4);
#pragma unroll
                    for (int eb = 0; eb < 2; ++eb) { S[dbl][eb] = dec * S[dbl][eb] + el * T[eb]; const f32x4 sv = S[dbl][eb] * er;
                        *(LAS v2u*)(stn + (16 * eb + li) * 272 + (16 * db + 4 * g4) * 2) = (v2u){cvtpk(sv[0], sv[1]), cvtpk(sv[2], sv[3])}; } }
            }
            sl = (sl == 2) ? 0 : sl + 1;
        }
        asm volatile("s_waitcnt vmcnt(0)" ::: "memory"); LDS_WAIT(); __builtin_amdgcn_s_barrier(); asm volatile("" ::: "memory");
#undef H4_DMA
    }
}
struct Args { const float* in[11]; float* out; unsigned char* ws; int ph_lo, ph_hi, li, pad; };
__global__ void __launch_bounds__(NWAVES * 64, 2) mega_fwd(Args args) {
    extern __shared__ __attribute__((aligned(16))) unsigned char lds[];
    Frame F;
    F.lds = (LAS unsigned char*)lds;
    F.MISC = (volatile LAS unsigned*)(F.lds + MISC_OFF);
    F.tid = threadIdx.x; F.lane = F.tid & 63; F.wave = __builtin_amdgcn_readfirstlane(F.tid >> 6);
    F.G = gridDim.x; { const int bx = blockIdx.x; F.vcu = (F.G % 8 == 0) ? (bx % 8) * (F.G / 8) + bx / 8 : bx; }
#define GRID_BAR(seam) do { if (N_LAUNCHES != 1) { if (F.tid == 0) __hip_atomic_store(F.ctl + CW_TMO, 0xBADBA0u | (unsigned)(seam), RLX_AGENT); } \
    else { xcd_barrier(bar); } } while (0)
    unsigned char* ws = args.ws; F.ws = ws;
    F.ctl = (gu32*)(ws + WS_CTL);
    F.x = args.in[0]; F.gains = args.in[1]; F.rel_bias = args.in[2]; F.w_att_in = args.in[3]; F.w_att_out = args.in[4]; F.w_hg_in = args.in[5];
    F.lb_logits = args.in[6]; F.hg_gain = args.in[7]; F.w_hg_out = args.in[8]; F.w_ff_in = args.in[9]; F.w_ff_out = args.in[10]; F.out = args.out;
    for (int u = F.tid; u < (LDS_BYTES - LDSCTL_OFF) / 4; u += NWAVES * 64) ((LAS unsigned*)(F.lds + LDSCTL_OFF))[u] = 0u;
    __syncthreads();
    XcdBarrier bar; bar.bar = (unsigned*)(F.ctl + CW_BAR); bar.x = 0; bar.st = nullptr;
    if (N_LAUNCHES == 1) bar = xcd_barrier_post((unsigned*)(F.ctl + CW_BAR), F.MISC + 8);

    const int lo = args.ph_lo, hi = args.ph_hi;
#define IN(k) (lo <= (k) && (k) < hi)
#define BOTH(k) (IN(k) && IN((k) + 1))
    bf16* const XN = (bf16*)(ws + WS_XN); bf16* const HB = (bf16*)(ws + WS_HB); bf16* const Y = (bf16*)(ws + WS_Y); bf16* const ACT = (bf16*)(ws + WS_ACT);

    if (IN(0)) { for (int rep_ = 0; rep_ < REP_P0; ++rep_) p0_prologue(F);
        if (FFN_I8 && !P0_STRIP) { GRID_BAR(18);
            for (int l = 0; l < 2; ++l) p0_quant_rows<TM_FFI>(F, (const bf16*)(ws + WS_WFFI + l * WFFI_STRIDE), ws + WS_W8 + l * W8_STRIDE, (float*)(ws + WS_SW) + l * 2 * DFF, 2 * DFF);
            if (HGO_I8) p0_quant_wout<DM>(F, (const bf16*)(ws + WS_WHGO), ws + WS_W8G, (float*)(ws + WS_SWG));
            if (FFO_I8) for (int l = 0; l < 2; ++l) p0_quant_wout<DFF>(F, (const bf16*)(ws + WS_WFFO + l * WFFO_STRIDE), ws + WS_W8O + l * W8O_STRIDE, (float*)(ws + WS_SWO) + l * DM);
            if (ATT_I8) p0_quant_rows<false>(F, (const bf16*)(ws + WS_WATTI), ws + WS_W8A, (float*)(ws + WS_SWA), NQKV);
            if (HG_I8) p0_quant_rows<false>(F, (const bf16*)(ws + WS_WHGI), ws + WS_W8H, (float*)(ws + WS_SWH), NHG); }
        if (BOTH(0)) GRID_BAR(0); }
    if (IN(1)) {
        pg8::StaticOrder S; S.init(M, NQKV, F.G, (int)blockIdx.x);
        pg8::Gemm g{XN, ATT_I8 ? (const bf16*)(ws + WS_W8A) : (const bf16*)(ws + WS_WATTI), M, NQKV, ATT_I8 ? DM / 2 : DM};
        pg8::EpiBf16T<ATT_I8> E{(bf16*)(ws + WS_QKV), ATTN_MFMA ? 2048 : NQKV, ATTN_MFMA ? 2048 : 0, ATTN_MFMA ? (size_t)M * 2048 : 0, ATTN_MFMA ? 1 : 0, (const float*)(ws + WS_SA), (const float*)(ws + WS_SWA)};
        pg8::gemm_phase<pg8::EpiBf16T<ATT_I8>, pg8::StaticOrder, PG8_ALIGN, PG8_SP2, ATT_I8>(F.lds + RING_OFF, g, S, E); if (REP_GEMM > 1) { pg8::gemm_phase<pg8::EpiBf16T<ATT_I8>, pg8::StaticOrder, PG8_ALIGN, PG8_SP2, ATT_I8>(F.lds + RING_OFF, g, S, E); }
        if (BOTH(1)) GRID_BAR(1);
    }
    if (IN(2)) { if (ATTN_MFMA) { for (int rep_ = 0; rep_ < REP_ATT; ++rep_) { attn_mfma(F); GRID_BAR(16); attn_merge(F); if (rep_ + 1 < REP_ATT) GRID_BAR(17); } } else attn_naive(F); if (BOTH(2)) GRID_BAR(2); }
    if (IN(3)) {
        pg8::Gemm g{(const bf16*)(ws + WS_MRG), (const bf16*)(ws + WS_WATTO), M, DM, DATT}; pg8::StaticOrder S; S.init(M, DM, F.G, (int)blockIdx.x);
        pg8::EpiBf16 E{Y, DM, 0, 0, 0, nullptr, nullptr};
        pg8::gemm_phase<pg8::EpiBf16, pg8::StaticOrder, PG8_ALIGN, PG8_SP2>(F.lds + RING_OFF, g, S, E); if (REP_GEMM > 1) { pg8::gemm_phase<pg8::EpiBf16, pg8::StaticOrder, PG8_ALIGN, PG8_SP2>(F.lds + RING_OFF, g, S, E); }
        if (BOTH(3)) GRID_BAR(3);
    }
    if (IN(4)) { for (int rep_ = 0; rep_ < REP_NORM; ++rep_) norm_rows<true, FFN_I8 ? (TM_FFI ? 3 : 2) : 1, false, true>(F, F.x, Y, HB, XN, F.gains + 1 * DM, F.gains + 2 * DM, (float*)(ws + WS_SA)); if (BOTH(4)) GRID_BAR(4); }
    if (IN(5)) {
        pg8::StaticOrder S; S.init(M, 2 * DFF, F.G, (int)blockIdx.x);
        if (FFN_I8) {
            pg8::Gemm g{XN, (const bf16*)(ws + WS_W8), M, 2 * DFF, DM / 2};
            if (FFO_I8) {
                pg8::EpiSwiGLU8R E{ACT, DFF, (const float*)(ws + WS_SA), (const float*)(ws + WS_SW) + 0, (unsigned*)(ws + WS_RMAX) + 0 * M};
                pg8::gemm_phase<pg8::EpiSwiGLU8R, pg8::StaticOrder, PG8_ALIGN, PG8_SP2, true, 1, 1, TM_FFI>(F.lds + RING_OFF, g, S, E);
                if (P0_STRIP) run_deferred_strips<1>(F, (M / 256) * (2 * DFF / 256));
            } else {
            pg8::EpiSwiGLU8 E{ACT, DFF, (const float*)(ws + WS_SA), (const float*)(ws + WS_SW) + 0, (bf16*)(ws + WS_QKV)};
                pg8::gemm_phase<pg8::EpiSwiGLU8, pg8::StaticOrder, PG8_ALIGN, PG8_SP2, true, KREP_FFI, EREP_FFI, TM_FFI, TCH_FFI, LT_FFI>(F.lds + RING_OFF, g, S, E); if (REP_GEMM > 1 || REP_FFI > 1) { pg8::gemm_phase<pg8::EpiSwiGLU8, pg8::StaticOrder, PG8_ALIGN, PG8_SP2, true, 1, 1, TM_FFI>(F.lds + RING_OFF, g, S, E); }
            }
        } else {
            pg8::Gemm g{XN, (const bf16*)(ws + WS_WFFI), M, 2 * DFF, DM};
            pg8::EpiSwiGLU E{ACT, DFF};
            pg8::gemm_phase<pg8::EpiSwiGLU, pg8::StaticOrder, PG8_ALIGN, PG8_SP2>(F.lds + RING_OFF, g, S, E); if (REP_GEMM > 1) { pg8::gemm_phase<pg8::EpiSwiGLU, pg8::StaticOrder, PG8_ALIGN, PG8_SP2>(F.lds + RING_OFF, g, S, E); }
        }
        if (BOTH(5)) GRID_BAR(5);
    }
    if (IN(6)) {
        pg8::StaticOrder S; S.init(M, DM, F.G, (int)blockIdx.x);
        if (FFO_I8) {
            act_quant_rows(F, ACT, ws + WS_ACT8, (const unsigned*)(ws + WS_RMAX) + 0 * M, (float*)(ws + WS_SA2));
            GRID_BAR(20);
            pg8::Gemm g{(const bf16*)(ws + WS_ACT8), (const bf16*)(ws + WS_W8O + 0 * W8O_STRIDE), M, DM, DFF / 2};
            pg8::EpiBf16T<true> E{Y, DM, 0, 0, 0, (const float*)(ws + WS_SA2), (const float*)(ws + WS_SWO) + 0 * DM};
            pg8::gemm_phase<pg8::EpiBf16T<true>, pg8::StaticOrder, PG8_ALIGN, PG8_SP2, true>(F.lds + RING_OFF, g, S, E);
        } else {
            pg8::Gemm g{ACT, (const bf16*)(ws + WS_WFFO), M, DM, DFF};
            pg8::EpiBf16 E{Y, DM, 0, 0, 0, nullptr, nullptr};
            pg8::gemm_phase<pg8::EpiBf16, pg8::StaticOrder, PG8_ALIGN, PG8_SP2>(F.lds + RING_OFF, g, S, E);
        }
        if (BOTH(6)) GRID_BAR(6);
    }
    if (IN(7)) { norm_rows<true, HG_I8 ? 2 : 1, true, true>(F, HB, Y, HB, XN, F.gains + 3 * DM, F.gains + 4 * DM, (float*)(ws + WS_SA)); if (BOTH(7)) GRID_BAR(7); }
    if (IN(8)) {
        pg8::StaticOrder S; S.init(M, NHG, F.G, (int)blockIdx.x);
        pg8::Gemm g{XN, HG_I8 ? (const bf16*)(ws + WS_W8H) : (const bf16*)(ws + WS_WHGI), M, NHG, HG_I8 ? DM / 2 : DM};
        if (HG_FUSE == 0) {
            pg8::EpiHgrn<HG_I8> E{(bf16*)(ws + WS_QKV), (bf16*)(ws + WS_AO), (const float*)(ws + WS_TAB + 65536), (const float*)(ws + WS_SA), (const float*)(ws + WS_SWH)};
            pg8::gemm_phase<pg8::EpiHgrn<HG_I8>, pg8::StaticOrder, PG8_ALIGN, PG8_SP2, HG_I8>(F.lds + RING_OFF, g, S, E);
        } else if (HG_FUSE == 1) {
            pg8::EpiHgrn2<HG_I8> E{(bf16*)(ws + WS_QKV), (bf16*)(ws + WS_AO), (const float*)(ws + WS_TAB + 65536), (const float*)(ws + WS_SA), (const float*)(ws + WS_SWH)};
            pg8::gemm_phase<pg8::EpiHgrn2<HG_I8>, pg8::StaticOrder, PG8_ALIGN, PG8_SP2, HG_I8>(F.lds + RING_OFF, g, S, E);
        } else {
            pg8::EpiHgrn3<HG_I8> E{(bf16*)(ws + WS_H3QR), (WS_H3KR - WS_H3QR) / 2, (WS_H3VH - WS_H3QR) / 2, (WS_H3SG - WS_H3QR) / 2, (float*)(ws + WS_H3EL), (float*)(ws + WS_H3DEC), (float*)(ws + WS_H3ER),
                                   (const float*)(ws + WS_TAB + 65536), (const float*)(ws + WS_SA), (const float*)(ws + WS_SWH)};
            pg8::gemm_phase<pg8::EpiHgrn3<HG_I8>, pg8::StaticOrder, PG8_ALIGN, PG8_SP2, HG_I8>(F.lds + RING_OFF, g, S, E);
            if (REP_P8 > 1) { pg8::gemm_phase<pg8::EpiHgrn3<HG_I8>, pg8::StaticOrder, PG8_ALIGN, PG8_SP2, HG_I8>(F.lds + RING_OFF, g, S, E); }
        }
        if (BOTH(8)) GRID_BAR(8);
    }
    if (IN(9)) { if (HG_FUSE == 2) { hgrn_mfma3(F); if (REP_HG > 1) hgrn_mfma3(F); } else { hgrn_mfma2(F); if (REP_HG > 1) hgrn_mfma2(F); } if (BOTH(9)) GRID_BAR(9); }
    if (IN(10)) { if (HGO_I8) hgrn_gate3(F); else { hgrn_gate2(F); if (REP_HG > 1) hgrn_gate2(F); } if (BOTH(10)) GRID_BAR(10); }
    if (IN(11)) {
        pg8::StaticOrder S; S.init(M, DM, F.G, (int)blockIdx.x);
        if (HGO_I8) {
            pg8::Gemm g{(const bf16*)(ws + WS_OG), (const bf16*)(ws + WS_W8G), M, DM, DM / 2};
            pg8::EpiBf16T<true> E{Y, DM, 0, 0, 0, (const float*)(ws + WS_SA3), (const float*)(ws + WS_SWG)};
            pg8::gemm_phase<pg8::EpiBf16T<true>, pg8::StaticOrder, PG8_ALIGN, PG8_SP2, true>(F.lds + RING_OFF, g, S, E);
        } else {
            pg8::Gemm g{(const bf16*)(ws + WS_OG), (const bf16*)(ws + WS_WHGO), M, DM, DM};
            pg8::EpiBf16 E{Y, DM, 0, 0, 0, nullptr, nullptr};
            pg8::gemm_phase<pg8::EpiBf16, pg8::StaticOrder, PG8_ALIGN, PG8_SP2>(F.lds + RING_OFF, g, S, E);
        }
        if (BOTH(11)) GRID_BAR(11);
    }
    if (IN(12)) { norm_rows<true, FFN_I8 ? (TM_FFI ? 3 : 2) : 1, true, true>(F, HB, Y, HB, XN, F.gains + 5 * DM, F.gains + 6 * DM, (float*)(ws + WS_SA)); if (BOTH(12)) GRID_BAR(12); }
    if (IN(13)) {
        pg8::StaticOrder S; S.init(M, 2 * DFF, F.G, (int)blockIdx.x);
        if (FFN_I8) {
            pg8::Gemm g{XN, (const bf16*)(ws + WS_W8 + W8_STRIDE), M, 2 * DFF, DM / 2};
            if (FFO_I8) {
                pg8::EpiSwiGLU8R E{ACT, DFF, (const float*)(ws + WS_SA), (const float*)(ws + WS_SW) + 2 * DFF, (unsigned*)(ws + WS_RMAX) + 1 * M};
                pg8::gemm_phase<pg8::EpiSwiGLU8R, pg8::StaticOrder, PG8_ALIGN, PG8_SP2, true, 1, 1, TM_FFI>(F.lds + RING_OFF, g, S, E);
                if (P0_STRIP) run_deferred_strips<2>(F, (M / 256) * (2 * DFF / 256));
            } else {
            pg8::EpiSwiGLU8 E{ACT, DFF, (const float*)(ws + WS_SA), (const float*)(ws + WS_SW) + 2 * DFF, (bf16*)(ws + WS_QKV)};
                pg8::gemm_phase<pg8::EpiSwiGLU8, pg8::StaticOrder, PG8_ALIGN, PG8_SP2, true, KREP_FFI, EREP_FFI, TM_FFI, TCH_FFI, LT_FFI>(F.lds + RING_OFF, g, S, E); if (REP_GEMM > 1 || REP_FFI > 1) { pg8::gemm_phase<pg8::EpiSwiGLU8, pg8::StaticOrder, PG8_ALIGN, PG8_SP2, true, 1, 1, TM_FFI>(F.lds + RING_OFF, g, S, E); }
            }
        } else {
            pg8::Gemm g{XN, (const bf16*)(ws + WS_WFFI + WFFI_STRIDE), M, 2 * DFF, DM};
            pg8::EpiSwiGLU E{ACT, DFF};
            pg8::gemm_phase<pg8::EpiSwiGLU, pg8::StaticOrder, PG8_ALIGN, PG8_SP2>(F.lds + RING_OFF, g, S, E); if (REP_GEMM > 1) { pg8::gemm_phase<pg8::EpiSwiGLU, pg8::StaticOrder, PG8_ALIGN, PG8_SP2>(F.lds + RING_OFF, g, S, E); }
        }
        if (BOTH(13)) GRID_BAR(13);
    }
    if (IN(14)) {
        pg8::StaticOrder S; S.init(M, DM, F.G, (int)blockIdx.x);
        if (FFO_I8) {
            act_quant_rows(F, ACT, ws + WS_ACT8, (const unsigned*)(ws + WS_RMAX) + 1 * M, (float*)(ws + WS_SA2));
            GRID_BAR(21);
            pg8::Gemm g{(const bf16*)(ws + WS_ACT8), (const bf16*)(ws + WS_W8O + 1 * W8O_STRIDE), M, DM, DFF / 2};
            pg8::EpiBf16T<true> E{Y, DM, 0, 0, 0, (const float*)(ws + WS_SA2), (const float*)(ws + WS_SWO) + 1 * DM};
            pg8::gemm_phase<pg8::EpiBf16T<true>, pg8::StaticOrder, PG8_ALIGN, PG8_SP2, true>(F.lds + RING_OFF, g, S, E);
        } else {
            pg8::Gemm g{ACT, (const bf16*)(ws + WS_WFFO + WFFO_STRIDE), M, DM, DFF};
            pg8::EpiBf16 E{Y, DM, 0, 0, 0, nullptr, nullptr};
            pg8::gemm_phase<pg8::EpiBf16, pg8::StaticOrder, PG8_ALIGN, PG8_SP2>(F.lds + RING_OFF, g, S, E);
        }
        if (BOTH(14)) GRID_BAR(14);
    }
    if (REP_BAR > 0) { for (int rb_ = 0; rb_ < REP_BAR; ++rb_) GRID_BAR(30); }
    if (IN(15)) { norm_rows<true, 0, true, false>(F, HB, Y, F.out, nullptr, F.gains + 7 * DM, nullptr); }
#undef IN
#undef BOTH
}

extern "C" void kernel_launch(void* const* d_in, const int* in_sizes, int n_in, void* d_out, int out_size, void* d_ws, size_t ws_size, hipStream_t stream) {
    static int grid = 0;
    if (grid == 0) {
        if (n_in != 11 || in_sizes[0] != M * DM || out_size != M * DM || ws_size < WS_END5) { fprintf(stderr, "kernel_launch: unexpected shapes (n_in %d, in0 %d, out %d, ws %zu, need %zu); nothing launched\n", n_in, n_in > 0 ? in_sizes[0] : -1, out_size, ws_size, (size_t)WS_END); grid = -1; return; }
        int dev = 0, cus = 0, per_cu = 0;
        if (hipGetDevice(&dev) != hipSuccess || hipDeviceGetAttribute(&cus, hipDeviceAttributeMultiprocessorCount, dev) != hipSuccess) { grid = -1; return; }
        if (hipFuncSetAttribute((const void*)mega_fwd, hipFuncAttributeMaxDynamicSharedMemorySize, LDS_BYTES) != hipSuccess) { fprintf(stderr, "kernel_launch: hipFuncSetAttribute failed\n"); grid = -1; return; }
        if (hipOccupancyMaxActiveBlocksPerMultiprocessor(&per_cu, (const void*)mega_fwd, NWAVES * 64, LDS_BYTES) != hipSuccess || per_cu < 1)
            fprintf(stderr, "kernel_launch: note: occupancy query reports %d workgroups per CU\n", per_cu);
        (void)hipGetLastError();
        grid = cus;
    }
    if (grid < 0) return;
    if (hipMemsetAsync((char*)d_ws + WS_CTL, 0, CTL_ZERO_BYTES, stream) != hipSuccess) { fprintf(stderr, "kernel_launch: hipMemsetAsync failed\n"); return; }
    Args a{};
    for (int i = 0; i < 11; ++i) a.in[i] = (const float*)d_in[i];
    a.out = (float*)d_out; a.ws = (unsigned char*)d_ws;
    for (int li = 0; li < N_LAUNCHES; ++li) {
        a.ph_lo = (N_LAUNCHES == 1) ? 0 : li; a.ph_hi = (N_LAUNCHES == 1) ? NPH : li + 1; a.li = li;
        hipLaunchKernelGGL(mega_fwd, dim3(grid), dim3(NWAVES * 64), LDS_BYTES, stream, a);
        const hipError_t le = hipPeekAtLastError();
        if (le != hipSuccess) { fprintf(stderr, "kernel_launch: launch %d failed: %s\n", li, hipGetErrorName(le)); break; }
    }
}
```

```cpp
#include <hip/hip_runtime.h>
#include <cstdio>
#include <cstdint>
#ifndef PG8_WGM
#define PG8_WGM 8
#endif
#ifndef MK_FFO_ROT
#define MK_FFO_ROT 1
#endif
namespace pg8 {
#define PG8_LAS __attribute__((address_space(3)))
typedef unsigned short bf16_t;
typedef short bf16x8 __attribute__((ext_vector_type(8)));
typedef float f32x4 __attribute__((ext_vector_type(4)));
typedef unsigned u32x4 __attribute__((ext_vector_type(4)));
constexpr int BM = 256, BK = 64, HALF = 128, HTB = HALF * BK * 2  , STAGE_BYTES = 8 * HTB, NXCD = 8, WGM = PG8_WGM;

__host__ __device__ __forceinline__ int lds_byte(int r, int c) { const int st = (r >> 4) * 2 + (c >> 5), rr = r & 15, cc = c & 31, ob = rr * 64 + cc * 2; return st * 1024 + (ob ^ (((ob >> 9) & 1) << 5)); }
__host__ __device__ __forceinline__ void stage_rc(int b, int& R, int& C) { const int st = b / 1024, sb = b % 1024, swz = sb ^ (((sb >> 9) & 1) << 5); R = (st >> 1) * 16 + swz / 64; C = (st & 1) * 32 + (swz % 64) / 2; }
__host__ __device__ __forceinline__ int perm32(int rho) { const int n = rho >> 4, i = rho & 15; return 8 * (i >> 2) + 4 * n + (i & 3); }

struct Unit { int pm, pn; };
struct Gemm { const bf16_t* A; const bf16_t* Bt; int M, N, K; };

struct StaticOrder {
    int nM, nN, nwg, G, c;
    __host__ __device__ void init(int M, int N, int G_, int c_) { nM = M / BM; nN = N / BM; nwg = nM * nN; G = G_; c = c_; }
    __host__ __device__ bool next(int i, Unit& u) const {
        const long L = (long)i * G + c; if (L >= nwg) return false;
        int wgid = (int)L; { const int q = nwg / NXCD, r = nwg % NXCD, xcd = wgid % NXCD, off = wgid / NXCD; wgid = (xcd < r ? xcd * (q + 1) : r * (q + 1) + (xcd - r) * q) + off; }
        const int nig = WGM * nN, gid = wgid / nig, fm = gid * WGM, gsz = (nM - fm) < WGM ? (nM - fm) : WGM;
        u.pm = fm + ((wgid % nig) % gsz); u.pn = (wgid % nig) / gsz; return true;
    }
    __device__ __forceinline__ void a_ready(const Unit&) const {}
    __device__ __forceinline__ void done(const Unit&) const {}
};

__device__ __forceinline__ unsigned cvt_pk_bf16(float lo, float hi) { unsigned r; asm volatile("v_cvt_pk_bf16_f32 %0, %1, %2" : "=v"(r) : "v"(lo), "v"(hi)); return r; }
typedef float f32x2 __attribute__((ext_vector_type(2)));
typedef int i32x4 __attribute__((ext_vector_type(4)));
template <bool I8> struct AccT { typedef f32x4 type; static __device__ __forceinline__ f32x4 zero() { return (f32x4){0.f, 0.f, 0.f, 0.f}; } };
template <> struct AccT<true> { typedef i32x4 type; static __device__ __forceinline__ i32x4 zero() { return (i32x4){0, 0, 0, 0}; } };
__device__ __forceinline__ f32x4 mma16(bf16x8 a, bf16x8 b, f32x4 c) { return __builtin_amdgcn_mfma_f32_16x16x32_bf16(a, b, c, 0, 0, 0); }
__device__ __forceinline__ i32x4 mma16(bf16x8 a, bf16x8 b, i32x4 c) { return __builtin_amdgcn_mfma_i32_16x16x64_i8(__builtin_bit_cast(i32x4, a), __builtin_bit_cast(i32x4, b), c, 0, 0, 0); }
__host__ __device__ __forceinline__ size_t tm_chunk_off(int r, int cb, int nt, bool perm) {
    const int p = r >> 8, rr = r & 255, half = rr >> 7; int R = rr & 127;
    if (perm) { const int x = R & 31; R = (R & ~31) + 16 * ((x >> 2) & 1) + 4 * (x >> 3) + (x & 3); }
    return ((size_t)(p * nt + (cb >> 7)) * 2 + half) * 16384 + (size_t)lds_byte(R, (cb & 127) >> 1) + (cb & 1);
}
#ifndef MK_ACT_NT
#define MK_ACT_NT 0
#endif
#ifndef MK_ST_SC1
#define MK_ST_SC1 0
#endif
__device__ __forceinline__ void st16nt(void* p, u32x4 v) {
#if MK_ACT_NT
    __builtin_nontemporal_store(v, (u32x4*)p);
#else
    *(u32x4*)p = v;
#endif
}
__device__ __forceinline__ void st16(void* p, u32x4 v) {
#if MK_ST_SC1
    asm volatile("global_store_dwordx4 %0, %1, off sc1\n\ts_nop 1" :: "v"(p), "v"(v) : "memory");
#else
    *(u32x4*)p = v;
#endif
}
__device__ __forceinline__ float silu_f(float x) { return x * __builtin_amdgcn_rcpf(1.0f + __expf(-x)); }
template <bool I8> struct EpiBf16T {
    static constexpr bool PERM = true, AFTER_DRAIN = false;
    bf16_t* O; int ldc; int split_cols; size_t split_stride; int dil; const float* sa; const float* sw;
    __device__ __forceinline__ void operator()(const typename AccT<I8>::type (&acc)[2][2][4][2], const Unit& u, int wr, int wc, int fr, int fq) const {
        const int row0 = u.pm * BM + wr * 64 + fr; int colt = u.pn * BM; bf16_t* base = O; int sh = 0;
        if (split_cols) { const int t = colt / split_cols; base += (size_t)t * split_stride; colt -= t * split_cols; if (dil) sh = 2 * (t / 3); }
        const int col0 = colt + wc * 32 + 8 * fq;
        f32x4 swv[2][2];
#pragma unroll
        for (int bj = 0; bj < 2; ++bj)
#pragma unroll
            for (int n = 0; n < 2; ++n) swv[bj][n] = I8 ? *(const f32x4*)(sw + u.pn * BM + wc * 32 + 8 * fq + bj * HALF + 4 * n) : (f32x4){1.f, 1.f, 1.f, 1.f};
#pragma unroll
        for (int ai = 0; ai < 2; ++ai)
#pragma unroll
            for (int m = 0; m < 4; ++m) { int r = row0 + ai * HALF + m * 16; const float sr = I8 ? sa[r] : 1.f;
                if (sh) { const int tt = r & 8191; r = (r & ~8191) + ((tt & ((1 << sh) - 1)) << (13 - sh)) + (tt >> sh); }
                bf16_t* rowp = base + (size_t)r * ldc + col0;
#pragma unroll
                for (int bj = 0; bj < 2; ++bj) { f32x4 v0, v1;
#pragma unroll
                    for (int j = 0; j < 4; ++j) { v0[j] = I8 ? (float)acc[ai][bj][m][0][j] * (sr * swv[bj][0][j]) : (float)acc[ai][bj][m][0][j]; v1[j] = I8 ? (float)acc[ai][bj][m][1][j] * (sr * swv[bj][1][j]) : (float)acc[ai][bj][m][1][j]; }
                    u32x4 w; w.x = cvt_pk_bf16(v0[0], v0[1]); w.y = cvt_pk_bf16(v0[2], v0[3]); w.z = cvt_pk_bf16(v1[0], v1[1]); w.w = cvt_pk_bf16(v1[2], v1[3]);
                    st16(rowp + bj * HALF, w); } }
    }
};
typedef EpiBf16T<false> EpiBf16;
struct EpiF32 {
    static constexpr bool PERM = false, AFTER_DRAIN = false;
    float* C; int ldc;
    __device__ __forceinline__ void operator()(const f32x4 (&acc)[2][2][4][2], const Unit& u, int wr, int wc, int fr, int fq) const {
        const int row0 = u.pm * BM + wr * 64 + fr, col0 = u.pn * BM + wc * 32 + 4 * fq;
#pragma unroll
        for (int ai = 0; ai < 2; ++ai)
#pragma unroll
            for (int m = 0; m < 4; ++m) { float* rowp = C + (size_t)(row0 + ai * HALF + m * 16) * ldc + col0;
#pragma unroll
                for (int bj = 0; bj < 2; ++bj)
#pragma unroll
                    for (int n = 0; n < 2; ++n) *(f32x4*)(rowp + bj * HALF + n * 16) = acc[ai][bj][m][n]; }
    }
};
struct EpiSwiGLU {
    static constexpr bool PERM = true, AFTER_DRAIN = false;
    bf16_t* O; int ldc;
    __device__ __forceinline__ void operator()(const f32x4 (&acc)[2][2][4][2], const Unit& u, int wr, int wc, int fr, int fq) const {
        const int row0 = u.pm * BM + wr * 64 + fr, col0 = u.pn * HALF + wc * 32 + 8 * fq;
#pragma unroll
        for (int ai = 0; ai < 2; ++ai)
#pragma unroll
            for (int m = 0; m < 4; ++m) { bf16_t* rowp = O + (size_t)(row0 + ai * HALF + m * 16) * ldc + col0;
                const f32x4 g0 = acc[ai][0][m][0], g1 = acc[ai][0][m][1], u0 = acc[ai][1][m][0], u1 = acc[ai][1][m][1];
                f32x4 v0, v1;
#pragma unroll
                for (int j = 0; j < 4; ++j) { v0[j] = silu_f(g0[j]) * u0[j]; v1[j] = silu_f(g1[j]) * u1[j]; }
                u32x4 w; w.x = cvt_pk_bf16(v0[0], v0[1]); w.y = cvt_pk_bf16(v0[2], v0[3]); w.z = cvt_pk_bf16(v1[0], v1[1]); w.w = cvt_pk_bf16(v1[2], v1[3]);
                st16(rowp, w); }
    }
};

template <bool I8> struct EpiHgrn {
    static constexpr bool PERM = true, AFTER_DRAIN = false;
    bf16_t* base; bf16_t* KH; const float* lb; const float* sa; const float* sw;
    __device__ __forceinline__ void operator()(const typename AccT<I8>::type (&acc)[2][2][4][2], const Unit& u, int wr, int wc, int fr, int fq) const {
        const int row0 = u.pm * BM + wr * 64 + fr, sec = u.pn >> 4, cs0 = (u.pn & 15) * BM + wc * 32 + 8 * fq;
        f32x4 lbv[2][2], swv[2][2];
#pragma unroll
        for (int bj = 0; bj < 2; ++bj)
#pragma unroll
            for (int n = 0; n < 2; ++n) { lbv[bj][n] = (sec == 1) ? *(const f32x4*)(lb + cs0 + bj * HALF + 4 * n) : (f32x4){0.f, 0.f, 0.f, 0.f};
                swv[bj][n] = I8 ? *(const f32x4*)(sw + u.pn * BM + wc * 32 + 8 * fq + bj * HALF + 4 * n) : (f32x4){1.f, 1.f, 1.f, 1.f}; }
        bf16_t* const hm = base + (size_t)sec * ((size_t)16384 * 4096);
#pragma unroll
        for (int ai = 0; ai < 2; ++ai)
#pragma unroll
            for (int m = 0; m < 4; ++m) { const int r = row0 + ai * HALF + m * 16, bb = r >> 13, tt = r & 8191; const float sr = I8 ? sa[r] : 1.f;
#pragma unroll
                for (int bj = 0; bj < 2; ++bj) { f32x4 v[2]; u32x4 w;
#pragma unroll
                    for (int n = 0; n < 2; ++n)
#pragma unroll
                        for (int j = 0; j < 4; ++j) v[n][j] = I8 ? (float)acc[ai][bj][m][n][j] * (sr * swv[bj][n][j]) : (float)acc[ai][bj][m][n][j];
                    const size_t hoff = ((size_t)(bb * 32 + (u.pn & 15) * 2 + bj) * 8192 + tt) * 128 + wc * 32 + 8 * fq;
                    if (sec == 1) { f32x4 kk[2];
#pragma unroll
                        for (int n = 0; n < 2; ++n)
#pragma unroll
                            for (int j = 0; j < 4; ++j) { const float fg = lbv[bj][n][j] + (1.f - lbv[bj][n][j]) * __builtin_amdgcn_rcpf(1.0f + __expf(-v[n][j])); kk[n][j] = 1.f - fg; v[n][j] = __logf(fg); }
                        u32x4 kw; kw.x = cvt_pk_bf16(kk[0][0], kk[0][1]); kw.y = cvt_pk_bf16(kk[0][2], kk[0][3]); kw.z = cvt_pk_bf16(kk[1][0], kk[1][1]); kw.w = cvt_pk_bf16(kk[1][2], kk[1][3]);
                        st16(KH + hoff, kw);
                    } else if (sec == 0) {
#pragma unroll
                        for (int n = 0; n < 2; ++n)
#pragma unroll
                            for (int j = 0; j < 4; ++j) v[n][j] = silu_f(v[n][j]) * 0.08838834764831845f;
                    } else if (sec == 3) {
#pragma unroll
                        for (int n = 0; n < 2; ++n)
#pragma unroll
                            for (int j = 0; j < 4; ++j) v[n][j] = silu_f(v[n][j]);
                    }
                    w.x = cvt_pk_bf16(v[0][0], v[0][1]); w.y = cvt_pk_bf16(v[0][2], v[0][3]); w.z = cvt_pk_bf16(v[1][0], v[1][1]); w.w = cvt_pk_bf16(v[1][2], v[1][3]);
                    st16(hm + ((sec == 3) ? ((size_t)r * 4096 + cs0 + bj * HALF) : hoff), w); } }
    }
};
struct EpiSwiGLU8 {
    static constexpr bool PERM = true, AFTER_DRAIN = false;
    bf16_t* O; int ldc; const float* sa; const float* sw; bf16_t* O2;
    __device__ __forceinline__ EpiSwiGLU8 alt() const { EpiSwiGLU8 e = *this; e.O = O2; return e; }
    __device__ __forceinline__ void operator()(const i32x4 (&acc)[2][2][4][2], const Unit& u, int wr, int wc, int fr, int fq) const {
        const int row0 = u.pm * BM + wr * 64 + fr, col0 = u.pn * HALF + wc * 32 + 8 * fq, brow0 = u.pn * BM + wc * 32 + 8 * fq;
        f32x4 sg[2], su[2];
#pragma unroll
        for (int n = 0; n < 2; ++n) { sg[n] = *(const f32x4*)(sw + brow0 + 4 * n); su[n] = *(const f32x4*)(sw + brow0 + HALF + 4 * n); }
#pragma unroll
        for (int ai = 0; ai < 2; ++ai)
#pragma unroll
            for (int m = 0; m < 4; ++m) { const int r = row0 + ai * HALF + m * 16; const float sr = sa[r]; bf16_t* rowp = O + (size_t)r * ldc + col0;
                f32x4 v[2];
#pragma unroll
                for (int n = 0; n < 2; ++n)
#pragma unroll
                    for (int j = 0; j < 4; ++j) { const float gt = (float)acc[ai][0][m][n][j] * (sr * sg[n][j]), up = (float)acc[ai][1][m][n][j] * (sr * su[n][j]); v[n][j] = silu_f(gt) * up; }
                u32x4 w; w.x = cvt_pk_bf16(v[0][0], v[0][1]); w.y = cvt_pk_bf16(v[0][2], v[0][3]); w.z = cvt_pk_bf16(v[1][0], v[1][1]); w.w = cvt_pk_bf16(v[1][2], v[1][3]);
                st16(rowp, w); }
    }
};

template <bool I8> struct EpiHgrn2 {
    static constexpr bool PERM = true, AFTER_DRAIN = false;
    bf16_t* base; bf16_t* KH; const float* lb; const float* sa; const float* sw;
    __device__ __forceinline__ void operator()(const typename AccT<I8>::type (&acc)[2][2][4][2], const Unit& u, int wr, int wc, int fr, int fq) const {
        typedef unsigned u32x2 __attribute__((ext_vector_type(2)));
        const int row0 = u.pm * BM + wr * 64 + fr, head = u.pn >> 1, ch0 = 64 * (u.pn & 1) + 16 * wc + 4 * fq;
        const f32x4 lbv = *(const f32x4*)(lb + head * 128 + ch0);
        f32x4 swv[2][2];
#pragma unroll
        for (int bj = 0; bj < 2; ++bj)
#pragma unroll
            for (int n = 0; n < 2; ++n) swv[bj][n] = I8 ? *(const f32x4*)(sw + u.pn * BM + wc * 32 + 8 * fq + bj * HALF + 4 * n) : (f32x4){1.f, 1.f, 1.f, 1.f};
        const size_t MD = (size_t)16384 * 4096;
#pragma unroll
        for (int ai = 0; ai < 2; ++ai)
#pragma unroll
            for (int m = 0; m < 4; ++m) { const int r = row0 + ai * HALF + m * 16, bb = r >> 13, tt = r & 8191; const float sr = I8 ? sa[r] : 1.f;
                f32x4 v[2][2];
#pragma unroll
                for (int bj = 0; bj < 2; ++bj)
#pragma unroll
                    for (int n = 0; n < 2; ++n)
#pragma unroll
                        for (int j = 0; j < 4; ++j) v[bj][n][j] = I8 ? (float)acc[ai][bj][m][n][j] * (sr * swv[bj][n][j]) : (float)acc[ai][bj][m][n][j];
                const size_t hoff = ((size_t)(bb * 32 + head) * 8192 + tt) * 128 + ch0;
                f32x4 qv, lf, kk, sg;
#pragma unroll
                for (int j = 0; j < 4; ++j) { qv[j] = silu_f(v[0][0][j]) * 0.08838834764831845f;
                    const float fg = lbv[j] + (1.f - lbv[j]) * __builtin_amdgcn_rcpf(1.0f + __expf(-v[0][1][j])); kk[j] = 1.f - fg; lf[j] = __logf(fg); sg[j] = silu_f(v[1][1][j]); }
                *(u32x2*)(base + hoff) = (u32x2){cvt_pk_bf16(qv[0], qv[1]), cvt_pk_bf16(qv[2], qv[3])};
                *(u32x2*)(base + MD + hoff) = (u32x2){cvt_pk_bf16(lf[0], lf[1]), cvt_pk_bf16(lf[2], lf[3])};
                *(u32x2*)(KH + hoff) = (u32x2){cvt_pk_bf16(kk[0], kk[1]), cvt_pk_bf16(kk[2], kk[3])};
                *(u32x2*)(base + 2 * MD + hoff) = (u32x2){cvt_pk_bf16(v[1][0][0], v[1][0][1]), cvt_pk_bf16(v[1][0][2], v[1][0][3])};
                *(u32x2*)(base + 3 * MD + (size_t)r * 4096 + head * 128 + ch0) = (u32x2){cvt_pk_bf16(sg[0], sg[1]), cvt_pk_bf16(sg[2], sg[3])}; }
    }
};

#define PG8_DPP_SHR(x, n) __builtin_bit_cast(float, __builtin_amdgcn_update_dpp(0, __builtin_bit_cast(int, (x)), 0x110 + (n), 0xf, 0xf, false))
#define PG8_DPP_PERM(x, ctrl) __builtin_bit_cast(float, __builtin_amdgcn_update_dpp(0, __builtin_bit_cast(int, (x)), (ctrl), 0xf, 0xf, true))
__device__ __forceinline__ float row_sum16(float x) { x += PG8_DPP_PERM(x, 0x140); x += PG8_DPP_PERM(x, 0x141); x += PG8_DPP_PERM(x, 0xB1); x += PG8_DPP_PERM(x, 0x4E); return x; }
__device__ __forceinline__ float row_scan16(float x) { x += PG8_DPP_SHR(x, 1); x += PG8_DPP_SHR(x, 2); x += PG8_DPP_SHR(x, 4); x += PG8_DPP_SHR(x, 8); return x; }
template <bool I8> struct EpiHgrn3 {
    static constexpr bool PERM = true, AFTER_DRAIN = false;
    bf16_t* QR; size_t dKR, dVH, dSG;     float* EL; float* DEC; float* ER; const float* lb; const float* sa; const float* sw;
    __device__ __forceinline__ void operator()(const typename AccT<I8>::type (&acc)[2][2][4][2], const Unit& u, int wr, int wc, int fr, int fq) const {
        typedef unsigned u32x2 __attribute__((ext_vector_type(2)));
        const int lane = fr + 16 * fq, row0 = u.pm * BM + wr * 64 + fr, head = u.pn >> 1, ch0 = 64 * (u.pn & 1) + 16 * wc + 4 * fq;
        const f32x4 lbv = *(const f32x4*)(lb + head * 128 + ch0);
        f32x4 swv[2][2];
#pragma unroll
        for (int bj = 0; bj < 2; ++bj)
#pragma unroll
            for (int n = 0; n < 2; ++n) swv[bj][n] = I8 ? *(const f32x4*)(sw + u.pn * BM + wc * 32 + 8 * fq + bj * HALF + 4 * n) : (f32x4){1.f, 1.f, 1.f, 1.f};
#pragma unroll
        for (int ai = 0; ai < 2; ++ai) {
            f32x4 qv[4], lf[4], kk[4];
#pragma unroll
            for (int m = 0; m < 4; ++m) { const int r = row0 + ai * HALF + m * 16, bb = r >> 13, tt = r & 8191; const float sr = I8 ? sa[r] : 1.f;
                f32x4 v[2][2];
#pragma unroll
                for (int bj = 0; bj < 2; ++bj)
#pragma unroll
                    for (int n = 0; n < 2; ++n) { if constexpr (I8) v[bj][n] = __builtin_convertvector(acc[ai][bj][m][n], f32x4) * (swv[bj][n] * sr); else v[bj][n] = acc[ai][bj][m][n]; }
#pragma unroll
                for (int j = 0; j < 4; ++j) { qv[m][j] = silu_f(v[0][0][j]) * 0.08838834764831845f;
                    const float fg = lbv[j] + (1.f - lbv[j]) * __builtin_amdgcn_rcpf(1.0f + __expf(-v[0][1][j])); kk[m][j] = 1.f - fg; lf[m][j] = __builtin_amdgcn_logf(fg) * 0.6931471805599453f; }
                { const u32x2 p0 = __builtin_amdgcn_permlane16_swap(cvt_pk_bf16(v[1][0][0], v[1][0][1]), cvt_pk_bf16(v[1][1][0], v[1][1][1]), false, false);
                  const u32x2 p1 = __builtin_amdgcn_permlane16_swap(cvt_pk_bf16(v[1][0][2], v[1][0][3]), cvt_pk_bf16(v[1][1][2], v[1][1][3]), false, false);
                  const size_t doff = (fq & 1) ? (dSG + (size_t)r * 4096 + head * 128 + (ch0 - 4)) : (dVH + ((size_t)(bb * 32 + head) * 8192 + tt) * 128 + ch0);
                  *(u32x4*)(QR + doff) = (u32x4){p0.x, p1.x, p0.y, p1.y}; } }
            f32x4 bb[4], run = (f32x4){0.f, 0.f, 0.f, 0.f}, bref = run;
#pragma unroll
            for (int m = 0; m < 4; ++m) { f32x4 inc, tot;
#pragma unroll
                for (int j = 0; j < 4; ++j) { inc[j] = row_scan16(lf[m][j]); tot[j] = __shfl(inc[j], lane | 15); }
                bb[m] = inc + run; run = run + tot; if (m == 1) bref = run; }
            const int rb = u.pm * BM + ai * HALF + wr * 64; const size_t cid = (size_t)((rb >> 13) * 32 + head) * 128 + ((rb & 8191) >> 6);
#pragma unroll
            for (int m = 0; m < 4; ++m) { f32x4 qr, kr;
#pragma unroll
                for (int j = 0; j < 4; ++j) { const float e1 = __expf(bb[m][j] - bref[j]); qr[j] = qv[m][j] * e1; kr[j] = kk[m][j] * __builtin_amdgcn_rcpf(e1); }
                const size_t off = cid * 8704 + (size_t)(16 * m + fr) * 136 + (ch0 & ~7);
                const u32x2 p0 = __builtin_amdgcn_permlane16_swap(cvt_pk_bf16(qr[0], qr[1]), cvt_pk_bf16(kr[0], kr[1]), false, false);
                const u32x2 p1 = __builtin_amdgcn_permlane16_swap(cvt_pk_bf16(qr[2], qr[3]), cvt_pk_bf16(kr[2], kr[3]), false, false);
                *(u32x4*)(QR + off + ((fq & 1) ? dKR : (size_t)0)) = (u32x4){p0.x, p1.x, p0.y, p1.y}; }
            if (fr == 0) { f32x4 el, dc, er;
#pragma unroll
                for (int j = 0; j < 4; ++j) { el[j] = __expf(run[j] - bref[j]); dc[j] = __expf(run[j]); er[j] = __expf(bref[j]); }
                *(f32x4*)(EL + cid * 128 + ch0) = el; *(f32x4*)(DEC + cid * 128 + ch0) = dc; *(f32x4*)(ER + cid * 128 + ch0) = er; }
        }
    }
};

struct EpiSwiGLU8R {
    static constexpr bool PERM = true, AFTER_DRAIN = false;
    bf16_t* O; int ldc; const float* sa; const float* sw; unsigned* rmax;
    __device__ __forceinline__ void operator()(const i32x4 (&acc)[2][2][4][2], const Unit& u, int wr, int wc, int fr, int fq) const {
        const int row0 = u.pm * BM + wr * 64 + fr, col0 = u.pn * HALF + wc * 32 + 8 * fq, brow0 = u.pn * BM + wc * 32 + 8 * fq;
        f32x4 sg[2], su[2];
#pragma unroll
        for (int n = 0; n < 2; ++n) { sg[n] = *(const f32x4*)(sw + brow0 + 4 * n); su[n] = *(const f32x4*)(sw + brow0 + HALF + 4 * n); }
#pragma unroll
        for (int ai = 0; ai < 2; ++ai)
#pragma unroll
            for (int m = 0; m < 4; ++m) { const int r = row0 + ai * HALF + m * 16; const float sr = sa[r], sru = MK_FFO_ROT ? sr * 0.17677669529663687f : sr; bf16_t* rowp = O + (size_t)r * ldc + col0;
                f32x2 X[4];
#pragma unroll
                for (int n = 0; n < 2; ++n)
#pragma unroll
                    for (int j = 0; j < 4; ++j) { const float gt = (float)acc[ai][0][m][n][j] * (sr * sg[n][j]), up = (float)acc[ai][1][m][n][j] * (sru * su[n][j]); X[2 * n + (j >> 1)][j & 1] = silu_f(gt) * up; }
#if MK_FFO_ROT
#pragma unroll
                for (int k = 0; k < 4; ++k) { const float a = X[k].x, b = X[k].y; X[k] = (f32x2){a + b, a - b}; }
                { f32x2 a = X[0], b = X[1]; X[0] = a + b; X[1] = a - b; a = X[2]; b = X[3]; X[2] = a + b; X[3] = a - b; }
                { f32x2 a = X[0], b = X[2]; X[0] = a + b; X[2] = a - b; a = X[1]; b = X[3]; X[1] = a + b; X[3] = a - b; }
                { float x0 = X[0].x, x1 = X[0].y, x2 = X[1].x, x3 = X[1].y, x4 = X[2].x, x5 = X[2].y, x6 = X[3].x, x7 = X[3].y;
                  asm volatile("v_nop\n\tv_nop\n\tv_permlane16_swap_b32 %0, %4\n\tv_permlane16_swap_b32 %1, %5\n\tv_permlane16_swap_b32 %2, %6\n\tv_permlane16_swap_b32 %3, %7\n\ts_nop 1"
                               : "+v"(x0), "+v"(x1), "+v"(x2), "+v"(x3), "+v"(x4), "+v"(x5), "+v"(x6), "+v"(x7));
                  { const f32x2 a = (f32x2){x0, x1}, b = (f32x2){x4, x5}, c = (f32x2){x2, x3}, d = (f32x2){x6, x7}; X[0] = a + b; X[2] = a - b; X[1] = c + d; X[3] = c - d; }
                  x0 = X[0].x; x1 = X[0].y; x2 = X[1].x; x3 = X[1].y; x4 = X[2].x; x5 = X[2].y; x6 = X[3].x; x7 = X[3].y;
                  asm volatile("v_nop\n\tv_nop\n\tv_permlane32_swap_b32 %0, %2\n\tv_permlane32_swap_b32 %1, %3\n\tv_permlane32_swap_b32 %4, %6\n\tv_permlane32_swap_b32 %5, %7\n\ts_nop 1"
                               : "+v"(x0), "+v"(x1), "+v"(x2), "+v"(x3), "+v"(x4), "+v"(x5), "+v"(x6), "+v"(x7));
                  { const f32x2 a = (f32x2){x0, x1}, b = (f32x2){x2, x3}, c = (f32x2){x4, x5}, d = (f32x2){x6, x7}; X[0] = a + b; X[1] = a - b; X[2] = c + d; X[3] = c - d; } }
#endif
                u32x4 w; w.x = cvt_pk_bf16(X[0].x, X[0].y); w.y = cvt_pk_bf16(X[1].x, X[1].y); w.z = cvt_pk_bf16(X[2].x, X[2].y); w.w = cvt_pk_bf16(X[3].x, X[3].y);
                st16nt(rowp, w);
                float am = fmaxf(fmaxf(fmaxf(fabsf(X[0].x), fabsf(X[0].y)), fmaxf(fabsf(X[1].x), fabsf(X[1].y))), fmaxf(fmaxf(fabsf(X[2].x), fabsf(X[2].y)), fmaxf(fabsf(X[3].x), fabsf(X[3].y))));
                am = fmaxf(am, __shfl_xor(am, 16)); am = fmaxf(am, __shfl_xor(am, 32));
                if (fq == 0) __hip_atomic_fetch_max(rmax + r, cvt_pk_bf16(am, am) << 16, __ATOMIC_RELAXED, __HIP_MEMORY_SCOPE_AGENT); }
    }
};
template <class Epi, class Sched, bool ALIGN_EPI = false, bool SP2 = false, bool I8 = false, int KREP = 1, int EREP = 1, bool TM = false, int TCH = 0, int LT = 0>
__device__ __forceinline__ void gemm_phase(PG8_LAS unsigned char* lds, const Gemm g, const Sched& S, const Epi& E) {
    const int tid = threadIdx.x, wid = __builtin_amdgcn_readfirstlane(tid >> 6), lane = tid & 63, wr = wid >> 2, wc = wid & 3, fr = lane & 15, fq = lane >> 4;
    const int K = g.K, nt = K / BK;
    unsigned voffA[2], voffB[2];
#pragma unroll
    for (int i = 0; i < 2; ++i) { int R, C; stage_rc(tid * 16 + i * 8192, R, C); const int Rb = Epi::PERM ? ((R & ~31) + perm32(R & 31)) : R;
        voffA[i] = TM ? (unsigned)(tid * 16 + i * 8192) : (unsigned)(R * K + C) * 2u; voffB[i] = TM ? (unsigned)(tid * 16 + i * 8192) : (unsigned)(Rb * K + C) * 2u; }
    const size_t kstep = TM ? (size_t)32768 : (size_t)(BK * 2);
    const size_t hstep = TM ? (size_t)16384 : (size_t)HALF * K * 2;
    const size_t tstep = TM ? (size_t)nt * 32768 : 2 * hstep;
    const unsigned ldsw = (unsigned)wid * 1024u;
    const int aoff = lds_byte(wr * 64 + fr, fq * 8), boff = lds_byte(wc * 32 + fr, fq * 8);
#define PG8_SA(b, h) (((b) * 2 + (h)) * HTB)
#define PG8_SB(b, h) ((4 + (b) * 2 + (h)) * HTB)
#define PG8_STAGE(bufoff, gbase, voff) do { _Pragma("unroll") for (int _i = 0; _i < 2; ++_i) \
        __builtin_amdgcn_global_load_lds((const unsigned*)((const char*)(gbase) + (voff)[_i]), (PG8_LAS unsigned*)(lds + (bufoff) + ldsw + _i * 8192), 16, 0, 0); } while (0)
#define PG8_LDA(dst, b, h) do { _Pragma("unroll") for (int m = 0; m < 4; ++m) _Pragma("unroll") for (int k = 0; k < 2; ++k) dst[m][k] = *(const PG8_LAS bf16x8*)(lds + PG8_SA(b, h) + aoff + m * 2048 + k * 1024); } while (0)
#define PG8_LDB(dst, b, h) do { _Pragma("unroll") for (int n = 0; n < 2; ++n) _Pragma("unroll") for (int k = 0; k < 2; ++k) dst[n][k] = *(const PG8_LAS bf16x8*)(lds + PG8_SB(b, h) + boff + n * 2048 + k * 1024); } while (0)
#ifndef PG8_PRIO
#define PG8_PRIO 1
#endif
#define PG8_MMA(ai, bj, At, Bt) do { if (PG8_PRIO) __builtin_amdgcn_s_setprio(PG8_PRIO); _Pragma("unroll") for (int m = 0; m < 4; ++m) _Pragma("unroll") for (int n = 0; n < 2; ++n) _Pragma("unroll") for (int k = 0; k < 2; ++k) \
        acc[ai][bj][m][n] = mma16(Bt[n][k], At[m][k], acc[ai][bj][m][n]); if (PG8_PRIO) __builtin_amdgcn_s_setprio(0); } while (0)
#define PG8_WAIT_V(n) asm volatile("s_waitcnt vmcnt(" #n ")" ::: "memory")
#define PG8_WAIT_L(n) asm volatile("s_waitcnt lgkmcnt(" #n ")" ::: "memory")
#define PG8_BAR __builtin_amdgcn_s_barrier()
#define PG8_SCHED __builtin_amdgcn_sched_barrier(0)
#define PG8_TOUCH(uidx) do { if constexpr (TCH > 0) { Unit tu_; if (S.next((uidx), tu_)) { const char* tb_ = (const char*)g.Bt + (size_t)tu_.pn * tstep; const unsigned sh_ = (unsigned)cur.pm & 63u; \
        for (int l_ = tid; l_ < nt * 4; l_ += 512) { const size_t o_ = TM ? ((size_t)sh_ * (size_t)(nt * 512) + (size_t)l_ * 128) : ((size_t)(4 * sh_ + l_ / nt) * (size_t)(nt * 128) + (size_t)(l_ % nt) * 128); \
            __builtin_amdgcn_global_load_lds((const unsigned*)(tb_ + o_), (PG8_LAS unsigned*)(lds + STAGE_BYTES + wid * 256), 4, 0, 0); } } } } while (0)
    const unsigned ltoff = (lane < 8) ? (unsigned)(wid * 1024 + lane * 128) : (unsigned)(wid * 512 + (lane - 8) * 128);
#define PG8_LTOUCH(abase, bbase) do { if constexpr (LT > 0) { if (lane < 12) { const char* tp_ = (lane < 8) ? ((abase) + ltA) : ((bbase) + ltB); \
        __builtin_amdgcn_global_load_lds((const unsigned*)(tp_ + ltoff), (PG8_LAS unsigned*)(lds + STAGE_BYTES + wid * 256), 4, 0, 0); } } } while (0)
#define PG8_WAIT_VS() do { if constexpr (LT > 0) PG8_WAIT_V(9); else PG8_WAIT_V(8); } while (0)
    Unit cur, nxt; int ui = 0;
    if (!S.next(0, cur)) return;
    typedef typename AccT<I8>::type acc_t;
    acc_t acc[2][2][4][2];
#pragma unroll
    for (int a = 0; a < 2; ++a)
#pragma unroll
        for (int b = 0; b < 2; ++b)
#pragma unroll
            for (int m = 0; m < 4; ++m)
#pragma unroll
                for (int n = 0; n < 2; ++n) acc[a][b][m][n] = AccT<I8>::zero();
    bf16x8 At[4][2], B0[2][2], B1[2][2];
    const char* cA = (const char*)g.A + (size_t)cur.pm * tstep; const char* cB = (const char*)g.Bt + (size_t)cur.pn * tstep;
    unsigned ltA = (unsigned)(cur.pn & 3) * 8192u, ltB = (unsigned)(cur.pm & 7) * 4096u;
    S.a_ready(cur);
    if constexpr (TCH > 0) { PG8_TOUCH(1); if constexpr (TCH > 1) PG8_TOUCH(2); }
    if constexpr (SP2) {
        PG8_STAGE(PG8_SB(0, 0), cB, voffB); PG8_STAGE(PG8_SB(0, 1), cB + hstep, voffB); PG8_STAGE(PG8_SA(0, 0), cA, voffA); PG8_STAGE(PG8_SA(0, 1), cA + hstep, voffA);
        if (wr == 1) PG8_BAR;
        PG8_WAIT_V(2); PG8_BAR;
        PG8_STAGE(PG8_SB(1, 0), cB + kstep, voffB); PG8_STAGE(PG8_SA(1, 0), cA + kstep, voffA); PG8_STAGE(PG8_SB(1, 1), cB + hstep + kstep, voffB);
        PG8_WAIT_V(6); PG8_BAR;
    } else {
        PG8_STAGE(PG8_SB(0, 0), cB, voffB); PG8_STAGE(PG8_SA(0, 0), cA, voffA); PG8_STAGE(PG8_SB(0, 1), cB + hstep, voffB); PG8_STAGE(PG8_SA(0, 1), cA + hstep, voffA);
        if (wr == 1) PG8_BAR;
        PG8_WAIT_V(4); PG8_BAR;
        PG8_STAGE(PG8_SB(1, 0), cB + kstep, voffB); PG8_STAGE(PG8_SA(1, 0), cA + kstep, voffA); PG8_STAGE(PG8_SB(1, 1), cB + hstep + kstep, voffB);
        PG8_WAIT_V(6); PG8_BAR;
    }
    for (;;) {
        const bool has_next = S.next(ui + 1, nxt);
        const char* nA = has_next ? (const char*)g.A + (size_t)nxt.pm * tstep : cA; const char* nB = has_next ? (const char*)g.Bt + (size_t)nxt.pn * tstep : cB;
        for (int krep = 0; krep < KREP; ++krep) {
        if (KREP > 1 && krep == KREP - 1 && krep > 0) {
_Pragma("unroll") for (int a = 0; a < 2; ++a) _Pragma("unroll") for (int b = 0; b < 2; ++b) _Pragma("unroll") for (int m = 0; m < 4; ++m) _Pragma("unroll") for (int n = 0; n < 2; ++n) acc[a][b][m][n] = AccT<I8>::zero(); }
        const char* nA2 = (krep == KREP - 1) ? nA : cA; const char* nB2 = (krep == KREP - 1) ? nB : cB;
        for (int t = 0; t < nt; t += 2) {
            const bool last = (t == nt - 2);
            const char* a1 = cA + (size_t)(t + 1) * kstep;
            const char* a2 = last ? nA2 : cA + (size_t)(t + 2) * kstep; const char* b2 = last ? nB2 : cB + (size_t)(t + 2) * kstep;
            const char* a3 = a2 + kstep; const char* b3 = b2 + kstep;
            const char *ta0 = cA, *tb0 = cB, *ta1 = cA, *tb1 = cB;
            if constexpr (LT > 0) { const int q0 = t + LT, q1 = t + 1 + LT;
                if (q0 < nt) { ta0 = cA + (size_t)q0 * kstep; tb0 = cB + (size_t)q0 * kstep; } else if (krep == KREP - 1 && has_next && q0 - nt < nt) { ta0 = nA + (size_t)(q0 - nt) * kstep; tb0 = nB + (size_t)(q0 - nt) * kstep; }
                if (q1 < nt) { ta1 = cA + (size_t)q1 * kstep; tb1 = cB + (size_t)q1 * kstep; } else if (krep == KREP - 1 && has_next && q1 - nt < nt) { ta1 = nA + (size_t)(q1 - nt) * kstep; tb1 = nB + (size_t)(q1 - nt) * kstep; } }
            if (last && has_next && krep == KREP - 1) S.a_ready(nxt);
            if constexpr (SP2) {
            PG8_LDB(B0, 0, 0); PG8_LDB(B1, 0, 1); PG8_SCHED; PG8_LDA(At, 0, 0); PG8_STAGE(PG8_SA(1, 1), a1 + hstep, voffA);
            PG8_WAIT_VS(); PG8_WAIT_L(0); PG8_BAR; PG8_MMA(0, 0, At, B0); PG8_MMA(0, 1, At, B1); PG8_BAR; PG8_SCHED;
            PG8_LDA(At, 0, 1); PG8_LTOUCH(ta0, tb0); PG8_STAGE(PG8_SB(0, 0), b2, voffB); PG8_STAGE(PG8_SB(0, 1), b2 + hstep, voffB); PG8_STAGE(PG8_SA(0, 0), a2, voffA);
            PG8_WAIT_VS(); PG8_WAIT_L(0); PG8_BAR; PG8_MMA(1, 0, At, B0); PG8_MMA(1, 1, At, B1); PG8_BAR; PG8_SCHED;
            PG8_LDB(B0, 1, 0); PG8_LDB(B1, 1, 1); PG8_SCHED; PG8_LDA(At, 1, 0); PG8_STAGE(PG8_SA(0, 1), a2 + hstep, voffA);
            PG8_WAIT_VS(); PG8_WAIT_L(0); PG8_BAR; PG8_MMA(0, 0, At, B0); PG8_MMA(0, 1, At, B1); PG8_BAR; PG8_SCHED;
            PG8_LDA(At, 1, 1); PG8_LTOUCH(ta1, tb1); PG8_STAGE(PG8_SB(1, 0), b3, voffB); PG8_STAGE(PG8_SB(1, 1), b3 + hstep, voffB); PG8_STAGE(PG8_SA(1, 0), a3, voffA);
            PG8_WAIT_VS(); PG8_WAIT_L(0); PG8_BAR; PG8_MMA(1, 0, At, B0); PG8_MMA(1, 1, At, B1); PG8_BAR; PG8_SCHED;
            } else {
            PG8_LDB(B0, 0, 0); PG8_SCHED; PG8_LDA(At, 0, 0); PG8_STAGE(PG8_SA(1, 1), a1 + hstep, voffA);
            PG8_WAIT_L(8); PG8_BAR; PG8_WAIT_L(0); PG8_MMA(0, 0, At, B0); PG8_BAR; PG8_SCHED;
            PG8_LDB(B1, 0, 1); PG8_STAGE(PG8_SB(0, 0), b2, voffB);
            PG8_BAR; PG8_WAIT_L(0); PG8_MMA(0, 1, At, B1); PG8_BAR;
            PG8_LDA(At, 0, 1); PG8_STAGE(PG8_SA(0, 0), a2, voffA);
            PG8_BAR; PG8_WAIT_L(0); PG8_MMA(1, 0, At, B0); PG8_BAR; PG8_SCHED;
            PG8_STAGE(PG8_SB(0, 1), b2 + hstep, voffB);
            PG8_WAIT_V(6); PG8_BAR; PG8_MMA(1, 1, At, B1); PG8_BAR;
            PG8_LDB(B0, 1, 0); PG8_SCHED; PG8_LDA(At, 1, 0); PG8_STAGE(PG8_SA(0, 1), a2 + hstep, voffA);
            PG8_WAIT_L(8); PG8_BAR; PG8_WAIT_L(0); PG8_MMA(0, 0, At, B0); PG8_BAR; PG8_SCHED;
            PG8_LDB(B1, 1, 1); PG8_STAGE(PG8_SB(1, 0), b3, voffB);
            PG8_BAR; PG8_WAIT_L(0); PG8_MMA(0, 1, At, B1); PG8_BAR;
            PG8_LDA(At, 1, 1); PG8_STAGE(PG8_SA(1, 0), a3, voffA);
            PG8_BAR; PG8_WAIT_L(0); PG8_MMA(1, 0, At, B0); PG8_BAR; PG8_SCHED;
            PG8_STAGE(PG8_SB(1, 1), b3 + hstep, voffB);
            PG8_WAIT_V(6); PG8_BAR; PG8_MMA(1, 1, At, B1); PG8_BAR;
            }
        }
        }
        if constexpr (ALIGN_EPI) { if (wr == 0) PG8_BAR; }
        if constexpr (!Epi::AFTER_DRAIN) { E(acc, cur, wr, wc, fr, fq); if constexpr (EREP > 1) { asm volatile("" ::: "memory"); E.alt()(acc, cur, wr, wc, fr, fq); } S.done(cur); PG8_TOUCH(ui + 1 + TCH); }
        if (!has_next) break;
#pragma unroll
        for (int a = 0; a < 2; ++a)
#pragma unroll
            for (int b = 0; b < 2; ++b)
#pragma unroll
                for (int m = 0; m < 4; ++m)
#pragma unroll
                    for (int n = 0; n < 2; ++n) acc[a][b][m][n] = AccT<I8>::zero();
        cur = nxt; cA = nA; cB = nB; ++ui; ltA = (unsigned)(cur.pn & 3) * 8192u; ltB = (unsigned)(cur.pm & 7) * 4096u;
        if constexpr (ALIGN_EPI) { if (wr == 1) PG8_BAR; }
    }
    PG8_WAIT_V(0);
    if constexpr (!ALIGN_EPI) { if (wr == 0) PG8_BAR; }
    PG8_BAR;
    if constexpr (Epi::AFTER_DRAIN) { E.fused(acc, cur, wr, wc, fr, fq, lds, wid, lane); S.done(cur); }
#undef PG8_TOUCH
#undef PG8_LTOUCH
#undef PG8_WAIT_VS
#undef PG8_SA
#undef PG8_SB
#undef PG8_STAGE
#undef PG8_LDA
#undef PG8_LDB
#undef PG8_MMA
#undef PG8_WAIT_V
#undef PG8_WAIT_L
#undef PG8_BAR
#undef PG8_SCHED
}
}
#ifndef PG8_SP2
#define PG8_SP2 true
#endif
#ifndef PG8_ALIGN
#define PG8_ALIGN true
#endif
constexpr int NWAVES = 8;
#ifndef MK_N_LAUNCHES
#define MK_N_LAUNCHES 1
#endif
#ifndef MK_HGRN_MFMA
#define MK_HGRN_MFMA 1
#endif
#ifndef MK_ATTN_MFMA
#define MK_ATTN_MFMA 1
#endif
constexpr bool HGRN_MFMA = MK_HGRN_MFMA, ATTN_MFMA = MK_ATTN_MFMA;
#ifndef MK_REP_GEMM
#define MK_REP_GEMM 1
#endif
#ifndef MK_REP_P0
#define MK_REP_P0 1
#endif
#ifndef MK_REP_ATT
#define MK_REP_ATT 1
#endif
#ifndef MK_REP_HG
#define MK_REP_HG 1
#endif
#ifndef MK_REP_NORM
#define MK_REP_NORM 1
#endif
constexpr int REP_GEMM = MK_REP_GEMM, REP_P0 = MK_REP_P0, REP_ATT = MK_REP_ATT, REP_HG = MK_REP_HG, REP_NORM = MK_REP_NORM;
#ifndef MK_FFN_I8
#define MK_FFN_I8 1
#endif
static_assert(MK_FFN_I8 == 1, "the workspace map overlays ACT on the bf16 FFN-in weight copies: int8 FFN path only");
#ifndef MK_HG_I8
#define MK_HG_I8 1
#endif
constexpr bool HG_I8 = MK_HG_I8;
#ifndef MK_ATT_I8
#define MK_ATT_I8 0
#endif
constexpr bool ATT_I8 = MK_ATT_I8;
constexpr bool FFN_I8 = MK_FFN_I8;
#ifndef MK_KREP_FFI
#define MK_KREP_FFI 1
#endif
#ifndef MK_EREP_FFI
#define MK_EREP_FFI 1
#endif
constexpr int EREP_FFI = MK_EREP_FFI;
#ifndef MK_REP_FFI
#define MK_REP_FFI 1
#endif
constexpr int REP_FFI = MK_REP_FFI;
constexpr int KREP_FFI = MK_KREP_FFI;
#ifndef MK_TM_FFI
#define MK_TM_FFI 1
#endif
constexpr bool TM_FFI = MK_TM_FFI;
#ifndef MK_TCH_FFI
#define MK_TCH_FFI 0
#endif
#ifndef MK_TCH_ALL
#define MK_TCH_ALL 0
#endif
constexpr int TCH_FFI = MK_TCH_FFI, TCH_ALL = MK_TCH_ALL;
#ifndef MK_LT_FFI
#define MK_LT_FFI 0
#endif
constexpr int LT_FFI = MK_LT_FFI;
#ifndef MK_HG_FUSE
#define MK_HG_FUSE 2
#endif
constexpr int HG_FUSE = MK_HG_FUSE;
#ifndef MK_REP_P8
#define MK_REP_P8 1
#endif
constexpr int REP_P8 = MK_REP_P8;
#ifndef MK_FFO_I8
#define MK_FFO_I8 1
#endif
#ifndef MK_FFO_ROT
#define MK_FFO_ROT 1
#endif
constexpr bool FFO_I8 = MK_FFO_I8;
#ifndef MK_REP_BAR
#define MK_REP_BAR 0
#endif
constexpr int REP_BAR = MK_REP_BAR;
#ifndef MK_NT_W
#define MK_NT_W 0
#endif
#if MK_NT_W
#define MK_LD_W(p) __builtin_nontemporal_load(p)
#else
#define MK_LD_W(p) (*(p))
#endif
#ifndef MK_P0_OVL
#define MK_P0_OVL 1
#endif
constexpr bool P0_OVL = MK_P0_OVL;
#ifndef MK_P0_STRIP
#define MK_P0_STRIP 1
#endif
constexpr bool P0_STRIP = MK_P0_STRIP;
#ifndef MK_HGO_I8
#define MK_HGO_I8 1
#endif
constexpr bool HGO_I8 = MK_HGO_I8;
constexpr int NPH = 16;
constexpr int N_LAUNCHES = MK_N_LAUNCHES;
static_assert(N_LAUNCHES == 1 || N_LAUNCHES == NPH, "MK_N_LAUNCHES is 1 or NPH");

constexpr int BATCH = 2, SEQ = 8192, DM = 4096, M = BATCH * SEQ, DFF = 11008, NQKV = 18432, NHG = 16384, DATT = 2048, HD = 128;
constexpr float RMS_EPS = 1e-6f;
constexpr float QSCALE = 0.08838834764831845f;

constexpr size_t MiB = 1u << 20;
constexpr size_t WS_CTL = 0, CTL_ZERO_BYTES = 1 * MiB;
constexpr size_t WS_TAB = 1 * MiB;
constexpr size_t WS_WATTI = 2 * MiB, WS_WATTO = 146 * MiB, WS_WHGI = 162 * MiB, WS_WHGO = 290 * MiB;
constexpr size_t WS_WFFI = 322 * MiB, WFFI_STRIDE = 172 * MiB, WS_WFFO = 666 * MiB, WFFO_STRIDE = 86 * MiB;
constexpr size_t WS_XN = 838 * MiB;
constexpr size_t WS_Y = 966 * MiB;
constexpr size_t WS_ACT = 322 * MiB;
constexpr size_t WS_ACT_OLD = 1222 * MiB;
constexpr size_t WS_QKV = 1566 * MiB;
constexpr size_t WS_MRG = 2142 * MiB;
constexpr size_t WS_OG = 2206 * MiB;
constexpr size_t WS_END = 2334 * MiB;
constexpr size_t WS_SA = WS_TAB + 128 * 1024, WS_SW = WS_TAB + 256 * 1024;
constexpr size_t WS_W8 = 1222 * MiB, W8_STRIDE = 86 * MiB, WS_W8H = 1394 * MiB, WS_END3 = 2529 * MiB;
constexpr size_t WS_SWH = WS_SW + 4 * 2 * 2 * DFF, WS_SWA = WS_SWH + 4 * NHG, WS_W8A = 1458 * MiB;
static_assert(WS_W8A + (size_t)NQKV * DM <= WS_QKV && WS_SWA + 4 * NQKV <= WS_WATTI, "int8 maps");
constexpr size_t WS_HB = 2529 * MiB, WS_END4 = 2657 * MiB;
constexpr size_t WS_W8O = 2657 * MiB, W8O_STRIDE = 43 * MiB, WS_END5 = 2743 * MiB, WS_SWO = WS_TAB + 640 * 1024, WS_SA2 = WS_TAB + 704 * 1024, WS_ACT8 = WS_QKV, WS_RMAX = WS_CTL + 512 * 1024;
constexpr size_t WS_W8G = 1530 * MiB, WS_SWG = WS_TAB + 768 * 1024, WS_SA3 = WS_TAB + 800 * 1024;
static_assert(WS_W8G + (size_t)DM * DM <= WS_QKV && WS_SA3 + 4 * M <= WS_WATTI, "HGO_I8 maps");
constexpr int CW_TMO = 0, CW_CODE = 1;
constexpr int CW_BAR = 4096;
constexpr int RING_OFF = 0, RING_BYTES = 131072;
constexpr int LDSCTL_OFF = 150528, MISC_OFF = LDSCTL_OFF + 320;
constexpr int LDS_BYTES = 152576;
static_assert(MISC_OFF + 128 <= LDS_BYTES, "LDS map");

#define GAS __attribute__((address_space(1)))
#define LAS __attribute__((address_space(3)))
typedef unsigned short bf16;
typedef unsigned v4u __attribute__((ext_vector_type(4)));
typedef unsigned v2u __attribute__((ext_vector_type(2)));
typedef float f32x4 __attribute__((ext_vector_type(4)));
typedef short bf16x8 __attribute__((ext_vector_type(8)));
typedef GAS unsigned gu32;
typedef GAS unsigned long long gu64;
#define RLX_AGENT __ATOMIC_RELAXED, __HIP_MEMORY_SCOPE_AGENT
#define LDS_WAIT() asm volatile("s_waitcnt lgkmcnt(0)" ::: "memory")
#define VM_WAIT() asm volatile("s_waitcnt vmcnt(0)" ::: "memory")
__device__ __forceinline__ unsigned f2bf(float f) { unsigned u = __builtin_bit_cast(unsigned, f); return (u + 0x7fffu + ((u >> 16) & 1u)) >> 16; }
__device__ __forceinline__ unsigned pk2(float lo, float hi) { return f2bf(lo) | (f2bf(hi) << 16); }
__device__ __forceinline__ unsigned cvtpk(float lo, float hi) { return pg8::cvt_pk_bf16(lo, hi); }
__device__ __forceinline__ float bflo(unsigned w) { return __builtin_bit_cast(float, w << 16); }
__device__ __forceinline__ float bfhi(unsigned w) { return __builtin_bit_cast(float, w & 0xffff0000u); }
#define XB_TMO      128
#define XB_XCNT(j)  (256  + 64 * (j))
#define XB_XSUB(j)  (1280 + 64 * (j))
#define XB_XGEN(j)  (2304 + 64 * (j))
#define XB_TOP      3328
#define XB_TOPGEN   3392
#define XCD_BAR_WORDS 3456
#define XB_SPIN_CAP (1u << 18)

__device__ __forceinline__ unsigned xb_ld(unsigned* p)              { return __hip_atomic_load(p, __ATOMIC_RELAXED, __HIP_MEMORY_SCOPE_AGENT); }
__device__ __forceinline__ unsigned xb_add(unsigned* p, unsigned v) { return __hip_atomic_fetch_add(p, v, __ATOMIC_RELAXED, __HIP_MEMORY_SCOPE_AGENT); }
__device__ __forceinline__ unsigned xb_xcc_id() { return (unsigned)__builtin_amdgcn_s_getreg((3 << 11) | 20) & 0xFu; }
#define XB_SPIN(cond, bar) do { unsigned _sp = 0; while (cond) { __builtin_amdgcn_s_sleep(1); \
    if ((++_sp & 255u) == 0u) { if (xb_ld(&(bar)[XB_TMO])) break; if (_sp > XB_SPIN_CAP) { atomicAdd(&(bar)[XB_TMO], 1u); break; } } } } while (0)

struct XcdBarrier {
    unsigned* bar; unsigned x;
    volatile LAS unsigned* st;
};

__device__ __forceinline__ XcdBarrier xcd_barrier_post(unsigned* bar, volatile LAS unsigned* st) {
    XcdBarrier b; b.bar = bar; b.x = xb_xcc_id(); b.st = st;
    if (threadIdx.x == 0) (void)xb_add(&bar[XB_XCNT(b.x)], 1u);
    return b;
}
__device__ __forceinline__ void xcd_barrier_complete(unsigned* bar, unsigned x, unsigned& nloc, unsigned& nx) {
    const unsigned G = gridDim.x * gridDim.y * gridDim.z;
    unsigned sum, cnt, mine, sp = 0u;
    for (;;) {
        sum = 0u; cnt = 0u; mine = 0u;
#pragma unroll
        for (unsigned j = 0; j < 16; ++j) { const unsigned c = xb_ld(&bar[XB_XCNT(j)]); sum += c; cnt += (c > 0u) ? 1u : 0u; mine = (j == x) ? c : mine; }
        if (sum == G) break;
        __builtin_amdgcn_s_sleep(1);
        if ((++sp & 255u) == 0u) { if (xb_ld(&bar[XB_TMO])) break; if (sp > XB_SPIN_CAP) { atomicAdd(&bar[XB_TMO], 1u); break; } }
    }
    nloc = mine > 0u ? mine : 1u; nx = cnt > 0u ? cnt : 1u;
}

__device__ __forceinline__ void xcd_barrier(const XcdBarrier& b) {
    asm volatile("s_waitcnt vmcnt(0)" ::: "memory");
    __syncthreads();
    if (threadIdx.x == 0) {
        unsigned* bar = b.bar;
        __builtin_amdgcn_s_waitcnt(0);
        unsigned nloc = b.st[0], nx = b.st[1];
        if (nloc == 0u) { xcd_barrier_complete(bar, b.x, nloc, nx); b.st[0] = nloc; b.st[1] = nx; }
        const unsigned old = xb_add(&bar[XB_XSUB(b.x)], 1u);
        const unsigned gen = old / nloc;
        if (old + 1u == (gen + 1u) * nloc) {
            __builtin_amdgcn_fence(__ATOMIC_RELEASE, "agent");
            asm volatile("s_waitcnt vmcnt(0)" ::: "memory");
            const unsigned og = xb_add(&bar[XB_TOP], 1u);
            const unsigned tg = og / nx;
            if (og + 1u == (tg + 1u) * nx) xb_add(&bar[XB_TOPGEN], 1u);
            else XB_SPIN(xb_ld(&bar[XB_TOPGEN]) == tg, bar);
            __builtin_amdgcn_fence(__ATOMIC_ACQUIRE, "agent");
            xb_add(&bar[XB_XGEN(b.x)], 1u);
            asm volatile("s_waitcnt vmcnt(0)" ::: "memory");
        } else {
            XB_SPIN(xb_ld(&bar[XB_XGEN(b.x)]) == gen, bar);
            __builtin_amdgcn_fence(__ATOMIC_ACQUIRE, "agent");
            asm volatile("s_waitcnt vmcnt(0)" ::: "memory");
        }
    }
    __syncthreads();
}
struct Frame {
    LAS unsigned char* lds;
    volatile LAS unsigned* MISC;
    gu32* ctl;
    int tid, lane, wave;
    int vcu, G;
    const float *x, *gains, *rel_bias, *w_att_in, *w_att_out, *w_hg_in, *lb_logits, *hg_gain, *w_hg_out, *w_ff_in, *w_ff_out;
    float* out;
    unsigned char* ws;
};
__device__ __forceinline__ float wave_sum(float v) {
#pragma unroll
    for (int o = 1; o < 64; o <<= 1) v += __shfl_xor(v, o);
    return v;
}
__device__ __forceinline__ void p0_transpose_item(const float* W, int K, int N, bf16* WT, int mode, LAS float* scr, int item, int lane) {
    const int nblk = N / 32, kb = item / nblk, nb = item % nblk, k0 = 64 * kb, n0 = 32 * nb;
    int r0 = n0;
    if (mode == 1) { const int c = (n0 < DFF) ? n0 : n0 - DFF; r0 = 256 * (c >> 7) + (c & 127) + ((n0 < DFF) ? 0 : 128); }
#pragma unroll
    for (int i = 0; i < 32; ++i) { const int kk = 2 * i + (lane >> 5); scr[kk * 33 + (lane & 31)] = MK_LD_W(W + (size_t)(k0 + kk) * N + n0 + (lane & 31)); }
    LDS_WAIT(); asm volatile("" ::: "memory");
    const int c = lane & 7;
#pragma unroll
    for (int j = 0; j < 4; ++j) { const int n = (lane >> 3) + 8 * j; const LAS float* s = scr + (8 * c) * 33 + n;
        v4u o; o.x = pk2(s[0 * 33], s[1 * 33]); o.y = pk2(s[2 * 33], s[3 * 33]); o.z = pk2(s[4 * 33], s[5 * 33]); o.w = pk2(s[6 * 33], s[7 * 33]);
        int row = r0 + n;
        if (mode == 2) { const int col = n0 + n, s = col >> 12, cc = col & 4095, c64 = cc & 63; row = 256 * (cc >> 6) + 128 * (s >> 1) + 32 * (c64 >> 4) + 8 * ((c64 >> 2) & 3) + 4 * (s & 1) + (c64 & 3); }
        *(GAS v4u*)(WT + (size_t)row * K + k0 + 8 * c) = o; }
    LDS_WAIT(); asm volatile("" ::: "memory");
}
__device__ __forceinline__ int t5_bucket(int dist) {
    if (dist < 16) return dist;
    int large = 16 + (int)(log((double)dist / 16.0) / log(128.0) * 16.0);
    return large < 31 ? large : 31;
}
template <bool HAS_Y, int XNM, bool HIB = false, bool HOB = false>
__device__ __forceinline__ void norm_rows(Frame& F, const void* hin, const bf16* y, void* hout, bf16* xn, const float* ga, const float* gb, float* sa = nullptr) {
    const int gw = F.vcu * NWAVES + F.wave, NGW = F.G * NWAVES;
    for (int m = gw; m < M; m += NGW) {
        f32x4 h[16];
        if (HIB) { const GAS v2u* hr = (const GAS v2u*)((const bf16*)hin + (size_t)m * DM) + F.lane;
#pragma unroll
            for (int j = 0; j < 16; ++j) { const v2u hw = hr[64 * j]; h[j] = (f32x4){bflo(hw.x), bfhi(hw.x), bflo(hw.y), bfhi(hw.y)}; }
        } else { const GAS f32x4* hr = (const GAS f32x4*)((const float*)hin + (size_t)m * DM) + F.lane;
#pragma unroll
            for (int j = 0; j < 16; ++j) h[j] = hr[64 * j]; }
        if (HAS_Y) {
            const GAS v2u* yr = (const GAS v2u*)(y + (size_t)m * DM) + F.lane;
            f32x4 yv[16]; float ss = 0.f;
#pragma unroll
            for (int j = 0; j < 16; ++j) { const v2u yw = yr[64 * j]; yv[j] = (f32x4){bflo(yw.x), bfhi(yw.x), bflo(yw.y), bfhi(yw.y)}; ss += (yv[j].x * yv[j].x + yv[j].y * yv[j].y) + (yv[j].z * yv[j].z + yv[j].w * yv[j].w); }
            const float rstd = 1.f / sqrtf(wave_sum(ss) * (1.f / DM) + RMS_EPS);
            GAS f32x4* ho = (GAS f32x4*)((float*)hout + (size_t)m * DM) + F.lane; GAS v2u* hob = (GAS v2u*)((bf16*)hout + (size_t)m * DM) + F.lane;
#pragma unroll
            for (int j = 0; j < 16; ++j) { const f32x4 g = ((const GAS f32x4*)ga)[64 * j + F.lane]; h[j] = h[j] + yv[j] * rstd * g;
                if (HOB) { const v2u hw = (v2u){cvtpk(h[j].x, h[j].y), cvtpk(h[j].z, h[j].w)}; hob[64 * j] = hw; h[j] = (f32x4){bflo(hw.x), bfhi(hw.x), bflo(hw.y), bfhi(hw.y)}; }
                else ho[64 * j] = h[j]; }
        }
        if (XNM != 0) {
            float s2 = 0.f;
#pragma unroll
            for (int j = 0; j < 16; ++j) s2 += (h[j].x * h[j].x + h[j].y * h[j].y) + (h[j].z * h[j].z + h[j].w * h[j].w);
            const float r2 = 1.f / sqrtf(wave_sum(s2) * (1.f / DM) + RMS_EPS);
            if (XNM == 1) {
                GAS v2u* o8 = (GAS v2u*)(xn + (size_t)m * DM) + F.lane;
#pragma unroll
                for (int j = 0; j < 16; ++j) { const f32x4 g = ((const GAS f32x4*)gb)[64 * j + F.lane]; const f32x4 v = h[j] * r2 * g;
                    v2u w; w.x = pk2(v.x, v.y); w.y = pk2(v.z, v.w); o8[64 * j] = w; }
            } else {
                float am = 0.f;
#pragma unroll
                for (int j = 0; j < 16; ++j) { const f32x4 g = ((const GAS f32x4*)gb)[64 * j + F.lane]; h[j] = h[j] * r2 * g;
                    am = fmaxf(fmaxf(am, fmaxf(fabsf(h[j].x), fabsf(h[j].y))), fmaxf(fabsf(h[j].z), fabsf(h[j].w))); }
#pragma unroll
                for (int o = 1; o < 64; o <<= 1) am = fmaxf(am, __shfl_xor(am, o));
                am = fmaxf(am, 1e-20f);
                const float qs = 127.f / am;
                GAS unsigned char* o1 = (GAS unsigned char*)xn; GAS unsigned* o4 = (GAS unsigned*)(o1 + (size_t)m * DM) + F.lane;
#pragma unroll
                for (int j = 0; j < 16; ++j) { const int q0 = (int)rintf(h[j].x * qs), q1 = (int)rintf(h[j].y * qs), q2 = (int)rintf(h[j].z * qs), q3 = (int)rintf(h[j].w * qs);
                    const unsigned qw = (unsigned)(q0 & 255) | ((unsigned)(q1 & 255) << 8) | ((unsigned)(q2 & 255) << 16) | ((unsigned)q3 << 24);
                    if (XNM == 3) *(GAS unsigned*)(o1 + pg8::tm_chunk_off(m, 256 * j + 4 * F.lane, DM / 128, false)) = qw; else o4[64 * j] = qw; }
                if (F.lane == 0) sa[m] = am * (1.f / 127.f);
            }
        }
    }
}
template <bool TMW> __device__ __forceinline__ void p0_quant_rows(Frame& F, const bf16* WT, unsigned char* W8, float* sw, int rows) {
    const int gw = F.vcu * NWAVES + F.wave, NGW = F.G * NWAVES;
    for (int r = gw; r < rows; r += NGW) {
        const GAS v4u* src = (const GAS v4u*)(WT + (size_t)r * DM) + F.lane;
        v4u c[8]; float am = 0.f;
#pragma unroll
        for (int i = 0; i < 8; ++i) { c[i] = src[64 * i];
#pragma unroll
            for (int j = 0; j < 4; ++j) am = fmaxf(am, fmaxf(fabsf(bflo(c[i][j])), fabsf(bfhi(c[i][j])))); }
#pragma unroll
        for (int o = 1; o < 64; o <<= 1) am = fmaxf(am, __shfl_xor(am, o));
        am = fmaxf(am, 1e-30f);
        const float qs = 127.f / am;
        GAS v2u* dst = (GAS v2u*)(W8 + (size_t)r * DM) + F.lane;
#pragma unroll
        for (int i = 0; i < 8; ++i) { unsigned w[2];
#pragma unroll
            for (int hf = 0; hf < 2; ++hf) { const int q0 = (int)rintf(bflo(c[i][2 * hf]) * qs), q1 = (int)rintf(bfhi(c[i][2 * hf]) * qs), q2 = (int)rintf(bflo(c[i][2 * hf + 1]) * qs), q3 = (int)rintf(bfhi(c[i][2 * hf + 1]) * qs);
                w[hf] = (unsigned)(q0 & 255) | ((unsigned)(q1 & 255) << 8) | ((unsigned)(q2 & 255) << 16) | ((unsigned)q3 << 24); }
            if (TMW) *(GAS v2u*)(W8 + pg8::tm_chunk_off(r, 8 * (F.lane + 64 * i), DM / 128, true)) = (v2u){w[0], w[1]}; else dst[64 * i] = (v2u){w[0], w[1]}; }
        if (F.lane == 0) sw[r] = am * (1.f / 127.f);
    }
}
#define DPP_QUAD(x, ctrl) __builtin_bit_cast(float, __builtin_amdgcn_update_dpp(0, __builtin_bit_cast(int, (x)), (ctrl), 0xf, 0xf, true))
__device__ __forceinline__ void fwht8(float (&x)[8]) {
#pragma unroll
    for (int s = 1; s < 8; s <<= 1)
#pragma unroll
        for (int i = 0; i < 8; ++i) if (!(i & s)) { const float a = x[i], b = x[i + s]; x[i] = a + b; x[i + s] = a - b; }
}
__device__ __forceinline__ void fwht32_quad(float (&x)[8], int lane) {
    fwht8(x);
    const float s1 = (lane & 1) ? -1.f : 1.f, s2 = (lane & 2) ? -1.f : 1.f;
#pragma unroll
    for (int i = 0; i < 8; ++i) { const float p = DPP_QUAD(x[i], 0xB1); x[i] = p + s1 * x[i]; }
#pragma unroll
    for (int i = 0; i < 8; ++i) { const float p = DPP_QUAD(x[i], 0x4E); x[i] = (p + s2 * x[i]) * 0.17677669529663687f; }
}
template <int KL> __device__ __forceinline__ void p0_quant_wout(Frame& F, const bf16* WT, unsigned char* W8, float* sw) {
    const int gw = F.vcu * NWAVES + F.wave, NGW = F.G * NWAVES;
    constexpr int NCH = KL / 8, NI = (NCH + 63) / 64;
    for (int r = gw; r < DM; r += NGW) {
        const GAS v4u* src = (const GAS v4u*)(WT + (size_t)r * KL);
        v4u c[NI]; float am = 0.f;
#pragma unroll
        for (int i = 0; i < NI; ++i) { const int ch = F.lane + 64 * i; c[i] = (ch < NCH) ? src[ch] : (v4u){0u, 0u, 0u, 0u}; }
#pragma unroll
        for (int i = 0; i < NI; ++i) { float x[8];
#pragma unroll
            for (int j = 0; j < 4; ++j) { x[2 * j] = bflo(c[i][j]); x[2 * j + 1] = bfhi(c[i][j]); }
#if MK_FFO_ROT
            fwht32_quad(x, F.lane);
#endif
#pragma unroll
            for (int j = 0; j < 4; ++j) { c[i][j] = cvtpk(x[2 * j], x[2 * j + 1]); am = fmaxf(am, fmaxf(fabsf(bflo(c[i][j])), fabsf(bfhi(c[i][j])))); } }
#pragma unroll
        for (int o = 1; o < 64; o <<= 1) am = fmaxf(am, __shfl_xor(am, o));
        am = fmaxf(am, 1e-30f);
        const float qs = 127.f / am;
#pragma unroll
        for (int i = 0; i < NI; ++i) { const int ch = F.lane + 64 * i; unsigned w[2];
#pragma unroll
            for (int hf = 0; hf < 2; ++hf) { const int q0 = (int)rintf(bflo(c[i][2 * hf]) * qs), q1 = (int)rintf(bfhi(c[i][2 * hf]) * qs), q2 = (int)rintf(bflo(c[i][2 * hf + 1]) * qs), q3 = (int)rintf(bfhi(c[i][2 * hf + 1]) * qs);
                w[hf] = (unsigned)(q0 & 255) | ((unsigned)(q1 & 255) << 8) | ((unsigned)(q2 & 255) << 16) | ((unsigned)q3 << 24); }
            if (ch < NCH) *(GAS v2u*)(W8 + (size_t)r * KL + 8 * ch) = (v2u){w[0], w[1]}; }
        if (F.lane == 0) sw[r] = am * (1.f / 127.f);
    }
}
__device__ __forceinline__ void act_quant_rows(Frame& F, const bf16* ACTp, unsigned char* A8, const unsigned* rmax, float* sa2) {
    const int gw = F.vcu * NWAVES + F.wave, NGW = F.G * NWAVES;
    constexpr int NCH = DFF / 8, NI = (NCH + 63) / 64;
    for (int m = gw; m < M; m += NGW) {
        const float am = fmaxf(__builtin_bit_cast(float, rmax[m]), 1e-30f), qs = 127.f / am;
        const GAS v4u* src = (const GAS v4u*)(ACTp + (size_t)m * DFF);
#pragma unroll 11
        for (int i = 0; i < NI; ++i) { const int ch = F.lane + 64 * i; if (ch < NCH) { const v4u c = src[ch]; unsigned w[2];
#pragma unroll
            for (int hf = 0; hf < 2; ++hf) { const int q0 = (int)rintf(bflo(c[2 * hf]) * qs), q1 = (int)rintf(bfhi(c[2 * hf]) * qs), q2 = (int)rintf(bflo(c[2 * hf + 1]) * qs), q3 = (int)rintf(bfhi(c[2 * hf + 1]) * qs);
                w[hf] = (unsigned)(q0 & 255) | ((unsigned)(q1 & 255) << 8) | ((unsigned)(q2 & 255) << 16) | ((unsigned)q3 << 24); }
            *(GAS v2u*)(A8 + (size_t)m * DFF + 8 * ch) = (v2u){w[0], w[1]}; } }
        if (F.lane == 0) sa2[m] = am * (1.f / 127.f);
    }
}
constexpr int ST_PITCH = 8200, ST_K = 4096, ST_CM_OFF = RING_OFF + 16 * ST_PITCH;
__device__ __forceinline__ void strip_rot4(float (&v)[32]) {
#pragma unroll
    for (int g = 0; g < 4; ++g)
#pragma unroll
        for (int st = 1; st < 8; st <<= 1)
#pragma unroll
            for (int a = 0; a < 8; ++a) if (!(a & st)) { const float x = v[8 * g + a], y = v[8 * g + a + st]; v[8 * g + a] = x + y; v[8 * g + a + st] = x - y; }
#pragma unroll
    for (int g = 0; g < 4; ++g) {
        asm volatile("v_nop\n\tv_nop\n\tv_permlane16_swap_b32 %0, %1\n\tv_permlane16_swap_b32 %2, %3\n\tv_permlane16_swap_b32 %4, %5\n\tv_permlane16_swap_b32 %6, %7\n\ts_nop 1"
                     : "+v"(v[8 * g + 0]), "+v"(v[8 * g + 1]), "+v"(v[8 * g + 2]), "+v"(v[8 * g + 3]), "+v"(v[8 * g + 4]), "+v"(v[8 * g + 5]), "+v"(v[8 * g + 6]), "+v"(v[8 * g + 7]));
#pragma unroll
        for (int a = 0; a < 8; a += 2) { const float x = v[8 * g + a], y = v[8 * g + a + 1]; v[8 * g + a] = x + y; v[8 * g + a + 1] = x - y; }
        asm volatile("v_nop\n\tv_nop\n\tv_permlane32_swap_b32 %0, %2\n\tv_permlane32_swap_b32 %1, %3\n\tv_permlane32_swap_b32 %4, %6\n\tv_permlane32_swap_b32 %5, %7\n\ts_nop 1"
                     : "+v"(v[8 * g + 0]), "+v"(v[8 * g + 1]), "+v"(v[8 * g + 2]), "+v"(v[8 * g + 3]), "+v"(v[8 * g + 4]), "+v"(v[8 * g + 5]), "+v"(v[8 * g + 6]), "+v"(v[8 * g + 7]));
#pragma unroll
        for (int a = 0; a < 8; ++a) if (!(a & 2)) { const float x = v[8 * g + a], y = v[8 * g + a + 2]; v[8 * g + a] = x + y; v[8 * g + a + 2] = x - y; }
    }
}
__device__ __forceinline__ unsigned q8bits(float x, float qs) { return __builtin_bit_cast(unsigned, fmaf(x, qs, 12582912.f)) & 255u; }
constexpr size_t WS_FOMAX = WS_CTL + 256 * 1024, WS_FOCNT = WS_FOMAX + 32 * 1024;
__device__ __forceinline__ void strip_desc(const Frame& F, int s, const float*& p, int& N, int& kind, int& l, int& c0, int& b0, int& nb, int& cgl) {
    constexpr int S_FO = 3 * (DM / 16), S_FI = 2 * DFF / 16, S_HI = NHG / 16;
    int r = s; b0 = 0; nb = 32; cgl = 0;
    if (r < 2 * S_FO) { cgl = r / 3; const int part = r - 3 * cgl; l = cgl / (DM / 16); kind = 0; N = DM; p = F.w_ff_out + (size_t)l * DFF * DM; c0 = 16 * (cgl - l * (DM / 16));
        b0 = 29 * part; nb = (part == 2) ? 28 : 29; return; } r -= 2 * S_FO;
    if (r < 2 * S_FI) { l = r / S_FI; r -= l * S_FI; kind = 1; N = 2 * DFF; p = F.w_ff_in + (size_t)l * DM * 2 * DFF; c0 = 16 * r; return; } r -= 2 * S_FI;
    if (r < S_HI) { l = 0; kind = 2; N = NHG; p = F.w_hg_in; c0 = 16 * r; return; } r -= S_HI;
    l = 0; kind = 3; N = DM; p = F.w_hg_out; c0 = 16 * r;
}
template <int KL, int N, bool ROT, bool TMW, int MODE, bool SYNC3, bool PERMK>
__device__ __forceinline__ void p0_strip(Frame& F, float (&v)[32], const float* src, const float* nsrc, int nN, int c0, int b0, int nb, int cgl, unsigned char* W8, float* sw, int par) {
    LAS unsigned char* st = F.lds + RING_OFF;
    LAS float* cm = (LAS float*)(F.lds + ST_CM_OFF) + par * 128;
    const int n = F.lane & 15, kq = F.lane >> 4;
    float mx = 0.f;
#pragma unroll 1
    for (int blk = b0 + F.wave; blk < b0 + nb; blk += NWAVES) {
        float x[32];
#pragma unroll
        for (int i = 0; i < 32; ++i) x[i] = v[i];
        const bool last = blk + NWAVES >= b0 + nb;
        const float* q = last ? nsrc : src + (size_t)(128 * (blk + NWAVES)) * N;
        const size_t step = (size_t)4 * (last ? nN : N);
#pragma unroll
        for (int i = 0; i < 32; ++i) v[i] = MK_LD_W(q + i * step);
        if (ROT) strip_rot4(x);
        LAS unsigned short* d = (LAS unsigned short*)(st + n * ST_PITCH + 256 * (blk - b0)) + (!ROT ? kq : PERMK ? 4 * (kq >> 1) + 8 * (kq & 1) : 4 * kq);
#pragma unroll
        for (int i = 0; i < 32; i += 2) { const unsigned w = cvtpk(x[i], x[i + 1]); mx = fmaxf(mx, fmaxf(fabsf(x[i]), fabsf(x[i + 1])));
            const int r3 = (i >> 1) & 1, r4 = (i >> 2) & 1;
            if (ROT) *(LAS unsigned*)(d + 32 * (i >> 3) + (PERMK ? 2 * r4 + 16 * r3 : 2 * r3 + 16 * r4)) = w;
            else { d[4 * i] = (unsigned short)w; d[4 * i + 4] = (unsigned short)(w >> 16); } }
    }
    mx = fmaxf(mx, __shfl_xor(mx, 16)); mx = fmaxf(mx, __shfl_xor(mx, 32));
    if (F.lane < 16) cm[F.wave * 16 + n] = mx;
    __syncthreads();
    float am = 1e-30f;
#pragma unroll
    for (int w = 0; w < NWAVES; ++w) am = fmaxf(am, cm[w * 16 + n]);
    am = bflo(cvtpk(am, am));
    if (SYNC3) {
        unsigned* gmax = (unsigned*)(F.ws + WS_FOMAX) + cgl * 16; unsigned* cnt = (unsigned*)(F.ws + WS_FOCNT) + cgl;
        if (F.tid < 16) am = fmaxf(am, __builtin_bit_cast(float, __hip_atomic_fetch_max(gmax + n, __builtin_bit_cast(unsigned, am), __ATOMIC_RELAXED, __HIP_MEMORY_SCOPE_AGENT)));
        if (F.wave == 0) { asm volatile("s_waitcnt vmcnt(0)" ::: "memory");
            if (F.tid == 0) { (void)xb_add(cnt, 1u); unsigned sp = 0; while (xb_ld(cnt) < 3u && ++sp < (1u << 22)) __builtin_amdgcn_s_sleep(1); } }
        __syncthreads();
        am = fmaxf(am, __builtin_bit_cast(float, xb_ld(gmax + n)));
    }
    const float qs = 127.f / am;
    const int col = c0 + n; int R = col;
    if (MODE == 1) { const int c = (col < DFF) ? col : col - DFF; R = 256 * (c >> 7) + (c & 127) + ((col < DFF) ? 0 : 128); }
    if (MODE == 2) { const int s = col >> 12, cc = col & 4095, c64 = cc & 63; R = 256 * (cc >> 6) + 128 * (s >> 1) + 32 * (c64 >> 4) + 8 * ((c64 >> 2) & 3) + 4 * (s & 1) + (c64 & 3); }
#pragma unroll 2
    for (int t = 0; t < 8; ++t) {
        const int c = 4 * (F.wave + NWAVES * t) + kq;
        if (c < 8 * nb) {
            const LAS v2u* s2 = (const LAS v2u*)(st + n * ST_PITCH + 32 * c);
            unsigned w[4];
#pragma unroll
            for (int j = 0; j < 4; ++j) { const v2u u = s2[j];
                w[j] = q8bits(bflo(u.x), qs) | (q8bits(bfhi(u.x), qs) << 8) | (q8bits(bflo(u.y), qs) << 16) | (q8bits(bfhi(u.y), qs) << 24); }
            const int kb = 128 * b0 + 16 * c;
            if (TMW) *(GAS v4u*)(W8 + pg8::tm_chunk_off(R, kb, KL / 128, true)) = (v4u){w[0], w[1], w[2], w[3]};
            else *(GAS v4u*)(W8 + (size_t)R * KL + kb) = (v4u){w[0], w[1], w[2], w[3]};
        }
    }
    if (F.tid < 16 && b0 == 0) sw[R] = am * (ROT ? 0.17677669529663687f / 127.f : 1.f / 127.f);
    __syncthreads();
}
#ifndef MK_P0_DEFER
#define MK_P0_DEFER 0
#endif
constexpr int SX_FO = 3 * (DM / 16), SX_FI = 2 * DFF / 16, SX_HI = NHG / 16, SX_HO = DM / 16, SX_ALL = 2 * SX_FO + 2 * SX_FI + SX_HI + SX_HO;
constexpr int DEF_FI = MK_P0_DEFER ? 640 : 0, DEF_FO = MK_P0_DEFER ? 213 : 0;
static_assert(DEF_FI <= SX_FI && 3 * DEF_FO <= SX_FO, "deferred strip counts");
__device__ __forceinline__ int strip_full_index(int lst, int j) {
    if (lst == 3) return j;
    if (lst == 4) return 2 * SX_FO + j;
    if (lst == 1) return 2 * SX_FO + SX_FI + j;
    if (lst == 2) return SX_FO + j;
    if (j < SX_FO) return j;
    j -= SX_FO; if (j < SX_FO - 3 * DEF_FO) return SX_FO + 3 * DEF_FO + j;
    j -= SX_FO - 3 * DEF_FO; if (j < SX_FI) return 2 * SX_FO + j;
    j -= SX_FI; if (j < SX_FI - DEF_FI) return 2 * SX_FO + SX_FI + DEF_FI + j;
    j -= SX_FI - DEF_FI; return 2 * SX_FO + 2 * SX_FI + j;
}
template <int LST> __device__ __forceinline__ void run_strips(Frame& F, int j0, int jstep) {
    constexpr int CNT = LST == 0 ? SX_ALL - 3 * DEF_FO - DEF_FI : LST == 1 ? DEF_FI : LST == 2 ? 3 * DEF_FO : LST == 3 ? 2 * SX_FO : SX_ALL - 2 * SX_FO;
    const int n = F.lane & 15, kq = F.lane >> 4;
    int j = j0, par = 0;
    if (j < 0 || j >= CNT) return;
    const float* p; int N, kind, l, c0, b0, nb, cgl;
    strip_desc(F, strip_full_index(LST, j), p, N, kind, l, c0, b0, nb, cgl);
    const float* src = p + (size_t)kq * N + c0 + n;
    float v[32];
    { const float* q = src + (size_t)(128 * (b0 + F.wave)) * N; const size_t step = (size_t)4 * N;
#pragma unroll
      for (int i = 0; i < 32; ++i) v[i] = MK_LD_W(q + i * step); }
#pragma unroll 1
    while (j < CNT) {
        const int jn = j + jstep;
        const float* pn; int Nn, kindn, ln, c0n, b0n, nbn, cgln;
        strip_desc(F, strip_full_index(LST, jn < CNT ? jn : j), pn, Nn, kindn, ln, c0n, b0n, nbn, cgln);
        const float* srcn = pn + (size_t)kq * Nn + c0n + n;
        const float* nsrc = srcn + (size_t)(128 * (b0n + F.wave)) * Nn;
        if (LST != 1 && LST != 4 && kind == 0) p0_strip<DFF, DM, true, false, 0, true, true>(F, v, src, nsrc, Nn, c0, b0, nb, cgl, F.ws + WS_W8O + l * W8O_STRIDE, (float*)(F.ws + WS_SWO) + l * DM, par);
        else if (LST != 2 && LST != 3 && kind == 1) p0_strip<DM, 2 * DFF, false, TM_FFI, 1, false, false>(F, v, src, nsrc, Nn, c0, 0, 32, 0, F.ws + WS_W8 + l * W8_STRIDE, (float*)(F.ws + WS_SW) + l * 2 * DFF, par);
        else if ((LST == 0 || LST == 4) && kind == 2) p0_strip<DM, NHG, false, false, 2, false, false>(F, v, src, nsrc, Nn, c0, 0, 32, 0, F.ws + WS_W8H, (float*)(F.ws + WS_SWH), par);
        else if (LST == 0 || LST == 4) p0_strip<DM, DM, true, false, 0, false, false>(F, v, src, nsrc, Nn, c0, 0, 32, 0, F.ws + WS_W8G, (float*)(F.ws + WS_SWG), par);
        j = jn; src = srcn; kind = kindn; l = ln; c0 = c0n; b0 = b0n; nb = nbn; cgl = cgln; par ^= 1;
    }
    asm volatile("s_waitcnt vmcnt(0)" ::: "memory");
    __syncthreads();
}
template <int LST> __device__ __forceinline__ void run_deferred_strips(Frame& F, int units) {
    if ((LST == 1 ? DEF_FI : 3 * DEF_FO) == 0) return;
    const int rem = units % F.G, bx = (int)blockIdx.x;
    asm volatile("s_waitcnt vmcnt(0)" ::: "memory"); __syncthreads();
    run_strips<LST>(F, rem == 0 ? bx : bx - rem, rem == 0 ? F.G : F.G - rem);
}
__device__ __forceinline__ void p0_prologue(Frame& F) {
    LAS float* scr = (LAS float*)(F.lds + RING_OFF + F.wave * 16384);
    const int gw = F.vcu * NWAVES + F.wave, NGW = F.G * NWAVES;
    constexpr int I0 = (DM / 64) * (NQKV / 32), I1 = (DATT / 64) * (DM / 32), I2 = (DM / 64) * (NHG / 32), I3 = (DM / 64) * (DM / 32), I4 = (DM / 64) * (2 * DFF / 32), I6 = (DFF / 64) * (DM / 32);
    constexpr int NITEMS = P0_STRIP ? I0 + I1 : I0 + I1 + I2 + I3 + 2 * I4 + 2 * I6;
    if (P0_STRIP) { if (P0_OVL) run_strips<3>(F, F.vcu, F.G); else run_strips<0>(F, F.vcu, F.G); }
    for (int it = gw; it < NITEMS; it += NGW) {
        int r = it;
        if (r < I0) { p0_transpose_item(F.w_att_in, DM, NQKV, (bf16*)(F.ws + WS_WATTI), 0, scr, r, F.lane); continue; } r -= I0;
        if (r < I1) { p0_transpose_item(F.w_att_out, DATT, DM, (bf16*)(F.ws + WS_WATTO), 0, scr, r, F.lane); continue; } r -= I1;
        if (r < I2) { p0_transpose_item(F.w_hg_in, DM, NHG, (bf16*)(F.ws + WS_WHGI), HG_FUSE ? 2 : 0, scr, r, F.lane); continue; } r -= I2;
        if (r < I3) { p0_transpose_item(F.w_hg_out, DM, DM, (bf16*)(F.ws + WS_WHGO), 0, scr, r, F.lane); continue; } r -= I3;
        if (r < 2 * I4) { const int l = r / I4; p0_transpose_item(F.w_ff_in + (size_t)l * DM * 2 * DFF, DM, 2 * DFF, (bf16*)(F.ws + WS_WFFI + l * WFFI_STRIDE), 1, scr, r - l * I4, F.lane); continue; } r -= 2 * I4;
        { const int l = r / I6; p0_transpose_item(F.w_ff_out + (size_t)l * DFF * DM, DFF, DM, (bf16*)(F.ws + WS_WFFO + l * WFFO_STRIDE), 0, scr, r - l * I6, F.lane); }
    }
    float* BT = (float*)(F.ws + WS_TAB); float* LB = (float*)(F.ws + WS_TAB + 65536);
    const int gt = blockIdx.x * (NWAVES * 64) + F.tid, NT = F.G * NWAVES * 64;
    for (int idx = gt; idx < 3 * 16 * 129; idx += NT) { const int g = idx / (16 * 129), rem = idx - g * 16 * 129, h = rem / 129, j = rem - h * 129;
        BT[idx] = F.rel_bias[t5_bucket(j << (2 * g)) * 48 + g * 16 + h]; }
    for (int c = gt; c < DM; c += NT) { const float l0 = F.lb_logits[c], l1 = F.lb_logits[DM + c]; LB[c] = 1.f / (1.f + expf(l0 - l1)); }
    norm_rows<false, ATT_I8 ? 2 : 1>(F, F.x, nullptr, nullptr, (bf16*)(F.ws + WS_XN), nullptr, F.gains, (float*)(F.ws + WS_SA));
}
__device__ __forceinline__ void attn_naive(Frame& F) {
    const int gw = F.vcu * NWAVES + F.wave, NGW = F.G * NWAVES;
    const bf16* QKV = (const bf16*)(F.ws + WS_QKV); bf16* MRG = (bf16*)(F.ws + WS_MRG); const float* BT = (const float*)(F.ws + WS_TAB);
    for (int item = gw; item < M * 16; item += NGW) {
        const int m = item >> 4, h = item & 15, t = m & (SEQ - 1);
        float mx = -1e30f, l = 0.f, a0 = 0.f, a1 = 0.f;
#pragma unroll 1
        for (int g = 0; g < 3; ++g) {
            const int sh = 2 * g;
            const unsigned qw = *(const GAS unsigned*)(QKV + (size_t)m * NQKV + g * 6144 + h * 128 + 2 * F.lane);
            const float q0 = bflo(qw) * QSCALE, q1 = bfhi(qw) * QSCALE;
            const int jmax = (t >> sh) < 128 ? (t >> sh) : 128;
            const float* bt = BT + (g * 16 + h) * 129;
#pragma unroll 1
            for (int j0 = 0; j0 <= jmax; j0 += 8) {
                unsigned kw[8], vw[8]; float bs[8];
#pragma unroll
                for (int u = 0; u < 8; ++u) { const int jj = (j0 + u) <= jmax ? (j0 + u) : jmax; const bf16* rp = QKV + (size_t)(m - (jj << sh)) * NQKV + g * 6144 + h * 128 + 2 * F.lane;
                    kw[u] = *(const GAS unsigned*)(rp + 2048); vw[u] = *(const GAS unsigned*)(rp + 4096); bs[u] = bt[jj]; }
                float s[8]; float cm = -INFINITY;
#pragma unroll
                for (int u = 0; u < 8; ++u) { s[u] = wave_sum(q0 * bflo(kw[u]) + q1 * bfhi(kw[u])) + bs[u]; if (j0 + u > jmax) s[u] = -INFINITY; cm = fmaxf(cm, s[u]); }
                const float mn = fmaxf(mx, cm), sc = __expf(mx - mn); l *= sc; a0 *= sc; a1 *= sc; mx = mn;
#pragma unroll
                for (int u = 0; u < 8; ++u) { const float p = __expf(s[u] - mn); l += p; a0 += p * bflo(vw[u]); a1 += p * bfhi(vw[u]); }
            }
        }
        const float inv = 1.f / l;
        *(GAS unsigned*)(MRG + (size_t)m * DATT + h * 128 + 2 * F.lane) = pk2(a0 * inv, a1 * inv);
    }
}
__device__ __forceinline__ void hgrn_naive(Frame& F) {
    if (blockIdx.x >= 64) return;
    const int b = blockIdx.x >> 5, h = blockIdx.x & 31;
    const bf16* HP = (const bf16*)(F.ws + WS_QKV); float* ORAW = (float*)(F.ws + WS_ACT); const float* LB = (const float*)(F.ws + WS_TAB + 65536);
    LAS f32x4* PRM = (LAS f32x4*)(F.lds);
    LAS float* VV = (LAS float*)(F.lds + 32768);
    LAS float* OP = (LAS float*)(F.lds + 32768 + 8192);
    const int e = F.tid & 127, qd = F.tid >> 7, ps = F.tid >> 6, pl = F.tid & 63;
    const float lb0 = LB[h * 128 + 2 * pl], lb1 = LB[h * 128 + 2 * pl + 1];
    float S[32];
#pragma unroll
    for (int d = 0; d < 32; ++d) S[d] = 0.f;
    unsigned qw, fw, iw;
#define HG_LOAD(n) do { const bf16* bp = HP + (size_t)(b * SEQ + (n) * 8 + ps) * NHG + h * 128 + 2 * pl; qw = *(const GAS unsigned*)bp; fw = *(const GAS unsigned*)(bp + 4096); iw = *(const GAS unsigned*)(bp + 8192); } while (0)
#define HG_WRITE(buf) do { const float f0 = bflo(fw), f1 = bfhi(fw), r0 = bflo(qw), r1 = bfhi(qw); \
        const float g0 = lb0 + (1.f - lb0) / (1.f + __expf(-f0)), g1 = lb1 + (1.f - lb1) / (1.f + __expf(-f1)); \
        const int o = ((buf) * 8 + ps) * 128 + 2 * pl; \
        PRM[o] = (f32x4){g0, 1.f - g0, r0 / (1.f + __expf(-r0)) * QSCALE, 0.f}; PRM[o + 1] = (f32x4){g1, 1.f - g1, r1 / (1.f + __expf(-r1)) * QSCALE, 0.f}; \
        VV[o] = bflo(iw); VV[o + 1] = bfhi(iw); } while (0)
    HG_LOAD(0); HG_WRITE(0); __syncthreads();
#pragma unroll 1
    for (int n = 0; n < SEQ / 8; ++n) {
        const int buf = n & 1;
        if (n + 1 < SEQ / 8) HG_LOAD(n + 1);
#pragma unroll 1
        for (int st = 0; st < 8; ++st) {
            const float v = VV[(buf * 8 + st) * 128 + e]; float o = 0.f;
#pragma unroll
            for (int dd = 0; dd < 32; ++dd) { const f32x4 P = PRM[(buf * 8 + st) * 128 + qd * 32 + dd]; S[dd] = P.x * S[dd] + P.y * v; o += P.z * S[dd]; }
            OP[(st * 4 + qd) * 128 + e] = o;
        }
        if (n + 1 < SEQ / 8) HG_WRITE(buf ^ 1);
        __syncthreads();
#pragma unroll
        for (int r = 0; r < 2; ++r) { const int idx = F.tid + 512 * r, st = idx >> 7, ee = idx & 127;
            const float sum = (OP[(st * 4 + 0) * 128 + ee] + OP[(st * 4 + 1) * 128 + ee]) + (OP[(st * 4 + 2) * 128 + ee] + OP[(st * 4 + 3) * 128 + ee]);
            ORAW[(size_t)(b * SEQ + n * 8 + st) * DM + h * 128 + ee] = sum; }
        __syncthreads();
    }
#undef HG_LOAD
#undef HG_WRITE
}
__device__ __forceinline__ void hgrn_gate(Frame& F) {
    const int gw = F.vcu * NWAVES + F.wave, NGW = F.G * NWAVES;
    const float* ORAW = (const float*)(F.ws + WS_ACT); const bf16* HP = (const bf16*)(F.ws + WS_QKV); bf16* OG = (bf16*)(F.ws + WS_OG);
    const f32x4 gn = *(const GAS f32x4*)(F.hg_gain + 4 * (F.lane & 31));
    for (int m = gw; m < M; m += NGW) {
        const GAS f32x4* orow = (const GAS f32x4*)(ORAW + (size_t)m * DM) + F.lane;
        const GAS v2u* grow = (const GAS v2u*)(HP + (size_t)m * NHG + 3 * DM) + F.lane;
        GAS v2u* o8 = (GAS v2u*)(OG + (size_t)m * DM) + F.lane;
#pragma unroll 4
        for (int j = 0; j < 16; ++j) {
            const f32x4 o = orow[64 * j]; const v2u gw2 = grow[64 * j];
            float ss = (o.x * o.x + o.y * o.y) + (o.z * o.z + o.w * o.w);
#pragma unroll
            for (int k = 1; k < 32; k <<= 1) ss += __shfl_xor(ss, k);
            const float rstd = 1.f / sqrtf(ss * (1.f / HD) + RMS_EPS);
            const float g0 = bflo(gw2.x), g1 = bfhi(gw2.x), g2 = bflo(gw2.y), g3 = bfhi(gw2.y);
            v2u w; w.x = pk2(o.x * rstd * gn.x * (g0 / (1.f + __expf(-g0))), o.y * rstd * gn.y * (g1 / (1.f + __expf(-g1))));
            w.y = pk2(o.z * rstd * gn.z * (g2 / (1.f + __expf(-g2))), o.w * rstd * gn.w * (g3 / (1.f + __expf(-g3))));
            o8[64 * j] = w;
        }
    }
}
typedef short v4i16_t __attribute__((ext_vector_type(4)));
constexpr int AT_K = 0, AT_KP = 128 * 272, AT_V = 2 * AT_KP, AT_VP = 128 * 288, AT_BT = AT_V + 2 * AT_VP, AT_END = AT_BT + 1024;
static_assert(AT_END <= LDSCTL_OFF, "attention LDS map");
constexpr size_t WS_AO = 2334 * MiB, WS_LSE = 2526 * MiB, WS_END2 = 2529 * MiB;
__device__ __forceinline__ void attn_load_page(LAS unsigned char* L, int tid, const bf16* Kt, const bf16* Vt, int row0, int h, int slot) {
#pragma unroll
    for (int i = 0; i < 4; ++i) { const int chunk = tid + 512 * i, r = chunk >> 4, c = chunk & 15;
        const v4u kv = *(const GAS v4u*)(Kt + (size_t)(row0 + r) * 2048 + h * 128 + 8 * c); const v4u vv = *(const GAS v4u*)(Vt + (size_t)(row0 + r) * 2048 + h * 128 + 8 * c);
        *(LAS v4u*)(L + AT_K + slot * AT_KP + r * 272 + 16 * c) = kv; *(LAS v4u*)(L + AT_V + slot * AT_VP + r * 288 + 16 * c) = vv; }
}
__device__ __forceinline__ void attn_mfma(Frame& F) {
    const bf16* QKVp = (const bf16*)(F.ws + WS_QKV); bf16* AO = (bf16*)(F.ws + WS_AO); float* LSE = (float*)(F.ws + WS_LSE); const float* BT = (const float*)(F.ws + WS_TAB);
    LAS unsigned char* L = F.lds;
    const int w = F.wave, li = F.lane & 15, g4 = F.lane >> 4;
    const int per = (6144 + F.G - 1) / F.G, U0 = F.vcu * per, U1 = (U0 + per) < 6144 ? (U0 + per) : 6144;
    int prevU = -2;
    v4u pk[4], pv[4];
#define AT_DECODE(UU, gh_, qb_, g_, h_, q0_) const int gh_ = (UU) >> 7, qb_ = (UU) & 127, g_ = gh_ >> 4, h_ = gh_ & 15, q0_ = 128 * qb_
#define AT_PREFETCH(UU) do { AT_DECODE(UU, ghn, qbn, gn_, hn, q0n); (void)qbn; const bf16* Kn = QKVp + (size_t)(3 * gn_ + 1) * M * 2048; const bf16* Vn = Kn + (size_t)M * 2048; \
        _Pragma("unroll") for (int i = 0; i < 4; ++i) { const int chunk = F.tid + 512 * i, r = chunk >> 4, c = chunk & 15; \
            pk[i] = *(const GAS v4u*)(Kn + (size_t)(q0n + r) * 2048 + hn * 128 + 8 * c); pv[i] = *(const GAS v4u*)(Vn + (size_t)(q0n + r) * 2048 + hn * 128 + 8 * c); } \
        } while (0)
    if (U0 < U1) AT_PREFETCH(U0);
#pragma unroll 1
    for (int U = U0; U < U1; ++U) {
        const int gh = U >> 7, qb = U & 127, g = gh >> 4, h = gh & 15, sh = 2 * g, n = SEQ >> sh, q0 = 128 * qb, i0 = q0 & (n - 1);
        const bool first = (i0 == 0);
        const bf16* Qt = QKVp + (size_t)(3 * g) * M * 2048; const bf16* Kt = Qt + (size_t)M * 2048; const bf16* Vt = Kt + (size_t)M * 2048;
        __builtin_amdgcn_s_barrier(); asm volatile("" ::: "memory");
        if (U == U0 || qb == 0) { if (F.tid < 161) { const int rel = F.tid - 16; ((LAS float*)(L + AT_BT))[F.tid] = (rel >= 0 && rel <= 128) ? BT[gh * 129 + rel] : 0.f; } }
        if (first) { for (int i = F.tid; i < AT_VP / 16; i += NWAVES * 64) *(LAS v4u*)(L + AT_V + ((qb - 1) & 1) * AT_VP + 16 * i) = (v4u){0u, 0u, 0u, 0u}; }
        else if (prevU != U - 1) attn_load_page(L, F.tid, Kt, Vt, q0 - 128, h, (qb - 1) & 1);
#pragma unroll
        for (int i = 0; i < 4; ++i) { const int chunk = F.tid + 512 * i, r = chunk >> 4, c = chunk & 15;
            *(LAS v4u*)(L + AT_K + (qb & 1) * AT_KP + r * 272 + 16 * c) = pk[i]; *(LAS v4u*)(L + AT_V + (qb & 1) * AT_VP + r * 288 + 16 * c) = pv[i]; }
        prevU = U;
        bf16x8 qf[4];
        { const bf16* qp = Qt + (size_t)(q0 + 16 * w + li) * 2048 + h * 128 + 8 * g4;
#pragma unroll
          for (int ds = 0; ds < 4; ++ds) qf[ds] = *(const GAS bf16x8*)(qp + 32 * ds); }
        LDS_WAIT(); __builtin_amdgcn_s_barrier(); asm volatile("" ::: "memory");
        { const int Un = (U + 1 < U1) ? U + 1 : U; AT_PREFETCH(Un); }
        f32x4 sc[9];
#pragma unroll
        for (int blk = 0; blk < 9; ++blk) { const int kb = w + blk, slot = (qb - 1 + (kb >> 3)) & 1;
            const LAS unsigned char* kp = L + AT_K + slot * AT_KP + ((kb & 7) * 16 + li) * 272 + 16 * g4;
            f32x4 acc = (f32x4){0.f, 0.f, 0.f, 0.f};
#pragma unroll
            for (int ds = 0; ds < 4; ++ds) { const bf16x8 a = *(const LAS bf16x8*)(kp + 64 * ds); acc = __builtin_amdgcn_mfma_f32_16x16x32_bf16(a, qf[ds], acc, 0, 0, 0); }
            sc[blk] = acc; }
        const LAS float* bt = (const LAS float*)(L + AT_BT) + (16 + 128 + li - 4 * g4);
        const int ql = 16 * w + li, relmax = first ? (ql < 128 ? ql : 128) : 128;
        float mx = -INFINITY;
#pragma unroll
        for (int blk = 0; blk < 9; ++blk)
#pragma unroll
            for (int r = 0; r < 4; ++r) { const int rel = 128 + li - 16 * blk - 4 * g4 - r; const float bias = bt[-(16 * blk + r)];
                const float s = (rel >= 0 && rel <= relmax) ? sc[blk][r] * QSCALE + bias : -INFINITY; sc[blk][r] = s; mx = fmaxf(mx, s); }
        mx = fmaxf(mx, __shfl_xor(mx, 16)); mx = fmaxf(mx, __shfl_xor(mx, 32));
        float lsum = 0.f;
#pragma unroll
        for (int blk = 0; blk < 9; ++blk)
#pragma unroll
            for (int r = 0; r < 4; ++r) { const float p = __expf(sc[blk][r] - mx); sc[blk][r] = p; lsum += p; }
        lsum += __shfl_xor(lsum, 16); lsum += __shfl_xor(lsum, 32);
        f32x4 o[8];
#pragma unroll
        for (int db = 0; db < 8; ++db) o[db] = (f32x4){0.f, 0.f, 0.f, 0.f};
#pragma unroll
        for (int st = 0; st < 5; ++st) {
            const int ba = 2 * st, bb = (2 * st + 1) < 9 ? (2 * st + 1) : 8;
            v4u pw; pw.x = cvtpk(sc[ba][0], sc[ba][1]); pw.y = cvtpk(sc[ba][2], sc[ba][3]);
            if (2 * st + 1 < 9) { pw.z = cvtpk(sc[bb][0], sc[bb][1]); pw.w = cvtpk(sc[bb][2], sc[bb][3]); } else { pw.z = 0u; pw.w = 0u; }
            const bf16x8 pf = __builtin_bit_cast(bf16x8, pw);
            const int kba = w + ba, kbb = w + bb;
            const LAS unsigned char* va = L + AT_V + ((qb - 1 + (kba >> 3)) & 1) * AT_VP + ((kba & 7) * 16 + 4 * g4 + (li >> 2)) * 288 + 8 * (li & 3);
            const LAS unsigned char* vb = L + AT_V + ((qb - 1 + (kbb >> 3)) & 1) * AT_VP + ((kbb & 7) * 16 + 4 * g4 + (li >> 2)) * 288 + 8 * (li & 3);
#pragma unroll
            for (int db = 0; db < 8; ++db) {
                const v4i16_t lo = __builtin_amdgcn_ds_read_tr16_b64_v4i16((LAS v4i16_t*)(va + 32 * db)), hi = __builtin_amdgcn_ds_read_tr16_b64_v4i16((LAS v4i16_t*)(vb + 32 * db));
                const bf16x8 a = __builtin_shufflevector(lo, hi, 0, 1, 2, 3, 4, 5, 6, 7);
                o[db] = __builtin_amdgcn_mfma_f32_16x16x32_bf16(a, pf, o[db], 0, 0, 0); }
        }
        const float inv = 1.f / lsum;
        const size_t orow = (size_t)g * M + (size_t)(q0 + 16 * w + li);
        bf16* op = AO + orow * 2048 + h * 128 + 4 * g4;
#pragma unroll
        for (int db = 0; db < 8; ++db) *(GAS v2u*)(op + 16 * db) = (v2u){cvtpk(o[db][0] * inv, o[db][1] * inv), cvtpk(o[db][2] * inv, o[db][3] * inv)};
        if (g4 == 0) LSE[orow * 16 + h] = mx + __logf(lsum);
    }
#undef AT_PREFETCH
#undef AT_DECODE
}
__device__ __forceinline__ void attn_merge(Frame& F) {
    const int gw = F.vcu * NWAVES + F.wave, NGW = F.G * NWAVES;
    const bf16* AO = (const bf16*)(F.ws + WS_AO); const float* LSE = (const float*)(F.ws + WS_LSE); bf16* MRG = (bf16*)(F.ws + WS_MRG);
    for (int m = gw; m < M; m += NGW) {
        const int t = m & (SEQ - 1), bbase = m & ~(SEQ - 1);
        size_t rows[3];
#pragma unroll
        for (int g = 0; g < 3; ++g) { const int sh = 2 * g; rows[g] = (size_t)g * M + (size_t)(bbase + ((t & ((1 << sh) - 1)) << (13 - sh)) + (t >> sh)); }
#pragma unroll
        for (int k = 0; k < 4; ++k) {
            const int hd = (F.lane >> 4) + 4 * k, c = F.lane + 64 * k;
            const float l0 = LSE[rows[0] * 16 + hd], l1 = LSE[rows[1] * 16 + hd], l2 = LSE[rows[2] * 16 + hd];
            const float mx = fmaxf(l0, fmaxf(l1, l2)); float w0 = __expf(l0 - mx), w1 = __expf(l1 - mx), w2 = __expf(l2 - mx); const float inv = 1.f / (w0 + w1 + w2); w0 *= inv; w1 *= inv; w2 *= inv;
            const v4u a = *(const GAS v4u*)(AO + rows[0] * 2048 + 8 * c), b = *(const GAS v4u*)(AO + rows[1] * 2048 + 8 * c), d = *(const GAS v4u*)(AO + rows[2] * 2048 + 8 * c);
            v4u o;
#pragma unroll
            for (int j = 0; j < 4; ++j) o[j] = cvtpk(w0 * bflo(a[j]) + w1 * bflo(b[j]) + w2 * bflo(d[j]), w0 * bfhi(a[j]) + w1 * bfhi(b[j]) + w2 * bfhi(d[j]));
            *(GAS v4u*)(MRG + (size_t)m * DATT + 8 * c) = o;
        }
    }
}
typedef float f32x16 __attribute__((ext_vector_type(16)));
typedef short s16x4 __attribute__((ext_vector_type(4)));
constexpr int HG_QR = 0, HG_QD = 17408, HG_KR = 34816, HG_KRT = 52224, HG_VT = 70656, HG_ST0 = 75264, HG_ST1 = 83968, HG_SEG = 92672, HG_EL = 96768, HG_DEC = 97280, HG_END = 97792;
static_assert(HG_END <= RING_BYTES, "hgrn LDS map");
__device__ __forceinline__ void hgrn_mfma(Frame& F) {
    const bf16* HP = (const bf16*)(F.ws + WS_QKV); float* ORAW = (float*)(F.ws + WS_ACT); const float* LB = (const float*)(F.ws + WS_TAB + 65536);
    LAS unsigned char* L = F.lds;
    const int w = F.wave, cp = F.lane, l31 = F.lane & 31, hh = F.lane >> 5;
#pragma unroll 1
    for (int u = blockIdx.x; u < 256; u += F.G) {
        const int bh = u >> 2, e0 = (u & 3) * 32, b = bh >> 5, h = bh & 31;
        const float lb0 = LB[h * 128 + 2 * cp], lb1 = LB[h * 128 + 2 * cp + 1];
        const size_t rowbase = (size_t)b * SEQ;
        unsigned qraw[8], fraw[8], vraw[2];
#define HGM_LOAD(c) do { \
            _Pragma("unroll") for (int i = 0; i < 8; ++i) { const bf16* bp = HP + (rowbase + 64 * (c) + 8 * w + i) * NHG + h * 128 + 2 * cp; qraw[i] = *(const GAS unsigned*)bp; fraw[i] = *(const GAS unsigned*)(bp + 4096); } \
            _Pragma("unroll") for (int k = 0; k < 2; ++k) { const int vrow = (F.tid >> 4) + 32 * k; vraw[k] = *(const GAS unsigned*)(HP + (rowbase + 64 * (c) + vrow) * NHG + 8192 + h * 128 + e0 + 2 * (F.tid & 15)); } } while (0)
        f32x16 S;
#pragma unroll
        for (int i = 0; i < 16; ++i) S[i] = 0.f;
        for (int i = F.tid; i < 8704 / 4; i += NWAVES * 64) ((LAS unsigned*)(L + HG_ST0))[i] = 0u;
        HGM_LOAD(0);
#pragma unroll 1
        for (int c = 0; c < SEQ / 64; ++c) {
            float q[8][2], k[8][2], cs[8][2]; float run0 = 0.f, run1 = 0.f;
#pragma unroll
            for (int i = 0; i < 8; ++i) {
                const float f0 = bflo(fraw[i]), f1 = bfhi(fraw[i]), r0 = bflo(qraw[i]), r1 = bfhi(qraw[i]);
                const float g0 = lb0 + (1.f - lb0) * __builtin_amdgcn_rcpf(1.f + __expf(-f0)), g1 = lb1 + (1.f - lb1) * __builtin_amdgcn_rcpf(1.f + __expf(-f1));
                run0 += __logf(g0); run1 += __logf(g1); cs[i][0] = run0; cs[i][1] = run1;
                k[i][0] = 1.f - g0; k[i][1] = 1.f - g1;
                q[i][0] = r0 * __builtin_amdgcn_rcpf(1.f + __expf(-r0)) * QSCALE; q[i][1] = r1 * __builtin_amdgcn_rcpf(1.f + __expf(-r1)) * QSCALE;
            }
            { typedef float f32x2v __attribute__((ext_vector_type(2))); *(LAS f32x2v*)(L + HG_SEG + (w * 128 + 2 * cp) * 4) = (f32x2v){run0, run1}; }
            const unsigned v0 = vraw[0], v1 = vraw[1];
            LDS_WAIT(); __builtin_amdgcn_s_barrier(); asm volatile("" ::: "memory");
            float off0 = 0.f, off1 = 0.f, bref0 = 0.f, bref1 = 0.f, p0 = 0.f, p1 = 0.f;
#pragma unroll
            for (int s = 0; s < 8; ++s) { typedef float f32x2v __attribute__((ext_vector_type(2))); const f32x2v t = *(const LAS f32x2v*)(L + HG_SEG + (s * 128 + 2 * cp) * 4);
                if (s == w) { off0 = p0; off1 = p1; } p0 += t.x; p1 += t.y; if (s == 3) { bref0 = p0; bref1 = p1; } }
            const float er0 = __expf(bref0), er1 = __expf(bref1);
            unsigned krt0[4], krt1[4];
#pragma unroll
            for (int i = 0; i < 8; ++i) {
                const float e10 = __expf(cs[i][0] + off0 - bref0), e11 = __expf(cs[i][1] + off1 - bref1);
                const float qr0 = q[i][0] * e10, qr1 = q[i][1] * e11, kr0 = k[i][0] * __builtin_amdgcn_rcpf(e10), kr1 = k[i][1] * __builtin_amdgcn_rcpf(e11);
                const int ro = (8 * w + i) * 272 + 4 * cp;
                *(LAS unsigned*)(L + HG_QR + ro) = cvtpk(qr0, qr1);
                *(LAS unsigned*)(L + HG_QD + ro) = cvtpk(qr0 * er0, qr1 * er1);
                *(LAS unsigned*)(L + HG_KR + ro) = cvtpk(kr0, kr1);
                if (i & 1) { krt0[i >> 1] = cvtpk(k[i - 1][0] * __builtin_amdgcn_rcpf(__expf(cs[i - 1][0] + off0 - bref0)), kr0); krt1[i >> 1] = cvtpk(k[i - 1][1] * __builtin_amdgcn_rcpf(__expf(cs[i - 1][1] + off1 - bref1)), kr1); }
            }
            *(LAS v4u*)(L + HG_KRT + (2 * cp) * 144 + 16 * w) = (v4u){krt0[0], krt0[1], krt0[2], krt0[3]};
            *(LAS v4u*)(L + HG_KRT + (2 * cp + 1) * 144 + 16 * w) = (v4u){krt1[0], krt1[1], krt1[2], krt1[3]};
            if (w == 0) { typedef float f32x2v __attribute__((ext_vector_type(2)));
                *(LAS f32x2v*)(L + HG_EL + 8 * cp) = (f32x2v){__expf(p0 - bref0), __expf(p1 - bref1)}; *(LAS f32x2v*)(L + HG_DEC + 8 * cp) = (f32x2v){__expf(p0), __expf(p1)}; }
            { const int ee = 2 * (F.tid & 15), ss = F.tid >> 4;
                *(LAS unsigned short*)(L + HG_VT + ee * 144 + ss * 2) = (unsigned short)(v0 & 0xffffu); *(LAS unsigned short*)(L + HG_VT + (ee + 1) * 144 + ss * 2) = (unsigned short)(v0 >> 16);
                *(LAS unsigned short*)(L + HG_VT + ee * 144 + (ss + 32) * 2) = (unsigned short)(v1 & 0xffffu); *(LAS unsigned short*)(L + HG_VT + (ee + 1) * 144 + (ss + 32) * 2) = (unsigned short)(v1 >> 16); }
            if (c + 1 < SEQ / 64) HGM_LOAD(c + 1);
            LDS_WAIT(); __builtin_amdgcn_s_barrier(); asm volatile("" ::: "memory");
            const LAS unsigned char* stc = L + ((c & 1) ? HG_ST1 : HG_ST0);
            LAS unsigned char* stn = L + ((c & 1) ? HG_ST0 : HG_ST1);
            if (w < 2) {
                const int th = w;
                f32x16 Y;
#pragma unroll
                for (int i = 0; i < 16; ++i) Y[i] = 0.f;
#pragma unroll
                for (int kd = 0; kd < 8; ++kd) { const bf16x8 a = *(const LAS bf16x8*)(stc + l31 * 272 + (16 * kd + 8 * hh) * 2); const bf16x8 bq = *(const LAS bf16x8*)(L + HG_QD + (32 * th + l31) * 272 + (16 * kd + 8 * hh) * 2);
                    Y = __builtin_amdgcn_mfma_f32_32x32x16_bf16(a, bq, Y, 0, 0, 0); }
#pragma unroll
                for (int sb = 0; sb < 2; ++sb) { if (sb <= th) {
                    f32x16 X;
#pragma unroll
                    for (int i = 0; i < 16; ++i) X[i] = 0.f;
#pragma unroll
                    for (int kd = 0; kd < 8; ++kd) { const bf16x8 a = *(const LAS bf16x8*)(L + HG_KR + (32 * sb + l31) * 272 + (16 * kd + 8 * hh) * 2); const bf16x8 bq = *(const LAS bf16x8*)(L + HG_QR + (32 * th + l31) * 272 + (16 * kd + 8 * hh) * 2);
                        X = __builtin_amdgcn_mfma_f32_32x32x16_bf16(a, bq, X, 0, 0, 0); }
                    if (sb == th) {
#pragma unroll
                        for (int r = 0; r < 16; ++r) { const int s = (r & 3) + 8 * (r >> 2) + 4 * hh; if (s > l31) X[r] = 0.f; } }
#pragma unroll
                    for (int ks = 0; ks < 2; ++ks) {
                        const unsigned x0 = cvtpk(X[8 * ks + 0], X[8 * ks + 1]), x1 = cvtpk(X[8 * ks + 2], X[8 * ks + 3]), x2 = cvtpk(X[8 * ks + 4], X[8 * ks + 5]), x3 = cvtpk(X[8 * ks + 6], X[8 * ks + 7]);
                        const bf16x8 xb = __builtin_bit_cast(bf16x8, (v4u){x0, x1, x2, x3});
                        const v2u alo = *(const LAS v2u*)(L + HG_VT + l31 * 144 + (32 * sb + 16 * ks + 4 * hh) * 2), ahi = *(const LAS v2u*)(L + HG_VT + l31 * 144 + (32 * sb + 16 * ks + 8 + 4 * hh) * 2);
                        const bf16x8 a = __builtin_bit_cast(bf16x8, (v4u){alo.x, alo.y, ahi.x, ahi.y});
                        Y = __builtin_amdgcn_mfma_f32_32x32x16_bf16(a, xb, Y, 0, 0, 0); }
                } }
                float* orow = ORAW + (rowbase + 64 * c + 32 * th + l31) * DM + h * 128 + e0 + 4 * hh;
#pragma unroll
                for (int g = 0; g < 4; ++g) *(GAS f32x4*)(orow + 8 * g) = (f32x4){Y[4 * g], Y[4 * g + 1], Y[4 * g + 2], Y[4 * g + 3]};
            } else if (w >= 4) {
                const int dt = w - 4;
                f32x16 T;
#pragma unroll
                for (int i = 0; i < 16; ++i) T[i] = 0.f;
#pragma unroll
                for (int ks = 0; ks < 4; ++ks) { const bf16x8 a = *(const LAS bf16x8*)(L + HG_KRT + (32 * dt + l31) * 144 + (16 * ks + 8 * hh) * 2); const bf16x8 bv = *(const LAS bf16x8*)(L + HG_VT + l31 * 144 + (16 * ks + 8 * hh) * 2);
                    T = __builtin_amdgcn_mfma_f32_32x32x16_bf16(a, bv, T, 0, 0, 0); }
#pragma unroll
                for (int g = 0; g < 4; ++g) { const f32x4 dec = *(const LAS f32x4*)(L + HG_DEC + (32 * dt + 8 * g + 4 * hh) * 4), el = *(const LAS f32x4*)(L + HG_EL + (32 * dt + 8 * g + 4 * hh) * 4);
#pragma unroll
                    for (int i = 0; i < 4; ++i) S[4 * g + i] = dec[i] * S[4 * g + i] + el[i] * T[4 * g + i];
                    *(LAS v2u*)(stn + l31 * 272 + (32 * dt + 8 * g + 4 * hh) * 2) = (v2u){cvtpk(S[4 * g], S[4 * g + 1]), cvtpk(S[4 * g + 2], S[4 * g + 3])}; }
            }
        }
        LDS_WAIT(); __builtin_amdgcn_s_barrier(); asm volatile("" ::: "memory");
#undef HGM_LOAD
    }
}
__device__ __forceinline__ void hgrn_mfma2(Frame& F) {
    const bf16* QH = (const bf16*)(F.ws + WS_QKV); const bf16* FH = QH + (size_t)M * DM; const bf16* VH = FH + (size_t)M * DM; const bf16* KH = (const bf16*)(F.ws + WS_AO); bf16* ORAW = (bf16*)(F.ws + WS_ACT);
    LAS unsigned char* L = F.lds;
    const int w = F.wave, cp = F.lane, l31 = F.lane & 31, hh = F.lane >> 5, li = F.lane & 15, g4 = F.lane >> 4;
    typedef float f32x2v __attribute__((ext_vector_type(2)));
#pragma unroll 1
    for (int u = blockIdx.x; u < 256; u += F.G) {
        const int ux = u & 7, uy = u >> 3, bh = ux + 8 * (uy >> 2), e0 = (uy & 3) * 32, b = bh >> 5, h = bh & 31;
        const size_t rowbase = (size_t)b * SEQ;
        unsigned qn[8], fn[8], kn[8], vn[2];
        const bf16* pq = QH + ((size_t)bh * SEQ + 8 * w) * 128 + 2 * cp; const bf16* pf = FH + ((size_t)bh * SEQ + 8 * w) * 128 + 2 * cp; const bf16* pk = KH + ((size_t)bh * SEQ + 8 * w) * 128 + 2 * cp;
        const bf16* pv = VH + ((size_t)bh * SEQ + (F.tid >> 4)) * 128 + e0 + 2 * (F.tid & 15);
#define HG2_LOAD() do { \
            _Pragma("unroll") for (int i = 0; i < 8; ++i) { qn[i] = *(const GAS unsigned*)(pq + 128 * i); fn[i] = *(const GAS unsigned*)(pf + 128 * i); kn[i] = *(const GAS unsigned*)(pk + 128 * i); } \
            vn[0] = *(const GAS unsigned*)pv; vn[1] = *(const GAS unsigned*)(pv + 32 * 128); pq += 64 * 128; pf += 64 * 128; pk += 64 * 128; pv += 64 * 128; } while (0)
        f32x16 S;
#pragma unroll
        for (int i = 0; i < 16; ++i) S[i] = 0.f;
        for (int i = F.tid; i < 8704 / 4; i += NWAVES * 64) ((LAS unsigned*)(L + HG_ST0))[i] = 0u;
        HG2_LOAD();
#pragma unroll 1
        for (int c = 0; c < SEQ / 64; ++c) {
            float qf[8][2], kf[8][2], cs[8][2]; float run0 = 0.f, run1 = 0.f;
#pragma unroll
            for (int i = 0; i < 8; ++i) { qf[i][0] = bflo(qn[i]); qf[i][1] = bfhi(qn[i]); kf[i][0] = bflo(kn[i]); kf[i][1] = bfhi(kn[i]); run0 += bflo(fn[i]); run1 += bfhi(fn[i]); cs[i][0] = run0; cs[i][1] = run1; }
            const unsigned v0 = vn[0], v1 = vn[1];
            { const int back = (c + 1 < SEQ / 64) ? 0 : 64 * 128; pq -= back; pf -= back; pk -= back; pv -= back; }
            HG2_LOAD();
            *(LAS f32x2v*)(L + HG_SEG + (w * 128 + 2 * cp) * 4) = (f32x2v){run0, run1};
            LDS_WAIT(); __builtin_amdgcn_s_barrier(); asm volatile("" ::: "memory");
            float off0 = 0.f, off1 = 0.f, bref0 = 0.f, bref1 = 0.f, p0 = 0.f, p1 = 0.f;
#pragma unroll
            for (int s = 0; s < 8; ++s) { const f32x2v t = *(const LAS f32x2v*)(L + HG_SEG + (s * 128 + 2 * cp) * 4);
                if (s == w) { off0 = p0; off1 = p1; } p0 += t.x; p1 += t.y; if (s == 3) { bref0 = p0; bref1 = p1; } }
            const float er0 = __expf(bref0), er1 = __expf(bref1);
            off0 -= bref0; off1 -= bref1;
            float kr[8][2];
#pragma unroll
            for (int i = 0; i < 8; ++i) {
                const float e10 = __expf(cs[i][0] + off0), e11 = __expf(cs[i][1] + off1);
                const float qr0 = qf[i][0] * e10, qr1 = qf[i][1] * e11; kr[i][0] = kf[i][0] * __builtin_amdgcn_rcpf(e10); kr[i][1] = kf[i][1] * __builtin_amdgcn_rcpf(e11);
                const int ro = (8 * w + i) * 272 + 4 * cp;
                *(LAS unsigned*)(L + HG_QR + ro) = cvtpk(qr0, qr1);
                *(LAS unsigned*)(L + HG_QD + ro) = cvtpk(qr0 * er0, qr1 * er1);
                *(LAS unsigned*)(L + HG_KR + ro) = cvtpk(kr[i][0], kr[i][1]);
            }
            *(LAS v4u*)(L + HG_KRT + (2 * cp) * 144 + 16 * w) = (v4u){cvtpk(kr[0][0], kr[1][0]), cvtpk(kr[2][0], kr[3][0]), cvtpk(kr[4][0], kr[5][0]), cvtpk(kr[6][0], kr[7][0])};
            *(LAS v4u*)(L + HG_KRT + (2 * cp + 1) * 144 + 16 * w) = (v4u){cvtpk(kr[0][1], kr[1][1]), cvtpk(kr[2][1], kr[3][1]), cvtpk(kr[4][1], kr[5][1]), cvtpk(kr[6][1], kr[7][1])};
            if (w == 0) { *(LAS f32x2v*)(L + HG_EL + 8 * cp) = (f32x2v){__expf(p0 - bref0), __expf(p1 - bref1)}; *(LAS f32x2v*)(L + HG_DEC + 8 * cp) = (f32x2v){__expf(p0), __expf(p1)}; }
            { const int ee = 2 * (F.tid & 15), ss = F.tid >> 4;
                *(LAS unsigned short*)(L + HG_VT + ee * 144 + ss * 2) = (unsigned short)(v0 & 0xffffu); *(LAS unsigned short*)(L + HG_VT + (ee + 1) * 144 + ss * 2) = (unsigned short)(v0 >> 16);
                *(LAS unsigned short*)(L + HG_VT + ee * 144 + (ss + 32) * 2) = (unsigned short)(v1 & 0xffffu); *(LAS unsigned short*)(L + HG_VT + (ee + 1) * 144 + (ss + 32) * 2) = (unsigned short)(v1 >> 16); }
            LDS_WAIT(); __builtin_amdgcn_s_barrier(); asm volatile("" ::: "memory");
            const LAS unsigned char* stc = L + ((c & 1) ? HG_ST1 : HG_ST0);
            LAS unsigned char* stn = L + ((c & 1) ? HG_ST0 : HG_ST1);
            if (w < 4) {
                const int tq = w;
                f32x4 Y[2]; Y[0] = (f32x4){0.f, 0.f, 0.f, 0.f}; Y[1] = Y[0];
                bf16x8 bqr[4];
#pragma unroll
                for (int kd = 0; kd < 4; ++kd) { const bf16x8 bq = *(const LAS bf16x8*)(L + HG_QD + (16 * tq + li) * 272 + (32 * kd + 8 * g4) * 2); bqr[kd] = *(const LAS bf16x8*)(L + HG_QR + (16 * tq + li) * 272 + (32 * kd + 8 * g4) * 2);
#pragma unroll
                    for (int eb = 0; eb < 2; ++eb) { const bf16x8 a = *(const LAS bf16x8*)(stc + (16 * eb + li) * 272 + (32 * kd + 8 * g4) * 2); Y[eb] = __builtin_amdgcn_mfma_f32_16x16x32_bf16(a, bq, Y[eb], 0, 0, 0); } }
                f32x4 X[4];
#pragma unroll
                for (int sb = 0; sb < 4; ++sb) { f32x4 acc = (f32x4){0.f, 0.f, 0.f, 0.f};
                    if (sb <= tq) {
#pragma unroll
                        for (int kd = 0; kd < 4; ++kd) { const bf16x8 a = *(const LAS bf16x8*)(L + HG_KR + (16 * sb + li) * 272 + (32 * kd + 8 * g4) * 2); acc = __builtin_amdgcn_mfma_f32_16x16x32_bf16(a, bqr[kd], acc, 0, 0, 0); }
                        if (sb == tq) {
#pragma unroll
                            for (int r = 0; r < 4; ++r) if (4 * g4 + r > li) acc[r] = 0.f; } }
                    X[sb] = acc; }
#pragma unroll
                for (int pr = 0; pr < 2; ++pr) { if (2 * pr <= tq) {
                    const bf16x8 pf = __builtin_bit_cast(bf16x8, (v4u){cvtpk(X[2 * pr][0], X[2 * pr][1]), cvtpk(X[2 * pr][2], X[2 * pr][3]), cvtpk(X[2 * pr + 1][0], X[2 * pr + 1][1]), cvtpk(X[2 * pr + 1][2], X[2 * pr + 1][3])});
#pragma unroll
                    for (int eb = 0; eb < 2; ++eb) { const v2u alo = *(const LAS v2u*)(L + HG_VT + (16 * eb + li) * 144 + (32 * pr + 4 * g4) * 2), ahi = *(const LAS v2u*)(L + HG_VT + (16 * eb + li) * 144 + (32 * pr + 16 + 4 * g4) * 2);
                        const bf16x8 a = __builtin_bit_cast(bf16x8, (v4u){alo.x, alo.y, ahi.x, ahi.y}); Y[eb] = __builtin_amdgcn_mfma_f32_16x16x32_bf16(a, pf, Y[eb], 0, 0, 0); } } }
                bf16* orow = ORAW + (rowbase + 64 * c + 16 * tq + li) * DM + h * 128 + e0 + 4 * g4;
#pragma unroll
                for (int eb = 0; eb < 2; ++eb) *(GAS v2u*)(orow + 16 * eb) = (v2u){cvtpk(Y[eb][0], Y[eb][1]), cvtpk(Y[eb][2], Y[eb][3])};
            } else {
                const int dt = w - 4;
                f32x16 T;
#pragma unroll
                for (int i = 0; i < 16; ++i) T[i] = 0.f;
#pragma unroll
                for (int ks = 0; ks < 4; ++ks) { const bf16x8 a = *(const LAS bf16x8*)(L + HG_KRT + (32 * dt + l31) * 144 + (16 * ks + 8 * hh) * 2); const bf16x8 bv = *(const LAS bf16x8*)(L + HG_VT + l31 * 144 + (16 * ks + 8 * hh) * 2);
                    T = __builtin_amdgcn_mfma_f32_32x32x16_bf16(a, bv, T, 0, 0, 0); }
#pragma unroll
                for (int g = 0; g < 4; ++g) { const f32x4 dec = *(const LAS f32x4*)(L + HG_DEC + (32 * dt + 8 * g + 4 * hh) * 4), el = *(const LAS f32x4*)(L + HG_EL + (32 * dt + 8 * g + 4 * hh) * 4);
#pragma unroll
                    for (int i = 0; i < 4; ++i) S[4 * g + i] = dec[i] * S[4 * g + i] + el[i] * T[4 * g + i];
                    *(LAS v2u*)(stn + l31 * 272 + (32 * dt + 8 * g + 4 * hh) * 2) = (v2u){cvtpk(S[4 * g], S[4 * g + 1]), cvtpk(S[4 * g + 2], S[4 * g + 3])}; }
            }
        }
        LDS_WAIT(); __builtin_amdgcn_s_barrier(); asm volatile("" ::: "memory");
#undef HG2_LOAD
    }
}
__device__ __forceinline__ void hgrn_gate2(Frame& F) {
    const int gw = F.vcu * NWAVES + F.wave, NGW = F.G * NWAVES;
    const bf16* ORAW = (const bf16*)(F.ws + WS_ACT); const bf16* SG = (HG_FUSE == 2) ? (const bf16*)(F.ws + WS_AO) : (const bf16*)(F.ws + WS_QKV) + 3 * (size_t)M * DM; bf16* OG = (bf16*)(F.ws + WS_OG);
    const f32x4 gn = *(const GAS f32x4*)(F.hg_gain + 4 * (F.lane & 31));
    for (int m = gw; m < M; m += NGW) {
        const GAS v2u* orow = (const GAS v2u*)(ORAW + (size_t)m * DM) + F.lane;
        const GAS v2u* grow = (const GAS v2u*)(SG + (size_t)m * DM) + F.lane;
        GAS v2u* o8 = (GAS v2u*)(OG + (size_t)m * DM) + F.lane;
#pragma unroll 8
        for (int j = 0; j < 16; ++j) {
            const v2u ow = orow[64 * j], gw2 = grow[64 * j];
            const float o0 = bflo(ow.x), o1 = bfhi(ow.x), o2 = bflo(ow.y), o3 = bfhi(ow.y);
            float ss = (o0 * o0 + o1 * o1) + (o2 * o2 + o3 * o3);
#pragma unroll
            for (int k = 1; k < 32; k <<= 1) ss += __shfl_xor(ss, k);
            const float rstd = 1.f / sqrtf(ss * (1.f / HD) + RMS_EPS);
            float s0 = bflo(gw2.x), s1 = bfhi(gw2.x), s2 = bflo(gw2.y), s3 = bfhi(gw2.y);
            if (HG_FUSE == 2) { s0 *= __builtin_amdgcn_rcpf(1.f + __expf(-s0)); s1 *= __builtin_amdgcn_rcpf(1.f + __expf(-s1)); s2 *= __builtin_amdgcn_rcpf(1.f + __expf(-s2)); s3 *= __builtin_amdgcn_rcpf(1.f + __expf(-s3)); }
            v2u wv; wv.x = cvtpk(o0 * rstd * gn.x * s0, o1 * rstd * gn.y * s1); wv.y = cvtpk(o2 * rstd * gn.z * s2, o3 * rstd * gn.w * s3);
            o8[64 * j] = wv;
        }
    }
}

#define DPP_MOV(x, ctrl) __builtin_bit_cast(float, __builtin_amdgcn_update_dpp(0, __builtin_bit_cast(int, (x)), (ctrl), 0xf, 0xf, false))
__device__ __forceinline__ void hgrn_gate3(Frame& F) {
    const int gw = F.vcu * NWAVES + F.wave, NGW = F.G * NWAVES;
    const bf16* ORAW = (const bf16*)(F.ws + WS_ACT); const bf16* SG = (const bf16*)(F.ws + WS_AO); unsigned char* OG8 = (unsigned char*)(F.ws + WS_OG); float* sa3 = (float*)(F.ws + WS_SA3);
    const f32x4 gn = *(const GAS f32x4*)(F.hg_gain + 4 * (F.lane & 31));
    const float s1 = (F.lane & 1) ? -1.f : 1.f, s2 = (F.lane & 2) ? -1.f : 1.f, s4 = (F.lane & 4) ? -1.f : 1.f;
    for (int m = gw; m < M; m += NGW) {
        const GAS v2u* orow = (const GAS v2u*)(ORAW + (size_t)m * DM) + F.lane;
        const GAS v2u* grow = (const GAS v2u*)(SG + (size_t)m * DM) + F.lane;
        float v[16][4]; float am = 0.f;
#pragma unroll
        for (int j = 0; j < 16; ++j) {
            const v2u ow = orow[64 * j], gw2 = grow[64 * j];
            const float o0 = bflo(ow.x), o1 = bfhi(ow.x), o2 = bflo(ow.y), o3 = bfhi(ow.y);
            float ss = (o0 * o0 + o1 * o1) + (o2 * o2 + o3 * o3);
#pragma unroll
            for (int k = 1; k < 32; k <<= 1) ss += __shfl_xor(ss, k);
            const float rstd = 1.f / sqrtf(ss * (1.f / HD) + RMS_EPS);
            float g0 = bflo(gw2.x), g1 = bfhi(gw2.x), g2 = bflo(gw2.y), g3 = bfhi(gw2.y);
            g0 *= __builtin_amdgcn_rcpf(1.f + __expf(-g0)); g1 *= __builtin_amdgcn_rcpf(1.f + __expf(-g1)); g2 *= __builtin_amdgcn_rcpf(1.f + __expf(-g2)); g3 *= __builtin_amdgcn_rcpf(1.f + __expf(-g3));
            float x0 = o0 * rstd * gn.x * g0, x1 = o1 * rstd * gn.y * g1, x2 = o2 * rstd * gn.z * g2, x3 = o3 * rstd * gn.w * g3;
            { const unsigned a = cvtpk(x0, x1), b = cvtpk(x2, x3); x0 = bflo(a); x1 = bfhi(a); x2 = bflo(b); x3 = bfhi(b); }
            { const float a = x0 + x1, b = x0 - x1, c = x2 + x3, d = x2 - x3; x0 = a + c; x1 = b + d; x2 = a - c; x3 = b - d; }
            float x[4] = {x0, x1, x2, x3};
#pragma unroll
            for (int i = 0; i < 4; ++i) { const float p = DPP_QUAD(x[i], 0xB1); x[i] = p + s1 * x[i]; }
#pragma unroll
            for (int i = 0; i < 4; ++i) { const float p = DPP_QUAD(x[i], 0x4E); x[i] = p + s2 * x[i]; }
#pragma unroll
            for (int i = 0; i < 4; ++i) { const float pl = DPP_MOV(x[i], 0x104), pr = DPP_MOV(x[i], 0x114); const float p = (F.lane & 4) ? pr : pl; x[i] = (p + s4 * x[i]) * 0.17677669529663687f; }
#pragma unroll
            for (int i = 0; i < 4; ++i) { v[j][i] = x[i]; am = fmaxf(am, fabsf(x[i])); }
        }
#pragma unroll
        for (int o = 1; o < 64; o <<= 1) am = fmaxf(am, __shfl_xor(am, o));
        am = fmaxf(am, 1e-30f);
        const float qs = 127.f / am;
        GAS unsigned* o4 = (GAS unsigned*)(OG8 + (size_t)m * DM) + F.lane;
#pragma unroll
        for (int j = 0; j < 16; ++j) { const int q0 = (int)rintf(v[j][0] * qs), q1 = (int)rintf(v[j][1] * qs), q2 = (int)rintf(v[j][2] * qs), q3 = (int)rintf(v[j][3] * qs);
            o4[64 * j] = (unsigned)(q0 & 255) | ((unsigned)(q1 & 255) << 8) | ((unsigned)(q2 & 255) << 16) | ((unsigned)q3 << 24); }
        if (F.lane == 0) sa3[m] = am * (1.f / 127.f);
    }
}
constexpr int H4_OPB = 34816, H4_KR = 17408, H4_ED0 = 3 * H4_OPB, H4_EDB = 1536, H4_VS0 = H4_ED0 + 3 * H4_EDB, H4_VSB = 4096, H4_VT0 = H4_VS0 + 3 * H4_VSB, H4_VTB = 4608, H4_ST0 = H4_VT0 + 2 * H4_VTB, H4_STB = 8704, H4_END = H4_ST0 + 2 * H4_STB;
static_assert(H4_END <= LDSCTL_OFF, "hgrn4 LDS map");
constexpr size_t WS_H3QR = WS_QKV, WS_H3KR = WS_QKV + 136 * MiB, WS_H3VH = WS_QKV + 272 * MiB, WS_H3SG = WS_AO, WS_H3EL = WS_AO + 128 * MiB, WS_H3DEC = WS_AO + 132 * MiB, WS_H3ER = WS_AO + 136 * MiB;
static_assert(WS_H3VH + 128 * MiB <= WS_MRG && WS_H3ER + 4 * MiB + 512 <= WS_LSE, "hgrn4 workspace map");
__device__ __forceinline__ void hgrn_mfma3(Frame& F) {
    const char* TQR = (const char*)(F.ws + WS_H3QR); const char* TKR = (const char*)(F.ws + WS_H3KR);
    const bf16* VH = (const bf16*)(F.ws + WS_H3VH); const float* ELg = (const float*)(F.ws + WS_H3EL); const float* DECg = (const float*)(F.ws + WS_H3DEC); const float* ERg = (const float*)(F.ws + WS_H3ER);
    bf16* ORAW = (bf16*)(F.ws + WS_ACT);
    LAS unsigned char* L = F.lds;
    const int w = F.wave, li = F.lane & 15, g4 = F.lane >> 4;
#pragma unroll 1
    for (int u = blockIdx.x; u < 256; u += F.G) {
        const int ux = u & 7, uy = u >> 3, bh = ux + 8 * (uy >> 2), e0 = (uy & 3) * 32, b = bh >> 5, h = bh & 31;
        const size_t rowbase = (size_t)b * SEQ;
#define H4_DMA(cc, sl) do { const size_t cid_ = (size_t)bh * 128 + (cc); const size_t cidn_ = ((cc) + 1 < SEQ / 64) ? cid_ + 1 : cid_; LAS unsigned char* ob_ = L + (sl) * H4_OPB; LAS unsigned char* eb_ = L + H4_ED0 + (sl) * H4_EDB; \
            _Pragma("unroll") for (int i_ = 0; i_ < 5; ++i_) { const int k_ = 5 * w + i_; \
                if (k_ < 34) { const int t_ = (k_ >= 17) ? 1 : 0, q_ = k_ - 17 * t_; \
                    __builtin_amdgcn_global_load_lds((const unsigned*)((t_ ? TKR : TQR) + cid_ * 17408 + q_ * 1024 + F.lane * 16), (LAS unsigned*)(ob_ + t_ * H4_KR + q_ * 1024), 16, 0, 0); } \
                else { const int e_ = k_ - 34, ar_ = e_ >> 1; const float* sp_ = (ar_ == 0) ? (ELg + cid_ * 128) : (ar_ == 1) ? (DECg + cid_ * 128) : (ERg + cidn_ * 128); \
                    __builtin_amdgcn_global_load_lds((const unsigned*)(sp_ + (e_ & 1) * 64 + F.lane), (LAS unsigned*)(eb_ + ar_ * 512 + (e_ & 1) * 256), 4, 0, 0); } } \
            _Pragma("unroll") for (int i_ = 0; i_ < 2; ++i_) { const int p_ = 2 * w + i_; \
                __builtin_amdgcn_global_load_lds((const unsigned*)(VH + ((size_t)bh * SEQ + 64 * (cc) + 4 * p_ + (F.lane >> 4)) * 128 + e0 + 2 * (F.lane & 15)), (LAS unsigned*)(L + H4_VS0 + (sl) * H4_VSB + p_ * 256), 4, 0, 0); } } while (0)
        f32x4 S[2][2];
#pragma unroll
        for (int a = 0; a < 2; ++a)
#pragma unroll
            for (int c2 = 0; c2 < 2; ++c2) S[a][c2] = (f32x4){0.f, 0.f, 0.f, 0.f};
        for (int i = F.tid; i < H4_STB / 4; i += NWAVES * 64) ((LAS unsigned*)(L + H4_ST0))[i] = 0u;
        H4_DMA(0, 0); H4_DMA(1, 1);
        int sl = 0;
#pragma unroll 1
        for (int c = 0; c < SEQ / 64; ++c) {
            if (w < 4 && c >= 2) asm volatile("s_waitcnt vmcnt(11)" ::: "memory"); else asm volatile("s_waitcnt vmcnt(7)" ::: "memory");
            {
                const LAS unsigned char* vs = L + H4_VS0 + sl * H4_VSB; LAS unsigned char* vt = L + H4_VT0 + (c & 1) * H4_VTB;
                const int row = 8 * w + (F.lane >> 3), eq = 4 * (F.lane & 7);
                const v2u vv = *(const LAS v2u*)(vs + row * 64 + eq * 2);
                *(LAS unsigned short*)(vt + (eq + 0) * 144 + row * 2) = (unsigned short)(vv.x & 0xffffu); *(LAS unsigned short*)(vt + (eq + 1) * 144 + row * 2) = (unsigned short)(vv.x >> 16);
                *(LAS unsigned short*)(vt + (eq + 2) * 144 + row * 2) = (unsigned short)(vv.y & 0xffffu); *(LAS unsigned short*)(vt + (eq + 3) * 144 + row * 2) = (unsigned short)(vv.y >> 16); }
            LDS_WAIT(); __builtin_amdgcn_s_barrier(); asm volatile("" ::: "memory");
            { const int cn = (c + 2 < SEQ / 64) ? c + 2 : SEQ / 64 - 1; const int sn = (sl == 0) ? 2 : sl - 1;
              H4_DMA(cn, sn); }
            const LAS unsigned char* OB = L + sl * H4_OPB; const LAS unsigned char* VT = L + H4_VT0 + (c & 1) * H4_VTB;
            const LAS unsigned char* stc = L + H4_ST0 + (c & 1) * H4_STB;
            LAS unsigned char* stn = L + H4_ST0 + ((c + 1) & 1) * H4_STB;
            if (w < 4) {
                const int tq = w;
                f32x4 Y[2]; Y[0] = (f32x4){0.f, 0.f, 0.f, 0.f}; Y[1] = Y[0];
                bf16x8 bqr[4];
#pragma unroll
                for (int kd = 0; kd < 4; ++kd) { bqr[kd] = *(const LAS bf16x8*)(OB + (16 * tq + li) * 272 + (32 * kd + 8 * g4) * 2);
#pragma unroll
                    for (int eb = 0; eb < 2; ++eb) { const bf16x8 a = *(const LAS bf16x8*)(stc + (16 * eb + li) * 272 + (32 * kd + 8 * g4) * 2); Y[eb] = __builtin_amdgcn_mfma_f32_16x16x32_bf16(a, bqr[kd], Y[eb], 0, 0, 0); } }
                f32x4 X[4];
#pragma unroll
                for (int sb = 0; sb < 4; ++sb) { f32x4 acc = (f32x4){0.f, 0.f, 0.f, 0.f};
                    if (sb <= tq) {
#pragma unroll
                        for (int kd = 0; kd < 4; ++kd) { const bf16x8 a = *(const LAS bf16x8*)(OB + H4_KR + (16 * sb + li) * 272 + (32 * kd + 8 * g4) * 2); acc = __builtin_amdgcn_mfma_f32_16x16x32_bf16(a, bqr[kd], acc, 0, 0, 0); }
                        if (sb == tq) {
#pragma unroll
                            for (int r = 0; r < 4; ++r) if (4 * g4 + r > li) acc[r] = 0.f; } }
                    X[sb] = acc; }
#pragma unroll
                for (int pr = 0; pr < 2; ++pr) { if (2 * pr <= tq) {
                    const bf16x8 pf = __builtin_bit_cast(bf16x8, (v4u){cvtpk(X[2 * pr][0], X[2 * pr][1]), cvtpk(X[2 * pr][2], X[2 * pr][3]), cvtpk(X[2 * pr + 1][0], X[2 * pr + 1][1]), cvtpk(X[2 * pr + 1][2], X[2 * pr + 1][3])});
#pragma unroll
                    for (int eb = 0; eb < 2; ++eb) { const v2u alo = *(const LAS v2u*)(VT + (16 * eb + li) * 144 + (32 * pr + 4 * g4) * 2), ahi = *(const LAS v2u*)(VT + (16 * eb + li) * 144 + (32 * pr + 16 + 4 * g4) * 2);
                        const bf16x8 a = __builtin_bit_cast(bf16x8, (v4u){alo.x, alo.y, ahi.x, ahi.y}); Y[eb] = __builtin_amdgcn_mfma_f32_16x16x32_bf16(a, pf, Y[eb], 0, 0, 0); } } }
                bf16* orow = ORAW + (rowbase + 64 * c + 16 * tq + li) * DM + h * 128 + e0 + 4 * g4;
#pragma unroll
                for (int eb = 0; eb < 2; ++eb) *(GAS v2u*)(orow + 16 * eb) = (v2u){cvtpk(Y[eb][0], Y[eb][1]), cvtpk(Y[eb][2], Y[eb][3])};
            } else {
                const int dt = w - 4;
                const LAS float* ELs = (const LAS float*)(L + H4_ED0 + sl * H4_EDB); const LAS float* DECs = ELs + 128; const LAS float* ERs = ELs + 256;
#pragma unroll
                for (int dbl = 0; dbl < 2; ++dbl) { const int db = 2 * dt + dbl;
                    f32x4 T[2]; T[0] = (f32x4){0.f, 0.f, 0.f, 0.f}; T[1] = T[0];
#pragma unroll
                    for (int ks = 0; ks < 2; ++ks) {
                        const unsigned ka = (unsigned)(size_t)(OB + H4_KR + (32 * ks + 4 * g4 + (li >> 2)) * 272 + (16 * db + 4 * (li & 3)) * 2);
                        v2u lo, hi;
                        asm volatile("ds_read_b64_tr_b16 %0, %2\n\tds_read_b64_tr_b16 %1, %2 offset:4352\n\ts_waitcnt lgkmcnt(0)" : "=&v"(lo), "=&v"(hi) : "v"(ka) : "memory");
                        const bf16x8 a = __builtin_bit_cast(bf16x8, (v4u){lo.x, lo.y, hi.x, hi.y});
#pragma unroll
                        for (int eb = 0; eb < 2; ++eb) { const v2u blo = *(const LAS v2u*)(VT + (16 * eb + li) * 144 + (32 * ks + 4 * g4) * 2), bhi = *(const LAS v2u*)(VT + (16 * eb + li) * 144 + (32 * ks + 16 + 4 * g4) * 2);
                            const bf16x8 bv = __builtin_bit_cast(bf16x8, (v4u){blo.x, blo.y, bhi.x, bhi.y}); T[eb] = __builtin_amdgcn_mfma_f32_16x16x32_bf16(a, bv, T[eb], 0, 0, 0); } }
                    const f32x4 dec = *(const LAS f32x4*)(DECs + 16 * db + 4 * g4), el = *(const LAS f32x4*)(ELs + 16 * db + 4 * g4), er = *(const LAS f32x4*)(ERs + 16 * db + 4 * g4);
#pragma unroll
                    for (int eb = 0; eb < 2; ++eb) { S[dbl][eb] = dec * S[dbl][eb] + el * T[eb]; const f32x4 sv = S[dbl][eb] * er;
                        *(LAS v2u*)(stn + (16 * eb + li) * 272 + (16 * db + 4 * g4) * 2) = (v2u){cvtpk(sv[0], sv[1]), cvtpk(sv[2], sv[3])}; } }
            }
            sl = (sl == 2) ? 0 : sl + 1;
        }
        asm volatile("s_waitcnt vmcnt(0)" ::: "memory"); LDS_WAIT(); __builtin_amdgcn_s_barrier(); asm volatile("" ::: "memory");
#undef H4_DMA
    }
}
struct Args { const float* in[11]; float* out; unsigned char* ws; int ph_lo, ph_hi, li, pad; };
__global__ void __launch_bounds__(NWAVES * 64, 2) mega_fwd(Args args) {
    extern __shared__ __attribute__((aligned(16))) unsigned char lds[];
    Frame F;
    F.lds = (LAS unsigned char*)lds;
    F.MISC = (volatile LAS unsigned*)(F.lds + MISC_OFF);
    F.tid = threadIdx.x; F.lane = F.tid & 63; F.wave = __builtin_amdgcn_readfirstlane(F.tid >> 6);
    F.G = gridDim.x; { const int bx = blockIdx.x; F.vcu = (F.G % 8 == 0) ? (bx % 8) * (F.G / 8) + bx / 8 : bx; }
#define GRID_BAR(seam) do { if (N_LAUNCHES != 1) { if (F.tid == 0) __hip_atomic_store(F.ctl + CW_TMO, 0xBADBA0u | (unsigned)(seam), RLX_AGENT); } \
    else { xcd_barrier(bar); } } while (0)
    unsigned char* ws = args.ws; F.ws = ws;
    F.ctl = (gu32*)(ws + WS_CTL);
    F.x = args.in[0]; F.gains = args.in[1]; F.rel_bias = args.in[2]; F.w_att_in = args.in[3]; F.w_att_out = args.in[4]; F.w_hg_in = args.in[5];
    F.lb_logits = args.in[6]; F.hg_gain = args.in[7]; F.w_hg_out = args.in[8]; F.w_ff_in = args.in[9]; F.w_ff_out = args.in[10]; F.out = args.out;
    for (int u = F.tid; u < (LDS_BYTES - LDSCTL_OFF) / 4; u += NWAVES * 64) ((LAS unsigned*)(F.lds + LDSCTL_OFF))[u] = 0u;
    __syncthreads();
    XcdBarrier bar; bar.bar = (unsigned*)(F.ctl + CW_BAR); bar.x = 0; bar.st = nullptr;
    if (N_LAUNCHES == 1) bar = xcd_barrier_post((unsigned*)(F.ctl + CW_BAR), F.MISC + 8);

    const int lo = args.ph_lo, hi = args.ph_hi;
#define IN(k) (lo <= (k) && (k) < hi)
#define BOTH(k) (IN(k) && IN((k) + 1))
    bf16* const XN = (bf16*)(ws + WS_XN); bf16* const HB = (bf16*)(ws + WS_HB); bf16* const Y = (bf16*)(ws + WS_Y); bf16* const ACT = (bf16*)(ws + WS_ACT);

    if (IN(0)) { for (int rep_ = 0; rep_ < REP_P0; ++rep_) p0_prologue(F);
        if (FFN_I8 && !P0_STRIP) { GRID_BAR(18);
            for (int l = 0; l < 2; ++l) p0_quant_rows<TM_FFI>(F, (const bf16*)(ws + WS_WFFI + l * WFFI_STRIDE), ws + WS_W8 + l * W8_STRIDE, (float*)(ws + WS_SW) + l * 2 * DFF, 2 * DFF);
            if (HGO_I8) p0_quant_wout<DM>(F, (const bf16*)(ws + WS_WHGO), ws + WS_W8G, (float*)(ws + WS_SWG));
            if (FFO_I8) for (int l = 0; l < 2; ++l) p0_quant_wout<DFF>(F, (const bf16*)(ws + WS_WFFO + l * WFFO_STRIDE), ws + WS_W8O + l * W8O_STRIDE, (float*)(ws + WS_SWO) + l * DM);
            if (ATT_I8) p0_quant_rows<false>(F, (const bf16*)(ws + WS_WATTI), ws + WS_W8A, (float*)(ws + WS_SWA), NQKV);
            if (HG_I8) p0_quant_rows<false>(F, (const bf16*)(ws + WS_WHGI), ws + WS_W8H, (float*)(ws + WS_SWH), NHG); }
        if (BOTH(0)) GRID_BAR(0); }
    if (IN(1)) {
        pg8::StaticOrder S; S.init(M, NQKV, F.G, (int)blockIdx.x);
        pg8::Gemm g{XN, ATT_I8 ? (const bf16*)(ws + WS_W8A) : (const bf16*)(ws + WS_WATTI), M, NQKV, ATT_I8 ? DM / 2 : DM};
        pg8::EpiBf16T<ATT_I8> E{(bf16*)(ws + WS_QKV), ATTN_MFMA ? 2048 : NQKV, ATTN_MFMA ? 2048 : 0, ATTN_MFMA ? (size_t)M * 2048 : 0, ATTN_MFMA ? 1 : 0, (const float*)(ws + WS_SA), (const float*)(ws + WS_SWA)};
        const bool ovl_first = ((int)blockIdx.x & 1) == 0;
        if (P0_STRIP && P0_OVL && ovl_first) run_strips<4>(F, F.vcu, F.G);
        pg8::gemm_phase<pg8::EpiBf16T<ATT_I8>, pg8::StaticOrder, PG8_ALIGN, PG8_SP2, ATT_I8>(F.lds + RING_OFF, g, S, E); if (REP_GEMM > 1) { pg8::gemm_phase<pg8::EpiBf16T<ATT_I8>, pg8::StaticOrder, PG8_ALIGN, PG8_SP2, ATT_I8>(F.lds + RING_OFF, g, S, E); }
        if (P0_STRIP && P0_OVL && !ovl_first) { asm volatile("s_waitcnt vmcnt(0)" ::: "memory"); __syncthreads(); run_strips<4>(F, F.vcu, F.G); }
        if (BOTH(1)) GRID_BAR(1);
    }
    if (IN(2)) { if (ATTN_MFMA) { for (int rep_ = 0; rep_ < REP_ATT; ++rep_) { attn_mfma(F); GRID_BAR(16); attn_merge(F); if (rep_ + 1 < REP_ATT) GRID_BAR(17); } } else attn_naive(F); if (BOTH(2)) GRID_BAR(2); }
    if (IN(3)) {
        pg8::Gemm g{(const bf16*)(ws + WS_MRG), (const bf16*)(ws + WS_WATTO), M, DM, DATT}; pg8::StaticOrder S; S.init(M, DM, F.G, (int)blockIdx.x);
        pg8::EpiBf16 E{Y, DM, 0, 0, 0, nullptr, nullptr};
        pg8::gemm_phase<pg8::EpiBf16, pg8::StaticOrder, PG8_ALIGN, PG8_SP2>(F.lds + RING_OFF, g, S, E); if (REP_GEMM > 1) { pg8::gemm_phase<pg8::EpiBf16, pg8::StaticOrder, PG8_ALIGN, PG8_SP2>(F.lds + RING_OFF, g, S, E); }
        if (BOTH(3)) GRID_BAR(3);
    }
    if (IN(4)) { for (int rep_ = 0; rep_ < REP_NORM; ++rep_) norm_rows<true, FFN_I8 ? (TM_FFI ? 3 : 2) : 1, false, true>(F, F.x, Y, HB, XN, F.gains + 1 * DM, F.gains + 2 * DM, (float*)(ws + WS_SA)); if (BOTH(4)) GRID_BAR(4); }
    if (IN(5)) {
        pg8::StaticOrder S; S.init(M, 2 * DFF, F.G, (int)blockIdx.x);
        if (FFN_I8) {
            pg8::Gemm g{XN, (const bf16*)(ws + WS_W8), M, 2 * DFF, DM / 2};
            if (FFO_I8) {
                pg8::EpiSwiGLU8R E{ACT, DFF, (const float*)(ws + WS_SA), (const float*)(ws + WS_SW) + 0, (unsigned*)(ws + WS_RMAX) + 0 * M};
                pg8::gemm_phase<pg8::EpiSwiGLU8R, pg8::StaticOrder, PG8_ALIGN, PG8_SP2, true, 1, 1, TM_FFI>(F.lds + RING_OFF, g, S, E);
                if (P0_STRIP) run_deferred_strips<1>(F, (M / 256) * (2 * DFF / 256));
            } else {
            pg8::EpiSwiGLU8 E{ACT, DFF, (const float*)(ws + WS_SA), (const float*)(ws + WS_SW) + 0, (bf16*)(ws + WS_QKV)};
                pg8::gemm_phase<pg8::EpiSwiGLU8, pg8::StaticOrder, PG8_ALIGN, PG8_SP2, true, KREP_FFI, EREP_FFI, TM_FFI, TCH_FFI, LT_FFI>(F.lds + RING_OFF, g, S, E); if (REP_GEMM > 1 || REP_FFI > 1) { pg8::gemm_phase<pg8::EpiSwiGLU8, pg8::StaticOrder, PG8_ALIGN, PG8_SP2, true, 1, 1, TM_FFI>(F.lds + RING_OFF, g, S, E); }
            }
        } else {
            pg8::Gemm g{XN, (const bf16*)(ws + WS_WFFI), M, 2 * DFF, DM};
            pg8::EpiSwiGLU E{ACT, DFF};
            pg8::gemm_phase<pg8::EpiSwiGLU, pg8::StaticOrder, PG8_ALIGN, PG8_SP2>(F.lds + RING_OFF, g, S, E); if (REP_GEMM > 1) { pg8::gemm_phase<pg8::EpiSwiGLU, pg8::StaticOrder, PG8_ALIGN, PG8_SP2>(F.lds + RING_OFF, g, S, E); }
        }
        if (BOTH(5)) GRID_BAR(5);
    }
    if (IN(6)) {
        pg8::StaticOrder S; S.init(M, DM, F.G, (int)blockIdx.x);
        if (FFO_I8) {
            act_quant_rows(F, ACT, ws + WS_ACT8, (const unsigned*)(ws + WS_RMAX) + 0 * M, (float*)(ws + WS_SA2));
            GRID_BAR(20);
            pg8::Gemm g{(const bf16*)(ws + WS_ACT8), (const bf16*)(ws + WS_W8O + 0 * W8O_STRIDE), M, DM, DFF / 2};
            pg8::EpiBf16T<true> E{Y, DM, 0, 0, 0, (const float*)(ws + WS_SA2), (const float*)(ws + WS_SWO) + 0 * DM};
            pg8::gemm_phase<pg8::EpiBf16T<true>, pg8::StaticOrder, PG8_ALIGN, PG8_SP2, true>(F.lds + RING_OFF, g, S, E);
        } else {
            pg8::Gemm g{ACT, (const bf16*)(ws + WS_WFFO), M, DM, DFF};
            pg8::EpiBf16 E{Y, DM, 0, 0, 0, nullptr, nullptr};
            pg8::gemm_phase<pg8::EpiBf16, pg8::StaticOrder, PG8_ALIGN, PG8_SP2>(F.lds + RING_OFF, g, S, E);
        }
        if (BOTH(6)) GRID_BAR(6);
    }
    if (IN(7)) { norm_rows<true, HG_I8 ? 2 : 1, true, true>(F, HB, Y, HB, XN, F.gains + 3 * DM, F.gains + 4 * DM, (float*)(ws + WS_SA)); if (BOTH(7)) GRID_BAR(7); }
    if (IN(8)) {
        pg8::StaticOrder S; S.init(M, NHG, F.G, (int)blockIdx.x);
        pg8::Gemm g{XN, HG_I8 ? (const bf16*)(ws + WS_W8H) : (const bf16*)(ws + WS_WHGI), M, NHG, HG_I8 ? DM / 2 : DM};
        if (HG_FUSE == 0) {
            pg8::EpiHgrn<HG_I8> E{(bf16*)(ws + WS_QKV), (bf16*)(ws + WS_AO), (const float*)(ws + WS_TAB + 65536), (const float*)(ws + WS_SA), (const float*)(ws + WS_SWH)};
            pg8::gemm_phase<pg8::EpiHgrn<HG_I8>, pg8::StaticOrder, PG8_ALIGN, PG8_SP2, HG_I8>(F.lds + RING_OFF, g, S, E);
        } else if (HG_FUSE == 1) {
            pg8::EpiHgrn2<HG_I8> E{(bf16*)(ws + WS_QKV), (bf16*)(ws + WS_AO), (const float*)(ws + WS_TAB + 65536), (const float*)(ws + WS_SA), (const float*)(ws + WS_SWH)};
            pg8::gemm_phase<pg8::EpiHgrn2<HG_I8>, pg8::StaticOrder, PG8_ALIGN, PG8_SP2, HG_I8>(F.lds + RING_OFF, g, S, E);
        } else {
            pg8::EpiHgrn3<HG_I8> E{(bf16*)(ws + WS_H3QR), (WS_H3KR - WS_H3QR) / 2, (WS_H3VH - WS_H3QR) / 2, (WS_H3SG - WS_H3QR) / 2, (float*)(ws + WS_H3EL), (float*)(ws + WS_H3DEC), (float*)(ws + WS_H3ER),
                                   (const float*)(ws + WS_TAB + 65536), (const float*)(ws + WS_SA), (const float*)(ws + WS_SWH)};
            pg8::gemm_phase<pg8::EpiHgrn3<HG_I8>, pg8::StaticOrder, PG8_ALIGN, PG8_SP2, HG_I8>(F.lds + RING_OFF, g, S, E);
            if (REP_P8 > 1) { pg8::gemm_phase<pg8::EpiHgrn3<HG_I8>, pg8::StaticOrder, PG8_ALIGN, PG8_SP2, HG_I8>(F.lds + RING_OFF, g, S, E); }
        }
        if (BOTH(8)) GRID_BAR(8);
    }
    if (IN(9)) { if (HG_FUSE == 2) { hgrn_mfma3(F); if (REP_HG > 1) hgrn_mfma3(F); } else { hgrn_mfma2(F); if (REP_HG > 1) hgrn_mfma2(F); } if (BOTH(9)) GRID_BAR(9); }
    if (IN(10)) { if (HGO_I8) hgrn_gate3(F); else { hgrn_gate2(F); if (REP_HG > 1) hgrn_gate2(F); } if (BOTH(10)) GRID_BAR(10); }
    if (IN(11)) {
        pg8::StaticOrder S; S.init(M, DM, F.G, (int)blockIdx.x);
        if (HGO_I8) {
            pg8::Gemm g{(const bf16*)(ws + WS_OG), (const bf16*)(ws + WS_W8G), M, DM, DM / 2};
            pg8::EpiBf16T<true> E{Y, DM, 0, 0, 0, (const float*)(ws + WS_SA3), (const float*)(ws + WS_SWG)};
            pg8::gemm_phase<pg8::EpiBf16T<true>, pg8::StaticOrder, PG8_ALIGN, PG8_SP2, true>(F.lds + RING_OFF, g, S, E);
        } else {
            pg8::Gemm g{(const bf16*)(ws + WS_OG), (const bf16*)(ws + WS_WHGO), M, DM, DM};
            pg8::EpiBf16 E{Y, DM, 0, 0, 0, nullptr, nullptr};
            pg8::gemm_phase<pg8::EpiBf16, pg8::StaticOrder, PG8_ALIGN, PG8_SP2>(F.lds + RING_OFF, g, S, E);
        }
        if (BOTH(11)) GRID_BAR(11);
    }
    if (IN(12)) { norm_rows<true, FFN_I8 ? (TM_FFI ? 3 : 2) : 1, true, true>(F, HB, Y, HB, XN, F.gains + 5 * DM, F.gains + 6 * DM, (float*)(ws + WS_SA)); if (BOTH(12)) GRID_BAR(12); }
    if (IN(13)) {
        pg8::StaticOrder S; S.init(M, 2 * DFF, F.G, (int)blockIdx.x);
        if (FFN_I8) {
            pg8::Gemm g{XN, (const bf16*)(ws + WS_W8 + W8_STRIDE), M, 2 * DFF, DM / 2};
            if (FFO_I8) {
                pg8::EpiSwiGLU8R E{ACT, DFF, (const float*)(ws + WS_SA), (const float*)(ws + WS_SW) + 2 * DFF, (unsigned*)(ws + WS_RMAX) + 1 * M};
                pg8::gemm_phase<pg8::EpiSwiGLU8R, pg8::StaticOrder, PG8_ALIGN, PG8_SP2, true, 1, 1, TM_FFI>(F.lds + RING_OFF, g, S, E);
                if (P0_STRIP) run_deferred_strips<2>(F, (M / 256) * (2 * DFF / 256));
            } else {
            pg8::EpiSwiGLU8 E{ACT, DFF, (const float*)(ws + WS_SA), (const float*)(ws + WS_SW) + 2 * DFF, (bf16*)(ws + WS_QKV)};
                pg8::gemm_phase<pg8::EpiSwiGLU8, pg8::StaticOrder, PG8_ALIGN, PG8_SP2, true, KREP_FFI, EREP_FFI, TM_FFI, TCH_FFI, LT_FFI>(F.lds + RING_OFF, g, S, E); if (REP_GEMM > 1 || REP_FFI > 1) { pg8::gemm_phase<pg8::EpiSwiGLU8, pg8::StaticOrder, PG8_ALIGN, PG8_SP2, true, 1, 1, TM_FFI>(F.lds + RING_OFF, g, S, E); }
            }
        } else {
            pg8::Gemm g{XN, (const bf16*)(ws + WS_WFFI + WFFI_STRIDE), M, 2 * DFF, DM};
            pg8::EpiSwiGLU E{ACT, DFF};
            pg8::gemm_phase<pg8::EpiSwiGLU, pg8::StaticOrder, PG8_ALIGN, PG8_SP2>(F.lds + RING_OFF, g, S, E); if (REP_GEMM > 1) { pg8::gemm_phase<pg8::EpiSwiGLU, pg8::StaticOrder, PG8_ALIGN, PG8_SP2>(F.lds + RING_OFF, g, S, E); }
        }
        if (BOTH(13)) GRID_BAR(13);
    }
    if (IN(14)) {
        pg8::StaticOrder S; S.init(M, DM, F.G, (int)blockIdx.x);
        if (FFO_I8) {
            act_quant_rows(F, ACT, ws + WS_ACT8, (const unsigned*)(ws + WS_RMAX) + 1 * M, (float*)(ws + WS_SA2));
            GRID_BAR(21);
            pg8::Gemm g{(const bf16*)(ws + WS_ACT8), (const bf16*)(ws + WS_W8O + 1 * W8O_STRIDE), M, DM, DFF / 2};
            pg8::EpiBf16T<true> E{Y, DM, 0, 0, 0, (const float*)(ws + WS_SA2), (const float*)(ws + WS_SWO) + 1 * DM};
            pg8::gemm_phase<pg8::EpiBf16T<true>, pg8::StaticOrder, PG8_ALIGN, PG8_SP2, true>(F.lds + RING_OFF, g, S, E);
        } else {
            pg8::Gemm g{ACT, (const bf16*)(ws + WS_WFFO + WFFO_STRIDE), M, DM, DFF};
            pg8::EpiBf16 E{Y, DM, 0, 0, 0, nullptr, nullptr};
            pg8::gemm_phase<pg8::EpiBf16, pg8::StaticOrder, PG8_ALIGN, PG8_SP2>(F.lds + RING_OFF, g, S, E);
        }
        if (BOTH(14)) GRID_BAR(14);
    }
    if (REP_BAR > 0) { for (int rb_ = 0; rb_ < REP_BAR; ++rb_) GRID_BAR(30); }
    if (IN(15)) { norm_rows<true, 0, true, false>(F, HB, Y, F.out, nullptr, F.gains + 7 * DM, nullptr); }
#undef IN
#undef BOTH
}

extern "C" void kernel_launch(void* const* d_in, const int* in_sizes, int n_in, void* d_out, int out_size, void* d_ws, size_t ws_size, hipStream_t stream) {
    static int grid = 0;
    if (grid == 0) {
        if (n_in != 11 || in_sizes[0] != M * DM || out_size != M * DM || ws_size < WS_END5) { fprintf(stderr, "kernel_launch: unexpected shapes (n_in %d, in0 %d, out %d, ws %zu, need %zu); nothing launched\n", n_in, n_in > 0 ? in_sizes[0] : -1, out_size, ws_size, (size_t)WS_END); grid = -1; return; }
        int dev = 0, cus = 0, per_cu = 0;
        if (hipGetDevice(&dev) != hipSuccess || hipDeviceGetAttribute(&cus, hipDeviceAttributeMultiprocessorCount, dev) != hipSuccess) { grid = -1; return; }
        if (hipFuncSetAttribute((const void*)mega_fwd, hipFuncAttributeMaxDynamicSharedMemorySize, LDS_BYTES) != hipSuccess) { fprintf(stderr, "kernel_launch: hipFuncSetAttribute failed\n"); grid = -1; return; }
        if (hipOccupancyMaxActiveBlocksPerMultiprocessor(&per_cu, (const void*)mega_fwd, NWAVES * 64, LDS_BYTES) != hipSuccess || per_cu < 1)
            fprintf(stderr, "kernel_launch: note: occupancy query reports %d workgroups per CU\n", per_cu);
        (void)hipGetLastError();
        grid = cus;
    }
    if (grid < 0) return;
    if (hipMemsetAsync((char*)d_ws + WS_CTL, 0, CTL_ZERO_BYTES, stream) != hipSuccess) { fprintf(stderr, "kernel_launch: hipMemsetAsync failed\n"); return; }
    Args a{};
    for (int i = 0; i < 11; ++i) a.in[i] = (const float*)d_in[i];
    a.out = (float*)d_out; a.ws = (unsigned char*)d_ws;
    for (int li = 0; li < N_LAUNCHES; ++li) {
        a.ph_lo = (N_LAUNCHES == 1) ? 0 : li; a.ph_hi = (N_LAUNCHES == 1) ? NPH : li + 1; a.li = li;
        hipLaunchKernelGGL(mega_fwd, dim3(grid), dim3(NWAVES * 64), LDS_BYTES, stream, a);
        const hipError_t le = hipPeekAtLastError();
        if (le != hipSuccess) { fprintf(stderr, "kernel_launch: launch %d failed: %s\n", li, hipGetErrorName(le)); break; }
    }
}
```

```cpp
#include <hip/hip_runtime.h>
#include <cstdio>
#include <cstdint>
#ifndef PG8_WGM
#define PG8_WGM 8
#endif
#ifndef MK_FFO_ROT
#define MK_FFO_ROT 1
#endif
namespace pg8 {
#define PG8_LAS __attribute__((address_space(3)))
typedef unsigned short bf16_t;
typedef short bf16x8 __attribute__((ext_vector_type(8)));
typedef float f32x4 __attribute__((ext_vector_type(4)));
typedef unsigned u32x4 __attribute__((ext_vector_type(4)));
constexpr int BM = 256, BK = 64, HALF = 128, HTB = HALF * BK * 2  , STAGE_BYTES = 8 * HTB, NXCD = 8, WGM = PG8_WGM;

__host__ __device__ __forceinline__ int lds_byte(int r, int c) { const int st = (r >> 4) * 2 + (c >> 5), rr = r & 15, cc = c & 31, ob = rr * 64 + cc * 2; return st * 1024 + (ob ^ (((ob >> 9) & 1) << 5)); }
__host__ __device__ __forceinline__ void stage_rc(int b, int& R, int& C) { const int st = b / 1024, sb = b % 1024, swz = sb ^ (((sb >> 9) & 1) << 5); R = (st >> 1) * 16 + swz / 64; C = (st & 1) * 32 + (swz % 64) / 2; }
__host__ __device__ __forceinline__ int perm32(int rho) { const int n = rho >> 4, i = rho & 15; return 8 * (i >> 2) + 4 * n + (i & 3); }

struct Unit { int pm, pn; };
struct Gemm { const bf16_t* A; const bf16_t* Bt; int M, N, K; };

struct StaticOrder {
    int nM, nN, nwg, G, c;
    __host__ __device__ void init(int M, int N, int G_, int c_) { nM = M / BM; nN = N / BM; nwg = nM * nN; G = G_; c = c_; }
    __host__ __device__ bool next(int i, Unit& u) const {
        const long L = (long)i * G + c; if (L >= nwg) return false;
        int wgid = (int)L; { const int q = nwg / NXCD, r = nwg % NXCD, xcd = wgid % NXCD, off = wgid / NXCD; wgid = (xcd < r ? xcd * (q + 1) : r * (q + 1) + (xcd - r) * q) + off; }
        const int nig = WGM * nN, gid = wgid / nig, fm = gid * WGM, gsz = (nM - fm) < WGM ? (nM - fm) : WGM;
        u.pm = fm + ((wgid % nig) % gsz); u.pn = (wgid % nig) / gsz; return true;
    }
    __device__ __forceinline__ void a_ready(const Unit&) const {}
    __device__ __forceinline__ void done(const Unit&) const {}
};

__device__ __forceinline__ unsigned cvt_pk_bf16(float lo, float hi) { unsigned r; asm volatile("v_cvt_pk_bf16_f32 %0, %1, %2" : "=v"(r) : "v"(lo), "v"(hi)); return r; }
typedef float f32x2 __attribute__((ext_vector_type(2)));
typedef int i32x4 __attribute__((ext_vector_type(4)));
template <bool I8> struct AccT { typedef f32x4 type; static __device__ __forceinline__ f32x4 zero() { return (f32x4){0.f, 0.f, 0.f, 0.f}; } };
template <> struct AccT<true> { typedef i32x4 type; static __device__ __forceinline__ i32x4 zero() { return (i32x4){0, 0, 0, 0}; } };
__device__ __forceinline__ f32x4 mma16(bf16x8 a, bf16x8 b, f32x4 c) { return __builtin_amdgcn_mfma_f32_16x16x32_bf16(a, b, c, 0, 0, 0); }
__device__ __forceinline__ i32x4 mma16(bf16x8 a, bf16x8 b, i32x4 c) { return __builtin_amdgcn_mfma_i32_16x16x64_i8(__builtin_bit_cast(i32x4, a), __builtin_bit_cast(i32x4, b), c, 0, 0, 0); }
__host__ __device__ __forceinline__ size_t tm_chunk_off(int r, int cb, int nt, bool perm) {
    const int p = r >> 8, rr = r & 255, half = rr >> 7; int R = rr & 127;
    if (perm) { const int x = R & 31; R = (R & ~31) + 16 * ((x >> 2) & 1) + 4 * (x >> 3) + (x & 3); }
    return ((size_t)(p * nt + (cb >> 7)) * 2 + half) * 16384 + (size_t)lds_byte(R, (cb & 127) >> 1) + (cb & 1);
}
#ifndef MK_ACT_NT
#define MK_ACT_NT 0
#endif
#ifndef MK_ST_SC1
#define MK_ST_SC1 0
#endif
__device__ __forceinline__ void st16nt(void* p, u32x4 v) {
#if MK_ACT_NT
    __builtin_nontemporal_store(v, (u32x4*)p);
#else
    *(u32x4*)p = v;
#endif
}
__device__ __forceinline__ void st16(void* p, u32x4 v) {
#if MK_ST_SC1
    asm volatile("global_store_dwordx4 %0, %1, off sc1\n\ts_nop 1" :: "v"(p), "v"(v) : "memory");
#else
    *(u32x4*)p = v;
#endif
}
__device__ __forceinline__ float silu_f(float x) { return x * __builtin_amdgcn_rcpf(1.0f + __expf(-x)); }
template <bool I8> struct EpiBf16T {
    static constexpr bool PERM = true, AFTER_DRAIN = false;
    bf16_t* O; int ldc; int split_cols; size_t split_stride; int dil; const float* sa; const float* sw;
    __device__ __forceinline__ void operator()(const typename AccT<I8>::type (&acc)[2][2][4][2], const Unit& u, int wr, int wc, int fr, int fq) const {
        const int row0 = u.pm * BM + wr * 64 + fr; int colt = u.pn * BM; bf16_t* base = O; int sh = 0;
        if (split_cols) { const int t = colt / split_cols; base += (size_t)t * split_stride; colt -= t * split_cols; if (dil) sh = 2 * (t / 3); }
        const int col0 = colt + wc * 32 + 8 * fq;
        f32x4 swv[2][2];
#pragma unroll
        for (int bj = 0; bj < 2; ++bj)
#pragma unroll
            for (int n = 0; n < 2; ++n) swv[bj][n] = I8 ? *(const f32x4*)(sw + u.pn * BM + wc * 32 + 8 * fq + bj * HALF + 4 * n) : (f32x4){1.f, 1.f, 1.f, 1.f};
#pragma unroll
        for (int ai = 0; ai < 2; ++ai)
#pragma unroll
            for (int m = 0; m < 4; ++m) { int r = row0 + ai * HALF + m * 16; const float sr = I8 ? sa[r] : 1.f;
                if (sh) { const int tt = r & 8191; r = (r & ~8191) + ((tt & ((1 << sh) - 1)) << (13 - sh)) + (tt >> sh); }
                bf16_t* rowp = base + (size_t)r * ldc + col0;
#pragma unroll
                for (int bj = 0; bj < 2; ++bj) { f32x4 v0, v1;
#pragma unroll
                    for (int j = 0; j < 4; ++j) { v0[j] = I8 ? (float)acc[ai][bj][m][0][j] * (sr * swv[bj][0][j]) : (float)acc[ai][bj][m][0][j]; v1[j] = I8 ? (float)acc[ai][bj][m][1][j] * (sr * swv[bj][1][j]) : (float)acc[ai][bj][m][1][j]; }
                    u32x4 w; w.x = cvt_pk_bf16(v0[0], v0[1]); w.y = cvt_pk_bf16(v0[2], v0[3]); w.z = cvt_pk_bf16(v1[0], v1[1]); w.w = cvt_pk_bf16(v1[2], v1[3]);
                    st16(rowp + bj * HALF, w); } }
    }
};
typedef EpiBf16T<false> EpiBf16;
struct EpiF32 {
    static constexpr bool PERM = false, AFTER_DRAIN = false;
    float* C; int ldc;
    __device__ __forceinline__ void operator()(const f32x4 (&acc)[2][2][4][2], const Unit& u, int wr, int wc, int fr, int fq) const {
        const int row0 = u.pm * BM + wr * 64 + fr, col0 = u.pn * BM + wc * 32 + 4 * fq;
#pragma unroll
        for (int ai = 0; ai < 2; ++ai)
#pragma unroll
            for (int m = 0; m < 4; ++m) { float* rowp = C + (size_t)(row0 + ai * HALF + m * 16) * ldc + col0;
#pragma unroll
                for (int bj = 0; bj < 2; ++bj)
#pragma unroll
                    for (int n = 0; n < 2; ++n) *(f32x4*)(rowp + bj * HALF + n * 16) = acc[ai][bj][m][n]; }
    }
};
struct EpiSwiGLU {
    static constexpr bool PERM = true, AFTER_DRAIN = false;
    bf16_t* O; int ldc;
    __device__ __forceinline__ void operator()(const f32x4 (&acc)[2][2][4][2], const Unit& u, int wr, int wc, int fr, int fq) const {
        const int row0 = u.pm * BM + wr * 64 + fr, col0 = u.pn * HALF + wc * 32 + 8 * fq;
#pragma unroll
        for (int ai = 0; ai < 2; ++ai)
#pragma unroll
            for (int m = 0; m < 4; ++m) { bf16_t* rowp = O + (size_t)(row0 + ai * HALF + m * 16) * ldc + col0;
                const f32x4 g0 = acc[ai][0][m][0], g1 = acc[ai][0][m][1], u0 = acc[ai][1][m][0], u1 = acc[ai][1][m][1];
                f32x4 v0, v1;
#pragma unroll
                for (int j = 0; j < 4; ++j) { v0[j] = silu_f(g0[j]) * u0[j]; v1[j] = silu_f(g1[j]) * u1[j]; }
                u32x4 w; w.x = cvt_pk_bf16(v0[0], v0[1]); w.y = cvt_pk_bf16(v0[2], v0[3]); w.z = cvt_pk_bf16(v1[0], v1[1]); w.w = cvt_pk_bf16(v1[2], v1[3]);
                st16(rowp, w); }
    }
};

template <bool I8> struct EpiHgrn {
    static constexpr bool PERM = true, AFTER_DRAIN = false;
    bf16_t* base; bf16_t* KH; const float* lb; const float* sa; const float* sw;
    __device__ __forceinline__ void operator()(const typename AccT<I8>::type (&acc)[2][2][4][2], const Unit& u, int wr, int wc, int fr, int fq) const {
        const int row0 = u.pm * BM + wr * 64 + fr, sec = u.pn >> 4, cs0 = (u.pn & 15) * BM + wc * 32 + 8 * fq;
        f32x4 lbv[2][2], swv[2][2];
#pragma unroll
        for (int bj = 0; bj < 2; ++bj)
#pragma unroll
            for (int n = 0; n < 2; ++n) { lbv[bj][n] = (sec == 1) ? *(const f32x4*)(lb + cs0 + bj * HALF + 4 * n) : (f32x4){0.f, 0.f, 0.f, 0.f};
                swv[bj][n] = I8 ? *(const f32x4*)(sw + u.pn * BM + wc * 32 + 8 * fq + bj * HALF + 4 * n) : (f32x4){1.f, 1.f, 1.f, 1.f}; }
        bf16_t* const hm = base + (size_t)sec * ((size_t)16384 * 4096);
#pragma unroll
        for (int ai = 0; ai < 2; ++ai)
#pragma unroll
            for (int m = 0; m < 4; ++m) { const int r = row0 + ai * HALF + m * 16, bb = r >> 13, tt = r & 8191; const float sr = I8 ? sa[r] : 1.f;
#pragma unroll
                for (int bj = 0; bj < 2; ++bj) { f32x4 v[2]; u32x4 w;
#pragma unroll
                    for (int n = 0; n < 2; ++n)
#pragma unroll
                        for (int j = 0; j < 4; ++j) v[n][j] = I8 ? (float)acc[ai][bj][m][n][j] * (sr * swv[bj][n][j]) : (float)acc[ai][bj][m][n][j];
                    const size_t hoff = ((size_t)(bb * 32 + (u.pn & 15) * 2 + bj) * 8192 + tt) * 128 + wc * 32 + 8 * fq;
                    if (sec == 1) { f32x4 kk[2];
#pragma unroll
                        for (int n = 0; n < 2; ++n)
#pragma unroll
                            for (int j = 0; j < 4; ++j) { const float fg = lbv[bj][n][j] + (1.f - lbv[bj][n][j]) * __builtin_amdgcn_rcpf(1.0f + __expf(-v[n][j])); kk[n][j] = 1.f - fg; v[n][j] = __logf(fg); }
                        u32x4 kw; kw.x = cvt_pk_bf16(kk[0][0], kk[0][1]); kw.y = cvt_pk_bf16(kk[0][2], kk[0][3]); kw.z = cvt_pk_bf16(kk[1][0], kk[1][1]); kw.w = cvt_pk_bf16(kk[1][2], kk[1][3]);
                        st16(KH + hoff, kw);
                    } else if (sec == 0) {
#pragma unroll
                        for (int n = 0; n < 2; ++n)
#pragma unroll
                            for (int j = 0; j < 4; ++j) v[n][j] = silu_f(v[n][j]) * 0.08838834764831845f;
                    } else if (sec == 3) {
#pragma unroll
                        for (int n = 0; n < 2; ++n)
#pragma unroll
                            for (int j = 0; j < 4; ++j) v[n][j] = silu_f(v[n][j]);
                    }
                    w.x = cvt_pk_bf16(v[0][0], v[0][1]); w.y = cvt_pk_bf16(v[0][2], v[0][3]); w.z = cvt_pk_bf16(v[1][0], v[1][1]); w.w = cvt_pk_bf16(v[1][2], v[1][3]);
                    st16(hm + ((sec == 3) ? ((size_t)r * 4096 + cs0 + bj * HALF) : hoff), w); } }
    }
};
struct EpiSwiGLU8 {
    static constexpr bool PERM = true, AFTER_DRAIN = false;
    bf16_t* O; int ldc; const float* sa; const float* sw; bf16_t* O2;
    __device__ __forceinline__ EpiSwiGLU8 alt() const { EpiSwiGLU8 e = *this; e.O = O2; return e; }
    __device__ __forceinline__ void operator()(const i32x4 (&acc)[2][2][4][2], const Unit& u, int wr, int wc, int fr, int fq) const {
        const int row0 = u.pm * BM + wr * 64 + fr, col0 = u.pn * HALF + wc * 32 + 8 * fq, brow0 = u.pn * BM + wc * 32 + 8 * fq;
        f32x4 sg[2], su[2];
#pragma unroll
        for (int n = 0; n < 2; ++n) { sg[n] = *(const f32x4*)(sw + brow0 + 4 * n); su[n] = *(const f32x4*)(sw + brow0 + HALF + 4 * n); }
#pragma unroll
        for (int ai = 0; ai < 2; ++ai)
#pragma unroll
            for (int m = 0; m < 4; ++m) { const int r = row0 + ai * HALF + m * 16; const float sr = sa[r]; bf16_t* rowp = O + (size_t)r * ldc + col0;
                f32x4 v[2];
#pragma unroll
                for (int n = 0; n < 2; ++n)
#pragma unroll
                    for (int j = 0; j < 4; ++j) { const float gt = (float)acc[ai][0][m][n][j] * (sr * sg[n][j]), up = (float)acc[ai][1][m][n][j] * (sr * su[n][j]); v[n][j] = silu_f(gt) * up; }
                u32x4 w; w.x = cvt_pk_bf16(v[0][0], v[0][1]); w.y = cvt_pk_bf16(v[0][2], v[0][3]); w.z = cvt_pk_bf16(v[1][0], v[1][1]); w.w = cvt_pk_bf16(v[1][2], v[1][3]);
                st16(rowp, w); }
    }
};

template <bool I8> struct EpiHgrn2 {
    static constexpr bool PERM = true, AFTER_DRAIN = false;
    bf16_t* base; bf16_t* KH; const float* lb; const float* sa; const float* sw;
    __device__ __forceinline__ void operator()(const typename AccT<I8>::type (&acc)[2][2][4][2], const Unit& u, int wr, int wc, int fr, int fq) const {
        typedef unsigned u32x2 __attribute__((ext_vector_type(2)));
        const int row0 = u.pm * BM + wr * 64 + fr, head = u.pn >> 1, ch0 = 64 * (u.pn & 1) + 16 * wc + 4 * fq;
        const f32x4 lbv = *(const f32x4*)(lb + head * 128 + ch0);
        f32x4 swv[2][2];
#pragma unroll
        for (int bj = 0; bj < 2; ++bj)
#pragma unroll
            for (int n = 0; n < 2; ++n) swv[bj][n] = I8 ? *(const f32x4*)(sw + u.pn * BM + wc * 32 + 8 * fq + bj * HALF + 4 * n) : (f32x4){1.f, 1.f, 1.f, 1.f};
        const size_t MD = (size_t)16384 * 4096;
#pragma unroll
        for (int ai = 0; ai < 2; ++ai)
#pragma unroll
            for (int m = 0; m < 4; ++m) { const int r = row0 + ai * HALF + m * 16, bb = r >> 13, tt = r & 8191; const float sr = I8 ? sa[r] : 1.f;
                f32x4 v[2][2];
#pragma unroll
                for (int bj = 0; bj < 2; ++bj)
#pragma unroll
                    for (int n = 0; n < 2; ++n)
#pragma unroll
                        for (int j = 0; j < 4; ++j) v[bj][n][j] = I8 ? (float)acc[ai][bj][m][n][j] * (sr * swv[bj][n][j]) : (float)acc[ai][bj][m][n][j];
                const size_t hoff = ((size_t)(bb * 32 + head) * 8192 + tt) * 128 + ch0;
                f32x4 qv, lf, kk, sg;
#pragma unroll
                for (int j = 0; j < 4; ++j) { qv[j] = silu_f(v[0][0][j]) * 0.08838834764831845f;
                    const float fg = lbv[j] + (1.f - lbv[j]) * __builtin_amdgcn_rcpf(1.0f + __expf(-v[0][1][j])); kk[j] = 1.f - fg; lf[j] = __logf(fg); sg[j] = silu_f(v[1][1][j]); }
                *(u32x2*)(base + hoff) = (u32x2){cvt_pk_bf16(qv[0], qv[1]), cvt_pk_bf16(qv[2], qv[3])};
                *(u32x2*)(base + MD + hoff) = (u32x2){cvt_pk_bf16(lf[0], lf[1]), cvt_pk_bf16(lf[2], lf[3])};
                *(u32x2*)(KH + hoff) = (u32x2){cvt_pk_bf16(kk[0], kk[1]), cvt_pk_bf16(kk[2], kk[3])};
                *(u32x2*)(base + 2 * MD + hoff) = (u32x2){cvt_pk_bf16(v[1][0][0], v[1][0][1]), cvt_pk_bf16(v[1][0][2], v[1][0][3])};
                *(u32x2*)(base + 3 * MD + (size_t)r * 4096 + head * 128 + ch0) = (u32x2){cvt_pk_bf16(sg[0], sg[1]), cvt_pk_bf16(sg[2], sg[3])}; }
    }
};

#define PG8_DPP_SHR(x, n) __builtin_bit_cast(float, __builtin_amdgcn_update_dpp(0, __builtin_bit_cast(int, (x)), 0x110 + (n), 0xf, 0xf, false))
#define PG8_DPP_PERM(x, ctrl) __builtin_bit_cast(float, __builtin_amdgcn_update_dpp(0, __builtin_bit_cast(int, (x)), (ctrl), 0xf, 0xf, true))
__device__ __forceinline__ float row_sum16(float x) { x += PG8_DPP_PERM(x, 0x140); x += PG8_DPP_PERM(x, 0x141); x += PG8_DPP_PERM(x, 0xB1); x += PG8_DPP_PERM(x, 0x4E); return x; }
__device__ __forceinline__ float row_scan16(float x) { x += PG8_DPP_SHR(x, 1); x += PG8_DPP_SHR(x, 2); x += PG8_DPP_SHR(x, 4); x += PG8_DPP_SHR(x, 8); return x; }
template <bool I8> struct EpiHgrn3 {
    static constexpr bool PERM = true, AFTER_DRAIN = false;
    bf16_t* QR; size_t dKR, dVH, dSG;     float* EL; float* DEC; float* ER; const float* lb; const float* sa; const float* sw;
    __device__ __forceinline__ void operator()(const typename AccT<I8>::type (&acc)[2][2][4][2], const Unit& u, int wr, int wc, int fr, int fq) const {
        typedef unsigned u32x2 __attribute__((ext_vector_type(2)));
        const int lane = fr + 16 * fq, row0 = u.pm * BM + wr * 64 + fr, head = u.pn >> 1, ch0 = 64 * (u.pn & 1) + 16 * wc + 4 * fq;
        const f32x4 lbv = *(const f32x4*)(lb + head * 128 + ch0);
        f32x4 swv[2][2];
#pragma unroll
        for (int bj = 0; bj < 2; ++bj)
#pragma unroll
            for (int n = 0; n < 2; ++n) swv[bj][n] = I8 ? *(const f32x4*)(sw + u.pn * BM + wc * 32 + 8 * fq + bj * HALF + 4 * n) : (f32x4){1.f, 1.f, 1.f, 1.f};
#pragma unroll
        for (int ai = 0; ai < 2; ++ai) {
            f32x4 qv[4], lf[4], kk[4];
#pragma unroll
            for (int m = 0; m < 4; ++m) { const int r = row0 + ai * HALF + m * 16, bb = r >> 13, tt = r & 8191; const float sr = I8 ? sa[r] : 1.f;
                f32x4 v[2][2];
#pragma unroll
                for (int bj = 0; bj < 2; ++bj)
#pragma unroll
                    for (int n = 0; n < 2; ++n) { if constexpr (I8) v[bj][n] = __builtin_convertvector(acc[ai][bj][m][n], f32x4) * (swv[bj][n] * sr); else v[bj][n] = acc[ai][bj][m][n]; }
#pragma unroll
                for (int j = 0; j < 4; ++j) { qv[m][j] = silu_f(v[0][0][j]) * 0.08838834764831845f;
                    const float fg = lbv[j] + (1.f - lbv[j]) * __builtin_amdgcn_rcpf(1.0f + __expf(-v[0][1][j])); kk[m][j] = 1.f - fg; lf[m][j] = __builtin_amdgcn_logf(fg) * 0.6931471805599453f; }
                { const u32x2 p0 = __builtin_amdgcn_permlane16_swap(cvt_pk_bf16(v[1][0][0], v[1][0][1]), cvt_pk_bf16(v[1][1][0], v[1][1][1]), false, false);
                  const u32x2 p1 = __builtin_amdgcn_permlane16_swap(cvt_pk_bf16(v[1][0][2], v[1][0][3]), cvt_pk_bf16(v[1][1][2], v[1][1][3]), false, false);
                  const size_t doff = (fq & 1) ? (dSG + (size_t)r * 4096 + head * 128 + (ch0 - 4)) : (dVH + ((size_t)(bb * 32 + head) * 8192 + tt) * 128 + ch0);
                  *(u32x4*)(QR + doff) = (u32x4){p0.x, p1.x, p0.y, p1.y}; } }
            f32x4 bb[4], run = (f32x4){0.f, 0.f, 0.f, 0.f}, bref = run;
#pragma unroll
            for (int m = 0; m < 4; ++m) { f32x4 inc, tot;
#pragma unroll
                for (int j = 0; j < 4; ++j) { inc[j] = row_scan16(lf[m][j]); tot[j] = __shfl(inc[j], lane | 15); }
                bb[m] = inc + run; run = run + tot; if (m == 1) bref = run; }
            const int rb = u.pm * BM + ai * HALF + wr * 64; const size_t cid = (size_t)((rb >> 13) * 32 + head) * 128 + ((rb & 8191) >> 6);
#pragma unroll
            for (int m = 0; m < 4; ++m) { f32x4 qr, kr;
#pragma unroll
                for (int j = 0; j < 4; ++j) { const float e1 = __expf(bb[m][j] - bref[j]); qr[j] = qv[m][j] * e1; kr[j] = kk[m][j] * __builtin_amdgcn_rcpf(e1); }
                const size_t off = cid * 8704 + (size_t)(16 * m + fr) * 136 + (ch0 & ~7);
                const u32x2 p0 = __builtin_amdgcn_permlane16_swap(cvt_pk_bf16(qr[0], qr[1]), cvt_pk_bf16(kr[0], kr[1]), false, false);
                const u32x2 p1 = __builtin_amdgcn_permlane16_swap(cvt_pk_bf16(qr[2], qr[3]), cvt_pk_bf16(kr[2], kr[3]), false, false);
                *(u32x4*)(QR + off + ((fq & 1) ? dKR : (size_t)0)) = (u32x4){p0.x, p1.x, p0.y, p1.y}; }
            if (fr == 0) { f32x4 el, dc, er;
#pragma unroll
                for (int j = 0; j < 4; ++j) { el[j] = __expf(run[j] - bref[j]); dc[j] = __expf(run[j]); er[j] = __expf(bref[j]); }
                *(f32x4*)(EL + cid * 128 + ch0) = el; *(f32x4*)(DEC + cid * 128 + ch0) = dc; *(f32x4*)(ER + cid * 128 + ch0) = er; }
        }
    }
};

struct EpiSwiGLU8R {
    static constexpr bool PERM = true, AFTER_DRAIN = false;
    bf16_t* O; int ldc; const float* sa; const float* sw; unsigned* rmax;
    __device__ __forceinline__ void operator()(const i32x4 (&acc)[2][2][4][2], const Unit& u, int wr, int wc, int fr, int fq) const {
        const int row0 = u.pm * BM + wr * 64 + fr, col0 = u.pn * HALF + wc * 32 + 8 * fq, brow0 = u.pn * BM + wc * 32 + 8 * fq;
        f32x4 sg[2], su[2];
#pragma unroll
        for (int n = 0; n < 2; ++n) { sg[n] = *(const f32x4*)(sw + brow0 + 4 * n); su[n] = *(const f32x4*)(sw + brow0 + HALF + 4 * n); }
#pragma unroll
        for (int ai = 0; ai < 2; ++ai)
#pragma unroll
            for (int m = 0; m < 4; ++m) { const int r = row0 + ai * HALF + m * 16; const float sr = sa[r], sru = MK_FFO_ROT ? sr * 0.17677669529663687f : sr; bf16_t* rowp = O + (size_t)r * ldc + col0;
                f32x2 X[4];
#pragma unroll
                for (int n = 0; n < 2; ++n)
#pragma unroll
                    for (int j = 0; j < 4; ++j) { const float gt = (float)acc[ai][0][m][n][j] * (sr * sg[n][j]), up = (float)acc[ai][1][m][n][j] * (sru * su[n][j]); X[2 * n + (j >> 1)][j & 1] = silu_f(gt) * up; }
#if MK_FFO_ROT
#pragma unroll
                for (int k = 0; k < 4; ++k) { const float a = X[k].x, b = X[k].y; X[k] = (f32x2){a + b, a - b}; }
                { f32x2 a = X[0], b = X[1]; X[0] = a + b; X[1] = a - b; a = X[2]; b = X[3]; X[2] = a + b; X[3] = a - b; }
                { f32x2 a = X[0], b = X[2]; X[0] = a + b; X[2] = a - b; a = X[1]; b = X[3]; X[1] = a + b; X[3] = a - b; }
                { float x0 = X[0].x, x1 = X[0].y, x2 = X[1].x, x3 = X[1].y, x4 = X[2].x, x5 = X[2].y, x6 = X[3].x, x7 = X[3].y;
                  asm volatile("v_nop\n\tv_nop\n\tv_permlane16_swap_b32 %0, %4\n\tv_permlane16_swap_b32 %1, %5\n\tv_permlane16_swap_b32 %2, %6\n\tv_permlane16_swap_b32 %3, %7\n\ts_nop 1"
                               : "+v"(x0), "+v"(x1), "+v"(x2), "+v"(x3), "+v"(x4), "+v"(x5), "+v"(x6), "+v"(x7));
                  { const f32x2 a = (f32x2){x0, x1}, b = (f32x2){x4, x5}, c = (f32x2){x2, x3}, d = (f32x2){x6, x7}; X[0] = a + b; X[2] = a - b; X[1] = c + d; X[3] = c - d; }
                  x0 = X[0].x; x1 = X[0].y; x2 = X[1].x; x3 = X[1].y; x4 = X[2].x; x5 = X[2].y; x6 = X[3].x; x7 = X[3].y;
                  asm volatile("v_nop\n\tv_nop\n\tv_permlane32_swap_b32 %0, %2\n\tv_permlane32_swap_b32 %1, %3\n\tv_permlane32_swap_b32 %4, %6\n\tv_permlane32_swap_b32 %5, %7\n\ts_nop 1"
                               : "+v"(x0), "+v"(x1), "+v"(x2), "+v"(x3), "+v"(x4), "+v"(x5), "+v"(x6), "+v"(x7));
                  { const f32x2 a = (f32x2){x0, x1}, b = (f32x2){x2, x3}, c = (f32x2){x4, x5}, d = (f32x2){x6, x7}; X[0] = a + b; X[1] = a - b; X[2] = c + d; X[3] = c - d; } }
#endif
                u32x4 w; w.x = cvt_pk_bf16(X[0].x, X[0].y); w.y = cvt_pk_bf16(X[1].x, X[1].y); w.z = cvt_pk_bf16(X[2].x, X[2].y); w.w = cvt_pk_bf16(X[3].x, X[3].y);
                st16nt(rowp, w);
                float am = fmaxf(fmaxf(fmaxf(fabsf(X[0].x), fabsf(X[0].y)), fmaxf(fabsf(X[1].x), fabsf(X[1].y))), fmaxf(fmaxf(fabsf(X[2].x), fabsf(X[2].y)), fmaxf(fabsf(X[3].x), fabsf(X[3].y))));
                am = fmaxf(am, __shfl_xor(am, 16)); am = fmaxf(am, __shfl_xor(am, 32));
                if (fq == 0) __hip_atomic_fetch_max(rmax + r, cvt_pk_bf16(am, am) << 16, __ATOMIC_RELAXED, __HIP_MEMORY_SCOPE_AGENT); }
    }
};
template <class Epi, class Sched, bool ALIGN_EPI = false, bool SP2 = false, bool I8 = false, int KREP = 1, int EREP = 1, bool TM = false, int TCH = 0, int LT = 0>
__device__ __forceinline__ void gemm_phase(PG8_LAS unsigned char* lds, const Gemm g, const Sched& S, const Epi& E) {
    const int tid = threadIdx.x, wid = __builtin_amdgcn_readfirstlane(tid >> 6), lane = tid & 63, wr = wid >> 2, wc = wid & 3, fr = lane & 15, fq = lane >> 4;
    const int K = g.K, nt = K / BK;
    unsigned voffA[2], voffB[2];
#pragma unroll
    for (int i = 0; i < 2; ++i) { int R, C; stage_rc(tid * 16 + i * 8192, R, C); const int Rb = Epi::PERM ? ((R & ~31) + perm32(R & 31)) : R;
        voffA[i] = TM ? (unsigned)(tid * 16 + i * 8192) : (unsigned)(R * K + C) * 2u; voffB[i] = TM ? (unsigned)(tid * 16 + i * 8192) : (unsigned)(Rb * K + C) * 2u; }
    const size_t kstep = TM ? (size_t)32768 : (size_t)(BK * 2);
    const size_t hstep = TM ? (size_t)16384 : (size_t)HALF * K * 2;
    const size_t tstep = TM ? (size_t)nt * 32768 : 2 * hstep;
    const unsigned ldsw = (unsigned)wid * 1024u;
    const int aoff = lds_byte(wr * 64 + fr, fq * 8), boff = lds_byte(wc * 32 + fr, fq * 8);
#define PG8_SA(b, h) (((b) * 2 + (h)) * HTB)
#define PG8_SB(b, h) ((4 + (b) * 2 + (h)) * HTB)
#define PG8_STAGE(bufoff, gbase, voff) do { _Pragma("unroll") for (int _i = 0; _i < 2; ++_i) \
        __builtin_amdgcn_global_load_lds((const unsigned*)((const char*)(gbase) + (voff)[_i]), (PG8_LAS unsigned*)(lds + (bufoff) + ldsw + _i * 8192), 16, 0, 0); } while (0)
#define PG8_LDA(dst, b, h) do { _Pragma("unroll") for (int m = 0; m < 4; ++m) _Pragma("unroll") for (int k = 0; k < 2; ++k) dst[m][k] = *(const PG8_LAS bf16x8*)(lds + PG8_SA(b, h) + aoff + m * 2048 + k * 1024); } while (0)
#define PG8_LDB(dst, b, h) do { _Pragma("unroll") for (int n = 0; n < 2; ++n) _Pragma("unroll") for (int k = 0; k < 2; ++k) dst[n][k] = *(const PG8_LAS bf16x8*)(lds + PG8_SB(b, h) + boff + n * 2048 + k * 1024); } while (0)
#ifndef PG8_PRIO
#define PG8_PRIO 1
#endif
#define PG8_MMA(ai, bj, At, Bt) do { if (PG8_PRIO) __builtin_amdgcn_s_setprio(PG8_PRIO); _Pragma("unroll") for (int m = 0; m < 4; ++m) _Pragma("unroll") for (int n = 0; n < 2; ++n) _Pragma("unroll") for (int k = 0; k < 2; ++k) \
        acc[ai][bj][m][n] = mma16(Bt[n][k], At[m][k], acc[ai][bj][m][n]); if (PG8_PRIO) __builtin_amdgcn_s_setprio(0); } while (0)
#define PG8_WAIT_V(n) asm volatile("s_waitcnt vmcnt(" #n ")" ::: "memory")
#define PG8_WAIT_L(n) asm volatile("s_waitcnt lgkmcnt(" #n ")" ::: "memory")
#define PG8_BAR __builtin_amdgcn_s_barrier()
#define PG8_SCHED __builtin_amdgcn_sched_barrier(0)
#define PG8_TOUCH(uidx) do { if constexpr (TCH > 0) { Unit tu_; if (S.next((uidx), tu_)) { const char* tb_ = (const char*)g.Bt + (size_t)tu_.pn * tstep; const unsigned sh_ = (unsigned)cur.pm & 63u; \
        for (int l_ = tid; l_ < nt * 4; l_ += 512) { const size_t o_ = TM ? ((size_t)sh_ * (size_t)(nt * 512) + (size_t)l_ * 128) : ((size_t)(4 * sh_ + l_ / nt) * (size_t)(nt * 128) + (size_t)(l_ % nt) * 128); \
            __builtin_amdgcn_global_load_lds((const unsigned*)(tb_ + o_), (PG8_LAS unsigned*)(lds + STAGE_BYTES + wid * 256), 4, 0, 0); } } } } while (0)
    const unsigned ltoff = (lane < 8) ? (unsigned)(wid * 1024 + lane * 128) : (unsigned)(wid * 512 + (lane - 8) * 128);
#define PG8_LTOUCH(abase, bbase) do { if constexpr (LT > 0) { if (lane < 12) { const char* tp_ = (lane < 8) ? ((abase) + ltA) : ((bbase) + ltB); \
        __builtin_amdgcn_global_load_lds((const unsigned*)(tp_ + ltoff), (PG8_LAS unsigned*)(lds + STAGE_BYTES + wid * 256), 4, 0, 0); } } } while (0)
#define PG8_WAIT_VS() do { if constexpr (LT > 0) PG8_WAIT_V(9); else PG8_WAIT_V(8); } while (0)
    Unit cur, nxt; int ui = 0;
    if (!S.next(0, cur)) return;
    typedef typename AccT<I8>::type acc_t;
    acc_t acc[2][2][4][2];
#pragma unroll
    for (int a = 0; a < 2; ++a)
#pragma unroll
        for (int b = 0; b < 2; ++b)
#pragma unroll
            for (int m = 0; m < 4; ++m)
#pragma unroll
                for (int n = 0; n < 2; ++n) acc[a][b][m][n] = AccT<I8>::zero();
    bf16x8 At[4][2], B0[2][2], B1[2][2];
    const char* cA = (const char*)g.A + (size_t)cur.pm * tstep; const char* cB = (const char*)g.Bt + (size_t)cur.pn * tstep;
    unsigned ltA = (unsigned)(cur.pn & 3) * 8192u, ltB = (unsigned)(cur.pm & 7) * 4096u;
    S.a_ready(cur);
    if constexpr (TCH > 0) { PG8_TOUCH(1); if constexpr (TCH > 1) PG8_TOUCH(2); }
    if constexpr (SP2) {
        PG8_STAGE(PG8_SB(0, 0), cB, voffB); PG8_STAGE(PG8_SB(0, 1), cB + hstep, voffB); PG8_STAGE(PG8_SA(0, 0), cA, voffA); PG8_STAGE(PG8_SA(0, 1), cA + hstep, voffA);
        if (wr == 1) PG8_BAR;
        PG8_WAIT_V(2); PG8_BAR;
        PG8_STAGE(PG8_SB(1, 0), cB + kstep, voffB); PG8_STAGE(PG8_SA(1, 0), cA + kstep, voffA); PG8_STAGE(PG8_SB(1, 1), cB + hstep + kstep, voffB);
        PG8_WAIT_V(6); PG8_BAR;
    } else {
        PG8_STAGE(PG8_SB(0, 0), cB, voffB); PG8_STAGE(PG8_SA(0, 0), cA, voffA); PG8_STAGE(PG8_SB(0, 1), cB + hstep, voffB); PG8_STAGE(PG8_SA(0, 1), cA + hstep, voffA);
        if (wr == 1) PG8_BAR;
        PG8_WAIT_V(4); PG8_BAR;
        PG8_STAGE(PG8_SB(1, 0), cB + kstep, voffB); PG8_STAGE(PG8_SA(1, 0), cA + kstep, voffA); PG8_STAGE(PG8_SB(1, 1), cB + hstep + kstep, voffB);
        PG8_WAIT_V(6); PG8_BAR;
    }
    for (;;) {
        const bool has_next = S.next(ui + 1, nxt);
        const char* nA = has_next ? (const char*)g.A + (size_t)nxt.pm * tstep : cA; const char* nB = has_next ? (const char*)g.Bt + (size_t)nxt.pn * tstep : cB;
        for (int krep = 0; krep < KREP; ++krep) {
        if (KREP > 1 && krep == KREP - 1 && krep > 0) {
_Pragma("unroll") for (int a = 0; a < 2; ++a) _Pragma("unroll") for (int b = 0; b < 2; ++b) _Pragma("unroll") for (int m = 0; m < 4; ++m) _Pragma("unroll") for (int n = 0; n < 2; ++n) acc[a][b][m][n] = AccT<I8>::zero(); }
        const char* nA2 = (krep == KREP - 1) ? nA : cA; const char* nB2 = (krep == KREP - 1) ? nB : cB;
        for (int t = 0; t < nt; t += 2) {
            const bool last = (t == nt - 2);
            const char* a1 = cA + (size_t)(t + 1) * kstep;
            const char* a2 = last ? nA2 : cA + (size_t)(t + 2) * kstep; const char* b2 = last ? nB2 : cB + (size_t)(t + 2) * kstep;
            const char* a3 = a2 + kstep; const char* b3 = b2 + kstep;
            const char *ta0 = cA, *tb0 = cB, *ta1 = cA, *tb1 = cB;
            if constexpr (LT > 0) { const int q0 = t + LT, q1 = t + 1 + LT;
                if (q0 < nt) { ta0 = cA + (size_t)q0 * kstep; tb0 = cB + (size_t)q0 * kstep; } else if (krep == KREP - 1 && has_next && q0 - nt < nt) { ta0 = nA + (size_t)(q0 - nt) * kstep; tb0 = nB + (size_t)(q0 - nt) * kstep; }
                if (q1 < nt) { ta1 = cA + (size_t)q1 * kstep; tb1 = cB + (size_t)q1 * kstep; } else if (krep == KREP - 1 && has_next && q1 - nt < nt) { ta1 = nA + (size_t)(q1 - nt) * kstep; tb1 = nB + (size_t)(q1 - nt) * kstep; } }
            if (last && has_next && krep == KREP - 1) S.a_ready(nxt);
            if constexpr (SP2) {
            PG8_LDB(B0, 0, 0); PG8_LDB(B1, 0, 1); PG8_SCHED; PG8_LDA(At, 0, 0); PG8_STAGE(PG8_SA(1, 1), a1 + hstep, voffA);
            PG8_WAIT_VS(); PG8_WAIT_L(0); PG8_BAR; PG8_MMA(0, 0, At, B0); PG8_MMA(0, 1, At, B1); PG8_BAR; PG8_SCHED;
            PG8_LDA(At, 0, 1); PG8_LTOUCH(ta0, tb0); PG8_STAGE(PG8_SB(0, 0), b2, voffB); PG8_STAGE(PG8_SB(0, 1), b2 + hstep, voffB); PG8_STAGE(PG8_SA(0, 0), a2, voffA);
            PG8_WAIT_VS(); PG8_WAIT_L(0); PG8_BAR; PG8_MMA(1, 0, At, B0); PG8_MMA(1, 1, At, B1); PG8_BAR; PG8_SCHED;
            PG8_LDB(B0, 1, 0); PG8_LDB(B1, 1, 1); PG8_SCHED; PG8_LDA(At, 1, 0); PG8_STAGE(PG8_SA(0, 1), a2 + hstep, voffA);
            PG8_WAIT_VS(); PG8_WAIT_L(0); PG8_BAR; PG8_MMA(0, 0, At, B0); PG8_MMA(0, 1, At, B1); PG8_BAR; PG8_SCHED;
            PG8_LDA(At, 1, 1); PG8_LTOUCH(ta1, tb1); PG8_STAGE(PG8_SB(1, 0), b3, voffB); PG8_STAGE(PG8_SB(1, 1), b3 + hstep, voffB); PG8_STAGE(PG8_SA(1, 0), a3, voffA);
            PG8_WAIT_VS(); PG8_WAIT_L(0); PG8_BAR; PG8_MMA(1, 0, At, B0); PG8_MMA(1, 1, At, B1); PG8_BAR; PG8_SCHED;
            } else {
            PG8_LDB(B0, 0, 0); PG8_SCHED; PG8_LDA(At, 0, 0); PG8_STAGE(PG8_SA(1, 1), a1 + hstep, voffA);
            PG8_WAIT_L(8); PG8_BAR; PG8_WAIT_L(0); PG8_MMA(0, 0, At, B0); PG8_BAR; PG8_SCHED;
            PG8_LDB(B1, 0, 1); PG8_STAGE(PG8_SB(0, 0), b2, voffB);
            PG8_BAR; PG8_WAIT_L(0); PG8_MMA(0, 1, At, B1); PG8_BAR;
            PG8_LDA(At, 0, 1); PG8_STAGE(PG8_SA(0, 0), a2, voffA);
            PG8_BAR; PG8_WAIT_L(0); PG8_MMA(1, 0, At, B0); PG8_BAR; PG8_SCHED;
            PG8_STAGE(PG8_SB(0, 1), b2 + hstep, voffB);
            PG8_WAIT_V(6); PG8_BAR; PG8_MMA(1, 1, At, B1); PG8_BAR;
            PG8_LDB(B0, 1, 0); PG8_SCHED; PG8_LDA(At, 1, 0); PG8_STAGE(PG8_SA(0, 1), a2 + hstep, voffA);
            PG8_WAIT_L(8); PG8_BAR; PG8_WAIT_L(0); PG8_MMA(0, 0, At, B0); PG8_BAR; PG8_SCHED;
            PG8_LDB(B1, 1, 1); PG8_STAGE(PG8_SB(1, 0), b3, voffB);
            PG8_BAR; PG8_WAIT_L(0); PG8_MMA(0, 1, At, B1); PG8_BAR;
            PG8_LDA(At, 1, 1); PG8_STAGE(PG8_SA(1, 0), a3, voffA);
            PG8_BAR; PG8_WAIT_L(0); PG8_MMA(1, 0, At, B0); PG8_BAR; PG8_SCHED;
            PG8_STAGE(PG8_SB(1, 1), b3 + hstep, voffB);
            PG8_WAIT_V(6); PG8_BAR; PG8_MMA(1, 1, At, B1); PG8_BAR;
            }
        }
        }
        if constexpr (ALIGN_EPI) { if (wr == 0) PG8_BAR; }
        if constexpr (!Epi::AFTER_DRAIN) { E(acc, cur, wr, wc, fr, fq); if constexpr (EREP > 1) { asm volatile("" ::: "memory"); E.alt()(acc, cur, wr, wc, fr, fq); } S.done(cur); PG8_TOUCH(ui + 1 + TCH); }
        if (!has_next) break;
#pragma unroll
        for (int a = 0; a < 2; ++a)
#pragma unroll
            for (int b = 0; b < 2; ++b)
#pragma unroll
                for (int m = 0; m < 4; ++m)
#pragma unroll
                    for (int n = 0; n < 2; ++n) acc[a][b][m][n] = AccT<I8>::zero();
        cur = nxt; cA = nA; cB = nB; ++ui; ltA = (unsigned)(cur.pn & 3) * 8192u; ltB = (unsigned)(cur.pm & 7) * 4096u;
        if constexpr (ALIGN_EPI) { if (wr == 1) PG8_BAR; }
    }
    PG8_WAIT_V(0);
    if constexpr (!ALIGN_EPI) { if (wr == 0) PG8_BAR; }
    PG8_BAR;
    if constexpr (Epi::AFTER_DRAIN) { E.fused(acc, cur, wr, wc, fr, fq, lds, wid, lane); S.done(cur); }
#undef PG8_TOUCH
#undef PG8_LTOUCH
#undef PG8_WAIT_VS
#undef PG8_SA
#undef PG8_SB
#undef PG8_STAGE
#undef PG8_LDA
#undef PG8_LDB
#undef PG8_MMA
#undef PG8_WAIT_V
#undef PG8_WAIT_L
#undef PG8_BAR
#undef PG8_SCHED
}
}
#ifndef PG8_SP2
#define PG8_SP2 true
#endif
#ifndef PG8_ALIGN
#define PG8_ALIGN true
#endif
constexpr int NWAVES = 8;
#ifndef MK_N_LAUNCHES
#define MK_N_LAUNCHES 1
#endif
#ifndef MK_HGRN_MFMA
#define MK_HGRN_MFMA 1
#endif
#ifndef MK_ATTN_MFMA
#define MK_ATTN_MFMA 1
#endif
constexpr bool HGRN_MFMA = MK_HGRN_MFMA, ATTN_MFMA = MK_ATTN_MFMA;
#ifndef MK_REP_GEMM
#define MK_REP_GEMM 1
#endif
#ifndef MK_REP_P0
#define MK_REP_P0 1
#endif
#ifndef MK_REP_ATT
#define MK_REP_ATT 1
#endif
#ifndef MK_REP_HG
#define MK_REP_HG 1
#endif
#ifndef MK_REP_NORM
#define MK_REP_NORM 1
#endif
constexpr int REP_GEMM = MK_REP_GEMM, REP_P0 = MK_REP_P0, REP_ATT = MK_REP_ATT, REP_HG = MK_REP_HG, REP_NORM = MK_REP_NORM;
#ifndef MK_FFN_I8
#define MK_FFN_I8 1
#endif
static_assert(MK_FFN_I8 == 1, "the workspace map overlays ACT on the bf16 FFN-in weight copies: int8 FFN path only");
#ifndef MK_HG_I8
#define MK_HG_I8 1
#endif
constexpr bool HG_I8 = MK_HG_I8;
#ifndef MK_ATT_I8
#define MK_ATT_I8 0
#endif
constexpr bool ATT_I8 = MK_ATT_I8;
constexpr bool FFN_I8 = MK_FFN_I8;
#ifndef MK_KREP_FFI
#define MK_KREP_FFI 1
#endif
#ifndef MK_EREP_FFI
#define MK_EREP_FFI 1
#endif
constexpr int EREP_FFI = MK_EREP_FFI;
#ifndef MK_REP_FFI
#define MK_REP_FFI 1
#endif
constexpr int REP_FFI = MK_REP_FFI;
constexpr int KREP_FFI = MK_KREP_FFI;
#ifndef MK_TM_FFI
#define MK_TM_FFI 1
#endif
constexpr bool TM_FFI = MK_TM_FFI;
#ifndef MK_TCH_FFI
#define MK_TCH_FFI 0
#endif
#ifndef MK_TCH_ALL
#define MK_TCH_ALL 0
#endif
constexpr int TCH_FFI = MK_TCH_FFI, TCH_ALL = MK_TCH_ALL;
#ifndef MK_LT_FFI
#define MK_LT_FFI 0
#endif
constexpr int LT_FFI = MK_LT_FFI;
#ifndef MK_HG_FUSE
#define MK_HG_FUSE 2
#endif
constexpr int HG_FUSE = MK_HG_FUSE;
#ifndef MK_REP_P8
#define MK_REP_P8 1
#endif
constexpr int REP_P8 = MK_REP_P8;
#ifndef MK_FFO_I8
#define MK_FFO_I8 1
#endif
#ifndef MK_FFO_ROT
#define MK_FFO_ROT 1
#endif
constexpr bool FFO_I8 = MK_FFO_I8;
#ifndef MK_REP_BAR
#define MK_REP_BAR 0
#endif
constexpr int REP_BAR = MK_REP_BAR;
#ifndef MK_NT_W
#define MK_NT_W 0
#endif
#if MK_NT_W
#define MK_LD_W(p) __builtin_nontemporal_load(p)
#else
#define MK_LD_W(p) (*(p))
#endif
#ifndef MK_P0_OVL
#define MK_P0_OVL 0
#endif
constexpr bool P0_OVL = MK_P0_OVL;
#ifndef MK_P0_STRIP
#define MK_P0_STRIP 1
#endif
constexpr bool P0_STRIP = MK_P0_STRIP;
#ifndef MK_HGO_I8
#define MK_HGO_I8 1
#endif
constexpr bool HGO_I8 = MK_HGO_I8;
constexpr int NPH = 16;
constexpr int N_LAUNCHES = MK_N_LAUNCHES;
static_assert(N_LAUNCHES == 1 || N_LAUNCHES == NPH, "MK_N_LAUNCHES is 1 or NPH");

constexpr int BATCH = 2, SEQ = 8192, DM = 4096, M = BATCH * SEQ, DFF = 11008, NQKV = 18432, NHG = 16384, DATT = 2048, HD = 128;
constexpr float RMS_EPS = 1e-6f;
constexpr float QSCALE = 0.08838834764831845f;

constexpr size_t MiB = 1u << 20;
constexpr size_t WS_CTL = 0, CTL_ZERO_BYTES = 1 * MiB;
constexpr size_t WS_TAB = 1 * MiB;
constexpr size_t WS_WATTI = 2 * MiB, WS_WATTO = 146 * MiB, WS_WHGI = 162 * MiB, WS_WHGO = 290 * MiB;
constexpr size_t WS_WFFI = 322 * MiB, WFFI_STRIDE = 172 * MiB, WS_WFFO = 666 * MiB, WFFO_STRIDE = 86 * MiB;
constexpr size_t WS_XN = 838 * MiB;
constexpr size_t WS_Y = 966 * MiB;
constexpr size_t WS_ACT = 322 * MiB;
constexpr size_t WS_ACT_OLD = 1222 * MiB;
constexpr size_t WS_QKV = 1566 * MiB;
constexpr size_t WS_MRG = 2142 * MiB;
constexpr size_t WS_OG = 2206 * MiB;
constexpr size_t WS_END = 2334 * MiB;
constexpr size_t WS_SA = WS_TAB + 128 * 1024, WS_SW = WS_TAB + 256 * 1024;
constexpr size_t WS_W8 = 1222 * MiB, W8_STRIDE = 86 * MiB, WS_W8H = 1394 * MiB, WS_END3 = 2529 * MiB;
constexpr size_t WS_SWH = WS_SW + 4 * 2 * 2 * DFF, WS_SWA = WS_SWH + 4 * NHG, WS_W8A = 1458 * MiB;
static_assert(WS_W8A + (size_t)NQKV * DM <= WS_QKV && WS_SWA + 4 * NQKV <= WS_WATTI, "int8 maps");
constexpr size_t WS_HB = 2529 * MiB, WS_END4 = 2657 * MiB;
constexpr size_t WS_W8O = 2657 * MiB, W8O_STRIDE = 43 * MiB, WS_END5 = 2743 * MiB, WS_SWO = WS_TAB + 640 * 1024, WS_SA2 = WS_TAB + 704 * 1024, WS_ACT8 = WS_QKV, WS_RMAX = WS_CTL + 512 * 1024;
constexpr size_t WS_W8G = 1530 * MiB, WS_SWG = WS_TAB + 768 * 1024, WS_SA3 = WS_TAB + 800 * 1024;
static_assert(WS_W8G + (size_t)DM * DM <= WS_QKV && WS_SA3 + 4 * M <= WS_WATTI, "HGO_I8 maps");
constexpr int CW_TMO = 0, CW_CODE = 1;
constexpr int CW_BAR = 4096;
constexpr int RING_OFF = 0, RING_BYTES = 131072;
constexpr int LDSCTL_OFF = 150528, MISC_OFF = LDSCTL_OFF + 320;
constexpr int LDS_BYTES = 152576;
static_assert(MISC_OFF + 128 <= LDS_BYTES, "LDS map");

#define GAS __attribute__((address_space(1)))
#define LAS __attribute__((address_space(3)))
typedef unsigned short bf16;
typedef unsigned v4u __attribute__((ext_vector_type(4)));
typedef unsigned v2u __attribute__((ext_vector_type(2)));
typedef float f32x4 __attribute__((ext_vector_type(4)));
typedef short bf16x8 __attribute__((ext_vector_type(8)));
typedef GAS unsigned gu32;
typedef GAS unsigned long long gu64;
#define RLX_AGENT __ATOMIC_RELAXED, __HIP_MEMORY_SCOPE_AGENT
#define LDS_WAIT() asm volatile("s_waitcnt lgkmcnt(0)" ::: "memory")
#define VM_WAIT() asm volatile("s_waitcnt vmcnt(0)" ::: "memory")
__device__ __forceinline__ unsigned f2bf(float f) { unsigned u = __builtin_bit_cast(unsigned, f); return (u + 0x7fffu + ((u >> 16) & 1u)) >> 16; }
__device__ __forceinline__ unsigned pk2(float lo, float hi) { return f2bf(lo) | (f2bf(hi) << 16); }
__device__ __forceinline__ unsigned cvtpk(float lo, float hi) { return pg8::cvt_pk_bf16(lo, hi); }
__device__ __forceinline__ float bflo(unsigned w) { return __builtin_bit_cast(float, w << 16); }
__device__ __forceinline__ float bfhi(unsigned w) { return __builtin_bit_cast(float, w & 0xffff0000u); }
#define XB_TMO      128
#define XB_XCNT(j)  (256  + 64 * (j))
#define XB_XSUB(j)  (1280 + 64 * (j))
#define XB_XGEN(j)  (2304 + 64 * (j))
#define XB_TOP      3328
#define XB_TOPGEN   3392
#define XCD_BAR_WORDS 3456
#define XB_SPIN_CAP (1u << 18)

__device__ __forceinline__ unsigned xb_ld(unsigned* p)              { return __hip_atomic_load(p, __ATOMIC_RELAXED, __HIP_MEMORY_SCOPE_AGENT); }
__device__ __forceinline__ unsigned xb_add(unsigned* p, unsigned v) { return __hip_atomic_fetch_add(p, v, __ATOMIC_RELAXED, __HIP_MEMORY_SCOPE_AGENT); }
__device__ __forceinline__ unsigned xb_xcc_id() { return (unsigned)__builtin_amdgcn_s_getreg((3 << 11) | 20) & 0xFu; }
#define XB_SPIN(cond, bar) do { unsigned _sp = 0; while (cond) { __builtin_amdgcn_s_sleep(1); \
    if ((++_sp & 255u) == 0u) { if (xb_ld(&(bar)[XB_TMO])) break; if (_sp > XB_SPIN_CAP) { atomicAdd(&(bar)[XB_TMO], 1u); break; } } } } while (0)

struct XcdBarrier {
    unsigned* bar; unsigned x;
    volatile LAS unsigned* st;
};

__device__ __forceinline__ XcdBarrier xcd_barrier_post(unsigned* bar, volatile LAS unsigned* st) {
    XcdBarrier b; b.bar = bar; b.x = xb_xcc_id(); b.st = st;
    if (threadIdx.x == 0) (void)xb_add(&bar[XB_XCNT(b.x)], 1u);
    return b;
}
__device__ __forceinline__ void xcd_barrier_complete(unsigned* bar, unsigned x, unsigned& nloc, unsigned& nx) {
    const unsigned G = gridDim.x * gridDim.y * gridDim.z;
    unsigned sum, cnt, mine, sp = 0u;
    for (;;) {
        sum = 0u; cnt = 0u; mine = 0u;
#pragma unroll
        for (unsigned j = 0; j < 16; ++j) { const unsigned c = xb_ld(&bar[XB_XCNT(j)]); sum += c; cnt += (c > 0u) ? 1u : 0u; mine = (j == x) ? c : mine; }
        if (sum == G) break;
        __builtin_amdgcn_s_sleep(1);
        if ((++sp & 255u) == 0u) { if (xb_ld(&bar[XB_TMO])) break; if (sp > XB_SPIN_CAP) { atomicAdd(&bar[XB_TMO], 1u); break; } }
    }
    nloc = mine > 0u ? mine : 1u; nx = cnt > 0u ? cnt : 1u;
}

__device__ __forceinline__ void xcd_barrier(const XcdBarrier& b) {
    asm volatile("s_waitcnt vmcnt(0)" ::: "memory");
    __syncthreads();
    if (threadIdx.x == 0) {
        unsigned* bar = b.bar;
        __builtin_amdgcn_s_waitcnt(0);
        unsigned nloc = b.st[0], nx = b.st[1];
        if (nloc == 0u) { xcd_barrier_complete(bar, b.x, nloc, nx); b.st[0] = nloc; b.st[1] = nx; }
        const unsigned old = xb_add(&bar[XB_XSUB(b.x)], 1u);
        const unsigned gen = old / nloc;
        if (old + 1u == (gen + 1u) * nloc) {
            __builtin_amdgcn_fence(__ATOMIC_RELEASE, "agent");
            asm volatile("s_waitcnt vmcnt(0)" ::: "memory");
            const unsigned og = xb_add(&bar[XB_TOP], 1u);
            const unsigned tg = og / nx;
            if (og + 1u == (tg + 1u) * nx) xb_add(&bar[XB_TOPGEN], 1u);
            else XB_SPIN(xb_ld(&bar[XB_TOPGEN]) == tg, bar);
            __builtin_amdgcn_fence(__ATOMIC_ACQUIRE, "agent");
            xb_add(&bar[XB_XGEN(b.x)], 1u);
            asm volatile("s_waitcnt vmcnt(0)" ::: "memory");
        } else {
            XB_SPIN(xb_ld(&bar[XB_XGEN(b.x)]) == gen, bar);
            __builtin_amdgcn_fence(__ATOMIC_ACQUIRE, "agent");
            asm volatile("s_waitcnt vmcnt(0)" ::: "memory");
        }
    }
    __syncthreads();
}
struct Frame {
    LAS unsigned char* lds;
    volatile LAS unsigned* MISC;
    gu32* ctl;
    int tid, lane, wave;
    int vcu, G;
    const float *x, *gains, *rel_bias, *w_att_in, *w_att_out, *w_hg_in, *lb_logits, *hg_gain, *w_hg_out, *w_ff_in, *w_ff_out;
    float* out;
    unsigned char* ws;
};
__device__ __forceinline__ float wave_sum(float v) {
#pragma unroll
    for (int o = 1; o < 64; o <<= 1) v += __shfl_xor(v, o);
    return v;
}
__device__ __forceinline__ void p0_transpose_item(const float* W, int K, int N, bf16* WT, int mode, LAS float* scr, int item, int lane) {
    const int nblk = N / 32, kb = item / nblk, nb = item % nblk, k0 = 64 * kb, n0 = 32 * nb;
    int r0 = n0;
    if (mode == 1) { const int c = (n0 < DFF) ? n0 : n0 - DFF; r0 = 256 * (c >> 7) + (c & 127) + ((n0 < DFF) ? 0 : 128); }
#pragma unroll
    for (int i = 0; i < 32; ++i) { const int kk = 2 * i + (lane >> 5); scr[kk * 33 + (lane & 31)] = MK_LD_W(W + (size_t)(k0 + kk) * N + n0 + (lane & 31)); }
    LDS_WAIT(); asm volatile("" ::: "memory");
    const int c = lane & 7;
#pragma unroll
    for (int j = 0; j < 4; ++j) { const int n = (lane >> 3) + 8 * j; const LAS float* s = scr + (8 * c) * 33 + n;
        v4u o; o.x = pk2(s[0 * 33], s[1 * 33]); o.y = pk2(s[2 * 33], s[3 * 33]); o.z = pk2(s[4 * 33], s[5 * 33]); o.w = pk2(s[6 * 33], s[7 * 33]);
        int row = r0 + n;
        if (mode == 2) { const int col = n0 + n, s = col >> 12, cc = col & 4095, c64 = cc & 63; row = 256 * (cc >> 6) + 128 * (s >> 1) + 32 * (c64 >> 4) + 8 * ((c64 >> 2) & 3) + 4 * (s & 1) + (c64 & 3); }
        *(GAS v4u*)(WT + (size_t)row * K + k0 + 8 * c) = o; }
    LDS_WAIT(); asm volatile("" ::: "memory");
}
__device__ __forceinline__ int t5_bucket(int dist) {
    if (dist < 16) return dist;
    int large = 16 + (int)(log((double)dist / 16.0) / log(128.0) * 16.0);
    return large < 31 ? large : 31;
}
template <bool HAS_Y, int XNM, bool HIB = false, bool HOB = false>
__device__ __forceinline__ void norm_rows(Frame& F, const void* hin, const bf16* y, void* hout, bf16* xn, const float* ga, const float* gb, float* sa = nullptr) {
    const int gw = F.vcu * NWAVES + F.wave, NGW = F.G * NWAVES;
    for (int m = gw; m < M; m += NGW) {
        f32x4 h[16];
        if (HIB) { const GAS v2u* hr = (const GAS v2u*)((const bf16*)hin + (size_t)m * DM) + F.lane;
#pragma unroll
            for (int j = 0; j < 16; ++j) { const v2u hw = hr[64 * j]; h[j] = (f32x4){bflo(hw.x), bfhi(hw.x), bflo(hw.y), bfhi(hw.y)}; }
        } else { const GAS f32x4* hr = (const GAS f32x4*)((const float*)hin + (size_t)m * DM) + F.lane;
#pragma unroll
            for (int j = 0; j < 16; ++j) h[j] = hr[64 * j]; }
        if (HAS_Y) {
            const GAS v2u* yr = (const GAS v2u*)(y + (size_t)m * DM) + F.lane;
            f32x4 yv[16]; float ss = 0.f;
#pragma unroll
            for (int j = 0; j < 16; ++j) { const v2u yw = yr[64 * j]; yv[j] = (f32x4){bflo(yw.x), bfhi(yw.x), bflo(yw.y), bfhi(yw.y)}; ss += (yv[j].x * yv[j].x + yv[j].y * yv[j].y) + (yv[j].z * yv[j].z + yv[j].w * yv[j].w); }
            const float rstd = 1.f / sqrtf(wave_sum(ss) * (1.f / DM) + RMS_EPS);
            GAS f32x4* ho = (GAS f32x4*)((float*)hout + (size_t)m * DM) + F.lane; GAS v2u* hob = (GAS v2u*)((bf16*)hout + (size_t)m * DM) + F.lane;
#pragma unroll
            for (int j = 0; j < 16; ++j) { const f32x4 g = ((const GAS f32x4*)ga)[64 * j + F.lane]; h[j] = h[j] + yv[j] * rstd * g;
                if (HOB) { const v2u hw = (v2u){cvtpk(h[j].x, h[j].y), cvtpk(h[j].z, h[j].w)}; hob[64 * j] = hw; h[j] = (f32x4){bflo(hw.x), bfhi(hw.x), bflo(hw.y), bfhi(hw.y)}; }
                else ho[64 * j] = h[j]; }
        }
        if (XNM != 0) {
            float s2 = 0.f;
#pragma unroll
            for (int j = 0; j < 16; ++j) s2 += (h[j].x * h[j].x + h[j].y * h[j].y) + (h[j].z * h[j].z + h[j].w * h[j].w);
            const float r2 = 1.f / sqrtf(wave_sum(s2) * (1.f / DM) + RMS_EPS);
            if (XNM == 1) {
                GAS v2u* o8 = (GAS v2u*)(xn + (size_t)m * DM) + F.lane;
#pragma unroll
                for (int j = 0; j < 16; ++j) { const f32x4 g = ((const GAS f32x4*)gb)[64 * j + F.lane]; const f32x4 v = h[j] * r2 * g;
                    v2u w; w.x = pk2(v.x, v.y); w.y = pk2(v.z, v.w); o8[64 * j] = w; }
            } else {
                float am = 0.f;
#pragma unroll
                for (int j = 0; j < 16; ++j) { const f32x4 g = ((const GAS f32x4*)gb)[64 * j + F.lane]; h[j] = h[j] * r2 * g;
                    am = fmaxf(fmaxf(am, fmaxf(fabsf(h[j].x), fabsf(h[j].y))), fmaxf(fabsf(h[j].z), fabsf(h[j].w))); }
#pragma unroll
                for (int o = 1; o < 64; o <<= 1) am = fmaxf(am, __shfl_xor(am, o));
                am = fmaxf(am, 1e-20f);
                const float qs = 127.f / am;
                GAS unsigned char* o1 = (GAS unsigned char*)xn; GAS unsigned* o4 = (GAS unsigned*)(o1 + (size_t)m * DM) + F.lane;
#pragma unroll
                for (int j = 0; j < 16; ++j) { const int q0 = (int)rintf(h[j].x * qs), q1 = (int)rintf(h[j].y * qs), q2 = (int)rintf(h[j].z * qs), q3 = (int)rintf(h[j].w * qs);
                    const unsigned qw = (unsigned)(q0 & 255) | ((unsigned)(q1 & 255) << 8) | ((unsigned)(q2 & 255) << 16) | ((unsigned)q3 << 24);
                    if (XNM == 3) *(GAS unsigned*)(o1 + pg8::tm_chunk_off(m, 256 * j + 4 * F.lane, DM / 128, false)) = qw; else o4[64 * j] = qw; }
                if (F.lane == 0) sa[m] = am * (1.f / 127.f);
            }
        }
    }
}
template <bool TMW> __device__ __forceinline__ void p0_quant_rows(Frame& F, const bf16* WT, unsigned char* W8, float* sw, int rows) {
    const int gw = F.vcu * NWAVES + F.wave, NGW = F.G * NWAVES;
    for (int r = gw; r < rows; r += NGW) {
        const GAS v4u* src = (const GAS v4u*)(WT + (size_t)r * DM) + F.lane;
        v4u c[8]; float am = 0.f;
#pragma unroll
        for (int i = 0; i < 8; ++i) { c[i] = src[64 * i];
#pragma unroll
            for (int j = 0; j < 4; ++j) am = fmaxf(am, fmaxf(fabsf(bflo(c[i][j])), fabsf(bfhi(c[i][j])))); }
#pragma unroll
        for (int o = 1; o < 64; o <<= 1) am = fmaxf(am, __shfl_xor(am, o));
        am = fmaxf(am, 1e-30f);
        const float qs = 127.f / am;
        GAS v2u* dst = (GAS v2u*)(W8 + (size_t)r * DM) + F.lane;
#pragma unroll
        for (int i = 0; i < 8; ++i) { unsigned w[2];
#pragma unroll
            for (int hf = 0; hf < 2; ++hf) { const int q0 = (int)rintf(bflo(c[i][2 * hf]) * qs), q1 = (int)rintf(bfhi(c[i][2 * hf]) * qs), q2 = (int)rintf(bflo(c[i][2 * hf + 1]) * qs), q3 = (int)rintf(bfhi(c[i][2 * hf + 1]) * qs);
                w[hf] = (unsigned)(q0 & 255) | ((unsigned)(q1 & 255) << 8) | ((unsigned)(q2 & 255) << 16) | ((unsigned)q3 << 24); }
            if (TMW) *(GAS v2u*)(W8 + pg8::tm_chunk_off(r, 8 * (F.lane + 64 * i), DM / 128, true)) = (v2u){w[0], w[1]}; else dst[64 * i] = (v2u){w[0], w[1]}; }
        if (F.lane == 0) sw[r] = am * (1.f / 127.f);
    }
}
#define DPP_QUAD(x, ctrl) __builtin_bit_cast(float, __builtin_amdgcn_update_dpp(0, __builtin_bit_cast(int, (x)), (ctrl), 0xf, 0xf, true))
__device__ __forceinline__ void fwht8(float (&x)[8]) {
#pragma unroll
    for (int s = 1; s < 8; s <<= 1)
#pragma unroll
        for (int i = 0; i < 8; ++i) if (!(i & s)) { const float a = x[i], b = x[i + s]; x[i] = a + b; x[i + s] = a - b; }
}
__device__ __forceinline__ void fwht32_quad(float (&x)[8], int lane) {
    fwht8(x);
    const float s1 = (lane & 1) ? -1.f : 1.f, s2 = (lane & 2) ? -1.f : 1.f;
#pragma unroll
    for (int i = 0; i < 8; ++i) { const float p = DPP_QUAD(x[i], 0xB1); x[i] = p + s1 * x[i]; }
#pragma unroll
    for (int i = 0; i < 8; ++i) { const float p = DPP_QUAD(x[i], 0x4E); x[i] = (p + s2 * x[i]) * 0.17677669529663687f; }
}
template <int KL> __device__ __forceinline__ void p0_quant_wout(Frame& F, const bf16* WT, unsigned char* W8, float* sw) {
    const int gw = F.vcu * NWAVES + F.wave, NGW = F.G * NWAVES;
    constexpr int NCH = KL / 8, NI = (NCH + 63) / 64;
    for (int r = gw; r < DM; r += NGW) {
        const GAS v4u* src = (const GAS v4u*)(WT + (size_t)r * KL);
        v4u c[NI]; float am = 0.f;
#pragma unroll
        for (int i = 0; i < NI; ++i) { const int ch = F.lane + 64 * i; c[i] = (ch < NCH) ? src[ch] : (v4u){0u, 0u, 0u, 0u}; }
#pragma unroll
        for (int i = 0; i < NI; ++i) { float x[8];
#pragma unroll
            for (int j = 0; j < 4; ++j) { x[2 * j] = bflo(c[i][j]); x[2 * j + 1] = bfhi(c[i][j]); }
#if MK_FFO_ROT
            fwht32_quad(x, F.lane);
#endif
#pragma unroll
            for (int j = 0; j < 4; ++j) { c[i][j] = cvtpk(x[2 * j], x[2 * j + 1]); am = fmaxf(am, fmaxf(fabsf(bflo(c[i][j])), fabsf(bfhi(c[i][j])))); } }
#pragma unroll
        for (int o = 1; o < 64; o <<= 1) am = fmaxf(am, __shfl_xor(am, o));
        am = fmaxf(am, 1e-30f);
        const float qs = 127.f / am;
#pragma unroll
        for (int i = 0; i < NI; ++i) { const int ch = F.lane + 64 * i; unsigned w[2];
#pragma unroll
            for (int hf = 0; hf < 2; ++hf) { const int q0 = (int)rintf(bflo(c[i][2 * hf]) * qs), q1 = (int)rintf(bfhi(c[i][2 * hf]) * qs), q2 = (int)rintf(bflo(c[i][2 * hf + 1]) * qs), q3 = (int)rintf(bfhi(c[i][2 * hf + 1]) * qs);
                w[hf] = (unsigned)(q0 & 255) | ((unsigned)(q1 & 255) << 8) | ((unsigned)(q2 & 255) << 16) | ((unsigned)q3 << 24); }
            if (ch < NCH) *(GAS v2u*)(W8 + (size_t)r * KL + 8 * ch) = (v2u){w[0], w[1]}; }
        if (F.lane == 0) sw[r] = am * (1.f / 127.f);
    }
}
__device__ __forceinline__ void act_quant_rows(Frame& F, const bf16* ACTp, unsigned char* A8, const unsigned* rmax, float* sa2) {
    const int gw = F.vcu * NWAVES + F.wave, NGW = F.G * NWAVES;
    constexpr int NCH = DFF / 8, NI = (NCH + 63) / 64;
    for (int m = gw; m < M; m += NGW) {
        const float am = fmaxf(__builtin_bit_cast(float, rmax[m]), 1e-30f), qs = 127.f / am;
        const GAS v4u* src = (const GAS v4u*)(ACTp + (size_t)m * DFF);
#pragma unroll 11
        for (int i = 0; i < NI; ++i) { const int ch = F.lane + 64 * i; if (ch < NCH) { const v4u c = src[ch]; unsigned w[2];
#pragma unroll
            for (int hf = 0; hf < 2; ++hf) { const int q0 = (int)rintf(bflo(c[2 * hf]) * qs), q1 = (int)rintf(bfhi(c[2 * hf]) * qs), q2 = (int)rintf(bflo(c[2 * hf + 1]) * qs), q3 = (int)rintf(bfhi(c[2 * hf + 1]) * qs);
                w[hf] = (unsigned)(q0 & 255) | ((unsigned)(q1 & 255) << 8) | ((unsigned)(q2 & 255) << 16) | ((unsigned)q3 << 24); }
            *(GAS v2u*)(A8 + (size_t)m * DFF + 8 * ch) = (v2u){w[0], w[1]}; } }
        if (F.lane == 0) sa2[m] = am * (1.f / 127.f);
    }
}
constexpr int ST_PITCH = 8200, ST_K = 4096, ST_CM_OFF = RING_OFF + 16 * ST_PITCH;
__device__ __forceinline__ void strip_rot4(float (&v)[32]) {
#pragma unroll
    for (int g = 0; g < 4; ++g)
#pragma unroll
        for (int st = 1; st < 8; st <<= 1)
#pragma unroll
            for (int a = 0; a < 8; ++a) if (!(a & st)) { const float x = v[8 * g + a], y = v[8 * g + a + st]; v[8 * g + a] = x + y; v[8 * g + a + st] = x - y; }
#pragma unroll
    for (int g = 0; g < 4; ++g) {
        asm volatile("v_nop\n\tv_nop\n\tv_permlane16_swap_b32 %0, %1\n\tv_permlane16_swap_b32 %2, %3\n\tv_permlane16_swap_b32 %4, %5\n\tv_permlane16_swap_b32 %6, %7\n\ts_nop 1"
                     : "+v"(v[8 * g + 0]), "+v"(v[8 * g + 1]), "+v"(v[8 * g + 2]), "+v"(v[8 * g + 3]), "+v"(v[8 * g + 4]), "+v"(v[8 * g + 5]), "+v"(v[8 * g + 6]), "+v"(v[8 * g + 7]));
#pragma unroll
        for (int a = 0; a < 8; a += 2) { const float x = v[8 * g + a], y = v[8 * g + a + 1]; v[8 * g + a] = x + y; v[8 * g + a + 1] = x - y; }
        asm volatile("v_nop\n\tv_nop\n\tv_permlane32_swap_b32 %0, %2\n\tv_permlane32_swap_b32 %1, %3\n\tv_permlane32_swap_b32 %4, %6\n\tv_permlane32_swap_b32 %5, %7\n\ts_nop 1"
                     : "+v"(v[8 * g + 0]), "+v"(v[8 * g + 1]), "+v"(v[8 * g + 2]), "+v"(v[8 * g + 3]), "+v"(v[8 * g + 4]), "+v"(v[8 * g + 5]), "+v"(v[8 * g + 6]), "+v"(v[8 * g + 7]));
#pragma unroll
        for (int a = 0; a < 8; ++a) if (!(a & 2)) { const float x = v[8 * g + a], y = v[8 * g + a + 2]; v[8 * g + a] = x + y; v[8 * g + a + 2] = x - y; }
    }
}
__device__ __forceinline__ unsigned q8bits(float x, float qs) { return __builtin_bit_cast(unsigned, fmaf(x, qs, 12582912.f)) & 255u; }
constexpr size_t WS_FOMAX = WS_CTL + 256 * 1024, WS_FOCNT = WS_FOMAX + 32 * 1024;
__device__ __forceinline__ void strip_desc(const Frame& F, int s, const float*& p, int& N, int& kind, int& l, int& c0, int& b0, int& nb, int& cgl) {
    constexpr int S_FO = 3 * (DM / 16), S_FI = 2 * DFF / 16, S_HI = NHG / 16;
    int r = s; b0 = 0; nb = 32; cgl = 0;
    if (r < 2 * S_FO) { cgl = r / 3; const int part = r - 3 * cgl; l = cgl / (DM / 16); kind = 0; N = DM; p = F.w_ff_out + (size_t)l * DFF * DM; c0 = 16 * (cgl - l * (DM / 16));
        b0 = 29 * part; nb = (part == 2) ? 28 : 29; return; } r -= 2 * S_FO;
    if (r < 2 * S_FI) { l = r / S_FI; r -= l * S_FI; kind = 1; N = 2 * DFF; p = F.w_ff_in + (size_t)l * DM * 2 * DFF; c0 = 16 * r; return; } r -= 2 * S_FI;
    if (r < S_HI) { l = 0; kind = 2; N = NHG; p = F.w_hg_in; c0 = 16 * r; return; } r -= S_HI;
    l = 0; kind = 3; N = DM; p = F.w_hg_out; c0 = 16 * r;
}
template <int KL, int N, bool ROT, bool TMW, int MODE, bool SYNC3, bool PERMK>
__device__ __forceinline__ void p0_strip(Frame& F, float (&v)[32], const float* src, const float* nsrc, int nN, int c0, int b0, int nb, int cgl, unsigned char* W8, float* sw, int par) {
    LAS unsigned char* st = F.lds + RING_OFF;
    LAS float* cm = (LAS float*)(F.lds + ST_CM_OFF) + par * 128;
    const int n = F.lane & 15, kq = F.lane >> 4;
    float mx = 0.f;
#pragma unroll 1
    for (int blk = b0 + F.wave; blk < b0 + nb; blk += NWAVES) {
        float x[32];
#pragma unroll
        for (int i = 0; i < 32; ++i) x[i] = v[i];
        const bool last = blk + NWAVES >= b0 + nb;
        const float* q = last ? nsrc : src + (size_t)(128 * (blk + NWAVES)) * N;
        const size_t step = (size_t)4 * (last ? nN : N);
#pragma unroll
        for (int i = 0; i < 32; ++i) v[i] = MK_LD_W(q + i * step);
        if (ROT) strip_rot4(x);
        LAS unsigned short* d = (LAS unsigned short*)(st + n * ST_PITCH + 256 * (blk - b0)) + (!ROT ? kq : PERMK ? 4 * (kq >> 1) + 8 * (kq & 1) : 4 * kq);
#pragma unroll
        for (int i = 0; i < 32; i += 2) { const unsigned w = cvtpk(x[i], x[i + 1]); mx = fmaxf(mx, fmaxf(fabsf(x[i]), fabsf(x[i + 1])));
            const int r3 = (i >> 1) & 1, r4 = (i >> 2) & 1;
            if (ROT) *(LAS unsigned*)(d + 32 * (i >> 3) + (PERMK ? 2 * r4 + 16 * r3 : 2 * r3 + 16 * r4)) = w;
            else { d[4 * i] = (unsigned short)w; d[4 * i + 4] = (unsigned short)(w >> 16); } }
    }
    mx = fmaxf(mx, __shfl_xor(mx, 16)); mx = fmaxf(mx, __shfl_xor(mx, 32));
    if (F.lane < 16) cm[F.wave * 16 + n] = mx;
    __syncthreads();
    float am = 1e-30f;
#pragma unroll
    for (int w = 0; w < NWAVES; ++w) am = fmaxf(am, cm[w * 16 + n]);
    am = bflo(cvtpk(am, am));
    if (SYNC3) {
        unsigned* gmax = (unsigned*)(F.ws + WS_FOMAX) + cgl * 16; unsigned* cnt = (unsigned*)(F.ws + WS_FOCNT) + cgl;
        if (F.tid < 16) am = fmaxf(am, __builtin_bit_cast(float, __hip_atomic_fetch_max(gmax + n, __builtin_bit_cast(unsigned, am), __ATOMIC_RELAXED, __HIP_MEMORY_SCOPE_AGENT)));
        if (F.wave == 0) { asm volatile("s_waitcnt vmcnt(0)" ::: "memory");
            if (F.tid == 0) { (void)xb_add(cnt, 1u); unsigned sp = 0; while (xb_ld(cnt) < 3u && ++sp < (1u << 22)) __builtin_amdgcn_s_sleep(1); } }
        __syncthreads();
        am = fmaxf(am, __builtin_bit_cast(float, xb_ld(gmax + n)));
    }
    const float qs = 127.f / am;
    const int col = c0 + n; int R = col;
    if (MODE == 1) { const int c = (col < DFF) ? col : col - DFF; R = 256 * (c >> 7) + (c & 127) + ((col < DFF) ? 0 : 128); }
    if (MODE == 2) { const int s = col >> 12, cc = col & 4095, c64 = cc & 63; R = 256 * (cc >> 6) + 128 * (s >> 1) + 32 * (c64 >> 4) + 8 * ((c64 >> 2) & 3) + 4 * (s & 1) + (c64 & 3); }
#pragma unroll 2
    for (int t = 0; t < 8; ++t) {
        const int c = 4 * (F.wave + NWAVES * t) + kq;
        if (c < 8 * nb) {
            const LAS v2u* s2 = (const LAS v2u*)(st + n * ST_PITCH + 32 * c);
            unsigned w[4];
#pragma unroll
            for (int j = 0; j < 4; ++j) { const v2u u = s2[j];
                w[j] = q8bits(bflo(u.x), qs) | (q8bits(bfhi(u.x), qs) << 8) | (q8bits(bflo(u.y), qs) << 16) | (q8bits(bfhi(u.y), qs) << 24); }
            const int kb = 128 * b0 + 16 * c;
            if (TMW) *(GAS v4u*)(W8 + pg8::tm_chunk_off(R, kb, KL / 128, true)) = (v4u){w[0], w[1], w[2], w[3]};
            else *(GAS v4u*)(W8 + (size_t)R * KL + kb) = (v4u){w[0], w[1], w[2], w[3]};
        }
    }
    if (F.tid < 16 && b0 == 0) sw[R] = am * (ROT ? 0.17677669529663687f / 127.f : 1.f / 127.f);
    __syncthreads();
}
#ifndef MK_P0_DEFER
#define MK_P0_DEFER 0
#endif
constexpr int SX_FO = 3 * (DM / 16), SX_FI = 2 * DFF / 16, SX_HI = NHG / 16, SX_HO = DM / 16, SX_ALL = 2 * SX_FO + 2 * SX_FI + SX_HI + SX_HO;
constexpr int DEF_FI = MK_P0_DEFER ? 640 : 0, DEF_FO = MK_P0_DEFER ? 213 : 0;
static_assert(DEF_FI <= SX_FI && 3 * DEF_FO <= SX_FO, "deferred strip counts");
__device__ __forceinline__ int strip_full_index(int lst, int j) {
    if (lst == 3) return j;
    if (lst == 4) return 2 * SX_FO + j;
    if (lst == 1) return 2 * SX_FO + SX_FI + j;
    if (lst == 2) return SX_FO + j;
    if (j < SX_FO) return j;
    j -= SX_FO; if (j < SX_FO - 3 * DEF_FO) return SX_FO + 3 * DEF_FO + j;
    j -= SX_FO - 3 * DEF_FO; if (j < SX_FI) return 2 * SX_FO + j;
    j -= SX_FI; if (j < SX_FI - DEF_FI) return 2 * SX_FO + SX_FI + DEF_FI + j;
    j -= SX_FI - DEF_FI; return 2 * SX_FO + 2 * SX_FI + j;
}
template <int LST> __device__ __forceinline__ void run_strips(Frame& F, int j0, int jstep) {
    constexpr int CNT = LST == 0 ? SX_ALL - 3 * DEF_FO - DEF_FI : LST == 1 ? DEF_FI : LST == 2 ? 3 * DEF_FO : LST == 3 ? 2 * SX_FO : SX_ALL - 2 * SX_FO;
    const int n = F.lane & 15, kq = F.lane >> 4;
    int j = j0, par = 0;
    if (j < 0 || j >= CNT) return;
    const float* p; int N, kind, l, c0, b0, nb, cgl;
    strip_desc(F, strip_full_index(LST, j), p, N, kind, l, c0, b0, nb, cgl);
    const float* src = p + (size_t)kq * N + c0 + n;
    float v[32];
    { const float* q = src + (size_t)(128 * (b0 + F.wave)) * N; const size_t step = (size_t)4 * N;
#pragma unroll
      for (int i = 0; i < 32; ++i) v[i] = MK_LD_W(q + i * step); }
#pragma unroll 1
    while (j < CNT) {
        const int jn = j + jstep;
        const float* pn; int Nn, kindn, ln, c0n, b0n, nbn, cgln;
        strip_desc(F, strip_full_index(LST, jn < CNT ? jn : j), pn, Nn, kindn, ln, c0n, b0n, nbn, cgln);
        const float* srcn = pn + (size_t)kq * Nn + c0n + n;
        const float* nsrc = srcn + (size_t)(128 * (b0n + F.wave)) * Nn;
        if (LST != 1 && LST != 4 && kind == 0) p0_strip<DFF, DM, true, false, 0, true, true>(F, v, src, nsrc, Nn, c0, b0, nb, cgl, F.ws + WS_W8O + l * W8O_STRIDE, (float*)(F.ws + WS_SWO) + l * DM, par);
        else if (LST != 2 && LST != 3 && kind == 1) p0_strip<DM, 2 * DFF, false, TM_FFI, 1, false, false>(F, v, src, nsrc, Nn, c0, 0, 32, 0, F.ws + WS_W8 + l * W8_STRIDE, (float*)(F.ws + WS_SW) + l * 2 * DFF, par);
        else if ((LST == 0 || LST == 4) && kind == 2) p0_strip<DM, NHG, false, false, 2, false, false>(F, v, src, nsrc, Nn, c0, 0, 32, 0, F.ws + WS_W8H, (float*)(F.ws + WS_SWH), par);
        else if (LST == 0 || LST == 4) p0_strip<DM, DM, true, false, 0, false, false>(F, v, src, nsrc, Nn, c0, 0, 32, 0, F.ws + WS_W8G, (float*)(F.ws + WS_SWG), par);
        j = jn; src = srcn; kind = kindn; l = ln; c0 = c0n; b0 = b0n; nb = nbn; cgl = cgln; par ^= 1;
    }
    asm volatile("s_waitcnt vmcnt(0)" ::: "memory");
    __syncthreads();
}
template <int LST> __device__ __forceinline__ void run_deferred_strips(Frame& F, int units) {
    if ((LST == 1 ? DEF_FI : 3 * DEF_FO) == 0) return;
    const int rem = units % F.G, bx = (int)blockIdx.x;
    asm volatile("s_waitcnt vmcnt(0)" ::: "memory"); __syncthreads();
    run_strips<LST>(F, rem == 0 ? bx : bx - rem, rem == 0 ? F.G : F.G - rem);
}
__device__ __forceinline__ void p0_prologue(Frame& F) {
    LAS float* scr = (LAS float*)(F.lds + RING_OFF + F.wave * 16384);
    const int gw = F.vcu * NWAVES + F.wave, NGW = F.G * NWAVES;
    constexpr int I0 = (DM / 64) * (NQKV / 32), I1 = (DATT / 64) * (DM / 32), I2 = (DM / 64) * (NHG / 32), I3 = (DM / 64) * (DM / 32), I4 = (DM / 64) * (2 * DFF / 32), I6 = (DFF / 64) * (DM / 32);
    constexpr int NITEMS = P0_STRIP ? I0 + I1 : I0 + I1 + I2 + I3 + 2 * I4 + 2 * I6;
    if (P0_STRIP) { if (P0_OVL) run_strips<3>(F, F.vcu, F.G); else run_strips<0>(F, F.vcu, F.G); }
    for (int it = gw; it < NITEMS; it += NGW) {
        int r = it;
        if (r < I0) { p0_transpose_item(F.w_att_in, DM, NQKV, (bf16*)(F.ws + WS_WATTI), 0, scr, r, F.lane); continue; } r -= I0;
        if (r < I1) { p0_transpose_item(F.w_att_out, DATT, DM, (bf16*)(F.ws + WS_WATTO), 0, scr, r, F.lane); continue; } r -= I1;
        if (r < I2) { p0_transpose_item(F.w_hg_in, DM, NHG, (bf16*)(F.ws + WS_WHGI), HG_FUSE ? 2 : 0, scr, r, F.lane); continue; } r -= I2;
        if (r < I3) { p0_transpose_item(F.w_hg_out, DM, DM, (bf16*)(F.ws + WS_WHGO), 0, scr, r, F.lane); continue; } r -= I3;
        if (r < 2 * I4) { const int l = r / I4; p0_transpose_item(F.w_ff_in + (size_t)l * DM * 2 * DFF, DM, 2 * DFF, (bf16*)(F.ws + WS_WFFI + l * WFFI_STRIDE), 1, scr, r - l * I4, F.lane); continue; } r -= 2 * I4;
        { const int l = r / I6; p0_transpose_item(F.w_ff_out + (size_t)l * DFF * DM, DFF, DM, (bf16*)(F.ws + WS_WFFO + l * WFFO_STRIDE), 0, scr, r - l * I6, F.lane); }
    }
    float* BT = (float*)(F.ws + WS_TAB); float* LB = (float*)(F.ws + WS_TAB + 65536);
    const int gt = blockIdx.x * (NWAVES * 64) + F.tid, NT = F.G * NWAVES * 64;
    for (int idx = gt; idx < 3 * 16 * 129; idx += NT) { const int g = idx / (16 * 129), rem = idx - g * 16 * 129, h = rem / 129, j = rem - h * 129;
        BT[idx] = F.rel_bias[t5_bucket(j << (2 * g)) * 48 + g * 16 + h]; }
    for (int c = gt; c < DM; c += NT) { const float l0 = F.lb_logits[c], l1 = F.lb_logits[DM + c]; LB[c] = 1.f / (1.f + expf(l0 - l1)); }
    norm_rows<false, ATT_I8 ? 2 : 1>(F, F.x, nullptr, nullptr, (bf16*)(F.ws + WS_XN), nullptr, F.gains, (float*)(F.ws + WS_SA));
}
__device__ __forceinline__ void attn_naive(Frame& F) {
    const int gw = F.vcu * NWAVES + F.wave, NGW = F.G * NWAVES;
    const bf16* QKV = (const bf16*)(F.ws + WS_QKV); bf16* MRG = (bf16*)(F.ws + WS_MRG); const float* BT = (const float*)(F.ws + WS_TAB);
    for (int item = gw; item < M * 16; item += NGW) {
        const int m = item >> 4, h = item & 15, t = m & (SEQ - 1);
        float mx = -1e30f, l = 0.f, a0 = 0.f, a1 = 0.f;
#pragma unroll 1
        for (int g = 0; g < 3; ++g) {
            const int sh = 2 * g;
            const unsigned qw = *(const GAS unsigned*)(QKV + (size_t)m * NQKV + g * 6144 + h * 128 + 2 * F.lane);
            const float q0 = bflo(qw) * QSCALE, q1 = bfhi(qw) * QSCALE;
            const int jmax = (t >> sh) < 128 ? (t >> sh) : 128;
            const float* bt = BT + (g * 16 + h) * 129;
#pragma unroll 1
            for (int j0 = 0; j0 <= jmax; j0 += 8) {
                unsigned kw[8], vw[8]; float bs[8];
#pragma unroll
                for (int u = 0; u < 8; ++u) { const int jj = (j0 + u) <= jmax ? (j0 + u) : jmax; const bf16* rp = QKV + (size_t)(m - (jj << sh)) * NQKV + g * 6144 + h * 128 + 2 * F.lane;
                    kw[u] = *(const GAS unsigned*)(rp + 2048); vw[u] = *(const GAS unsigned*)(rp + 4096); bs[u] = bt[jj]; }
                float s[8]; float cm = -INFINITY;
#pragma unroll
                for (int u = 0; u < 8; ++u) { s[u] = wave_sum(q0 * bflo(kw[u]) + q1 * bfhi(kw[u])) + bs[u]; if (j0 + u > jmax) s[u] = -INFINITY; cm = fmaxf(cm, s[u]); }
                const float mn = fmaxf(mx, cm), sc = __expf(mx - mn); l *= sc; a0 *= sc; a1 *= sc; mx = mn;
#pragma unroll
                for (int u = 0; u < 8; ++u) { const float p = __expf(s[u] - mn); l += p; a0 += p * bflo(vw[u]); a1 += p * bfhi(vw[u]); }
            }
        }
        const float inv = 1.f / l;
        *(GAS unsigned*)(MRG + (size_t)m * DATT + h * 128 + 2 * F.lane) = pk2(a0 * inv, a1 * inv);
    }
}
__device__ __forceinline__ void hgrn_naive(Frame& F) {
    if (blockIdx.x >= 64) return;
    const int b = blockIdx.x >> 5, h = blockIdx.x & 31;
    const bf16* HP = (const bf16*)(F.ws + WS_QKV); float* ORAW = (float*)(F.ws + WS_ACT); const float* LB = (const float*)(F.ws + WS_TAB + 65536);
    LAS f32x4* PRM = (LAS f32x4*)(F.lds);
    LAS float* VV = (LAS float*)(F.lds + 32768);
    LAS float* OP = (LAS float*)(F.lds + 32768 + 8192);
    const int e = F.tid & 127, qd = F.tid >> 7, ps = F.tid >> 6, pl = F.tid & 63;
    const float lb0 = LB[h * 128 + 2 * pl], lb1 = LB[h * 128 + 2 * pl + 1];
    float S[32];
#pragma unroll
    for (int d = 0; d < 32; ++d) S[d] = 0.f;
    unsigned qw, fw, iw;
#define HG_LOAD(n) do { const bf16* bp = HP + (size_t)(b * SEQ + (n) * 8 + ps) * NHG + h * 128 + 2 * pl; qw = *(const GAS unsigned*)bp; fw = *(const GAS unsigned*)(bp + 4096); iw = *(const GAS unsigned*)(bp + 8192); } while (0)
#define HG_WRITE(buf) do { const float f0 = bflo(fw), f1 = bfhi(fw), r0 = bflo(qw), r1 = bfhi(qw); \
        const float g0 = lb0 + (1.f - lb0) / (1.f + __expf(-f0)), g1 = lb1 + (1.f - lb1) / (1.f + __expf(-f1)); \
        const int o = ((buf) * 8 + ps) * 128 + 2 * pl; \
        PRM[o] = (f32x4){g0, 1.f - g0, r0 / (1.f + __expf(-r0)) * QSCALE, 0.f}; PRM[o + 1] = (f32x4){g1, 1.f - g1, r1 / (1.f + __expf(-r1)) * QSCALE, 0.f}; \
        VV[o] = bflo(iw); VV[o + 1] = bfhi(iw); } while (0)
    HG_LOAD(0); HG_WRITE(0); __syncthreads();
#pragma unroll 1
    for (int n = 0; n < SEQ / 8; ++n) {
        const int buf = n & 1;
        if (n + 1 < SEQ / 8) HG_LOAD(n + 1);
#pragma unroll 1
        for (int st = 0; st < 8; ++st) {
            const float v = VV[(buf * 8 + st) * 128 + e]; float o = 0.f;
#pragma unroll
            for (int dd = 0; dd < 32; ++dd) { const f32x4 P = PRM[(buf * 8 + st) * 128 + qd * 32 + dd]; S[dd] = P.x * S[dd] + P.y * v; o += P.z * S[dd]; }
            OP[(st * 4 + qd) * 128 + e] = o;
        }
        if (n + 1 < SEQ / 8) HG_WRITE(buf ^ 1);
        __syncthreads();
#pragma unroll
        for (int r = 0; r < 2; ++r) { const int idx = F.tid + 512 * r, st = idx >> 7, ee = idx & 127;
            const float sum = (OP[(st * 4 + 0) * 128 + ee] + OP[(st * 4 + 1) * 128 + ee]) + (OP[(st * 4 + 2) * 128 + ee] + OP[(st * 4 + 3) * 128 + ee]);
            ORAW[(size_t)(b * SEQ + n * 8 + st) * DM + h * 128 + ee] = sum; }
        __syncthreads();
    }
#undef HG_LOAD
#undef HG_WRITE
}
__device__ __forceinline__ void hgrn_gate(Frame& F) {
    const int gw = F.vcu * NWAVES + F.wave, NGW = F.G * NWAVES;
    const float* ORAW = (const float*)(F.ws + WS_ACT); const bf16* HP = (const bf16*)(F.ws + WS_QKV); bf16* OG = (bf16*)(F.ws + WS_OG);
    const f32x4 gn = *(const GAS f32x4*)(F.hg_gain + 4 * (F.lane & 31));
    for (int m = gw; m < M; m += NGW) {
        const GAS f32x4* orow = (const GAS f32x4*)(ORAW + (size_t)m * DM) + F.lane;
        const GAS v2u* grow = (const GAS v2u*)(HP + (size_t)m * NHG + 3 * DM) + F.lane;
        GAS v2u* o8 = (GAS v2u*)(OG + (size_t)m * DM) + F.lane;
#pragma unroll 4
        for (int j = 0; j < 16; ++j) {
            const f32x4 o = orow[64 * j]; const v2u gw2 = grow[64 * j];
            float ss = (o.x * o.x + o.y * o.y) + (o.z * o.z + o.w * o.w);
#pragma unroll
            for (int k = 1; k < 32; k <<= 1) ss += __shfl_xor(ss, k);
            const float rstd = 1.f / sqrtf(ss * (1.f / HD) + RMS_EPS);
            const float g0 = bflo(gw2.x), g1 = bfhi(gw2.x), g2 = bflo(gw2.y), g3 = bfhi(gw2.y);
            v2u w; w.x = pk2(o.x * rstd * gn.x * (g0 / (1.f + __expf(-g0))), o.y * rstd * gn.y * (g1 / (1.f + __expf(-g1))));
            w.y = pk2(o.z * rstd * gn.z * (g2 / (1.f + __expf(-g2))), o.w * rstd * gn.w * (g3 / (1.f + __expf(-g3))));
            o8[64 * j] = w;
        }
    }
}
typedef short v4i16_t __attribute__((ext_vector_type(4)));
constexpr int AT_K = 0, AT_KP = 128 * 272, AT_V = 2 * AT_KP, AT_VP = 128 * 288, AT_BT = AT_V + 2 * AT_VP, AT_END = AT_BT + 1024;
static_assert(AT_END <= LDSCTL_OFF, "attention LDS map");
constexpr size_t WS_AO = 2334 * MiB, WS_LSE = 2526 * MiB, WS_END2 = 2529 * MiB;
__device__ __forceinline__ void attn_load_page(LAS unsigned char* L, int tid, const bf16* Kt, const bf16* Vt, int row0, int h, int slot) {
#pragma unroll
    for (int i = 0; i < 4; ++i) { const int chunk = tid + 512 * i, r = chunk >> 4, c = chunk & 15;
        const v4u kv = *(const GAS v4u*)(Kt + (size_t)(row0 + r) * 2048 + h * 128 + 8 * c); const v4u vv = *(const GAS v4u*)(Vt + (size_t)(row0 + r) * 2048 + h * 128 + 8 * c);
        *(LAS v4u*)(L + AT_K + slot * AT_KP + r * 272 + 16 * c) = kv; *(LAS v4u*)(L + AT_V + slot * AT_VP + r * 288 + 16 * c) = vv; }
}
__device__ __forceinline__ void attn_mfma(Frame& F) {
    const bf16* QKVp = (const bf16*)(F.ws + WS_QKV); bf16* AO = (bf16*)(F.ws + WS_AO); float* LSE = (float*)(F.ws + WS_LSE); const float* BT = (const float*)(F.ws + WS_TAB);
    LAS unsigned char* L = F.lds;
    const int w = F.wave, li = F.lane & 15, g4 = F.lane >> 4;
    const int per = (6144 + F.G - 1) / F.G, U0 = F.vcu * per, U1 = (U0 + per) < 6144 ? (U0 + per) : 6144;
    int prevU = -2;
    v4u pk[4], pv[4];
#define AT_DECODE(UU, gh_, qb_, g_, h_, q0_) const int gh_ = (UU) >> 7, qb_ = (UU) & 127, g_ = gh_ >> 4, h_ = gh_ & 15, q0_ = 128 * qb_
#define AT_PREFETCH(UU) do { AT_DECODE(UU, ghn, qbn, gn_, hn, q0n); (void)qbn; const bf16* Kn = QKVp + (size_t)(3 * gn_ + 1) * M * 2048; const bf16* Vn = Kn + (size_t)M * 2048; \
        _Pragma("unroll") for (int i = 0; i < 4; ++i) { const int chunk = F.tid + 512 * i, r = chunk >> 4, c = chunk & 15; \
            pk[i] = *(const GAS v4u*)(Kn + (size_t)(q0n + r) * 2048 + hn * 128 + 8 * c); pv[i] = *(const GAS v4u*)(Vn + (size_t)(q0n + r) * 2048 + hn * 128 + 8 * c); } \
        } while (0)
    if (U0 < U1) AT_PREFETCH(U0);
#pragma unroll 1
    for (int U = U0; U < U1; ++U) {
        const int gh = U >> 7, qb = U & 127, g = gh >> 4, h = gh & 15, sh = 2 * g, n = SEQ >> sh, q0 = 128 * qb, i0 = q0 & (n - 1);
        const bool first = (i0 == 0);
        const bf16* Qt = QKVp + (size_t)(3 * g) * M * 2048; const bf16* Kt = Qt + (size_t)M * 2048; const bf16* Vt = Kt + (size_t)M * 2048;
        __builtin_amdgcn_s_barrier(); asm volatile("" ::: "memory");
        if (U == U0 || qb == 0) { if (F.tid < 161) { const int rel = F.tid - 16; ((LAS float*)(L + AT_BT))[F.tid] = (rel >= 0 && rel <= 128) ? BT[gh * 129 + rel] : 0.f; } }
        if (first) { for (int i = F.tid; i < AT_VP / 16; i += NWAVES * 64) *(LAS v4u*)(L + AT_V + ((qb - 1) & 1) * AT_VP + 16 * i) = (v4u){0u, 0u, 0u, 0u}; }
        else if (prevU != U - 1) attn_load_page(L, F.tid, Kt, Vt, q0 - 128, h, (qb - 1) & 1);
#pragma unroll
        for (int i = 0; i < 4; ++i) { const int chunk = F.tid + 512 * i, r = chunk >> 4, c = chunk & 15;
            *(LAS v4u*)(L + AT_K + (qb & 1) * AT_KP + r * 272 + 16 * c) = pk[i]; *(LAS v4u*)(L + AT_V + (qb & 1) * AT_VP + r * 288 + 16 * c) = pv[i]; }
        prevU = U;
        bf16x8 qf[4];
        { const bf16* qp = Qt + (size_t)(q0 + 16 * w + li) * 2048 + h * 128 + 8 * g4;
#pragma unroll
          for (int ds = 0; ds < 4; ++ds) qf[ds] = *(const GAS bf16x8*)(qp + 32 * ds); }
        LDS_WAIT(); __builtin_amdgcn_s_barrier(); asm volatile("" ::: "memory");
        { const int Un = (U + 1 < U1) ? U + 1 : U; AT_PREFETCH(Un); }
        f32x4 sc[9];
        __builtin_amdgcn_s_setprio(1);
#pragma unroll
        for (int blk = 0; blk < 9; ++blk) { const int kb = w + blk, slot = (qb - 1 + (kb >> 3)) & 1;
            const LAS unsigned char* kp = L + AT_K + slot * AT_KP + ((kb & 7) * 16 + li) * 272 + 16 * g4;
            f32x4 acc = (f32x4){0.f, 0.f, 0.f, 0.f};
#pragma unroll
            for (int ds = 0; ds < 4; ++ds) { const bf16x8 a = *(const LAS bf16x8*)(kp + 64 * ds); acc = __builtin_amdgcn_mfma_f32_16x16x32_bf16(a, qf[ds], acc, 0, 0, 0); }
            sc[blk] = acc; }
        __builtin_amdgcn_s_setprio(0);
        const LAS float* bt = (const LAS float*)(L + AT_BT) + (16 + 128 + li - 4 * g4);
        const int ql = 16 * w + li, relmax = first ? (ql < 128 ? ql : 128) : 128;
        float mx = -INFINITY;
#pragma unroll
        for (int blk = 0; blk < 9; ++blk)
#pragma unroll
            for (int r = 0; r < 4; ++r) { const int rel = 128 + li - 16 * blk - 4 * g4 - r; const float bias = bt[-(16 * blk + r)];
                const float s = (rel >= 0 && rel <= relmax) ? sc[blk][r] * QSCALE + bias : -INFINITY; sc[blk][r] = s; mx = fmaxf(mx, s); }
        mx = fmaxf(mx, __shfl_xor(mx, 16)); mx = fmaxf(mx, __shfl_xor(mx, 32));
        float lsum = 0.f;
#pragma unroll
        for (int blk = 0; blk < 9; ++blk)
#pragma unroll
            for (int r = 0; r < 4; ++r) { const float p = __expf(sc[blk][r] - mx); sc[blk][r] = p; lsum += p; }
        lsum += __shfl_xor(lsum, 16); lsum += __shfl_xor(lsum, 32);
        f32x4 o[8];
#pragma unroll
        for (int db = 0; db < 8; ++db) o[db] = (f32x4){0.f, 0.f, 0.f, 0.f};
        __builtin_amdgcn_s_setprio(1);
#pragma unroll
        for (int st = 0; st < 5; ++st) {
            const int ba = 2 * st, bb = (2 * st + 1) < 9 ? (2 * st + 1) : 8;
            v4u pw; pw.x = cvtpk(sc[ba][0], sc[ba][1]); pw.y = cvtpk(sc[ba][2], sc[ba][3]);
            if (2 * st + 1 < 9) { pw.z = cvtpk(sc[bb][0], sc[bb][1]); pw.w = cvtpk(sc[bb][2], sc[bb][3]); } else { pw.z = 0u; pw.w = 0u; }
            const bf16x8 pf = __builtin_bit_cast(bf16x8, pw);
            const int kba = w + ba, kbb = w + bb;
            const LAS unsigned char* va = L + AT_V + ((qb - 1 + (kba >> 3)) & 1) * AT_VP + ((kba & 7) * 16 + 4 * g4 + (li >> 2)) * 288 + 8 * (li & 3);
            const LAS unsigned char* vb = L + AT_V + ((qb - 1 + (kbb >> 3)) & 1) * AT_VP + ((kbb & 7) * 16 + 4 * g4 + (li >> 2)) * 288 + 8 * (li & 3);
#pragma unroll
            for (int db = 0; db < 8; ++db) {
                const v4i16_t lo = __builtin_amdgcn_ds_read_tr16_b64_v4i16((LAS v4i16_t*)(va + 32 * db)), hi = __builtin_amdgcn_ds_read_tr16_b64_v4i16((LAS v4i16_t*)(vb + 32 * db));
                const bf16x8 a = __builtin_shufflevector(lo, hi, 0, 1, 2, 3, 4, 5, 6, 7);
                o[db] = __builtin_amdgcn_mfma_f32_16x16x32_bf16(a, pf, o[db], 0, 0, 0); }
        }
        __builtin_amdgcn_s_setprio(0);
        const float inv = 1.f / lsum;
        const size_t orow = (size_t)g * M + (size_t)(q0 + 16 * w + li);
        bf16* op = AO + orow * 2048 + h * 128 + 4 * g4;
#pragma unroll
        for (int db = 0; db < 8; ++db) *(GAS v2u*)(op + 16 * db) = (v2u){cvtpk(o[db][0] * inv, o[db][1] * inv), cvtpk(o[db][2] * inv, o[db][3] * inv)};
        if (g4 == 0) LSE[orow * 16 + h] = mx + __logf(lsum);
    }
#undef AT_PREFETCH
#undef AT_DECODE
}
__device__ __forceinline__ void attn_merge(Frame& F) {
    const int gw = F.vcu * NWAVES + F.wave, NGW = F.G * NWAVES;
    const bf16* AO = (const bf16*)(F.ws + WS_AO); const float* LSE = (const float*)(F.ws + WS_LSE); bf16* MRG = (bf16*)(F.ws + WS_MRG);
    for (int m = gw; m < M; m += NGW) {
        const int t = m & (SEQ - 1), bbase = m & ~(SEQ - 1);
        size_t rows[3];
#pragma unroll
        for (int g = 0; g < 3; ++g) { const int sh = 2 * g; rows[g] = (size_t)g * M + (size_t)(bbase + ((t & ((1 << sh) - 1)) << (13 - sh)) + (t >> sh)); }
#pragma unroll
        for (int k = 0; k < 4; ++k) {
            const int hd = (F.lane >> 4) + 4 * k, c = F.lane + 64 * k;
            const float l0 = LSE[rows[0] * 16 + hd], l1 = LSE[rows[1] * 16 + hd], l2 = LSE[rows[2] * 16 + hd];
            const float mx = fmaxf(l0, fmaxf(l1, l2)); float w0 = __expf(l0 - mx), w1 = __expf(l1 - mx), w2 = __expf(l2 - mx); const float inv = 1.f / (w0 + w1 + w2); w0 *= inv; w1 *= inv; w2 *= inv;
            const v4u a = *(const GAS v4u*)(AO + rows[0] * 2048 + 8 * c), b = *(const GAS v4u*)(AO + rows[1] * 2048 + 8 * c), d = *(const GAS v4u*)(AO + rows[2] * 2048 + 8 * c);
            v4u o;
#pragma unroll
            for (int j = 0; j < 4; ++j) o[j] = cvtpk(w0 * bflo(a[j]) + w1 * bflo(b[j]) + w2 * bflo(d[j]), w0 * bfhi(a[j]) + w1 * bfhi(b[j]) + w2 * bfhi(d[j]));
            *(GAS v4u*)(MRG + (size_t)m * DATT + 8 * c) = o;
        }
    }
}
typedef float f32x16 __attribute__((ext_vector_type(16)));
typedef short s16x4 __attribute__((ext_vector_type(4)));
constexpr int HG_QR = 0, HG_QD = 17408, HG_KR = 34816, HG_KRT = 52224, HG_VT = 70656, HG_ST0 = 75264, HG_ST1 = 83968, HG_SEG = 92672, HG_EL = 96768, HG_DEC = 97280, HG_END = 97792;
static_assert(HG_END <= RING_BYTES, "hgrn LDS map");
__device__ __forceinline__ void hgrn_mfma(Frame& F) {
    const bf16* HP = (const bf16*)(F.ws + WS_QKV); float* ORAW = (float*)(F.ws + WS_ACT); const float* LB = (const float*)(F.ws + WS_TAB + 65536);
    LAS unsigned char* L = F.lds;
    const int w = F.wave, cp = F.lane, l31 = F.lane & 31, hh = F.lane >> 5;
#pragma unroll 1
    for (int u = blockIdx.x; u < 256; u += F.G) {
        const int bh = u >> 2, e0 = (u & 3) * 32, b = bh >> 5, h = bh & 31;
        const float lb0 = LB[h * 128 + 2 * cp], lb1 = LB[h * 128 + 2 * cp + 1];
        const size_t rowbase = (size_t)b * SEQ;
        unsigned qraw[8], fraw[8], vraw[2];
#define HGM_LOAD(c) do { \
            _Pragma("unroll") for (int i = 0; i < 8; ++i) { const bf16* bp = HP + (rowbase + 64 * (c) + 8 * w + i) * NHG + h * 128 + 2 * cp; qraw[i] = *(const GAS unsigned*)bp; fraw[i] = *(const GAS unsigned*)(bp + 4096); } \
            _Pragma("unroll") for (int k = 0; k < 2; ++k) { const int vrow = (F.tid >> 4) + 32 * k; vraw[k] = *(const GAS unsigned*)(HP + (rowbase + 64 * (c) + vrow) * NHG + 8192 + h * 128 + e0 + 2 * (F.tid & 15)); } } while (0)
        f32x16 S;
#pragma unroll
        for (int i = 0; i < 16; ++i) S[i] = 0.f;
        for (int i = F.tid; i < 8704 / 4; i += NWAVES * 64) ((LAS unsigned*)(L + HG_ST0))[i] = 0u;
        HGM_LOAD(0);
#pragma unroll 1
        for (int c = 0; c < SEQ / 64; ++c) {
            float q[8][2], k[8][2], cs[8][2]; float run0 = 0.f, run1 = 0.f;
#pragma unroll
            for (int i = 0; i < 8; ++i) {
                const float f0 = bflo(fraw[i]), f1 = bfhi(fraw[i]), r0 = bflo(qraw[i]), r1 = bfhi(qraw[i]);
                const float g0 = lb0 + (1.f - lb0) * __builtin_amdgcn_rcpf(1.f + __expf(-f0)), g1 = lb1 + (1.f - lb1) * __builtin_amdgcn_rcpf(1.f + __expf(-f1));
                run0 += __logf(g0); run1 += __logf(g1); cs[i][0] = run0; cs[i][1] = run1;
                k[i][0] = 1.f - g0; k[i][1] = 1.f - g1;
                q[i][0] = r0 * __builtin_amdgcn_rcpf(1.f + __expf(-r0)) * QSCALE; q[i][1] = r1 * __builtin_amdgcn_rcpf(1.f + __expf(-r1)) * QSCALE;
            }
            { typedef float f32x2v __attribute__((ext_vector_type(2))); *(LAS f32x2v*)(L + HG_SEG + (w * 128 + 2 * cp) * 4) = (f32x2v){run0, run1}; }
            const unsigned v0 = vraw[0], v1 = vraw[1];
            LDS_WAIT(); __builtin_amdgcn_s_barrier(); asm volatile("" ::: "memory");
            float off0 = 0.f, off1 = 0.f, bref0 = 0.f, bref1 = 0.f, p0 = 0.f, p1 = 0.f;
#pragma unroll
            for (int s = 0; s < 8; ++s) { typedef float f32x2v __attribute__((ext_vector_type(2))); const f32x2v t = *(const LAS f32x2v*)(L + HG_SEG + (s * 128 + 2 * cp) * 4);
                if (s == w) { off0 = p0; off1 = p1; } p0 += t.x; p1 += t.y; if (s == 3) { bref0 = p0; bref1 = p1; } }
            const float er0 = __expf(bref0), er1 = __expf(bref1);
            unsigned krt0[4], krt1[4];
#pragma unroll
            for (int i = 0; i < 8; ++i) {
                const float e10 = __expf(cs[i][0] + off0 - bref0), e11 = __expf(cs[i][1] + off1 - bref1);
                const float qr0 = q[i][0] * e10, qr1 = q[i][1] * e11, kr0 = k[i][0] * __builtin_amdgcn_rcpf(e10), kr1 = k[i][1] * __builtin_amdgcn_rcpf(e11);
                const int ro = (8 * w + i) * 272 + 4 * cp;
                *(LAS unsigned*)(L + HG_QR + ro) = cvtpk(qr0, qr1);
                *(LAS unsigned*)(L + HG_QD + ro) = cvtpk(qr0 * er0, qr1 * er1);
                *(LAS unsigned*)(L + HG_KR + ro) = cvtpk(kr0, kr1);
                if (i & 1) { krt0[i >> 1] = cvtpk(k[i - 1][0] * __builtin_amdgcn_rcpf(__expf(cs[i - 1][0] + off0 - bref0)), kr0); krt1[i >> 1] = cvtpk(k[i - 1][1] * __builtin_amdgcn_rcpf(__expf(cs[i - 1][1] + off1 - bref1)), kr1); }
            }
            *(LAS v4u*)(L + HG_KRT + (2 * cp) * 144 + 16 * w) = (v4u){krt0[0], krt0[1], krt0[2], krt0[3]};
            *(LAS v4u*)(L + HG_KRT + (2 * cp + 1) * 144 + 16 * w) = (v4u){krt1[0], krt1[1], krt1[2], krt1[3]};
            if (w == 0) { typedef float f32x2v __attribute__((ext_vector_type(2)));
                *(LAS f32x2v*)(L + HG_EL + 8 * cp) = (f32x2v){__expf(p0 - bref0), __expf(p1 - bref1)}; *(LAS f32x2v*)(L + HG_DEC + 8 * cp) = (f32x2v){__expf(p0), __expf(p1)}; }
            { const int ee = 2 * (F.tid & 15), ss = F.tid >> 4;
                *(LAS unsigned short*)(L + HG_VT + ee * 144 + ss * 2) = (unsigned short)(v0 & 0xffffu); *(LAS unsigned short*)(L + HG_VT + (ee + 1) * 144 + ss * 2) = (unsigned short)(v0 >> 16);
                *(LAS unsigned short*)(L + HG_VT + ee * 144 + (ss + 32) * 2) = (unsigned short)(v1 & 0xffffu); *(LAS unsigned short*)(L + HG_VT + (ee + 1) * 144 + (ss + 32) * 2) = (unsigned short)(v1 >> 16); }
            if (c + 1 < SEQ / 64) HGM_LOAD(c + 1);
            LDS_WAIT(); __builtin_amdgcn_s_barrier(); asm volatile("" ::: "memory");
            const LAS unsigned char* stc = L + ((c & 1) ? HG_ST1 : HG_ST0);
            LAS unsigned char* stn = L + ((c & 1) ? HG_ST0 : HG_ST1);
            if (w < 2) {
                const int th = w;
                f32x16 Y;
#pragma unroll
                for (int i = 0; i < 16; ++i) Y[i] = 0.f;
#pragma unroll
                for (int kd = 0; kd < 8; ++kd) { const bf16x8 a = *(const LAS bf16x8*)(stc + l31 * 272 + (16 * kd + 8 * hh) * 2); const bf16x8 bq = *(const LAS bf16x8*)(L + HG_QD + (32 * th + l31) * 272 + (16 * kd + 8 * hh) * 2);
                    Y = __builtin_amdgcn_mfma_f32_32x32x16_bf16(a, bq, Y, 0, 0, 0); }
#pragma unroll
                for (int sb = 0; sb < 2; ++sb) { if (sb <= th) {
                    f32x16 X;
#pragma unroll
                    for (int i = 0; i < 16; ++i) X[i] = 0.f;
#pragma unroll
                    for (int kd = 0; kd < 8; ++kd) { const bf16x8 a = *(const LAS bf16x8*)(L + HG_KR + (32 * sb + l31) * 272 + (16 * kd + 8 * hh) * 2); const bf16x8 bq = *(const LAS bf16x8*)(L + HG_QR + (32 * th + l31) * 272 + (16 * kd + 8 * hh) * 2);
                        X = __builtin_amdgcn_mfma_f32_32x32x16_bf16(a, bq, X, 0, 0, 0); }
                    if (sb == th) {
#pragma unroll
                        for (int r = 0; r < 16; ++r) { const int s = (r & 3) + 8 * (r >> 2) + 4 * hh; if (s > l31) X[r] = 0.f; } }
#pragma unroll
                    for (int ks = 0; ks < 2; ++ks) {
                        const unsigned x0 = cvtpk(X[8 * ks + 0], X[8 * ks + 1]), x1 = cvtpk(X[8 * ks + 2], X[8 * ks + 3]), x2 = cvtpk(X[8 * ks + 4], X[8 * ks + 5]), x3 = cvtpk(X[8 * ks + 6], X[8 * ks + 7]);
                        const bf16x8 xb = __builtin_bit_cast(bf16x8, (v4u){x0, x1, x2, x3});
                        const v2u alo = *(const LAS v2u*)(L + HG_VT + l31 * 144 + (32 * sb + 16 * ks + 4 * hh) * 2), ahi = *(const LAS v2u*)(L + HG_VT + l31 * 144 + (32 * sb + 16 * ks + 8 + 4 * hh) * 2);
                        const bf16x8 a = __builtin_bit_cast(bf16x8, (v4u){alo.x, alo.y, ahi.x, ahi.y});
                        Y = __builtin_amdgcn_mfma_f32_32x32x16_bf16(a, xb, Y, 0, 0, 0); }
                } }
                float* orow = ORAW + (rowbase + 64 * c + 32 * th + l31) * DM + h * 128 + e0 + 4 * hh;
#pragma unroll
                for (int g = 0; g < 4; ++g) *(GAS f32x4*)(orow + 8 * g) = (f32x4){Y[4 * g], Y[4 * g + 1], Y[4 * g + 2], Y[4 * g + 3]};
            } else if (w >= 4) {
                const int dt = w - 4;
                f32x16 T;
#pragma unroll
                for (int i = 0; i < 16; ++i) T[i] = 0.f;
#pragma unroll
                for (int ks = 0; ks < 4; ++ks) { const bf16x8 a = *(const LAS bf16x8*)(L + HG_KRT + (32 * dt + l31) * 144 + (16 * ks + 8 * hh) * 2); const bf16x8 bv = *(const LAS bf16x8*)(L + HG_VT + l31 * 144 + (16 * ks + 8 * hh) * 2);
                    T = __builtin_amdgcn_mfma_f32_32x32x16_bf16(a, bv, T, 0, 0, 0); }
#pragma unroll
                for (int g = 0; g < 4; ++g) { const f32x4 dec = *(const LAS f32x4*)(L + HG_DEC + (32 * dt + 8 * g + 4 * hh) * 4), el = *(const LAS f32x4*)(L + HG_EL + (32 * dt + 8 * g + 4 * hh) * 4);
#pragma unroll
                    for (int i = 0; i < 4; ++i) S[4 * g + i] = dec[i] * S[4 * g + i] + el[i] * T[4 * g + i];
                    *(LAS v2u*)(stn + l31 * 272 + (32 * dt + 8 * g + 4 * hh) * 2) = (v2u){cvtpk(S[4 * g], S[4 * g + 1]), cvtpk(S[4 * g + 2], S[4 * g + 3])}; }
            }
        }
        LDS_WAIT(); __builtin_amdgcn_s_barrier(); asm volatile("" ::: "memory");
#undef HGM_LOAD
    }
}
__device__ __forceinline__ void hgrn_mfma2(Frame& F) {
    const bf16* QH = (const bf16*)(F.ws + WS_QKV); const bf16* FH = QH + (size_t)M * DM; const bf16* VH = FH + (size_t)M * DM; const bf16* KH = (const bf16*)(F.ws + WS_AO); bf16* ORAW = (bf16*)(F.ws + WS_ACT);
    LAS unsigned char* L = F.lds;
    const int w = F.wave, cp = F.lane, l31 = F.lane & 31, hh = F.lane >> 5, li = F.lane & 15, g4 = F.lane >> 4;
    typedef float f32x2v __attribute__((ext_vector_type(2)));
#pragma unroll 1
    for (int u = blockIdx.x; u < 256; u += F.G) {
        const int ux = u & 7, uy = u >> 3, bh = ux + 8 * (uy >> 2), e0 = (uy & 3) * 32, b = bh >> 5, h = bh & 31;
        const size_t rowbase = (size_t)b * SEQ;
        unsigned qn[8], fn[8], kn[8], vn[2];
        const bf16* pq = QH + ((size_t)bh * SEQ + 8 * w) * 128 + 2 * cp; const bf16* pf = FH + ((size_t)bh * SEQ + 8 * w) * 128 + 2 * cp; const bf16* pk = KH + ((size_t)bh * SEQ + 8 * w) * 128 + 2 * cp;
        const bf16* pv = VH + ((size_t)bh * SEQ + (F.tid >> 4)) * 128 + e0 + 2 * (F.tid & 15);
#define HG2_LOAD() do { \
            _Pragma("unroll") for (int i = 0; i < 8; ++i) { qn[i] = *(const GAS unsigned*)(pq + 128 * i); fn[i] = *(const GAS unsigned*)(pf + 128 * i); kn[i] = *(const GAS unsigned*)(pk + 128 * i); } \
            vn[0] = *(const GAS unsigned*)pv; vn[1] = *(const GAS unsigned*)(pv + 32 * 128); pq += 64 * 128; pf += 64 * 128; pk += 64 * 128; pv += 64 * 128; } while (0)
        f32x16 S;
#pragma unroll
        for (int i = 0; i < 16; ++i) S[i] = 0.f;
        for (int i = F.tid; i < 8704 / 4; i += NWAVES * 64) ((LAS unsigned*)(L + HG_ST0))[i] = 0u;
        HG2_LOAD();
#pragma unroll 1
        for (int c = 0; c < SEQ / 64; ++c) {
            float qf[8][2], kf[8][2], cs[8][2]; float run0 = 0.f, run1 = 0.f;
#pragma unroll
            for (int i = 0; i < 8; ++i) { qf[i][0] = bflo(qn[i]); qf[i][1] = bfhi(qn[i]); kf[i][0] = bflo(kn[i]); kf[i][1] = bfhi(kn[i]); run0 += bflo(fn[i]); run1 += bfhi(fn[i]); cs[i][0] = run0; cs[i][1] = run1; }
            const unsigned v0 = vn[0], v1 = vn[1];
            { const int back = (c + 1 < SEQ / 64) ? 0 : 64 * 128; pq -= back; pf -= back; pk -= back; pv -= back; }
            HG2_LOAD();
            *(LAS f32x2v*)(L + HG_SEG + (w * 128 + 2 * cp) * 4) = (f32x2v){run0, run1};
            LDS_WAIT(); __builtin_amdgcn_s_barrier(); asm volatile("" ::: "memory");
            float off0 = 0.f, off1 = 0.f, bref0 = 0.f, bref1 = 0.f, p0 = 0.f, p1 = 0.f;
#pragma unroll
            for (int s = 0; s < 8; ++s) { const f32x2v t = *(const LAS f32x2v*)(L + HG_SEG + (s * 128 + 2 * cp) * 4);
                if (s == w) { off0 = p0; off1 = p1; } p0 += t.x; p1 += t.y; if (s == 3) { bref0 = p0; bref1 = p1; } }
            const float er0 = __expf(bref0), er1 = __expf(bref1);
            off0 -= bref0; off1 -= bref1;
            float kr[8][2];
#pragma unroll
            for (int i = 0; i < 8; ++i) {
                const float e10 = __expf(cs[i][0] + off0), e11 = __expf(cs[i][1] + off1);
                const float qr0 = qf[i][0] * e10, qr1 = qf[i][1] * e11; kr[i][0] = kf[i][0] * __builtin_amdgcn_rcpf(e10); kr[i][1] = kf[i][1] * __builtin_amdgcn_rcpf(e11);
                const int ro = (8 * w + i) * 272 + 4 * cp;
                *(LAS unsigned*)(L + HG_QR + ro) = cvtpk(qr0, qr1);
                *(LAS unsigned*)(L + HG_QD + ro) = cvtpk(qr0 * er0, qr1 * er1);
                *(LAS unsigned*)(L + HG_KR + ro) = cvtpk(kr[i][0], kr[i][1]);
            }
            *(LAS v4u*)(L + HG_KRT + (2 * cp) * 144 + 16 * w) = (v4u){cvtpk(kr[0][0], kr[1][0]), cvtpk(kr[2][0], kr[3][0]), cvtpk(kr[4][0], kr[5][0]), cvtpk(kr[6][0], kr[7][0])};
            *(LAS v4u*)(L + HG_KRT + (2 * cp + 1) * 144 + 16 * w) = (v4u){cvtpk(kr[0][1], kr[1][1]), cvtpk(kr[2][1], kr[3][1]), cvtpk(kr[4][1], kr[5][1]), cvtpk(kr[6][1], kr[7][1])};
            if (w == 0) { *(LAS f32x2v*)(L + HG_EL + 8 * cp) = (f32x2v){__expf(p0 - bref0), __expf(p1 - bref1)}; *(LAS f32x2v*)(L + HG_DEC + 8 * cp) = (f32x2v){__expf(p0), __expf(p1)}; }
            { const int ee = 2 * (F.tid & 15), ss = F.tid >> 4;
                *(LAS unsigned short*)(L + HG_VT + ee * 144 + ss * 2) = (unsigned short)(v0 & 0xffffu); *(LAS unsigned short*)(L + HG_VT + (ee + 1) * 144 + ss * 2) = (unsigned short)(v0 >> 16);
                *(LAS unsigned short*)(L + HG_VT + ee * 144 + (ss + 32) * 2) = (unsigned short)(v1 & 0xffffu); *(LAS unsigned short*)(L + HG_VT + (ee + 1) * 144 + (ss + 32) * 2) = (unsigned short)(v1 >> 16); }
            LDS_WAIT(); __builtin_amdgcn_s_barrier(); asm volatile("" ::: "memory");
            const LAS unsigned char* stc = L + ((c & 1) ? HG_ST1 : HG_ST0);
            LAS unsigned char* stn = L + ((c & 1) ? HG_ST0 : HG_ST1);
            if (w < 4) {
                const int tq = w;
                f32x4 Y[2]; Y[0] = (f32x4){0.f, 0.f, 0.f, 0.f}; Y[1] = Y[0];
                bf16x8 bqr[4];
#pragma unroll
                for (int kd = 0; kd < 4; ++kd) { const bf16x8 bq = *(const LAS bf16x8*)(L + HG_QD + (16 * tq + li) * 272 + (32 * kd + 8 * g4) * 2); bqr[kd] = *(const LAS bf16x8*)(L + HG_QR + (16 * tq + li) * 272 + (32 * kd + 8 * g4) * 2);
#pragma unroll
                    for (int eb = 0; eb < 2; ++eb) { const bf16x8 a = *(const LAS bf16x8*)(stc + (16 * eb + li) * 272 + (32 * kd + 8 * g4) * 2); Y[eb] = __builtin_amdgcn_mfma_f32_16x16x32_bf16(a, bq, Y[eb], 0, 0, 0); } }
                f32x4 X[4];
#pragma unroll
                for (int sb = 0; sb < 4; ++sb) { f32x4 acc = (f32x4){0.f, 0.f, 0.f, 0.f};
                    if (sb <= tq) {
#pragma unroll
                        for (int kd = 0; kd < 4; ++kd) { const bf16x8 a = *(const LAS bf16x8*)(L + HG_KR + (16 * sb + li) * 272 + (32 * kd + 8 * g4) * 2); acc = __builtin_amdgcn_mfma_f32_16x16x32_bf16(a, bqr[kd], acc, 0, 0, 0); }
                        if (sb == tq) {
#pragma unroll
                            for (int r = 0; r < 4; ++r) if (4 * g4 + r > li) acc[r] = 0.f; } }
                    X[sb] = acc; }
#pragma unroll
                for (int pr = 0; pr < 2; ++pr) { if (2 * pr <= tq) {
                    const bf16x8 pf = __builtin_bit_cast(bf16x8, (v4u){cvtpk(X[2 * pr][0], X[2 * pr][1]), cvtpk(X[2 * pr][2], X[2 * pr][3]), cvtpk(X[2 * pr + 1][0], X[2 * pr + 1][1]), cvtpk(X[2 * pr + 1][2], X[2 * pr + 1][3])});
#pragma unroll
                    for (int eb = 0; eb < 2; ++eb) { const v2u alo = *(const LAS v2u*)(L + HG_VT + (16 * eb + li) * 144 + (32 * pr + 4 * g4) * 2), ahi = *(const LAS v2u*)(L + HG_VT + (16 * eb + li) * 144 + (32 * pr + 16 + 4 * g4) * 2);
                        const bf16x8 a = __builtin_bit_cast(bf16x8, (v4u){alo.x, alo.y, ahi.x, ahi.y}); Y[eb] = __builtin_amdgcn_mfma_f32_16x16x32_bf16(a, pf, Y[eb], 0, 0, 0); } } }
                bf16* orow = ORAW + (rowbase + 64 * c + 16 * tq + li) * DM + h * 128 + e0 + 4 * g4;
#pragma unroll
                for (int eb = 0; eb < 2; ++eb) *(GAS v2u*)(orow + 16 * eb) = (v2u){cvtpk(Y[eb][0], Y[eb][1]), cvtpk(Y[eb][2], Y[eb][3])};
            } else {
                const int dt = w - 4;
                f32x16 T;
#pragma unroll
                for (int i = 0; i < 16; ++i) T[i] = 0.f;
#pragma unroll
                for (int ks = 0; ks < 4; ++ks) { const bf16x8 a = *(const LAS bf16x8*)(L + HG_KRT + (32 * dt + l31) * 144 + (16 * ks + 8 * hh) * 2); const bf16x8 bv = *(const LAS bf16x8*)(L + HG_VT + l31 * 144 + (16 * ks + 8 * hh) * 2);
                    T = __builtin_amdgcn_mfma_f32_32x32x16_bf16(a, bv, T, 0, 0, 0); }
#pragma unroll
                for (int g = 0; g < 4; ++g) { const f32x4 dec = *(const LAS f32x4*)(L + HG_DEC + (32 * dt + 8 * g + 4 * hh) * 4), el = *(const LAS f32x4*)(L + HG_EL + (32 * dt + 8 * g + 4 * hh) * 4);
#pragma unroll
                    for (int i = 0; i < 4; ++i) S[4 * g + i] = dec[i] * S[4 * g + i] + el[i] * T[4 * g + i];
                    *(LAS v2u*)(stn + l31 * 272 + (32 * dt + 8 * g + 4 * hh) * 2) = (v2u){cvtpk(S[4 * g], S[4 * g + 1]), cvtpk(S[4 * g + 2], S[4 * g + 3])}; }
            }
        }
        LDS_WAIT(); __builtin_amdgcn_s_barrier(); asm volatile("" ::: "memory");
#undef HG2_LOAD
    }
}
__device__ __forceinline__ void hgrn_gate2(Frame& F) {
    const int gw = F.vcu * NWAVES + F.wave, NGW = F.G * NWAVES;
    const bf16* ORAW = (const bf16*)(F.ws + WS_ACT); const bf16* SG = (HG_FUSE == 2) ? (const bf16*)(F.ws + WS_AO) : (const bf16*)(F.ws + WS_QKV) + 3 * (size_t)M * DM; bf16* OG = (bf16*)(F.ws + WS_OG);
    const f32x4 gn = *(const GAS f32x4*)(F.hg_gain + 4 * (F.lane & 31));
    for (int m = gw; m < M; m += NGW) {
        const GAS v2u* orow = (const GAS v2u*)(ORAW + (size_t)m * DM) + F.lane;
        const GAS v2u* grow = (const GAS v2u*)(SG + (size_t)m * DM) + F.lane;
        GAS v2u* o8 = (GAS v2u*)(OG + (size_t)m * DM) + F.lane;
#pragma unroll 8
        for (int j = 0; j < 16; ++j) {
            const v2u ow = orow[64 * j], gw2 = grow[64 * j];
            const float o0 = bflo(ow.x), o1 = bfhi(ow.x), o2 = bflo(ow.y), o3 = bfhi(ow.y);
            float ss = (o0 * o0 + o1 * o1) + (o2 * o2 + o3 * o3);
#pragma unroll
            for (int k = 1; k < 32; k <<= 1) ss += __shfl_xor(ss, k);
            const float rstd = 1.f / sqrtf(ss * (1.f / HD) + RMS_EPS);
            float s0 = bflo(gw2.x), s1 = bfhi(gw2.x), s2 = bflo(gw2.y), s3 = bfhi(gw2.y);
            if (HG_FUSE == 2) { s0 *= __builtin_amdgcn_rcpf(1.f + __expf(-s0)); s1 *= __builtin_amdgcn_rcpf(1.f + __expf(-s1)); s2 *= __builtin_amdgcn_rcpf(1.f + __expf(-s2)); s3 *= __builtin_amdgcn_rcpf(1.f + __expf(-s3)); }
            v2u wv; wv.x = cvtpk(o0 * rstd * gn.x * s0, o1 * rstd * gn.y * s1); wv.y = cvtpk(o2 * rstd * gn.z * s2, o3 * rstd * gn.w * s3);
            o8[64 * j] = wv;
        }
    }
}

#define DPP_MOV(x, ctrl) __builtin_bit_cast(float, __builtin_amdgcn_update_dpp(0, __builtin_bit_cast(int, (x)), (ctrl), 0xf, 0xf, false))
__device__ __forceinline__ void hgrn_gate3(Frame& F) {
    const int gw = F.vcu * NWAVES + F.wave, NGW = F.G * NWAVES;
    const bf16* ORAW = (const bf16*)(F.ws + WS_ACT); const bf16* SG = (const bf16*)(F.ws + WS_AO); unsigned char* OG8 = (unsigned char*)(F.ws + WS_OG); float* sa3 = (float*)(F.ws + WS_SA3);
    const f32x4 gn = *(const GAS f32x4*)(F.hg_gain + 4 * (F.lane & 31));
    const float s1 = (F.lane & 1) ? -1.f : 1.f, s2 = (F.lane & 2) ? -1.f : 1.f, s4 = (F.lane & 4) ? -1.f : 1.f;
    for (int m = gw; m < M; m += NGW) {
        const GAS v2u* orow = (const GAS v2u*)(ORAW + (size_t)m * DM) + F.lane;
        const GAS v2u* grow = (const GAS v2u*)(SG + (size_t)m * DM) + F.lane;
        float v[16][4]; float am = 0.f;
#pragma unroll
        for (int j = 0; j < 16; ++j) {
            const v2u ow = orow[64 * j], gw2 = grow[64 * j];
            const float o0 = bflo(ow.x), o1 = bfhi(ow.x), o2 = bflo(ow.y), o3 = bfhi(ow.y);
            float ss = (o0 * o0 + o1 * o1) + (o2 * o2 + o3 * o3);
#pragma unroll
            for (int k = 1; k < 32; k <<= 1) ss += __shfl_xor(ss, k);
            const float rstd = 1.f / sqrtf(ss * (1.f / HD) + RMS_EPS);
            float g0 = bflo(gw2.x), g1 = bfhi(gw2.x), g2 = bflo(gw2.y), g3 = bfhi(gw2.y);
            g0 *= __builtin_amdgcn_rcpf(1.f + __expf(-g0)); g1 *= __builtin_amdgcn_rcpf(1.f + __expf(-g1)); g2 *= __builtin_amdgcn_rcpf(1.f + __expf(-g2)); g3 *= __builtin_amdgcn_rcpf(1.f + __expf(-g3));
            float x0 = o0 * rstd * gn.x * g0, x1 = o1 * rstd * gn.y * g1, x2 = o2 * rstd * gn.z * g2, x3 = o3 * rstd * gn.w * g3;
            { const unsigned a = cvtpk(x0, x1), b = cvtpk(x2, x3); x0 = bflo(a); x1 = bfhi(a); x2 = bflo(b); x3 = bfhi(b); }
            { const float a = x0 + x1, b = x0 - x1, c = x2 + x3, d = x2 - x3; x0 = a + c; x1 = b + d; x2 = a - c; x3 = b - d; }
            float x[4] = {x0, x1, x2, x3};
#pragma unroll
            for (int i = 0; i < 4; ++i) { const float p = DPP_QUAD(x[i], 0xB1); x[i] = p + s1 * x[i]; }
#pragma unroll
            for (int i = 0; i < 4; ++i) { const float p = DPP_QUAD(x[i], 0x4E); x[i] = p + s2 * x[i]; }
#pragma unroll
            for (int i = 0; i < 4; ++i) { const float pl = DPP_MOV(x[i], 0x104), pr = DPP_MOV(x[i], 0x114); const float p = (F.lane & 4) ? pr : pl; x[i] = (p + s4 * x[i]) * 0.17677669529663687f; }
#pragma unroll
            for (int i = 0; i < 4; ++i) { v[j][i] = x[i]; am = fmaxf(am, fabsf(x[i])); }
        }
#pragma unroll
        for (int o = 1; o < 64; o <<= 1) am = fmaxf(am, __shfl_xor(am, o));
        am = fmaxf(am, 1e-30f);
        const float qs = 127.f / am;
        GAS unsigned* o4 = (GAS unsigned*)(OG8 + (size_t)m * DM) + F.lane;
#pragma unroll
        for (int j = 0; j < 16; ++j) { const int q0 = (int)rintf(v[j][0] * qs), q1 = (int)rintf(v[j][1] * qs), q2 = (int)rintf(v[j][2] * qs), q3 = (int)rintf(v[j][3] * qs);
            o4[64 * j] = (unsigned)(q0 & 255) | ((unsigned)(q1 & 255) << 8) | ((unsigned)(q2 & 255) << 16) | ((unsigned)q3 << 24); }
        if (F.lane == 0) sa3[m] = am * (1.f / 127.f);
    }
}
constexpr int H4_OPB = 34816, H4_KR = 17408, H4_ED0 = 3 * H4_OPB, H4_EDB = 1536, H4_VS0 = H4_ED0 + 3 * H4_EDB, H4_VSB = 4096, H4_VT0 = H4_VS0 + 3 * H4_VSB, H4_VTB = 4608, H4_ST0 = H4_VT0 + 2 * H4_VTB, H4_STB = 8704, H4_END = H4_ST0 + 2 * H4_STB;
static_assert(H4_END <= LDSCTL_OFF, "hgrn4 LDS map");
constexpr size_t WS_H3QR = WS_QKV, WS_H3KR = WS_QKV + 136 * MiB, WS_H3VH = WS_QKV + 272 * MiB, WS_H3SG = WS_AO, WS_H3EL = WS_AO + 128 * MiB, WS_H3DEC = WS_AO + 132 * MiB, WS_H3ER = WS_AO + 136 * MiB;
static_assert(WS_H3VH + 128 * MiB <= WS_MRG && WS_H3ER + 4 * MiB + 512 <= WS_LSE, "hgrn4 workspace map");
__device__ __forceinline__ void hgrn_mfma3(Frame& F) {
    const char* TQR = (const char*)(F.ws + WS_H3QR); const char* TKR = (const char*)(F.ws + WS_H3KR);
    const bf16* VH = (const bf16*)(F.ws + WS_H3VH); const float* ELg = (const float*)(F.ws + WS_H3EL); const float* DECg = (const float*)(F.ws + WS_H3DEC); const float* ERg = (const float*)(F.ws + WS_H3ER);
    bf16* ORAW = (bf16*)(F.ws + WS_ACT);
    LAS unsigned char* L = F.lds;
    const int w = F.wave, li = F.lane & 15, g4 = F.lane >> 4;
#pragma unroll 1
    for (int u = blockIdx.x; u < 256; u += F.G) {
        const int ux = u & 7, uy = u >> 3, bh = ux + 8 * (uy >> 2), e0 = (uy & 3) * 32, b = bh >> 5, h = bh & 31;
        const size_t rowbase = (size_t)b * SEQ;
#define H4_DMA(cc, sl) do { const size_t cid_ = (size_t)bh * 128 + (cc); const size_t cidn_ = ((cc) + 1 < SEQ / 64) ? cid_ + 1 : cid_; LAS unsigned char* ob_ = L + (sl) * H4_OPB; LAS unsigned char* eb_ = L + H4_ED0 + (sl) * H4_EDB; \
            _Pragma("unroll") for (int i_ = 0; i_ < 5; ++i_) { const int k_ = 5 * w + i_; \
                if (k_ < 34) { const int t_ = (k_ >= 17) ? 1 : 0, q_ = k_ - 17 * t_; \
                    __builtin_amdgcn_global_load_lds((const unsigned*)((t_ ? TKR : TQR) + cid_ * 17408 + q_ * 1024 + F.lane * 16), (LAS unsigned*)(ob_ + t_ * H4_KR + q_ * 1024), 16, 0, 0); } \
                else { const int e_ = k_ - 34, ar_ = e_ >> 1; const float* sp_ = (ar_ == 0) ? (ELg + cid_ * 128) : (ar_ == 1) ? (DECg + cid_ * 128) : (ERg + cidn_ * 128); \
                    __builtin_amdgcn_global_load_lds((const unsigned*)(sp_ + (e_ & 1) * 64 + F.lane), (LAS unsigned*)(eb_ + ar_ * 512 + (e_ & 1) * 256), 4, 0, 0); } } \
            _Pragma("unroll") for (int i_ = 0; i_ < 2; ++i_) { const int p_ = 2 * w + i_; \
                __builtin_amdgcn_global_load_lds((const unsigned*)(VH + ((size_t)bh * SEQ + 64 * (cc) + 4 * p_ + (F.lane >> 4)) * 128 + e0 + 2 * (F.lane & 15)), (LAS unsigned*)(L + H4_VS0 + (sl) * H4_VSB + p_ * 256), 4, 0, 0); } } while (0)
        f32x4 S[2][2];
#pragma unroll
        for (int a = 0; a < 2; ++a)
#pragma unroll
            for (int c2 = 0; c2 < 2; ++c2) S[a][c2] = (f32x4){0.f, 0.f, 0.f, 0.f};
        for (int i = F.tid; i < H4_STB / 4; i += NWAVES * 64) ((LAS unsigned*)(L + H4_ST0))[i] = 0u;
        H4_DMA(0, 0); H4_DMA(1, 1);
        int sl = 0;
#pragma unroll 1
        for (int c = 0; c < SEQ / 64; ++c) {
            if (w < 4 && c >= 2) asm volatile("s_waitcnt vmcnt(11)" ::: "memory"); else asm volatile("s_waitcnt vmcnt(7)" ::: "memory");
            {
                const LAS unsigned char* vs = L + H4_VS0 + sl * H4_VSB; LAS unsigned char* vt = L + H4_VT0 + (c & 1) * H4_VTB;
                const int row = 8 * w + (F.lane >> 3), eq = 4 * (F.lane & 7);
                const v2u vv = *(const LAS v2u*)(vs + row * 64 + eq * 2);
                *(LAS unsigned short*)(vt + (eq + 0) * 144 + row * 2) = (unsigned short)(vv.x & 0xffffu); *(LAS unsigned short*)(vt + (eq + 1) * 144 + row * 2) = (unsigned short)(vv.x >> 16);
                *(LAS unsigned short*)(vt + (eq + 2) * 144 + row * 2) = (unsigned short)(vv.y & 0xffffu); *(LAS unsigned short*)(vt + (eq + 3) * 144 + row * 2) = (unsigned short)(vv.y >> 16); }
            LDS_WAIT(); __builtin_amdgcn_s_barrier(); asm volatile("" ::: "memory");
            { const int cn = (c + 2 < SEQ / 64) ? c + 2 : SEQ / 64 - 1; const int sn = (sl == 0) ? 2 : sl - 1;
              H4_DMA(cn, sn); }
            const LAS unsigned char* OB = L + sl * H4_OPB; const LAS unsigned char* VT = L + H4_VT0 + (c & 1) * H4_VTB;
            const LAS unsigned char* stc = L + H4_ST0 + (c & 1) * H4_STB;
            LAS unsigned char* stn = L + H4_ST0 + ((c + 1) & 1) * H4_STB;
            if (w < 4) {
                const int tq = w;
                f32x4 Y[2]; Y[0] = (f32x4){0.f, 0.f, 0.f, 0.f}; Y[1] = Y[0];
                bf16x8 bqr[4];
#pragma unroll
                for (int kd = 0; kd < 4; ++kd) { bqr[kd] = *(const LAS bf16x8*)(OB + (16 * tq + li) * 272 + (32 * kd + 8 * g4) * 2);
#pragma unroll
                    for (int eb = 0; eb < 2; ++eb) { const bf16x8 a = *(const LAS bf16x8*)(stc + (16 * eb + li) * 272 + (32 * kd + 8 * g4) * 2); Y[eb] = __builtin_amdgcn_mfma_f32_16x16x32_bf16(a, bqr[kd], Y[eb], 0, 0, 0); } }
                f32x4 X[4];
#pragma unroll
                for (int sb = 0; sb < 4; ++sb) { f32x4 acc = (f32x4){0.f, 0.f, 0.f, 0.f};
                    if (sb <= tq) {
#pragma unroll
                        for (int kd = 0; kd < 4; ++kd) { const bf16x8 a = *(const LAS bf16x8*)(OB + H4_KR + (16 * sb + li) * 272 + (32 * kd + 8 * g4) * 2); acc = __builtin_amdgcn_mfma_f32_16x16x32_bf16(a, bqr[kd], acc, 0, 0, 0); }
                        if (sb == tq) {
#pragma unroll
                            for (int r = 0; r < 4; ++r) if (4 * g4 + r > li) acc[r] = 0.f; } }
                    X[sb] = acc; }
#pragma unroll
                for (int pr = 0; pr < 2; ++pr) { if (2 * pr <= tq) {
                    const bf16x8 pf = __builtin_bit_cast(bf16x8, (v4u){cvtpk(X[2 * pr][0], X[2 * pr][1]), cvtpk(X[2 * pr][2], X[2 * pr][3]), cvtpk(X[2 * pr + 1][0], X[2 * pr + 1][1]), cvtpk(X[2 * pr + 1][2], X[2 * pr + 1][3])});
#pragma unroll
                    for (int eb = 0; eb < 2; ++eb) { const v2u alo = *(const LAS v2u*)(VT + (16 * eb + li) * 144 + (32 * pr + 4 * g4) * 2), ahi = *(const LAS v2u*)(VT + (16 * eb + li) * 144 + (32 * pr + 16 + 4 * g4) * 2);
                        const bf16x8 a = __builtin_bit_cast(bf16x8, (v4u){alo.x, alo.y, ahi.x, ahi.y}); Y[eb] = __builtin_amdgcn_mfma_f32_16x16x32_bf16(a, pf, Y[eb], 0, 0, 0); } } }
                bf16* orow = ORAW + (rowbase + 64 * c + 16 * tq + li) * DM + h * 128 + e0 + 4 * g4;
#pragma unroll
                for (int eb = 0; eb < 2; ++eb) *(GAS v2u*)(orow + 16 * eb) = (v2u){cvtpk(Y[eb][0], Y[eb][1]), cvtpk(Y[eb][2], Y[eb][3])};
            } else {
                const int dt = w - 4;
                const LAS float* ELs = (const LAS float*)(L + H4_ED0 + sl * H4_EDB); const LAS float* DECs = ELs + 128; const LAS float* ERs = ELs + 256;
#pragma unroll
                for (int dbl = 0; dbl < 2; ++dbl) { const int db = 2 * dt + dbl;
                    f32x4 T[2]; T[0] = (f32x4){0.f, 0.f, 0.f, 0.f}; T[1] = T[0];
#pragma unroll
                    for (int ks = 0; ks < 2; ++ks) {
                        const unsigned ka = (unsigned)(size_t)(OB + H4_KR + (32 * ks + 4 * g4 + (li >> 2)) * 272 + (16 * db + 4 * (li & 3)) * 2);
                        v2u lo, hi;
                        asm volatile("ds_read_b64_tr_b16 %0, %2\n\tds_read_b64_tr_b16 %1, %2 offset:4352\n\ts_waitcnt lgkmcnt(0)" : "=&v"(lo), "=&v"(hi) : "v"(ka) : "memory");
                        const bf16x8 a = __builtin_bit_cast(bf16x8, (v4u){lo.x, lo.y, hi.x, hi.y});
#pragma unroll
                        for (int eb = 0; eb < 2; ++eb) { const v2u blo = *(const LAS v2u*)(VT + (16 * eb + li) * 144 + (32 * ks + 4 * g4) * 2), bhi = *(const LAS v2u*)(VT + (16 * eb + li) * 144 + (32 * ks + 16 + 4 * g4) * 2);
                            const bf16x8 bv = __builtin_bit_cast(bf16x8, (v4u){blo.x, blo.y, bhi.x, bhi.y}); T[eb] = __builtin_amdgcn_mfma_f32_16x16x32_bf16(a, bv, T[eb], 0, 0, 0); } }
                    const f32x4 dec = *(const LAS f32x4*)(DECs + 16 * db + 4 * g4), el = *(const LAS f32x4*)(ELs + 16 * db + 4 * g4), er = *(const LAS f32x4*)(ERs + 16 * db + 4 * g4);
#pragma unroll
                    for (int eb = 0; eb < 2; ++eb) { S[dbl][eb] = dec * S[dbl][eb] + el * T[eb]; const f32x4 sv = S[dbl][eb] * er;
                        *(LAS v2u*)(stn + (16 * eb + li) * 272 + (16 * db + 4 * g4) * 2) = (v2u){cvtpk(sv[0], sv[1]), cvtpk(sv[2], sv[3])}; } }
            }
            sl = (sl == 2) ? 0 : sl + 1;
        }
        asm volatile("s_waitcnt vmcnt(0)" ::: "memory"); LDS_WAIT(); __builtin_amdgcn_s_barrier(); asm volatile("" ::: "memory");
#undef H4_DMA
    }
}
struct Args { const float* in[11]; float* out; unsigned char* ws; int ph_lo, ph_hi, li, pad; };
__global__ void __launch_bounds__(NWAVES * 64, 2) mega_fwd(Args args) {
    extern __shared__ __attribute__((aligned(16))) unsigned char lds[];
    Frame F;
    F.lds = (LAS unsigned char*)lds;
    F.MISC = (volatile LAS unsigned*)(F.lds + MISC_OFF);
    F.tid = threadIdx.x; F.lane = F.tid & 63; F.wave = __builtin_amdgcn_readfirstlane(F.tid >> 6);
    F.G = gridDim.x; { const int bx = blockIdx.x; F.vcu = (F.G % 8 == 0) ? (bx % 8) * (F.G / 8) + bx / 8 : bx; }
#define GRID_BAR(seam) do { if (N_LAUNCHES != 1) { if (F.tid == 0) __hip_atomic_store(F.ctl + CW_TMO, 0xBADBA0u | (unsigned)(seam), RLX_AGENT); } \
    else { xcd_barrier(bar); } } while (0)
    unsigned char* ws = args.ws; F.ws = ws;
    F.ctl = (gu32*)(ws + WS_CTL);
    F.x = args.in[0]; F.gains = args.in[1]; F.rel_bias = args.in[2]; F.w_att_in = args.in[3]; F.w_att_out = args.in[4]; F.w_hg_in = args.in[5];
    F.lb_logits = args.in[6]; F.hg_gain = args.in[7]; F.w_hg_out = args.in[8]; F.w_ff_in = args.in[9]; F.w_ff_out = args.in[10]; F.out = args.out;
    for (int u = F.tid; u < (LDS_BYTES - LDSCTL_OFF) / 4; u += NWAVES * 64) ((LAS unsigned*)(F.lds + LDSCTL_OFF))[u] = 0u;
    __syncthreads();
    XcdBarrier bar; bar.bar = (unsigned*)(F.ctl + CW_BAR); bar.x = 0; bar.st = nullptr;
    if (N_LAUNCHES == 1) bar = xcd_barrier_post((unsigned*)(F.ctl + CW_BAR), F.MISC + 8);

    const int lo = args.ph_lo, hi = args.ph_hi;
#define IN(k) (lo <= (k) && (k) < hi)
#define BOTH(k) (IN(k) && IN((k) + 1))
    bf16* const XN = (bf16*)(ws + WS_XN); bf16* const HB = (bf16*)(ws + WS_HB); bf16* const Y = (bf16*)(ws + WS_Y); bf16* const ACT = (bf16*)(ws + WS_ACT);

    if (IN(0)) { for (int rep_ = 0; rep_ < REP_P0; ++rep_) p0_prologue(F);
        if (FFN_I8 && !P0_STRIP) { GRID_BAR(18);
            for (int l = 0; l < 2; ++l) p0_quant_rows<TM_FFI>(F, (const bf16*)(ws + WS_WFFI + l * WFFI_STRIDE), ws + WS_W8 + l * W8_STRIDE, (float*)(ws + WS_SW) + l * 2 * DFF, 2 * DFF);
            if (HGO_I8) p0_quant_wout<DM>(F, (const bf16*)(ws + WS_WHGO), ws + WS_W8G, (float*)(ws + WS_SWG));
            if (FFO_I8) for (int l = 0; l < 2; ++l) p0_quant_wout<DFF>(F, (const bf16*)(ws + WS_WFFO + l * WFFO_STRIDE), ws + WS_W8O + l * W8O_STRIDE, (float*)(ws + WS_SWO) + l * DM);
            if (ATT_I8) p0_quant_rows<false>(F, (const bf16*)(ws + WS_WATTI), ws + WS_W8A, (float*)(ws + WS_SWA), NQKV);
            if (HG_I8) p0_quant_rows<false>(F, (const bf16*)(ws + WS_WHGI), ws + WS_W8H, (float*)(ws + WS_SWH), NHG); }
        if (BOTH(0)) GRID_BAR(0); }
    if (IN(1)) {
        pg8::StaticOrder S; S.init(M, NQKV, F.G, (int)blockIdx.x);
        pg8::Gemm g{XN, ATT_I8 ? (const bf16*)(ws + WS_W8A) : (const bf16*)(ws + WS_WATTI), M, NQKV, ATT_I8 ? DM / 2 : DM};
        pg8::EpiBf16T<ATT_I8> E{(bf16*)(ws + WS_QKV), ATTN_MFMA ? 2048 : NQKV, ATTN_MFMA ? 2048 : 0, ATTN_MFMA ? (size_t)M * 2048 : 0, ATTN_MFMA ? 1 : 0, (const float*)(ws + WS_SA), (const float*)(ws + WS_SWA)};
        const bool ovl_first = ((int)blockIdx.x & 1) == 0;
        if (P0_STRIP && P0_OVL && ovl_first) run_strips<4>(F, F.vcu, F.G);
        pg8::gemm_phase<pg8::EpiBf16T<ATT_I8>, pg8::StaticOrder, PG8_ALIGN, PG8_SP2, ATT_I8>(F.lds + RING_OFF, g, S, E); if (REP_GEMM > 1) { pg8::gemm_phase<pg8::EpiBf16T<ATT_I8>, pg8::StaticOrder, PG8_ALIGN, PG8_SP2, ATT_I8>(F.lds + RING_OFF, g, S, E); }
        if (P0_STRIP && P0_OVL && !ovl_first) { asm volatile("s_waitcnt vmcnt(0)" ::: "memory"); __syncthreads(); run_strips<4>(F, F.vcu, F.G); }
        if (BOTH(1)) GRID_BAR(1);
    }
    if (IN(2)) { if (ATTN_MFMA) { for (int rep_ = 0; rep_ < REP_ATT; ++rep_) { attn_mfma(F); GRID_BAR(16); attn_merge(F); if (rep_ + 1 < REP_ATT) GRID_BAR(17); } } else attn_naive(F); if (BOTH(2)) GRID_BAR(2); }
    if (IN(3)) {
        pg8::Gemm g{(const bf16*)(ws + WS_MRG), (const bf16*)(ws + WS_WATTO), M, DM, DATT}; pg8::StaticOrder S; S.init(M, DM, F.G, (int)blockIdx.x);
        pg8::EpiBf16 E{Y, DM, 0, 0, 0, nullptr, nullptr};
        pg8::gemm_phase<pg8::EpiBf16, pg8::StaticOrder, PG8_ALIGN, PG8_SP2>(F.lds + RING_OFF, g, S, E); if (REP_GEMM > 1) { pg8::gemm_phase<pg8::EpiBf16, pg8::StaticOrder, PG8_ALIGN, PG8_SP2>(F.lds + RING_OFF, g, S, E); }
        if (BOTH(3)) GRID_BAR(3);
    }
    if (IN(4)) { for (int rep_ = 0; rep_ < REP_NORM; ++rep_) norm_rows<true, FFN_I8 ? (TM_FFI ? 3 : 2) : 1, false, true>(F, F.x, Y, HB, XN, F.gains + 1 * DM, F.gains + 2 * DM, (float*)(ws + WS_SA)); if (BOTH(4)) GRID_BAR(4); }
    if (IN(5)) {
        pg8::StaticOrder S; S.init(M, 2 * DFF, F.G, (int)blockIdx.x);
        if (FFN_I8) {
            pg8::Gemm g{XN, (const bf16*)(ws + WS_W8), M, 2 * DFF, DM / 2};
            if (FFO_I8) {
                pg8::EpiSwiGLU8R E{ACT, DFF, (const float*)(ws + WS_SA), (const float*)(ws + WS_SW) + 0, (unsigned*)(ws + WS_RMAX) + 0 * M};
                pg8::gemm_phase<pg8::EpiSwiGLU8R, pg8::StaticOrder, PG8_ALIGN, PG8_SP2, true, 1, 1, TM_FFI>(F.lds + RING_OFF, g, S, E);
                if (P0_STRIP) run_deferred_strips<1>(F, (M / 256) * (2 * DFF / 256));
            } else {
            pg8::EpiSwiGLU8 E{ACT, DFF, (const float*)(ws + WS_SA), (const float*)(ws + WS_SW) + 0, (bf16*)(ws + WS_QKV)};
                pg8::gemm_phase<pg8::EpiSwiGLU8, pg8::StaticOrder, PG8_ALIGN, PG8_SP2, true, KREP_FFI, EREP_FFI, TM_FFI, TCH_FFI, LT_FFI>(F.lds + RING_OFF, g, S, E); if (REP_GEMM > 1 || REP_FFI > 1) { pg8::gemm_phase<pg8::EpiSwiGLU8, pg8::StaticOrder, PG8_ALIGN, PG8_SP2, true, 1, 1, TM_FFI>(F.lds + RING_OFF, g, S, E); }
            }
        } else {
            pg8::Gemm g{XN, (const bf16*)(ws + WS_WFFI), M, 2 * DFF, DM};
            pg8::EpiSwiGLU E{ACT, DFF};
            pg8::gemm_phase<pg8::EpiSwiGLU, pg8::StaticOrder, PG8_ALIGN, PG8_SP2>(F.lds + RING_OFF, g, S, E); if (REP_GEMM > 1) { pg8::gemm_phase<pg8::EpiSwiGLU, pg8::StaticOrder, PG8_ALIGN, PG8_SP2>(F.lds + RING_OFF, g, S, E); }
        }
        if (BOTH(5)) GRID_BAR(5);
    }
    if (IN(6)) {
        pg8::StaticOrder S; S.init(M, DM, F.G, (int)blockIdx.x);
        if (FFO_I8) {
            act_quant_rows(F, ACT, ws + WS_ACT8, (const unsigned*)(ws + WS_RMAX) + 0 * M, (float*)(ws + WS_SA2));
            GRID_BAR(20);
            pg8::Gemm g{(const bf16*)(ws + WS_ACT8), (const bf16*)(ws + WS_W8O + 0 * W8O_STRIDE), M, DM, DFF / 2};
            pg8::EpiBf16T<true> E{Y, DM, 0, 0, 0, (const float*)(ws + WS_SA2), (const float*)(ws + WS_SWO) + 0 * DM};
            pg8::gemm_phase<pg8::EpiBf16T<true>, pg8::StaticOrder, PG8_ALIGN, PG8_SP2, true>(F.lds + RING_OFF, g, S, E);
        } else {
            pg8::Gemm g{ACT, (const bf16*)(ws + WS_WFFO), M, DM, DFF};
            pg8::EpiBf16 E{Y, DM, 0, 0, 0, nullptr, nullptr};
            pg8::gemm_phase<pg8::EpiBf16, pg8::StaticOrder, PG8_ALIGN, PG8_SP2>(F.lds + RING_OFF, g, S, E);
        }
        if (BOTH(6)) GRID_BAR(6);
    }
    if (IN(7)) { norm_rows<true, HG_I8 ? 2 : 1, true, true>(F, HB, Y, HB, XN, F.gains + 3 * DM, F.gains + 4 * DM, (float*)(ws + WS_SA)); if (BOTH(7)) GRID_BAR(7); }
    if (IN(8)) {
        pg8::StaticOrder S; S.init(M, NHG, F.G, (int)blockIdx.x);
        pg8::Gemm g{XN, HG_I8 ? (const bf16*)(ws + WS_W8H) : (const bf16*)(ws + WS_WHGI), M, NHG, HG_I8 ? DM / 2 : DM};
        if (HG_FUSE == 0) {
            pg8::EpiHgrn<HG_I8> E{(bf16*)(ws + WS_QKV), (bf16*)(ws + WS_AO), (const float*)(ws + WS_TAB + 65536), (const float*)(ws + WS_SA), (const float*)(ws + WS_SWH)};
            pg8::gemm_phase<pg8::EpiHgrn<HG_I8>, pg8::StaticOrder, PG8_ALIGN, PG8_SP2, HG_I8>(F.lds + RING_OFF, g, S, E);
        } else if (HG_FUSE == 1) {
            pg8::EpiHgrn2<HG_I8> E{(bf16*)(ws + WS_QKV), (bf16*)(ws + WS_AO), (const float*)(ws + WS_TAB + 65536), (const float*)(ws + WS_SA), (const float*)(ws + WS_SWH)};
            pg8::gemm_phase<pg8::EpiHgrn2<HG_I8>, pg8::StaticOrder, PG8_ALIGN, PG8_SP2, HG_I8>(F.lds + RING_OFF, g, S, E);
        } else {
            pg8::EpiHgrn3<HG_I8> E{(bf16*)(ws + WS_H3QR), (WS_H3KR - WS_H3QR) / 2, (WS_H3VH - WS_H3QR) / 2, (WS_H3SG - WS_H3QR) / 2, (float*)(ws + WS_H3EL), (float*)(ws + WS_H3DEC), (float*)(ws + WS_H3ER),
                                   (const float*)(ws + WS_TAB + 65536), (const float*)(ws + WS_SA), (const float*)(ws + WS_SWH)};
            pg8::gemm_phase<pg8::EpiHgrn3<HG_I8>, pg8::StaticOrder, PG8_ALIGN, PG8_SP2, HG_I8>(F.lds + RING_OFF, g, S, E);
            if (REP_P8 > 1) { pg8::gemm_phase<pg8::EpiHgrn3<HG_I8>, pg8::StaticOrder, PG8_ALIGN, PG8_SP2, HG_I8>(F.lds + RING_OFF, g, S, E); }
        }
        if (BOTH(8)) GRID_BAR(8);
    }
    if (IN(9)) { if (HG_FUSE == 2) { hgrn_mfma3(F); if (REP_HG > 1) hgrn_mfma3(F); } else { hgrn_mfma2(F); if (REP_HG > 1) hgrn_mfma2(F); } if (BOTH(9)) GRID_BAR(9); }
    if (IN(10)) { if (HGO_I8) hgrn_gate3(F); else { hgrn_gate2(F); if (REP_HG > 1) hgrn_gate2(F); } if (BOTH(10)) GRID_BAR(10); }
    if (IN(11)) {
        pg8::StaticOrder S; S.init(M, DM, F.G, (int)blockIdx.x);
        if (HGO_I8) {
            pg8::Gemm g{(const bf16*)(ws + WS_OG), (const bf16*)(ws + WS_W8G), M, DM, DM / 2};
            pg8::EpiBf16T<true> E{Y, DM, 0, 0, 0, (const float*)(ws + WS_SA3), (const float*)(ws + WS_SWG)};
            pg8::gemm_phase<pg8::EpiBf16T<true>, pg8::StaticOrder, PG8_ALIGN, PG8_SP2, true>(F.lds + RING_OFF, g, S, E);
        } else {
            pg8::Gemm g{(const bf16*)(ws + WS_OG), (const bf16*)(ws + WS_WHGO), M, DM, DM};
            pg8::EpiBf16 E{Y, DM, 0, 0, 0, nullptr, nullptr};
            pg8::gemm_phase<pg8::EpiBf16, pg8::StaticOrder, PG8_ALIGN, PG8_SP2>(F.lds + RING_OFF, g, S, E);
        }
        if (BOTH(11)) GRID_BAR(11);
    }
    if (IN(12)) { norm_rows<true, FFN_I8 ? (TM_FFI ? 3 : 2) : 1, true, true>(F, HB, Y, HB, XN, F.gains + 5 * DM, F.gains + 6 * DM, (float*)(ws + WS_SA)); if (BOTH(12)) GRID_BAR(12); }
    if (IN(13)) {
        pg8::StaticOrder S; S.init(M, 2 * DFF, F.G, (int)blockIdx.x);
        if (FFN_I8) {
            pg8::Gemm g{XN, (const bf16*)(ws + WS_W8 + W8_STRIDE), M, 2 * DFF, DM / 2};
            if (FFO_I8) {
                pg8::EpiSwiGLU8R E{ACT, DFF, (const float*)(ws + WS_SA), (const float*)(ws + WS_SW) + 2 * DFF, (unsigned*)(ws + WS_RMAX) + 1 * M};
                pg8::gemm_phase<pg8::EpiSwiGLU8R, pg8::StaticOrder, PG8_ALIGN, PG8_SP2, true, 1, 1, TM_FFI>(F.lds + RING_OFF, g, S, E);
                if (P0_STRIP) run_deferred_strips<2>(F, (M / 256) * (2 * DFF / 256));
            } else {
            pg8::EpiSwiGLU8 E{ACT, DFF, (const float*)(ws + WS_SA), (const float*)(ws + WS_SW) + 2 * DFF, (bf16*)(ws + WS_QKV)};
                pg8::gemm_phase<pg8::EpiSwiGLU8, pg8::StaticOrder, PG8_ALIGN, PG8_SP2, true, KREP_FFI, EREP_FFI, TM_FFI, TCH_FFI, LT_FFI>(F.lds + RING_OFF, g, S, E); if (REP_GEMM > 1 || REP_FFI > 1) { pg8::gemm_phase<pg8::EpiSwiGLU8, pg8::StaticOrder, PG8_ALIGN, PG8_SP2, true, 1, 1, TM_FFI>(F.lds + RING_OFF, g, S, E); }
            }
        } else {
            pg8::Gemm g{XN, (const bf16*)(ws + WS_WFFI + WFFI_STRIDE), M, 2 * DFF, DM};
            pg8::EpiSwiGLU E{ACT, DFF};
            pg8::gemm_phase<pg8::EpiSwiGLU, pg8::StaticOrder, PG8_ALIGN, PG8_SP2>(F.lds + RING_OFF, g, S, E); if (REP_GEMM > 1) { pg8::gemm_phase<pg8::EpiSwiGLU, pg8::StaticOrder, PG8_ALIGN, PG8_SP2>(F.lds + RING_OFF, g, S, E); }
        }
        if (BOTH(13)) GRID_BAR(13);
    }
    if (IN(14)) {
        pg8::StaticOrder S; S.init(M, DM, F.G, (int)blockIdx.x);
        if (FFO_I8) {
            act_quant_rows(F, ACT, ws + WS_ACT8, (const unsigned*)(ws + WS_RMAX) + 1 * M, (float*)(ws + WS_SA2));
            GRID_BAR(21);
            pg8::Gemm g{(const bf16*)(ws + WS_ACT8), (const bf16*)(ws + WS_W8O + 1 * W8O_STRIDE), M, DM, DFF / 2};
            pg8::EpiBf16T<true> E{Y, DM, 0, 0, 0, (const float*)(ws + WS_SA2), (const float*)(ws + WS_SWO) + 1 * DM};
            pg8::gemm_phase<pg8::EpiBf16T<true>, pg8::StaticOrder, PG8_ALIGN, PG8_SP2, true>(F.lds + RING_OFF, g, S, E);
        } else {
            pg8::Gemm g{ACT, (const bf16*)(ws + WS_WFFO + WFFO_STRIDE), M, DM, DFF};
            pg8::EpiBf16 E{Y, DM, 0, 0, 0, nullptr, nullptr};
            pg8::gemm_phase<pg8::EpiBf16, pg8::StaticOrder, PG8_ALIGN, PG8_SP2>(F.lds + RING_OFF, g, S, E);
        }
        if (BOTH(14)) GRID_BAR(14);
    }
    if (REP_BAR > 0) { for (int rb_ = 0; rb_ < REP_BAR; ++rb_) GRID_BAR(30); }
    if (IN(15)) { norm_rows<true, 0, true, false>(F, HB, Y, F.out, nullptr, F.gains + 7 * DM, nullptr); }
#undef IN
#undef BOTH
}

extern "C" void kernel_launch(void* const* d_in, const int* in_sizes, int n_in, void* d_out, int out_size, void* d_ws, size_t ws_size, hipStream_t stream) {
    static int grid = 0;
    if (grid == 0) {
        if (n_in != 11 || in_sizes[0] != M * DM || out_size != M * DM || ws_size < WS_END5) { fprintf(stderr, "kernel_launch: unexpected shapes (n_in %d, in0 %d, out %d, ws %zu, need %zu); nothing launched\n", n_in, n_in > 0 ? in_sizes[0] : -1, out_size, ws_size, (size_t)WS_END); grid = -1; return; }
        int dev = 0, cus = 0, per_cu = 0;
        if (hipGetDevice(&dev) != hipSuccess || hipDeviceGetAttribute(&cus, hipDeviceAttributeMultiprocessorCount, dev) != hipSuccess) { grid = -1; return; }
        if (hipFuncSetAttribute((const void*)mega_fwd, hipFuncAttributeMaxDynamicSharedMemorySize, LDS_BYTES) != hipSuccess) { fprintf(stderr, "kernel_launch: hipFuncSetAttribute failed\n"); grid = -1; return; }
        if (hipOccupancyMaxActiveBlocksPerMultiprocessor(&per_cu, (const void*)mega_fwd, NWAVES * 64, LDS_BYTES) != hipSuccess || per_cu < 1)
            fprintf(stderr, "kernel_launch: note: occupancy query reports %d workgroups per CU\n", per_cu);
        (void)hipGetLastError();
        grid = cus;
    }
    if (grid < 0) return;
    if (hipMemsetAsync((char*)d_ws + WS_CTL, 0, CTL_ZERO_BYTES, stream) != hipSuccess) { fprintf(stderr, "kernel_launch: hipMemsetAsync failed\n"); return; }
    Args a{};
    for (int i = 0; i < 11; ++i) a.in[i] = (const float*)d_in[i];
    a.out = (float*)d_out; a.ws = (unsigned char*)d_ws;
    for (int li = 0; li < N_LAUNCHES; ++li) {
        a.ph_lo = (N_LAUNCHES == 1) ? 0 : li; a.ph_hi = (N_LAUNCHES == 1) ? NPH : li + 1; a.li = li;
        hipLaunchKernelGGL(mega_fwd, dim3(grid), dim3(NWAVES * 64), LDS_BYTES, stream, a);
        const hipError_t le = hipPeekAtLastError();
        if (le != hipSuccess) { fprintf(stderr, "kernel_launch: launch %d failed: %s\n", li, hipGetErrorName(le)); break; }
    }
}
```

```cpp
#include <hip/hip_runtime.h>
#include <cstdio>
#include <cstdint>
#ifndef PG8_WGM
#define PG8_WGM 8
#endif
#ifndef MK_FFO_ROT
#define MK_FFO_ROT 1
#endif
namespace pg8 {
#define PG8_LAS __attribute__((address_space(3)))
typedef unsigned short bf16_t;
typedef short bf16x8 __attribute__((ext_vector_type(8)));
typedef float f32x4 __attribute__((ext_vector_type(4)));
typedef unsigned u32x4 __attribute__((ext_vector_type(4)));
constexpr int BM = 256, BK = 64, HALF = 128, HTB = HALF * BK * 2  , STAGE_BYTES = 8 * HTB, NXCD = 8, WGM = PG8_WGM;

__host__ __device__ __forceinline__ int lds_byte(int r, int c) { const int st = (r >> 4) * 2 + (c >> 5), rr = r & 15, cc = c & 31, ob = rr * 64 + cc * 2; return st * 1024 + (ob ^ (((ob >> 9) & 1) << 5)); }
__host__ __device__ __forceinline__ void stage_rc(int b, int& R, int& C) { const int st = b / 1024, sb = b % 1024, swz = sb ^ (((sb >> 9) & 1) << 5); R = (st >> 1) * 16 + swz / 64; C = (st & 1) * 32 + (swz % 64) / 2; }
__host__ __device__ __forceinline__ int perm32(int rho) { const int n = rho >> 4, i = rho & 15; return 8 * (i >> 2) + 4 * n + (i & 3); }

struct Unit { int pm, pn; };
struct Gemm { const bf16_t* A; const bf16_t* Bt; int M, N, K; };

struct StaticOrder {
    int nM, nN, nwg, G, c;
    __host__ __device__ void init(int M, int N, int G_, int c_) { nM = M / BM; nN = N / BM; nwg = nM * nN; G = G_; c = c_; }
    __host__ __device__ bool next(int i, Unit& u) const {
        const long L = (long)i * G + c; if (L >= nwg) return false;
        int wgid = (int)L; { const int q = nwg / NXCD, r = nwg % NXCD, xcd = wgid % NXCD, off = wgid / NXCD; wgid = (xcd < r ? xcd * (q + 1) : r * (q + 1) + (xcd - r) * q) + off; }
        const int nig = WGM * nN, gid = wgid / nig, fm = gid * WGM, gsz = (nM - fm) < WGM ? (nM - fm) : WGM;
        u.pm = fm + ((wgid % nig) % gsz); u.pn = (wgid % nig) / gsz; return true;
    }
    __device__ __forceinline__ void a_ready(const Unit&) const {}
    __device__ __forceinline__ void done(const Unit&) const {}
};

__device__ __forceinline__ unsigned cvt_pk_bf16(float lo, float hi) { unsigned r; asm volatile("v_cvt_pk_bf16_f32 %0, %1, %2" : "=v"(r) : "v"(lo), "v"(hi)); return r; }
typedef float f32x2 __attribute__((ext_vector_type(2)));
typedef int i32x4 __attribute__((ext_vector_type(4)));
template <bool I8> struct AccT { typedef f32x4 type; static __device__ __forceinline__ f32x4 zero() { return (f32x4){0.f, 0.f, 0.f, 0.f}; } };
template <> struct AccT<true> { typedef i32x4 type; static __device__ __forceinline__ i32x4 zero() { return (i32x4){0, 0, 0, 0}; } };
__device__ __forceinline__ f32x4 mma16(bf16x8 a, bf16x8 b, f32x4 c) { return __builtin_amdgcn_mfma_f32_16x16x32_bf16(a, b, c, 0, 0, 0); }
__device__ __forceinline__ i32x4 mma16(bf16x8 a, bf16x8 b, i32x4 c) { return __builtin_amdgcn_mfma_i32_16x16x64_i8(__builtin_bit_cast(i32x4, a), __builtin_bit_cast(i32x4, b), c, 0, 0, 0); }
__host__ __device__ __forceinline__ size_t tm_chunk_off(int r, int cb, int nt, bool perm) {
    const int p = r >> 8, rr = r & 255, half = rr >> 7; int R = rr & 127;
    if (perm) { const int x = R & 31; R = (R & ~31) + 16 * ((x >> 2) & 1) + 4 * (x >> 3) + (x & 3); }
    return ((size_t)(p * nt + (cb >> 7)) * 2 + half) * 16384 + (size_t)lds_byte(R, (cb & 127) >> 1) + (cb & 1);
}
#ifndef MK_ACT_NT
#define MK_ACT_NT 0
#endif
#ifndef MK_ST_SC1
#define MK_ST_SC1 0
#endif
__device__ __forceinline__ void st16nt(void* p, u32x4 v) {
#if MK_ACT_NT
    __builtin_nontemporal_store(v, (u32x4*)p);
#else
    *(u32x4*)p = v;
#endif
}
__device__ __forceinline__ void st16(void* p, u32x4 v) {
#if MK_ST_SC1
    asm volatile("global_store_dwordx4 %0, %1, off sc1\n\ts_nop 1" :: "v"(p), "v"(v) : "memory");
#else
    *(u32x4*)p = v;
#endif
}
__device__ __forceinline__ float silu_f(float x) { return x * __builtin_amdgcn_rcpf(1.0f + __expf(-x)); }
template <bool I8> struct EpiBf16T {
    static constexpr bool PERM = true, AFTER_DRAIN = false;
    bf16_t* O; int ldc; int split_cols; size_t split_stride; int dil; const float* sa; const float* sw;
    size_t hm = 0;
    __device__ __forceinline__ void operator()(const typename AccT<I8>::type (&acc)[2][2][4][2], const Unit& u, int wr, int wc, int fr, int fq) const {
        const int row0 = u.pm * BM + wr * 64 + fr; int colt = u.pn * BM; bf16_t* base = O; int sh = 0;
        if (split_cols) { const int t = colt / split_cols; base += (size_t)t * split_stride; colt -= t * split_cols; if (dil) sh = 2 * (t / 3); }
        const int col0 = colt + wc * 32 + 8 * fq;
        f32x4 swv[2][2];
#pragma unroll
        for (int bj = 0; bj < 2; ++bj)
#pragma unroll
            for (int n = 0; n < 2; ++n) swv[bj][n] = I8 ? *(const f32x4*)(sw + u.pn * BM + wc * 32 + 8 * fq + bj * HALF + 4 * n) : (f32x4){1.f, 1.f, 1.f, 1.f};
#pragma unroll
        for (int ai = 0; ai < 2; ++ai)
#pragma unroll
            for (int m = 0; m < 4; ++m) { int r = row0 + ai * HALF + m * 16; const float sr = I8 ? sa[r] : 1.f;
                if (sh) { const int tt = r & 8191; r = (r & ~8191) + ((tt & ((1 << sh) - 1)) << (13 - sh)) + (tt >> sh); }
                bf16_t* rowp = hm ? base + (size_t)(colt >> 7) * hm + (size_t)r * 128 + (col0 & 127) : base + (size_t)r * ldc + col0;
#pragma unroll
                for (int bj = 0; bj < 2; ++bj) { f32x4 v0, v1;
#pragma unroll
                    for (int j = 0; j < 4; ++j) { v0[j] = I8 ? (float)acc[ai][bj][m][0][j] * (sr * swv[bj][0][j]) : (float)acc[ai][bj][m][0][j]; v1[j] = I8 ? (float)acc[ai][bj][m][1][j] * (sr * swv[bj][1][j]) : (float)acc[ai][bj][m][1][j]; }
                    u32x4 w; w.x = cvt_pk_bf16(v0[0], v0[1]); w.y = cvt_pk_bf16(v0[2], v0[3]); w.z = cvt_pk_bf16(v1[0], v1[1]); w.w = cvt_pk_bf16(v1[2], v1[3]);
                    st16(rowp + (hm ? (size_t)bj * hm : (size_t)(bj * HALF)), w); } }
    }
};
typedef EpiBf16T<false> EpiBf16;
struct EpiF32 {
    static constexpr bool PERM = false, AFTER_DRAIN = false;
    float* C; int ldc;
    __device__ __forceinline__ void operator()(const f32x4 (&acc)[2][2][4][2], const Unit& u, int wr, int wc, int fr, int fq) const {
        const int row0 = u.pm * BM + wr * 64 + fr, col0 = u.pn * BM + wc * 32 + 4 * fq;
#pragma unroll
        for (int ai = 0; ai < 2; ++ai)
#pragma unroll
            for (int m = 0; m < 4; ++m) { float* rowp = C + (size_t)(row0 + ai * HALF + m * 16) * ldc + col0;
#pragma unroll
                for (int bj = 0; bj < 2; ++bj)
#pragma unroll
                    for (int n = 0; n < 2; ++n) *(f32x4*)(rowp + bj * HALF + n * 16) = acc[ai][bj][m][n]; }
    }
};
struct EpiSwiGLU {
    static constexpr bool PERM = true, AFTER_DRAIN = false;
    bf16_t* O; int ldc;
    __device__ __forceinline__ void operator()(const f32x4 (&acc)[2][2][4][2], const Unit& u, int wr, int wc, int fr, int fq) const {
        const int row0 = u.pm * BM + wr * 64 + fr, col0 = u.pn * HALF + wc * 32 + 8 * fq;
#pragma unroll
        for (int ai = 0; ai < 2; ++ai)
#pragma unroll
            for (int m = 0; m < 4; ++m) { bf16_t* rowp = O + (size_t)(row0 + ai * HALF + m * 16) * ldc + col0;
                const f32x4 g0 = acc[ai][0][m][0], g1 = acc[ai][0][m][1], u0 = acc[ai][1][m][0], u1 = acc[ai][1][m][1];
                f32x4 v0, v1;
#pragma unroll
                for (int j = 0; j < 4; ++j) { v0[j] = silu_f(g0[j]) * u0[j]; v1[j] = silu_f(g1[j]) * u1[j]; }
                u32x4 w; w.x = cvt_pk_bf16(v0[0], v0[1]); w.y = cvt_pk_bf16(v0[2], v0[3]); w.z = cvt_pk_bf16(v1[0], v1[1]); w.w = cvt_pk_bf16(v1[2], v1[3]);
                st16(rowp, w); }
    }
};

template <bool I8> struct EpiHgrn {
    static constexpr bool PERM = true, AFTER_DRAIN = false;
    bf16_t* base; bf16_t* KH; const float* lb; const float* sa; const float* sw;
    __device__ __forceinline__ void operator()(const typename AccT<I8>::type (&acc)[2][2][4][2], const Unit& u, int wr, int wc, int fr, int fq) const {
        const int row0 = u.pm * BM + wr * 64 + fr, sec = u.pn >> 4, cs0 = (u.pn & 15) * BM + wc * 32 + 8 * fq;
        f32x4 lbv[2][2], swv[2][2];
#pragma unroll
        for (int bj = 0; bj < 2; ++bj)
#pragma unroll
            for (int n = 0; n < 2; ++n) { lbv[bj][n] = (sec == 1) ? *(const f32x4*)(lb + cs0 + bj * HALF + 4 * n) : (f32x4){0.f, 0.f, 0.f, 0.f};
                swv[bj][n] = I8 ? *(const f32x4*)(sw + u.pn * BM + wc * 32 + 8 * fq + bj * HALF + 4 * n) : (f32x4){1.f, 1.f, 1.f, 1.f}; }
        bf16_t* const hm = base + (size_t)sec * ((size_t)16384 * 4096);
#pragma unroll
        for (int ai = 0; ai < 2; ++ai)
#pragma unroll
            for (int m = 0; m < 4; ++m) { const int r = row0 + ai * HALF + m * 16, bb = r >> 13, tt = r & 8191; const float sr = I8 ? sa[r] : 1.f;
#pragma unroll
                for (int bj = 0; bj < 2; ++bj) { f32x4 v[2]; u32x4 w;
#pragma unroll
                    for (int n = 0; n < 2; ++n)
#pragma unroll
                        for (int j = 0; j < 4; ++j) v[n][j] = I8 ? (float)acc[ai][bj][m][n][j] * (sr * swv[bj][n][j]) : (float)acc[ai][bj][m][n][j];
                    const size_t hoff = ((size_t)(bb * 32 + (u.pn & 15) * 2 + bj) * 8192 + tt) * 128 + wc * 32 + 8 * fq;
                    if (sec == 1) { f32x4 kk[2];
#pragma unroll
                        for (int n = 0; n < 2; ++n)
#pragma unroll
                            for (int j = 0; j < 4; ++j) { const float fg = lbv[bj][n][j] + (1.f - lbv[bj][n][j]) * __builtin_amdgcn_rcpf(1.0f + __expf(-v[n][j])); kk[n][j] = 1.f - fg; v[n][j] = __logf(fg); }
                        u32x4 kw; kw.x = cvt_pk_bf16(kk[0][0], kk[0][1]); kw.y = cvt_pk_bf16(kk[0][2], kk[0][3]); kw.z = cvt_pk_bf16(kk[1][0], kk[1][1]); kw.w = cvt_pk_bf16(kk[1][2], kk[1][3]);
                        st16(KH + hoff, kw);
                    } else if (sec == 0) {
#pragma unroll
                        for (int n = 0; n < 2; ++n)
#pragma unroll
                            for (int j = 0; j < 4; ++j) v[n][j] = silu_f(v[n][j]) * 0.08838834764831845f;
                    } else if (sec == 3) {
#pragma unroll
                        for (int n = 0; n < 2; ++n)
#pragma unroll
                            for (int j = 0; j < 4; ++j) v[n][j] = silu_f(v[n][j]);
                    }
                    w.x = cvt_pk_bf16(v[0][0], v[0][1]); w.y = cvt_pk_bf16(v[0][2], v[0][3]); w.z = cvt_pk_bf16(v[1][0], v[1][1]); w.w = cvt_pk_bf16(v[1][2], v[1][3]);
                    st16(hm + ((sec == 3) ? ((size_t)r * 4096 + cs0 + bj * HALF) : hoff), w); } }
    }
};
struct EpiSwiGLU8 {
    static constexpr bool PERM = true, AFTER_DRAIN = false;
    bf16_t* O; int ldc; const float* sa; const float* sw; bf16_t* O2;
    __device__ __forceinline__ EpiSwiGLU8 alt() const { EpiSwiGLU8 e = *this; e.O = O2; return e; }
    __device__ __forceinline__ void operator()(const i32x4 (&acc)[2][2][4][2], const Unit& u, int wr, int wc, int fr, int fq) const {
        const int row0 = u.pm * BM + wr * 64 + fr, col0 = u.pn * HALF + wc * 32 + 8 * fq, brow0 = u.pn * BM + wc * 32 + 8 * fq;
        f32x4 sg[2], su[2];
#pragma unroll
        for (int n = 0; n < 2; ++n) { sg[n] = *(const f32x4*)(sw + brow0 + 4 * n); su[n] = *(const f32x4*)(sw + brow0 + HALF + 4 * n); }
#pragma unroll
        for (int ai = 0; ai < 2; ++ai)
#pragma unroll
            for (int m = 0; m < 4; ++m) { const int r = row0 + ai * HALF + m * 16; const float sr = sa[r]; bf16_t* rowp = O + (size_t)r * ldc + col0;
                f32x4 v[2];
#pragma unroll
                for (int n = 0; n < 2; ++n)
#pragma unroll
                    for (int j = 0; j < 4; ++j) { const float gt = (float)acc[ai][0][m][n][j] * (sr * sg[n][j]), up = (float)acc[ai][1][m][n][j] * (sr * su[n][j]); v[n][j] = silu_f(gt) * up; }
                u32x4 w; w.x = cvt_pk_bf16(v[0][0], v[0][1]); w.y = cvt_pk_bf16(v[0][2], v[0][3]); w.z = cvt_pk_bf16(v[1][0], v[1][1]); w.w = cvt_pk_bf16(v[1][2], v[1][3]);
                st16(rowp, w); }
    }
};

template <bool I8> struct EpiHgrn2 {
    static constexpr bool PERM = true, AFTER_DRAIN = false;
    bf16_t* base; bf16_t* KH; const float* lb; const float* sa; const float* sw;
    __device__ __forceinline__ void operator()(const typename AccT<I8>::type (&acc)[2][2][4][2], const Unit& u, int wr, int wc, int fr, int fq) const {
        typedef unsigned u32x2 __attribute__((ext_vector_type(2)));
        const int row0 = u.pm * BM + wr * 64 + fr, head = u.pn >> 1, ch0 = 64 * (u.pn & 1) + 16 * wc + 4 * fq;
        const f32x4 lbv = *(const f32x4*)(lb + head * 128 + ch0);
        f32x4 swv[2][2];
#pragma unroll
        for (int bj = 0; bj < 2; ++bj)
#pragma unroll
            for (int n = 0; n < 2; ++n) swv[bj][n] = I8 ? *(const f32x4*)(sw + u.pn * BM + wc * 32 + 8 * fq + bj * HALF + 4 * n) : (f32x4){1.f, 1.f, 1.f, 1.f};
        const size_t MD = (size_t)16384 * 4096;
#pragma unroll
        for (int ai = 0; ai < 2; ++ai)
#pragma unroll
            for (int m = 0; m < 4; ++m) { const int r = row0 + ai * HALF + m * 16, bb = r >> 13, tt = r & 8191; const float sr = I8 ? sa[r] : 1.f;
                f32x4 v[2][2];
#pragma unroll
                for (int bj = 0; bj < 2; ++bj)
#pragma unroll
                    for (int n = 0; n < 2; ++n)
#pragma unroll
                        for (int j = 0; j < 4; ++j) v[bj][n][j] = I8 ? (float)acc[ai][bj][m][n][j] * (sr * swv[bj][n][j]) : (float)acc[ai][bj][m][n][j];
                const size_t hoff = ((size_t)(bb * 32 + head) * 8192 + tt) * 128 + ch0;
                f32x4 qv, lf, kk, sg;
#pragma unroll
                for (int j = 0; j < 4; ++j) { qv[j] = silu_f(v[0][0][j]) * 0.08838834764831845f;
                    const float fg = lbv[j] + (1.f - lbv[j]) * __builtin_amdgcn_rcpf(1.0f + __expf(-v[0][1][j])); kk[j] = 1.f - fg; lf[j] = __logf(fg); sg[j] = silu_f(v[1][1][j]); }
                *(u32x2*)(base + hoff) = (u32x2){cvt_pk_bf16(qv[0], qv[1]), cvt_pk_bf16(qv[2], qv[3])};
                *(u32x2*)(base + MD + hoff) = (u32x2){cvt_pk_bf16(lf[0], lf[1]), cvt_pk_bf16(lf[2], lf[3])};
                *(u32x2*)(KH + hoff) = (u32x2){cvt_pk_bf16(kk[0], kk[1]), cvt_pk_bf16(kk[2], kk[3])};
                *(u32x2*)(base + 2 * MD + hoff) = (u32x2){cvt_pk_bf16(v[1][0][0], v[1][0][1]), cvt_pk_bf16(v[1][0][2], v[1][0][3])};
                *(u32x2*)(base + 3 * MD + (size_t)r * 4096 + head * 128 + ch0) = (u32x2){cvt_pk_bf16(sg[0], sg[1]), cvt_pk_bf16(sg[2], sg[3])}; }
    }
};

#define PG8_DPP_SHR(x, n) __builtin_bit_cast(float, __builtin_amdgcn_update_dpp(0, __builtin_bit_cast(int, (x)), 0x110 + (n), 0xf, 0xf, false))
#define PG8_DPP_PERM(x, ctrl) __builtin_bit_cast(float, __builtin_amdgcn_update_dpp(0, __builtin_bit_cast(int, (x)), (ctrl), 0xf, 0xf, true))
__device__ __forceinline__ float row_sum16(float x) { x += PG8_DPP_PERM(x, 0x140); x += PG8_DPP_PERM(x, 0x141); x += PG8_DPP_PERM(x, 0xB1); x += PG8_DPP_PERM(x, 0x4E); return x; }
__device__ __forceinline__ float row_scan16(float x) { x += PG8_DPP_SHR(x, 1); x += PG8_DPP_SHR(x, 2); x += PG8_DPP_SHR(x, 4); x += PG8_DPP_SHR(x, 8); return x; }
template <bool I8> struct EpiHgrn3 {
    static constexpr bool PERM = true, AFTER_DRAIN = false;
    bf16_t* QR; size_t dKR, dVH, dSG;     float* EL; float* DEC; float* ER; const float* lb; const float* sa; const float* sw;
    __device__ __forceinline__ void operator()(const typename AccT<I8>::type (&acc)[2][2][4][2], const Unit& u, int wr, int wc, int fr, int fq) const {
        typedef unsigned u32x2 __attribute__((ext_vector_type(2)));
        const int lane = fr + 16 * fq, row0 = u.pm * BM + wr * 64 + fr, head = u.pn >> 1, ch0 = 64 * (u.pn & 1) + 16 * wc + 4 * fq;
        const f32x4 lbv = *(const f32x4*)(lb + head * 128 + ch0);
        f32x4 swv[2][2];
#pragma unroll
        for (int bj = 0; bj < 2; ++bj)
#pragma unroll
            for (int n = 0; n < 2; ++n) swv[bj][n] = I8 ? *(const f32x4*)(sw + u.pn * BM + wc * 32 + 8 * fq + bj * HALF + 4 * n) : (f32x4){1.f, 1.f, 1.f, 1.f};
#pragma unroll
        for (int ai = 0; ai < 2; ++ai) {
            f32x4 qv[4], lf[4], kk[4];
#pragma unroll
            for (int m = 0; m < 4; ++m) { const int r = row0 + ai * HALF + m * 16, bb = r >> 13, tt = r & 8191; const float sr = I8 ? sa[r] : 1.f;
                f32x4 v[2][2];
#pragma unroll
                for (int bj = 0; bj < 2; ++bj)
#pragma unroll
                    for (int n = 0; n < 2; ++n) { if constexpr (I8) v[bj][n] = __builtin_convertvector(acc[ai][bj][m][n], f32x4) * (swv[bj][n] * sr); else v[bj][n] = acc[ai][bj][m][n]; }
#pragma unroll
                for (int j = 0; j < 4; ++j) { qv[m][j] = silu_f(v[0][0][j]) * 0.08838834764831845f;
                    const float fg = lbv[j] + (1.f - lbv[j]) * __builtin_amdgcn_rcpf(1.0f + __expf(-v[0][1][j])); kk[m][j] = 1.f - fg; lf[m][j] = __builtin_amdgcn_logf(fg) * 0.6931471805599453f; }
                { const u32x2 p0 = __builtin_amdgcn_permlane16_swap(cvt_pk_bf16(v[1][0][0], v[1][0][1]), cvt_pk_bf16(v[1][1][0], v[1][1][1]), false, false);
                  const u32x2 p1 = __builtin_amdgcn_permlane16_swap(cvt_pk_bf16(v[1][0][2], v[1][0][3]), cvt_pk_bf16(v[1][1][2], v[1][1][3]), false, false);
                  const size_t doff = (fq & 1) ? (dSG + (size_t)r * 4096 + head * 128 + (ch0 - 4)) : (dVH + ((size_t)(bb * 32 + head) * 8192 + tt) * 128 + ch0);
                  *(u32x4*)(QR + doff) = (u32x4){p0.x, p1.x, p0.y, p1.y}; } }
            f32x4 bb[4], run = (f32x4){0.f, 0.f, 0.f, 0.f}, bref = run;
#pragma unroll
            for (int m = 0; m < 4; ++m) { f32x4 inc, tot;
#pragma unroll
                for (int j = 0; j < 4; ++j) { inc[j] = row_scan16(lf[m][j]); tot[j] = __shfl(inc[j], lane | 15); }
                bb[m] = inc + run; run = run + tot; if (m == 1) bref = run; }
            const int rb = u.pm * BM + ai * HALF + wr * 64; const size_t cid = (size_t)((rb >> 13) * 32 + head) * 128 + ((rb & 8191) >> 6);
#pragma unroll
            for (int m = 0; m < 4; ++m) { f32x4 qr, kr;
#pragma unroll
                for (int j = 0; j < 4; ++j) { const float e1 = __expf(bb[m][j] - bref[j]); qr[j] = qv[m][j] * e1; kr[j] = kk[m][j] * __builtin_amdgcn_rcpf(e1); }
                const size_t off = cid * 8704 + (size_t)(16 * m + fr) * 136 + (ch0 & ~7);
                const u32x2 p0 = __builtin_amdgcn_permlane16_swap(cvt_pk_bf16(qr[0], qr[1]), cvt_pk_bf16(kr[0], kr[1]), false, false);
                const u32x2 p1 = __builtin_amdgcn_permlane16_swap(cvt_pk_bf16(qr[2], qr[3]), cvt_pk_bf16(kr[2], kr[3]), false, false);
                *(u32x4*)(QR + off + ((fq & 1) ? dKR : (size_t)0)) = (u32x4){p0.x, p1.x, p0.y, p1.y}; }
            if (fr == 0) { f32x4 el, dc, er;
#pragma unroll
                for (int j = 0; j < 4; ++j) { el[j] = __expf(run[j] - bref[j]); dc[j] = __expf(run[j]); er[j] = __expf(bref[j]); }
                *(f32x4*)(EL + cid * 128 + ch0) = el; *(f32x4*)(DEC + cid * 128 + ch0) = dc; *(f32x4*)(ER + cid * 128 + ch0) = er; }
        }
    }
};

struct EpiSwiGLU8R {
    static constexpr bool PERM = true, AFTER_DRAIN = false;
    bf16_t* O; int ldc; const float* sa; const float* sw; unsigned* rmax;
    __device__ __forceinline__ void operator()(const i32x4 (&acc)[2][2][4][2], const Unit& u, int wr, int wc, int fr, int fq) const {
        const int row0 = u.pm * BM + wr * 64 + fr, col0 = u.pn * HALF + wc * 32 + 8 * fq, brow0 = u.pn * BM + wc * 32 + 8 * fq;
        f32x4 sg[2], su[2];
#pragma unroll
        for (int n = 0; n < 2; ++n) { sg[n] = *(const f32x4*)(sw + brow0 + 4 * n); su[n] = *(const f32x4*)(sw + brow0 + HALF + 4 * n); }
#pragma unroll
        for (int ai = 0; ai < 2; ++ai)
#pragma unroll
            for (int m = 0; m < 4; ++m) { const int r = row0 + ai * HALF + m * 16; const float sr = sa[r], sru = MK_FFO_ROT ? sr * 0.17677669529663687f : sr; bf16_t* rowp = O + (size_t)r * ldc + col0;
                f32x2 X[4];
#pragma unroll
                for (int n = 0; n < 2; ++n)
#pragma unroll
                    for (int j = 0; j < 4; ++j) { const float gt = (float)acc[ai][0][m][n][j] * (sr * sg[n][j]), up = (float)acc[ai][1][m][n][j] * (sru * su[n][j]); X[2 * n + (j >> 1)][j & 1] = silu_f(gt) * up; }
#if MK_FFO_ROT
#pragma unroll
                for (int k = 0; k < 4; ++k) { const float a = X[k].x, b = X[k].y; X[k] = (f32x2){a + b, a - b}; }
                { f32x2 a = X[0], b = X[1]; X[0] = a + b; X[1] = a - b; a = X[2]; b = X[3]; X[2] = a + b; X[3] = a - b; }
                { f32x2 a = X[0], b = X[2]; X[0] = a + b; X[2] = a - b; a = X[1]; b = X[3]; X[1] = a + b; X[3] = a - b; }
                { float x0 = X[0].x, x1 = X[0].y, x2 = X[1].x, x3 = X[1].y, x4 = X[2].x, x5 = X[2].y, x6 = X[3].x, x7 = X[3].y;
                  asm volatile("v_nop\n\tv_nop\n\tv_permlane16_swap_b32 %0, %4\n\tv_permlane16_swap_b32 %1, %5\n\tv_permlane16_swap_b32 %2, %6\n\tv_permlane16_swap_b32 %3, %7\n\ts_nop 1"
                               : "+v"(x0), "+v"(x1), "+v"(x2), "+v"(x3), "+v"(x4), "+v"(x5), "+v"(x6), "+v"(x7));
                  { const f32x2 a = (f32x2){x0, x1}, b = (f32x2){x4, x5}, c = (f32x2){x2, x3}, d = (f32x2){x6, x7}; X[0] = a + b; X[2] = a - b; X[1] = c + d; X[3] = c - d; }
                  x0 = X[0].x; x1 = X[0].y; x2 = X[1].x; x3 = X[1].y; x4 = X[2].x; x5 = X[2].y; x6 = X[3].x; x7 = X[3].y;
                  asm volatile("v_nop\n\tv_nop\n\tv_permlane32_swap_b32 %0, %2\n\tv_permlane32_swap_b32 %1, %3\n\tv_permlane32_swap_b32 %4, %6\n\tv_permlane32_swap_b32 %5, %7\n\ts_nop 1"
                               : "+v"(x0), "+v"(x1), "+v"(x2), "+v"(x3), "+v"(x4), "+v"(x5), "+v"(x6), "+v"(x7));
                  { const f32x2 a = (f32x2){x0, x1}, b = (f32x2){x2, x3}, c = (f32x2){x4, x5}, d = (f32x2){x6, x7}; X[0] = a + b; X[1] = a - b; X[2] = c + d; X[3] = c - d; } }
#endif
                u32x4 w; w.x = cvt_pk_bf16(X[0].x, X[0].y); w.y = cvt_pk_bf16(X[1].x, X[1].y); w.z = cvt_pk_bf16(X[2].x, X[2].y); w.w = cvt_pk_bf16(X[3].x, X[3].y);
                st16nt(rowp, w);
                float am = fmaxf(fmaxf(fmaxf(fabsf(X[0].x), fabsf(X[0].y)), fmaxf(fabsf(X[1].x), fabsf(X[1].y))), fmaxf(fmaxf(fabsf(X[2].x), fabsf(X[2].y)), fmaxf(fabsf(X[3].x), fabsf(X[3].y))));
                am = fmaxf(am, __shfl_xor(am, 16)); am = fmaxf(am, __shfl_xor(am, 32));
                if (fq == 0) __hip_atomic_fetch_max(rmax + r, cvt_pk_bf16(am, am) << 16, __ATOMIC_RELAXED, __HIP_MEMORY_SCOPE_AGENT); }
    }
};
template <class Epi, class Sched, bool ALIGN_EPI = false, bool SP2 = false, bool I8 = false, int KREP = 1, int EREP = 1, bool TM = false, int TCH = 0, int LT = 0>
__device__ __forceinline__ void gemm_phase(PG8_LAS unsigned char* lds, const Gemm g, const Sched& S, const Epi& E) {
    const int tid = threadIdx.x, wid = __builtin_amdgcn_readfirstlane(tid >> 6), lane = tid & 63, wr = wid >> 2, wc = wid & 3, fr = lane & 15, fq = lane >> 4;
    const int K = g.K, nt = K / BK;
    unsigned voffA[2], voffB[2];
#pragma unroll
    for (int i = 0; i < 2; ++i) { int R, C; stage_rc(tid * 16 + i * 8192, R, C); const int Rb = Epi::PERM ? ((R & ~31) + perm32(R & 31)) : R;
        voffA[i] = TM ? (unsigned)(tid * 16 + i * 8192) : (unsigned)(R * K + C) * 2u; voffB[i] = TM ? (unsigned)(tid * 16 + i * 8192) : (unsigned)(Rb * K + C) * 2u; }
    const size_t kstep = TM ? (size_t)32768 : (size_t)(BK * 2);
    const size_t hstep = TM ? (size_t)16384 : (size_t)HALF * K * 2;
    const size_t tstep = TM ? (size_t)nt * 32768 : 2 * hstep;
    const unsigned ldsw = (unsigned)wid * 1024u;
    const int aoff = lds_byte(wr * 64 + fr, fq * 8), boff = lds_byte(wc * 32 + fr, fq * 8);
#define PG8_SA(b, h) (((b) * 2 + (h)) * HTB)
#define PG8_SB(b, h) ((4 + (b) * 2 + (h)) * HTB)
#define PG8_STAGE(bufoff, gbase, voff) do { _Pragma("unroll") for (int _i = 0; _i < 2; ++_i) \
        __builtin_amdgcn_global_load_lds((const unsigned*)((const char*)(gbase) + (voff)[_i]), (PG8_LAS unsigned*)(lds + (bufoff) + ldsw + _i * 8192), 16, 0, 0); } while (0)
#ifndef MK_B_NT
#define MK_B_NT 0
#endif
#define PG8_STAGEB(bufoff, gbase, voff) do { _Pragma("unroll") for (int _i = 0; _i < 2; ++_i) \
        __builtin_amdgcn_global_load_lds((const unsigned*)((const char*)(gbase) + (voff)[_i]), (PG8_LAS unsigned*)(lds + (bufoff) + ldsw + _i * 8192), 16, 0, MK_B_NT ? 2 : 0); } while (0)
#define PG8_LDA(dst, b, h) do { _Pragma("unroll") for (int m = 0; m < 4; ++m) _Pragma("unroll") for (int k = 0; k < 2; ++k) dst[m][k] = *(const PG8_LAS bf16x8*)(lds + PG8_SA(b, h) + aoff + m * 2048 + k * 1024); } while (0)
#define PG8_LDB(dst, b, h) do { _Pragma("unroll") for (int n = 0; n < 2; ++n) _Pragma("unroll") for (int k = 0; k < 2; ++k) dst[n][k] = *(const PG8_LAS bf16x8*)(lds + PG8_SB(b, h) + boff + n * 2048 + k * 1024); } while (0)
#ifndef PG8_PRIO
#define PG8_PRIO 1
#endif
#define PG8_MMA(ai, bj, At, Bt) do { if (PG8_PRIO) __builtin_amdgcn_s_setprio(PG8_PRIO); _Pragma("unroll") for (int m = 0; m < 4; ++m) _Pragma("unroll") for (int n = 0; n < 2; ++n) _Pragma("unroll") for (int k = 0; k < 2; ++k) \
        acc[ai][bj][m][n] = mma16(Bt[n][k], At[m][k], acc[ai][bj][m][n]); if (PG8_PRIO) __builtin_amdgcn_s_setprio(0); } while (0)
#define PG8_WAIT_V(n) asm volatile("s_waitcnt vmcnt(" #n ")" ::: "memory")
#define PG8_WAIT_L(n) asm volatile("s_waitcnt lgkmcnt(" #n ")" ::: "memory")
#define PG8_BAR __builtin_amdgcn_s_barrier()
#define PG8_SCHED __builtin_amdgcn_sched_barrier(0)
#define PG8_TOUCH(uidx) do { if constexpr (TCH > 0) { Unit tu_; if (S.next((uidx), tu_)) { const char* tb_ = (const char*)g.Bt + (size_t)tu_.pn * tstep; const unsigned sh_ = (unsigned)cur.pm & 63u; \
        for (int l_ = tid; l_ < nt * 4; l_ += 512) { const size_t o_ = TM ? ((size_t)sh_ * (size_t)(nt * 512) + (size_t)l_ * 128) : ((size_t)(4 * sh_ + l_ / nt) * (size_t)(nt * 128) + (size_t)(l_ % nt) * 128); \
            __builtin_amdgcn_global_load_lds((const unsigned*)(tb_ + o_), (PG8_LAS unsigned*)(lds + STAGE_BYTES + wid * 256), 4, 0, 0); } } } } while (0)
    const unsigned ltoff = (lane < 8) ? (unsigned)(wid * 1024 + lane * 128) : (unsigned)(wid * 512 + (lane - 8) * 128);
#define PG8_LTOUCH(abase, bbase) do { if constexpr (LT > 0) { if (lane < 12) { const char* tp_ = (lane < 8) ? ((abase) + ltA) : ((bbase) + ltB); \
        __builtin_amdgcn_global_load_lds((const unsigned*)(tp_ + ltoff), (PG8_LAS unsigned*)(lds + STAGE_BYTES + wid * 256), 4, 0, 0); } } } while (0)
#define PG8_WAIT_VS() do { if constexpr (LT > 0) PG8_WAIT_V(9); else PG8_WAIT_V(8); } while (0)
    Unit cur, nxt; int ui = 0;
    if (!S.next(0, cur)) return;
    typedef typename AccT<I8>::type acc_t;
    acc_t acc[2][2][4][2];
#pragma unroll
    for (int a = 0; a < 2; ++a)
#pragma unroll
        for (int b = 0; b < 2; ++b)
#pragma unroll
            for (int m = 0; m < 4; ++m)
#pragma unroll
                for (int n = 0; n < 2; ++n) acc[a][b][m][n] = AccT<I8>::zero();
    bf16x8 At[4][2], B0[2][2], B1[2][2];
    const char* cA = (const char*)g.A + (size_t)cur.pm * tstep; const char* cB = (const char*)g.Bt + (size_t)cur.pn * tstep;
    unsigned ltA = (unsigned)(cur.pn & 3) * 8192u, ltB = (unsigned)(cur.pm & 7) * 4096u;
    S.a_ready(cur);
    if constexpr (TCH > 0) { PG8_TOUCH(1); if constexpr (TCH > 1) PG8_TOUCH(2); }
    if constexpr (SP2) {
        PG8_STAGEB(PG8_SB(0, 0), cB, voffB); PG8_STAGEB(PG8_SB(0, 1), cB + hstep, voffB); PG8_STAGE(PG8_SA(0, 0), cA, voffA); PG8_STAGE(PG8_SA(0, 1), cA + hstep, voffA);
        if (wr == 1) PG8_BAR;
        PG8_WAIT_V(2); PG8_BAR;
        PG8_STAGEB(PG8_SB(1, 0), cB + kstep, voffB); PG8_STAGE(PG8_SA(1, 0), cA + kstep, voffA); PG8_STAGEB(PG8_SB(1, 1), cB + hstep + kstep, voffB);
        PG8_WAIT_V(6); PG8_BAR;
    } else {
        PG8_STAGEB(PG8_SB(0, 0), cB, voffB); PG8_STAGE(PG8_SA(0, 0), cA, voffA); PG8_STAGEB(PG8_SB(0, 1), cB + hstep, voffB); PG8_STAGE(PG8_SA(0, 1), cA + hstep, voffA);
        if (wr == 1) PG8_BAR;
        PG8_WAIT_V(4); PG8_BAR;
        PG8_STAGEB(PG8_SB(1, 0), cB + kstep, voffB); PG8_STAGE(PG8_SA(1, 0), cA + kstep, voffA); PG8_STAGEB(PG8_SB(1, 1), cB + hstep + kstep, voffB);
        PG8_WAIT_V(6); PG8_BAR;
    }
    for (;;) {
        const bool has_next = S.next(ui + 1, nxt);
        const char* nA = has_next ? (const char*)g.A + (size_t)nxt.pm * tstep : cA; const char* nB = has_next ? (const char*)g.Bt + (size_t)nxt.pn * tstep : cB;
        for (int krep = 0; krep < KREP; ++krep) {
        if (KREP > 1 && krep == KREP - 1 && krep > 0) {
_Pragma("unroll") for (int a = 0; a < 2; ++a) _Pragma("unroll") for (int b = 0; b < 2; ++b) _Pragma("unroll") for (int m = 0; m < 4; ++m) _Pragma("unroll") for (int n = 0; n < 2; ++n) acc[a][b][m][n] = AccT<I8>::zero(); }
        const char* nA2 = (krep == KREP - 1) ? nA : cA; const char* nB2 = (krep == KREP - 1) ? nB : cB;
        for (int t = 0; t < nt; t += 2) {
            const bool last = (t == nt - 2);
            const char* a1 = cA + (size_t)(t + 1) * kstep;
            const char* a2 = last ? nA2 : cA + (size_t)(t + 2) * kstep; const char* b2 = last ? nB2 : cB + (size_t)(t + 2) * kstep;
            const char* a3 = a2 + kstep; const char* b3 = b2 + kstep;
            const char *ta0 = cA, *tb0 = cB, *ta1 = cA, *tb1 = cB;
            if constexpr (LT > 0) { const int q0 = t + LT, q1 = t + 1 + LT;
                if (q0 < nt) { ta0 = cA + (size_t)q0 * kstep; tb0 = cB + (size_t)q0 * kstep; } else if (krep == KREP - 1 && has_next && q0 - nt < nt) { ta0 = nA + (size_t)(q0 - nt) * kstep; tb0 = nB + (size_t)(q0 - nt) * kstep; }
                if (q1 < nt) { ta1 = cA + (size_t)q1 * kstep; tb1 = cB + (size_t)q1 * kstep; } else if (krep == KREP - 1 && has_next && q1 - nt < nt) { ta1 = nA + (size_t)(q1 - nt) * kstep; tb1 = nB + (size_t)(q1 - nt) * kstep; } }
            if (last && has_next && krep == KREP - 1) S.a_ready(nxt);
            if constexpr (SP2) {
            PG8_LDB(B0, 0, 0); PG8_LDB(B1, 0, 1); PG8_SCHED; PG8_LDA(At, 0, 0); PG8_STAGE(PG8_SA(1, 1), a1 + hstep, voffA);
            PG8_WAIT_VS(); PG8_WAIT_L(0); PG8_BAR; PG8_MMA(0, 0, At, B0); PG8_MMA(0, 1, At, B1); PG8_BAR; PG8_SCHED;
            PG8_LDA(At, 0, 1); PG8_LTOUCH(ta0, tb0); PG8_STAGEB(PG8_SB(0, 0), b2, voffB); PG8_STAGEB(PG8_SB(0, 1), b2 + hstep, voffB); PG8_STAGE(PG8_SA(0, 0), a2, voffA);
            PG8_WAIT_VS(); PG8_WAIT_L(0); PG8_BAR; PG8_MMA(1, 0, At, B0); PG8_MMA(1, 1, At, B1); PG8_BAR; PG8_SCHED;
            PG8_LDB(B0, 1, 0); PG8_LDB(B1, 1, 1); PG8_SCHED; PG8_LDA(At, 1, 0); PG8_STAGE(PG8_SA(0, 1), a2 + hstep, voffA);
            PG8_WAIT_VS(); PG8_WAIT_L(0); PG8_BAR; PG8_MMA(0, 0, At, B0); PG8_MMA(0, 1, At, B1); PG8_BAR; PG8_SCHED;
            PG8_LDA(At, 1, 1); PG8_LTOUCH(ta1, tb1); PG8_STAGEB(PG8_SB(1, 0), b3, voffB); PG8_STAGEB(PG8_SB(1, 1), b3 + hstep, voffB); PG8_STAGE(PG8_SA(1, 0), a3, voffA);
            PG8_WAIT_VS(); PG8_WAIT_L(0); PG8_BAR; PG8_MMA(1, 0, At, B0); PG8_MMA(1, 1, At, B1); PG8_BAR; PG8_SCHED;
            } else {
            PG8_LDB(B0, 0, 0); PG8_SCHED; PG8_LDA(At, 0, 0); PG8_STAGE(PG8_SA(1, 1), a1 + hstep, voffA);
            PG8_WAIT_L(8); PG8_BAR; PG8_WAIT_L(0); PG8_MMA(0, 0, At, B0); PG8_BAR; PG8_SCHED;
            PG8_LDB(B1, 0, 1); PG8_STAGEB(PG8_SB(0, 0), b2, voffB);
            PG8_BAR; PG8_WAIT_L(0); PG8_MMA(0, 1, At, B1); PG8_BAR;
            PG8_LDA(At, 0, 1); PG8_STAGE(PG8_SA(0, 0), a2, voffA);
            PG8_BAR; PG8_WAIT_L(0); PG8_MMA(1, 0, At, B0); PG8_BAR; PG8_SCHED;
            PG8_STAGEB(PG8_SB(0, 1), b2 + hstep, voffB);
            PG8_WAIT_V(6); PG8_BAR; PG8_MMA(1, 1, At, B1); PG8_BAR;
            PG8_LDB(B0, 1, 0); PG8_SCHED; PG8_LDA(At, 1, 0); PG8_STAGE(PG8_SA(0, 1), a2 + hstep, voffA);
            PG8_WAIT_L(8); PG8_BAR; PG8_WAIT_L(0); PG8_MMA(0, 0, At, B0); PG8_BAR; PG8_SCHED;
            PG8_LDB(B1, 1, 1); PG8_STAGEB(PG8_SB(1, 0), b3, voffB);
            PG8_BAR; PG8_WAIT_L(0); PG8_MMA(0, 1, At, B1); PG8_BAR;
            PG8_LDA(At, 1, 1); PG8_STAGE(PG8_SA(1, 0), a3, voffA);
            PG8_BAR; PG8_WAIT_L(0); PG8_MMA(1, 0, At, B0); PG8_BAR; PG8_SCHED;
            PG8_STAGEB(PG8_SB(1, 1), b3 + hstep, voffB);
            PG8_WAIT_V(6); PG8_BAR; PG8_MMA(1, 1, At, B1); PG8_BAR;
            }
        }
        }
        if constexpr (ALIGN_EPI) { if (wr == 0) PG8_BAR; }
        if constexpr (!Epi::AFTER_DRAIN) { E(acc, cur, wr, wc, fr, fq); if constexpr (EREP > 1) { asm volatile("" ::: "memory"); E.alt()(acc, cur, wr, wc, fr, fq); } S.done(cur); PG8_TOUCH(ui + 1 + TCH); }
        if (!has_next) break;
#pragma unroll
        for (int a = 0; a < 2; ++a)
#pragma unroll
            for (int b = 0; b < 2; ++b)
#pragma unroll
                for (int m = 0; m < 4; ++m)
#pragma unroll
                    for (int n = 0; n < 2; ++n) acc[a][b][m][n] = AccT<I8>::zero();
        cur = nxt; cA = nA; cB = nB; ++ui; ltA = (unsigned)(cur.pn & 3) * 8192u; ltB = (unsigned)(cur.pm & 7) * 4096u;
        if constexpr (ALIGN_EPI) { if (wr == 1) PG8_BAR; }
    }
    PG8_WAIT_V(0);
    if constexpr (!ALIGN_EPI) { if (wr == 0) PG8_BAR; }
    PG8_BAR;
    if constexpr (Epi::AFTER_DRAIN) { E.fused(acc, cur, wr, wc, fr, fq, lds, wid, lane); S.done(cur); }
#undef PG8_TOUCH
#undef PG8_LTOUCH
#undef PG8_WAIT_VS
#undef PG8_SA
#undef PG8_SB
#undef PG8_STAGE
#undef PG8_LDA
#undef PG8_LDB
#undef PG8_MMA
#undef PG8_WAIT_V
#undef PG8_WAIT_L
#undef PG8_BAR
#undef PG8_SCHED
}
}
#ifndef PG8_SP2
#define PG8_SP2 true
#endif
#ifndef PG8_ALIGN
#define PG8_ALIGN true
#endif
constexpr int NWAVES = 8;
#ifndef MK_N_LAUNCHES
#define MK_N_LAUNCHES 1
#endif
#ifndef MK_HGRN_MFMA
#define MK_HGRN_MFMA 1
#endif
#ifndef MK_ATTN_MFMA
#define MK_ATTN_MFMA 1
#endif
constexpr bool HGRN_MFMA = MK_HGRN_MFMA, ATTN_MFMA = MK_ATTN_MFMA;
#ifndef MK_REP_GEMM
#define MK_REP_GEMM 1
#endif
#ifndef MK_REP_P0
#define MK_REP_P0 1
#endif
#ifndef MK_REP_ATT
#define MK_REP_ATT 1
#endif
#ifndef MK_REP_HG
#define MK_REP_HG 1
#endif
#ifndef MK_REP_NORM
#define MK_REP_NORM 1
#endif
constexpr int REP_GEMM = MK_REP_GEMM, REP_P0 = MK_REP_P0, REP_ATT = MK_REP_ATT, REP_HG = MK_REP_HG, REP_NORM = MK_REP_NORM;
#ifndef MK_FFN_I8
#define MK_FFN_I8 1
#endif
static_assert(MK_FFN_I8 == 1, "the workspace map overlays ACT on the bf16 FFN-in weight copies: int8 FFN path only");
#ifndef MK_HG_I8
#define MK_HG_I8 1
#endif
constexpr bool HG_I8 = MK_HG_I8;
#ifndef MK_ATT_I8
#define MK_ATT_I8 0
#endif
constexpr bool ATT_I8 = MK_ATT_I8;
constexpr bool FFN_I8 = MK_FFN_I8;
#ifndef MK_KREP_FFI
#define MK_KREP_FFI 1
#endif
#ifndef MK_EREP_FFI
#define MK_EREP_FFI 1
#endif
constexpr int EREP_FFI = MK_EREP_FFI;
#ifndef MK_REP_FFI
#define MK_REP_FFI 1
#endif
constexpr int REP_FFI = MK_REP_FFI;
constexpr int KREP_FFI = MK_KREP_FFI;
#ifndef MK_TM_FFI
#define MK_TM_FFI 1
#endif
constexpr bool TM_FFI = MK_TM_FFI;
#ifndef MK_TCH_FFI
#define MK_TCH_FFI 0
#endif
#ifndef MK_TCH_ALL
#define MK_TCH_ALL 0
#endif
constexpr int TCH_FFI = MK_TCH_FFI, TCH_ALL = MK_TCH_ALL;
#ifndef MK_LT_FFI
#define MK_LT_FFI 0
#endif
constexpr int LT_FFI = MK_LT_FFI;
#ifndef MK_HG_FUSE
#define MK_HG_FUSE 2
#endif
constexpr int HG_FUSE = MK_HG_FUSE;
#ifndef MK_REP_P8
#define MK_REP_P8 1
#endif
constexpr int REP_P8 = MK_REP_P8;
#ifndef MK_FFO_I8
#define MK_FFO_I8 1
#endif
#ifndef MK_FFO_ROT
#define MK_FFO_ROT 1
#endif
constexpr bool FFO_I8 = MK_FFO_I8;
#ifndef MK_REP_BAR
#define MK_REP_BAR 0
#endif
constexpr int REP_BAR = MK_REP_BAR;
#ifndef MK_NT_W
#define MK_NT_W 0
#endif
#if MK_NT_W
#define MK_LD_W(p) __builtin_nontemporal_load(p)
#else
#define MK_LD_W(p) (*(p))
#endif
#ifndef MK_P0_OVL
#define MK_P0_OVL 0
#endif
constexpr bool P0_OVL = MK_P0_OVL;
#ifndef MK_QKV_HM
#define MK_QKV_HM 1
#endif
constexpr bool QKV_HM = MK_QKV_HM;
#ifndef MK_P0_STRIP
#define MK_P0_STRIP 1
#endif
constexpr bool P0_STRIP = MK_P0_STRIP;
#ifndef MK_HGO_I8
#define MK_HGO_I8 1
#endif
constexpr bool HGO_I8 = MK_HGO_I8;
constexpr int NPH = 16;
constexpr int N_LAUNCHES = MK_N_LAUNCHES;
static_assert(N_LAUNCHES == 1 || N_LAUNCHES == NPH, "MK_N_LAUNCHES is 1 or NPH");

constexpr int BATCH = 2, SEQ = 8192, DM = 4096, M = BATCH * SEQ, DFF = 11008, NQKV = 18432, NHG = 16384, DATT = 2048, HD = 128;
constexpr float RMS_EPS = 1e-6f;
constexpr float QSCALE = 0.08838834764831845f;

constexpr size_t MiB = 1u << 20;
constexpr size_t WS_CTL = 0, CTL_ZERO_BYTES = 1 * MiB;
constexpr size_t WS_TAB = 1 * MiB;
constexpr size_t WS_WATTI = 2 * MiB, WS_WATTO = 146 * MiB, WS_WHGI = 162 * MiB, WS_WHGO = 290 * MiB;
constexpr size_t WS_WFFI = 322 * MiB, WFFI_STRIDE = 172 * MiB, WS_WFFO = 666 * MiB, WFFO_STRIDE = 86 * MiB;
constexpr size_t WS_XN = 838 * MiB;
constexpr size_t WS_Y = 966 * MiB;
constexpr size_t WS_ACT = 322 * MiB;
constexpr size_t WS_ACT_OLD = 1222 * MiB;
constexpr size_t WS_QKV = 1566 * MiB;
constexpr size_t WS_MRG = 2142 * MiB;
constexpr size_t WS_OG = 2206 * MiB;
constexpr size_t WS_END = 2334 * MiB;
constexpr size_t WS_SA = WS_TAB + 128 * 1024, WS_SW = WS_TAB + 256 * 1024;
constexpr size_t WS_W8 = 1222 * MiB, W8_STRIDE = 86 * MiB, WS_W8H = 1394 * MiB, WS_END3 = 2529 * MiB;
constexpr size_t WS_SWH = WS_SW + 4 * 2 * 2 * DFF, WS_SWA = WS_SWH + 4 * NHG, WS_W8A = 1458 * MiB;
static_assert(WS_W8A + (size_t)NQKV * DM <= WS_QKV && WS_SWA + 4 * NQKV <= WS_WATTI, "int8 maps");
constexpr size_t WS_HB = 2529 * MiB, WS_END4 = 2657 * MiB;
constexpr size_t WS_W8O = 2657 * MiB, W8O_STRIDE = 43 * MiB, WS_END5 = 2743 * MiB, WS_SWO = WS_TAB + 640 * 1024, WS_SA2 = WS_TAB + 704 * 1024, WS_ACT8 = WS_QKV, WS_RMAX = WS_CTL + 512 * 1024;
constexpr size_t WS_W8G = 1530 * MiB, WS_SWG = WS_TAB + 768 * 1024, WS_SA3 = WS_TAB + 800 * 1024;
static_assert(WS_W8G + (size_t)DM * DM <= WS_QKV && WS_SA3 + 4 * M <= WS_WATTI, "HGO_I8 maps");
constexpr int CW_TMO = 0, CW_CODE = 1;
constexpr int CW_BAR = 4096;
constexpr int RING_OFF = 0, RING_BYTES = 131072;
constexpr int LDSCTL_OFF = 150528, MISC_OFF = LDSCTL_OFF + 320;
constexpr int LDS_BYTES = 152576;
static_assert(MISC_OFF + 128 <= LDS_BYTES, "LDS map");

#define GAS __attribute__((address_space(1)))
#define LAS __attribute__((address_space(3)))
typedef unsigned short bf16;
typedef unsigned v4u __attribute__((ext_vector_type(4)));
typedef unsigned v2u __attribute__((ext_vector_type(2)));
typedef float f32x4 __attribute__((ext_vector_type(4)));
typedef short bf16x8 __attribute__((ext_vector_type(8)));
typedef GAS unsigned gu32;
typedef GAS unsigned long long gu64;
#define RLX_AGENT __ATOMIC_RELAXED, __HIP_MEMORY_SCOPE_AGENT
#define LDS_WAIT() asm volatile("s_waitcnt lgkmcnt(0)" ::: "memory")
#define VM_WAIT() asm volatile("s_waitcnt vmcnt(0)" ::: "memory")
__device__ __forceinline__ unsigned f2bf(float f) { unsigned u = __builtin_bit_cast(unsigned, f); return (u + 0x7fffu + ((u >> 16) & 1u)) >> 16; }
__device__ __forceinline__ unsigned pk2(float lo, float hi) { return f2bf(lo) | (f2bf(hi) << 16); }
__device__ __forceinline__ unsigned cvtpk(float lo, float hi) { return pg8::cvt_pk_bf16(lo, hi); }
__device__ __forceinline__ float bflo(unsigned w) { return __builtin_bit_cast(float, w << 16); }
__device__ __forceinline__ float bfhi(unsigned w) { return __builtin_bit_cast(float, w & 0xffff0000u); }
#define XB_TMO      128
#define XB_XCNT(j)  (256  + 64 * (j))
#define XB_XSUB(j)  (1280 + 64 * (j))
#define XB_XGEN(j)  (2304 + 64 * (j))
#define XB_TOP      3328
#define XB_TOPGEN   3392
#define XCD_BAR_WORDS 3456
#define XB_SPIN_CAP (1u << 18)

__device__ __forceinline__ unsigned xb_ld(unsigned* p)              { return __hip_atomic_load(p, __ATOMIC_RELAXED, __HIP_MEMORY_SCOPE_AGENT); }
__device__ __forceinline__ unsigned xb_add(unsigned* p, unsigned v) { return __hip_atomic_fetch_add(p, v, __ATOMIC_RELAXED, __HIP_MEMORY_SCOPE_AGENT); }
__device__ __forceinline__ unsigned xb_xcc_id() { return (unsigned)__builtin_amdgcn_s_getreg((3 << 11) | 20) & 0xFu; }
#define XB_SPIN(cond, bar) do { unsigned _sp = 0; while (cond) { __builtin_amdgcn_s_sleep(1); \
    if ((++_sp & 255u) == 0u) { if (xb_ld(&(bar)[XB_TMO])) break; if (_sp > XB_SPIN_CAP) { atomicAdd(&(bar)[XB_TMO], 1u); break; } } } } while (0)

struct XcdBarrier {
    unsigned* bar; unsigned x;
    volatile LAS unsigned* st;
};

__device__ __forceinline__ XcdBarrier xcd_barrier_post(unsigned* bar, volatile LAS unsigned* st) {
    XcdBarrier b; b.bar = bar; b.x = xb_xcc_id(); b.st = st;
    if (threadIdx.x == 0) (void)xb_add(&bar[XB_XCNT(b.x)], 1u);
    return b;
}
__device__ __forceinline__ void xcd_barrier_complete(unsigned* bar, unsigned x, unsigned& nloc, unsigned& nx) {
    const unsigned G = gridDim.x * gridDim.y * gridDim.z;
    unsigned sum, cnt, mine, sp = 0u;
    for (;;) {
        sum = 0u; cnt = 0u; mine = 0u;
#pragma unroll
        for (unsigned j = 0; j < 16; ++j) { const unsigned c = xb_ld(&bar[XB_XCNT(j)]); sum += c; cnt += (c > 0u) ? 1u : 0u; mine = (j == x) ? c : mine; }
        if (sum == G) break;
        __builtin_amdgcn_s_sleep(1);
        if ((++sp & 255u) == 0u) { if (xb_ld(&bar[XB_TMO])) break; if (sp > XB_SPIN_CAP) { atomicAdd(&bar[XB_TMO], 1u); break; } }
    }
    nloc = mine > 0u ? mine : 1u; nx = cnt > 0u ? cnt : 1u;
}

__device__ __forceinline__ void xcd_barrier(const XcdBarrier& b) {
    asm volatile("s_waitcnt vmcnt(0)" ::: "memory");
    __syncthreads();
    if (threadIdx.x == 0) {
        unsigned* bar = b.bar;
        __builtin_amdgcn_s_waitcnt(0);
        unsigned nloc = b.st[0], nx = b.st[1];
        if (nloc == 0u) { xcd_barrier_complete(bar, b.x, nloc, nx); b.st[0] = nloc; b.st[1] = nx; }
        const unsigned old = xb_add(&bar[XB_XSUB(b.x)], 1u);
        const unsigned gen = old / nloc;
        if (old + 1u == (gen + 1u) * nloc) {
            __builtin_amdgcn_fence(__ATOMIC_RELEASE, "agent");
            asm volatile("s_waitcnt vmcnt(0)" ::: "memory");
            const unsigned og = xb_add(&bar[XB_TOP], 1u);
            const unsigned tg = og / nx;
            if (og + 1u == (tg + 1u) * nx) xb_add(&bar[XB_TOPGEN], 1u);
            else XB_SPIN(xb_ld(&bar[XB_TOPGEN]) == tg, bar);
            __builtin_amdgcn_fence(__ATOMIC_ACQUIRE, "agent");
            xb_add(&bar[XB_XGEN(b.x)], 1u);
            asm volatile("s_waitcnt vmcnt(0)" ::: "memory");
        } else {
            XB_SPIN(xb_ld(&bar[XB_XGEN(b.x)]) == gen, bar);
            __builtin_amdgcn_fence(__ATOMIC_ACQUIRE, "agent");
            asm volatile("s_waitcnt vmcnt(0)" ::: "memory");
        }
    }
    __syncthreads();
}
struct Frame {
    LAS unsigned char* lds;
    volatile LAS unsigned* MISC;
    gu32* ctl;
    int tid, lane, wave;
    int vcu, G;
    const float *x, *gains, *rel_bias, *w_att_in, *w_att_out, *w_hg_in, *lb_logits, *hg_gain, *w_hg_out, *w_ff_in, *w_ff_out;
    float* out;
    unsigned char* ws;
};
__device__ __forceinline__ float wave_sum(float v) {
#pragma unroll
    for (int o = 1; o < 64; o <<= 1) v += __shfl_xor(v, o);
    return v;
}
__device__ __forceinline__ void p0_transpose_item(const float* W, int K, int N, bf16* WT, int mode, LAS float* scr, int item, int lane) {
    const int nblk = N / 32, kb = item / nblk, nb = item % nblk, k0 = 64 * kb, n0 = 32 * nb;
    int r0 = n0;
    if (mode == 1) { const int c = (n0 < DFF) ? n0 : n0 - DFF; r0 = 256 * (c >> 7) + (c & 127) + ((n0 < DFF) ? 0 : 128); }
#pragma unroll
    for (int i = 0; i < 32; ++i) { const int kk = 2 * i + (lane >> 5); scr[kk * 33 + (lane & 31)] = MK_LD_W(W + (size_t)(k0 + kk) * N + n0 + (lane & 31)); }
    LDS_WAIT(); asm volatile("" ::: "memory");
    const int c = lane & 7;
#pragma unroll
    for (int j = 0; j < 4; ++j) { const int n = (lane >> 3) + 8 * j; const LAS float* s = scr + (8 * c) * 33 + n;
        v4u o; o.x = pk2(s[0 * 33], s[1 * 33]); o.y = pk2(s[2 * 33], s[3 * 33]); o.z = pk2(s[4 * 33], s[5 * 33]); o.w = pk2(s[6 * 33], s[7 * 33]);
        int row = r0 + n;
        if (mode == 2) { const int col = n0 + n, s = col >> 12, cc = col & 4095, c64 = cc & 63; row = 256 * (cc >> 6) + 128 * (s >> 1) + 32 * (c64 >> 4) + 8 * ((c64 >> 2) & 3) + 4 * (s & 1) + (c64 & 3); }
        *(GAS v4u*)(WT + (size_t)row * K + k0 + 8 * c) = o; }
    LDS_WAIT(); asm volatile("" ::: "memory");
}
__device__ __forceinline__ int t5_bucket(int dist) {
    if (dist < 16) return dist;
    int large = 16 + (int)(log((double)dist / 16.0) / log(128.0) * 16.0);
    return large < 31 ? large : 31;
}
template <bool HAS_Y, int XNM, bool HIB = false, bool HOB = false>
__device__ __forceinline__ void norm_rows(Frame& F, const void* hin, const bf16* y, void* hout, bf16* xn, const float* ga, const float* gb, float* sa = nullptr) {
    const int gw = F.vcu * NWAVES + F.wave, NGW = F.G * NWAVES;
    for (int m = gw; m < M; m += NGW) {
        f32x4 h[16];
        if (HIB) { const GAS v2u* hr = (const GAS v2u*)((const bf16*)hin + (size_t)m * DM) + F.lane;
#pragma unroll
            for (int j = 0; j < 16; ++j) { const v2u hw = hr[64 * j]; h[j] = (f32x4){bflo(hw.x), bfhi(hw.x), bflo(hw.y), bfhi(hw.y)}; }
        } else { const GAS f32x4* hr = (const GAS f32x4*)((const float*)hin + (size_t)m * DM) + F.lane;
#pragma unroll
            for (int j = 0; j < 16; ++j) h[j] = hr[64 * j]; }
        if (HAS_Y) {
            const GAS v2u* yr = (const GAS v2u*)(y + (size_t)m * DM) + F.lane;
            f32x4 yv[16]; float ss = 0.f;
#pragma unroll
            for (int j = 0; j < 16; ++j) { const v2u yw = yr[64 * j]; yv[j] = (f32x4){bflo(yw.x), bfhi(yw.x), bflo(yw.y), bfhi(yw.y)}; ss += (yv[j].x * yv[j].x + yv[j].y * yv[j].y) + (yv[j].z * yv[j].z + yv[j].w * yv[j].w); }
            const float rstd = 1.f / sqrtf(wave_sum(ss) * (1.f / DM) + RMS_EPS);
            GAS f32x4* ho = (GAS f32x4*)((float*)hout + (size_t)m * DM) + F.lane; GAS v2u* hob = (GAS v2u*)((bf16*)hout + (size_t)m * DM) + F.lane;
#pragma unroll
            for (int j = 0; j < 16; ++j) { const f32x4 g = ((const GAS f32x4*)ga)[64 * j + F.lane]; h[j] = h[j] + yv[j] * rstd * g;
                if (HOB) { const v2u hw = (v2u){cvtpk(h[j].x, h[j].y), cvtpk(h[j].z, h[j].w)}; hob[64 * j] = hw; h[j] = (f32x4){bflo(hw.x), bfhi(hw.x), bflo(hw.y), bfhi(hw.y)}; }
                else ho[64 * j] = h[j]; }
        }
        if (XNM != 0) {
            float s2 = 0.f;
#pragma unroll
            for (int j = 0; j < 16; ++j) s2 += (h[j].x * h[j].x + h[j].y * h[j].y) + (h[j].z * h[j].z + h[j].w * h[j].w);
            const float r2 = 1.f / sqrtf(wave_sum(s2) * (1.f / DM) + RMS_EPS);
            if (XNM == 1) {
                GAS v2u* o8 = (GAS v2u*)(xn + (size_t)m * DM) + F.lane;
#pragma unroll
                for (int j = 0; j < 16; ++j) { const f32x4 g = ((const GAS f32x4*)gb)[64 * j + F.lane]; const f32x4 v = h[j] * r2 * g;
                    v2u w; w.x = pk2(v.x, v.y); w.y = pk2(v.z, v.w); o8[64 * j] = w; }
            } else {
                float am = 0.f;
#pragma unroll
                for (int j = 0; j < 16; ++j) { const f32x4 g = ((const GAS f32x4*)gb)[64 * j + F.lane]; h[j] = h[j] * r2 * g;
                    am = fmaxf(fmaxf(am, fmaxf(fabsf(h[j].x), fabsf(h[j].y))), fmaxf(fabsf(h[j].z), fabsf(h[j].w))); }
#pragma unroll
                for (int o = 1; o < 64; o <<= 1) am = fmaxf(am, __shfl_xor(am, o));
                am = fmaxf(am, 1e-20f);
                const float qs = 127.f / am;
                GAS unsigned char* o1 = (GAS unsigned char*)xn; GAS unsigned* o4 = (GAS unsigned*)(o1 + (size_t)m * DM) + F.lane;
#pragma unroll
                for (int j = 0; j < 16; ++j) { const int q0 = (int)rintf(h[j].x * qs), q1 = (int)rintf(h[j].y * qs), q2 = (int)rintf(h[j].z * qs), q3 = (int)rintf(h[j].w * qs);
                    const unsigned qw = (unsigned)(q0 & 255) | ((unsigned)(q1 & 255) << 8) | ((unsigned)(q2 & 255) << 16) | ((unsigned)q3 << 24);
                    if (XNM == 3) *(GAS unsigned*)(o1 + pg8::tm_chunk_off(m, 256 * j + 4 * F.lane, DM / 128, false)) = qw; else o4[64 * j] = qw; }
                if (F.lane == 0) sa[m] = am * (1.f / 127.f);
            }
        }
    }
}
template <bool TMW> __device__ __forceinline__ void p0_quant_rows(Frame& F, const bf16* WT, unsigned char* W8, float* sw, int rows) {
    const int gw = F.vcu * NWAVES + F.wave, NGW = F.G * NWAVES;
    for (int r = gw; r < rows; r += NGW) {
        const GAS v4u* src = (const GAS v4u*)(WT + (size_t)r * DM) + F.lane;
        v4u c[8]; float am = 0.f;
#pragma unroll
        for (int i = 0; i < 8; ++i) { c[i] = src[64 * i];
#pragma unroll
            for (int j = 0; j < 4; ++j) am = fmaxf(am, fmaxf(fabsf(bflo(c[i][j])), fabsf(bfhi(c[i][j])))); }
#pragma unroll
        for (int o = 1; o < 64; o <<= 1) am = fmaxf(am, __shfl_xor(am, o));
        am = fmaxf(am, 1e-30f);
        const float qs = 127.f / am;
        GAS v2u* dst = (GAS v2u*)(W8 + (size_t)r * DM) + F.lane;
#pragma unroll
        for (int i = 0; i < 8; ++i) { unsigned w[2];
#pragma unroll
            for (int hf = 0; hf < 2; ++hf) { const int q0 = (int)rintf(bflo(c[i][2 * hf]) * qs), q1 = (int)rintf(bfhi(c[i][2 * hf]) * qs), q2 = (int)rintf(bflo(c[i][2 * hf + 1]) * qs), q3 = (int)rintf(bfhi(c[i][2 * hf + 1]) * qs);
                w[hf] = (unsigned)(q0 & 255) | ((unsigned)(q1 & 255) << 8) | ((unsigned)(q2 & 255) << 16) | ((unsigned)q3 << 24); }
            if (TMW) *(GAS v2u*)(W8 + pg8::tm_chunk_off(r, 8 * (F.lane + 64 * i), DM / 128, true)) = (v2u){w[0], w[1]}; else dst[64 * i] = (v2u){w[0], w[1]}; }
        if (F.lane == 0) sw[r] = am * (1.f / 127.f);
    }
}
#define DPP_QUAD(x, ctrl) __builtin_bit_cast(float, __builtin_amdgcn_update_dpp(0, __builtin_bit_cast(int, (x)), (ctrl), 0xf, 0xf, true))
__device__ __forceinline__ void fwht8(float (&x)[8]) {
#pragma unroll
    for (int s = 1; s < 8; s <<= 1)
#pragma unroll
        for (int i = 0; i < 8; ++i) if (!(i & s)) { const float a = x[i], b = x[i + s]; x[i] = a + b; x[i + s] = a - b; }
}
__device__ __forceinline__ void fwht32_quad(float (&x)[8], int lane) {
    fwht8(x);
    const float s1 = (lane & 1) ? -1.f : 1.f, s2 = (lane & 2) ? -1.f : 1.f;
#pragma unroll
    for (int i = 0; i < 8; ++i) { const float p = DPP_QUAD(x[i], 0xB1); x[i] = p + s1 * x[i]; }
#pragma unroll
    for (int i = 0; i < 8; ++i) { const float p = DPP_QUAD(x[i], 0x4E); x[i] = (p + s2 * x[i]) * 0.17677669529663687f; }
}
template <int KL> __device__ __forceinline__ void p0_quant_wout(Frame& F, const bf16* WT, unsigned char* W8, float* sw) {
    const int gw = F.vcu * NWAVES + F.wave, NGW = F.G * NWAVES;
    constexpr int NCH = KL / 8, NI = (NCH + 63) / 64;
    for (int r = gw; r < DM; r += NGW) {
        const GAS v4u* src = (const GAS v4u*)(WT + (size_t)r * KL);
        v4u c[NI]; float am = 0.f;
#pragma unroll
        for (int i = 0; i < NI; ++i) { const int ch = F.lane + 64 * i; c[i] = (ch < NCH) ? src[ch] : (v4u){0u, 0u, 0u, 0u}; }
#pragma unroll
        for (int i = 0; i < NI; ++i) { float x[8];
#pragma unroll
            for (int j = 0; j < 4; ++j) { x[2 * j] = bflo(c[i][j]); x[2 * j + 1] = bfhi(c[i][j]); }
#if MK_FFO_ROT
            fwht32_quad(x, F.lane);
#endif
#pragma unroll
            for (int j = 0; j < 4; ++j) { c[i][j] = cvtpk(x[2 * j], x[2 * j + 1]); am = fmaxf(am, fmaxf(fabsf(bflo(c[i][j])), fabsf(bfhi(c[i][j])))); } }
#pragma unroll
        for (int o = 1; o < 64; o <<= 1) am = fmaxf(am, __shfl_xor(am, o));
        am = fmaxf(am, 1e-30f);
        const float qs = 127.f / am;
#pragma unroll
        for (int i = 0; i < NI; ++i) { const int ch = F.lane + 64 * i; unsigned w[2];
#pragma unroll
            for (int hf = 0; hf < 2; ++hf) { const int q0 = (int)rintf(bflo(c[i][2 * hf]) * qs), q1 = (int)rintf(bfhi(c[i][2 * hf]) * qs), q2 = (int)rintf(bflo(c[i][2 * hf + 1]) * qs), q3 = (int)rintf(bfhi(c[i][2 * hf + 1]) * qs);
                w[hf] = (unsigned)(q0 & 255) | ((unsigned)(q1 & 255) << 8) | ((unsigned)(q2 & 255) << 16) | ((unsigned)q3 << 24); }
            if (ch < NCH) *(GAS v2u*)(W8 + (size_t)r * KL + 8 * ch) = (v2u){w[0], w[1]}; }
        if (F.lane == 0) sw[r] = am * (1.f / 127.f);
    }
}
__device__ __forceinline__ void act_quant_rows(Frame& F, const bf16* ACTp, unsigned char* A8, const unsigned* rmax, float* sa2) {
    const int gw = F.vcu * NWAVES + F.wave, NGW = F.G * NWAVES;
    constexpr int NCH = DFF / 8, NI = (NCH + 63) / 64;
    for (int m = gw; m < M; m += NGW) {
        const float am = fmaxf(__builtin_bit_cast(float, rmax[m]), 1e-30f), qs = 127.f / am;
        const GAS v4u* src = (const GAS v4u*)(ACTp + (size_t)m * DFF);
#pragma unroll 11
        for (int i = 0; i < NI; ++i) { const int ch = F.lane + 64 * i; if (ch < NCH) { const v4u c = src[ch]; unsigned w[2];
#pragma unroll
            for (int hf = 0; hf < 2; ++hf) { const int q0 = (int)rintf(bflo(c[2 * hf]) * qs), q1 = (int)rintf(bfhi(c[2 * hf]) * qs), q2 = (int)rintf(bflo(c[2 * hf + 1]) * qs), q3 = (int)rintf(bfhi(c[2 * hf + 1]) * qs);
                w[hf] = (unsigned)(q0 & 255) | ((unsigned)(q1 & 255) << 8) | ((unsigned)(q2 & 255) << 16) | ((unsigned)q3 << 24); }
            *(GAS v2u*)(A8 + (size_t)m * DFF + 8 * ch) = (v2u){w[0], w[1]}; } }
        if (F.lane == 0) sa2[m] = am * (1.f / 127.f);
    }
}
constexpr int ST_PITCH = 8200, ST_K = 4096, ST_CM_OFF = RING_OFF + 16 * ST_PITCH;
__device__ __forceinline__ void strip_rot4(float (&v)[32]) {
#pragma unroll
    for (int g = 0; g < 4; ++g)
#pragma unroll
        for (int st = 1; st < 8; st <<= 1)
#pragma unroll
            for (int a = 0; a < 8; ++a) if (!(a & st)) { const float x = v[8 * g + a], y = v[8 * g + a + st]; v[8 * g + a] = x + y; v[8 * g + a + st] = x - y; }
#pragma unroll
    for (int g = 0; g < 4; ++g) {
        asm volatile("v_nop\n\tv_nop\n\tv_permlane16_swap_b32 %0, %1\n\tv_permlane16_swap_b32 %2, %3\n\tv_permlane16_swap_b32 %4, %5\n\tv_permlane16_swap_b32 %6, %7\n\ts_nop 1"
                     : "+v"(v[8 * g + 0]), "+v"(v[8 * g + 1]), "+v"(v[8 * g + 2]), "+v"(v[8 * g + 3]), "+v"(v[8 * g + 4]), "+v"(v[8 * g + 5]), "+v"(v[8 * g + 6]), "+v"(v[8 * g + 7]));
#pragma unroll
        for (int a = 0; a < 8; a += 2) { const float x = v[8 * g + a], y = v[8 * g + a + 1]; v[8 * g + a] = x + y; v[8 * g + a + 1] = x - y; }
        asm volatile("v_nop\n\tv_nop\n\tv_permlane32_swap_b32 %0, %2\n\tv_permlane32_swap_b32 %1, %3\n\tv_permlane32_swap_b32 %4, %6\n\tv_permlane32_swap_b32 %5, %7\n\ts_nop 1"
                     : "+v"(v[8 * g + 0]), "+v"(v[8 * g + 1]), "+v"(v[8 * g + 2]), "+v"(v[8 * g + 3]), "+v"(v[8 * g + 4]), "+v"(v[8 * g + 5]), "+v"(v[8 * g + 6]), "+v"(v[8 * g + 7]));
#pragma unroll
        for (int a = 0; a < 8; ++a) if (!(a & 2)) { const float x = v[8 * g + a], y = v[8 * g + a + 2]; v[8 * g + a] = x + y; v[8 * g + a + 2] = x - y; }
    }
}
__device__ __forceinline__ unsigned q8bits(float x, float qs) { return __builtin_bit_cast(unsigned, fmaf(x, qs, 12582912.f)) & 255u; }
constexpr size_t WS_FOMAX = WS_CTL + 256 * 1024, WS_FOCNT = WS_FOMAX + 32 * 1024;
__device__ __forceinline__ void strip_desc(const Frame& F, int s, const float*& p, int& N, int& kind, int& l, int& c0, int& b0, int& nb, int& cgl) {
    constexpr int S_FO = 3 * (DM / 16), S_FI = 2 * DFF / 16, S_HI = NHG / 16;
    int r = s; b0 = 0; nb = 32; cgl = 0;
    if (r < 2 * S_FO) { cgl = r / 3; const int part = r - 3 * cgl; l = cgl / (DM / 16); kind = 0; N = DM; p = F.w_ff_out + (size_t)l * DFF * DM; c0 = 16 * (cgl - l * (DM / 16));
        b0 = 29 * part; nb = (part == 2) ? 28 : 29; return; } r -= 2 * S_FO;
    if (r < 2 * S_FI) { l = r / S_FI; r -= l * S_FI; kind = 1; N = 2 * DFF; p = F.w_ff_in + (size_t)l * DM * 2 * DFF; c0 = 16 * r; return; } r -= 2 * S_FI;
    if (r < S_HI) { l = 0; kind = 2; N = NHG; p = F.w_hg_in; c0 = 16 * r; return; } r -= S_HI;
    l = 0; kind = 3; N = DM; p = F.w_hg_out; c0 = 16 * r;
}
template <int KL, int N, bool ROT, bool TMW, int MODE, bool SYNC3, bool PERMK>
__device__ __forceinline__ void p0_strip(Frame& F, float (&v)[32], const float* src, const float* nsrc, int nN, int c0, int b0, int nb, int cgl, unsigned char* W8, float* sw, int par) {
    LAS unsigned char* st = F.lds + RING_OFF;
    LAS float* cm = (LAS float*)(F.lds + ST_CM_OFF) + par * 128;
    const int n = F.lane & 15, kq = F.lane >> 4;
    float mx = 0.f;
#pragma unroll 1
    for (int blk = b0 + F.wave; blk < b0 + nb; blk += NWAVES) {
        float x[32];
#pragma unroll
        for (int i = 0; i < 32; ++i) x[i] = v[i];
        const bool last = blk + NWAVES >= b0 + nb;
        const float* q = last ? nsrc : src + (size_t)(128 * (blk + NWAVES)) * N;
        const size_t step = (size_t)4 * (last ? nN : N);
#pragma unroll
        for (int i = 0; i < 32; ++i) v[i] = MK_LD_W(q + i * step);
        if (ROT) strip_rot4(x);
        LAS unsigned short* d = (LAS unsigned short*)(st + n * ST_PITCH + 256 * (blk - b0)) + (!ROT ? kq : PERMK ? 4 * (kq >> 1) + 8 * (kq & 1) : 4 * kq);
#pragma unroll
        for (int i = 0; i < 32; i += 2) { const unsigned w = cvtpk(x[i], x[i + 1]); mx = fmaxf(mx, fmaxf(fabsf(x[i]), fabsf(x[i + 1])));
            const int r3 = (i >> 1) & 1, r4 = (i >> 2) & 1;
            if (ROT) *(LAS unsigned*)(d + 32 * (i >> 3) + (PERMK ? 2 * r4 + 16 * r3 : 2 * r3 + 16 * r4)) = w;
            else { d[4 * i] = (unsigned short)w; d[4 * i + 4] = (unsigned short)(w >> 16); } }
    }
    mx = fmaxf(mx, __shfl_xor(mx, 16)); mx = fmaxf(mx, __shfl_xor(mx, 32));
    if (F.lane < 16) cm[F.wave * 16 + n] = mx;
    __syncthreads();
    float am = 1e-30f;
#pragma unroll
    for (int w = 0; w < NWAVES; ++w) am = fmaxf(am, cm[w * 16 + n]);
    am = bflo(cvtpk(am, am));
    if (SYNC3) {
        unsigned* gmax = (unsigned*)(F.ws + WS_FOMAX) + cgl * 16; unsigned* cnt = (unsigned*)(F.ws + WS_FOCNT) + cgl;
        if (F.tid < 16) am = fmaxf(am, __builtin_bit_cast(float, __hip_atomic_fetch_max(gmax + n, __builtin_bit_cast(unsigned, am), __ATOMIC_RELAXED, __HIP_MEMORY_SCOPE_AGENT)));
        if (F.wave == 0) { asm volatile("s_waitcnt vmcnt(0)" ::: "memory");
            if (F.tid == 0) { (void)xb_add(cnt, 1u); unsigned sp = 0; while (xb_ld(cnt) < 3u && ++sp < (1u << 22)) __builtin_amdgcn_s_sleep(1); } }
        __syncthreads();
        am = fmaxf(am, __builtin_bit_cast(float, xb_ld(gmax + n)));
    }
    const float qs = 127.f / am;
    const int col = c0 + n; int R = col;
    if (MODE == 1) { const int c = (col < DFF) ? col : col - DFF; R = 256 * (c >> 7) + (c & 127) + ((col < DFF) ? 0 : 128); }
    if (MODE == 2) { const int s = col >> 12, cc = col & 4095, c64 = cc & 63; R = 256 * (cc >> 6) + 128 * (s >> 1) + 32 * (c64 >> 4) + 8 * ((c64 >> 2) & 3) + 4 * (s & 1) + (c64 & 3); }
#pragma unroll 2
    for (int t = 0; t < 8; ++t) {
        const int c = 4 * (F.wave + NWAVES * t) + kq;
        if (c < 8 * nb) {
            const LAS v2u* s2 = (const LAS v2u*)(st + n * ST_PITCH + 32 * c);
            unsigned w[4];
#pragma unroll
            for (int j = 0; j < 4; ++j) { const v2u u = s2[j];
                w[j] = q8bits(bflo(u.x), qs) | (q8bits(bfhi(u.x), qs) << 8) | (q8bits(bflo(u.y), qs) << 16) | (q8bits(bfhi(u.y), qs) << 24); }
            const int kb = 128 * b0 + 16 * c;
            if (TMW) *(GAS v4u*)(W8 + pg8::tm_chunk_off(R, kb, KL / 128, true)) = (v4u){w[0], w[1], w[2], w[3]};
            else *(GAS v4u*)(W8 + (size_t)R * KL + kb) = (v4u){w[0], w[1], w[2], w[3]};
        }
    }
    if (F.tid < 16 && b0 == 0) sw[R] = am * (ROT ? 0.17677669529663687f / 127.f : 1.f / 127.f);
    __syncthreads();
}
#ifndef MK_P0_DEFER
#define MK_P0_DEFER 0
#endif
constexpr int SX_FO = 3 * (DM / 16), SX_FI = 2 * DFF / 16, SX_HI = NHG / 16, SX_HO = DM / 16, SX_ALL = 2 * SX_FO + 2 * SX_FI + SX_HI + SX_HO;
constexpr int DEF_FI = MK_P0_DEFER ? 640 : 0, DEF_FO = MK_P0_DEFER ? 213 : 0;
static_assert(DEF_FI <= SX_FI && 3 * DEF_FO <= SX_FO, "deferred strip counts");
__device__ __forceinline__ int strip_full_index(int lst, int j) {
    if (lst == 3) return j;
    if (lst == 4) return 2 * SX_FO + j;
    if (lst == 1) return 2 * SX_FO + SX_FI + j;
    if (lst == 2) return SX_FO + j;
    if (j < SX_FO) return j;
    j -= SX_FO; if (j < SX_FO - 3 * DEF_FO) return SX_FO + 3 * DEF_FO + j;
    j -= SX_FO - 3 * DEF_FO; if (j < SX_FI) return 2 * SX_FO + j;
    j -= SX_FI; if (j < SX_FI - DEF_FI) return 2 * SX_FO + SX_FI + DEF_FI + j;
    j -= SX_FI - DEF_FI; return 2 * SX_FO + 2 * SX_FI + j;
}
template <int LST> __device__ __forceinline__ void run_strips(Frame& F, int j0, int jstep) {
    constexpr int CNT = LST == 0 ? SX_ALL - 3 * DEF_FO - DEF_FI : LST == 1 ? DEF_FI : LST == 2 ? 3 * DEF_FO : LST == 3 ? 2 * SX_FO : SX_ALL - 2 * SX_FO;
    const int n = F.lane & 15, kq = F.lane >> 4;
    int j = j0, par = 0;
    if (j < 0 || j >= CNT) return;
    const float* p; int N, kind, l, c0, b0, nb, cgl;
    strip_desc(F, strip_full_index(LST, j), p, N, kind, l, c0, b0, nb, cgl);
    const float* src = p + (size_t)kq * N + c0 + n;
    float v[32];
    { const float* q = src + (size_t)(128 * (b0 + F.wave)) * N; const size_t step = (size_t)4 * N;
#pragma unroll
      for (int i = 0; i < 32; ++i) v[i] = MK_LD_W(q + i * step); }
#pragma unroll 1
    while (j < CNT) {
        const int jn = j + jstep;
        const float* pn; int Nn, kindn, ln, c0n, b0n, nbn, cgln;
        strip_desc(F, strip_full_index(LST, jn < CNT ? jn : j), pn, Nn, kindn, ln, c0n, b0n, nbn, cgln);
        const float* srcn = pn + (size_t)kq * Nn + c0n + n;
        const float* nsrc = srcn + (size_t)(128 * (b0n + F.wave)) * Nn;
        if (LST != 1 && LST != 4 && kind == 0) p0_strip<DFF, DM, true, false, 0, true, true>(F, v, src, nsrc, Nn, c0, b0, nb, cgl, F.ws + WS_W8O + l * W8O_STRIDE, (float*)(F.ws + WS_SWO) + l * DM, par);
        else if (LST != 2 && LST != 3 && kind == 1) p0_strip<DM, 2 * DFF, false, TM_FFI, 1, false, false>(F, v, src, nsrc, Nn, c0, 0, 32, 0, F.ws + WS_W8 + l * W8_STRIDE, (float*)(F.ws + WS_SW) + l * 2 * DFF, par);
        else if ((LST == 0 || LST == 4) && kind == 2) p0_strip<DM, NHG, false, false, 2, false, false>(F, v, src, nsrc, Nn, c0, 0, 32, 0, F.ws + WS_W8H, (float*)(F.ws + WS_SWH), par);
        else if (LST == 0 || LST == 4) p0_strip<DM, DM, true, false, 0, false, false>(F, v, src, nsrc, Nn, c0, 0, 32, 0, F.ws + WS_W8G, (float*)(F.ws + WS_SWG), par);
        j = jn; src = srcn; kind = kindn; l = ln; c0 = c0n; b0 = b0n; nb = nbn; cgl = cgln; par ^= 1;
    }
    asm volatile("s_waitcnt vmcnt(0)" ::: "memory");
    __syncthreads();
}
template <int LST> __device__ __forceinline__ void run_deferred_strips(Frame& F, int units) {
    if ((LST == 1 ? DEF_FI : 3 * DEF_FO) == 0) return;
    const int rem = units % F.G, bx = (int)blockIdx.x;
    asm volatile("s_waitcnt vmcnt(0)" ::: "memory"); __syncthreads();
    run_strips<LST>(F, rem == 0 ? bx : bx - rem, rem == 0 ? F.G : F.G - rem);
}
__device__ __forceinline__ void p0_prologue(Frame& F) {
    LAS float* scr = (LAS float*)(F.lds + RING_OFF + F.wave * 16384);
    const int gw = F.vcu * NWAVES + F.wave, NGW = F.G * NWAVES;
    constexpr int I0 = (DM / 64) * (NQKV / 32), I1 = (DATT / 64) * (DM / 32), I2 = (DM / 64) * (NHG / 32), I3 = (DM / 64) * (DM / 32), I4 = (DM / 64) * (2 * DFF / 32), I6 = (DFF / 64) * (DM / 32);
    constexpr int NITEMS = P0_STRIP ? I0 + I1 : I0 + I1 + I2 + I3 + 2 * I4 + 2 * I6;
    if (P0_STRIP) { if (P0_OVL) run_strips<3>(F, F.vcu, F.G); else run_strips<0>(F, F.vcu, F.G); }
    for (int it = gw; it < NITEMS; it += NGW) {
        int r = it;
        if (r < I0) { p0_transpose_item(F.w_att_in, DM, NQKV, (bf16*)(F.ws + WS_WATTI), 0, scr, r, F.lane); continue; } r -= I0;
        if (r < I1) { p0_transpose_item(F.w_att_out, DATT, DM, (bf16*)(F.ws + WS_WATTO), 0, scr, r, F.lane); continue; } r -= I1;
        if (r < I2) { p0_transpose_item(F.w_hg_in, DM, NHG, (bf16*)(F.ws + WS_WHGI), HG_FUSE ? 2 : 0, scr, r, F.lane); continue; } r -= I2;
        if (r < I3) { p0_transpose_item(F.w_hg_out, DM, DM, (bf16*)(F.ws + WS_WHGO), 0, scr, r, F.lane); continue; } r -= I3;
        if (r < 2 * I4) { const int l = r / I4; p0_transpose_item(F.w_ff_in + (size_t)l * DM * 2 * DFF, DM, 2 * DFF, (bf16*)(F.ws + WS_WFFI + l * WFFI_STRIDE), 1, scr, r - l * I4, F.lane); continue; } r -= 2 * I4;
        { const int l = r / I6; p0_transpose_item(F.w_ff_out + (size_t)l * DFF * DM, DFF, DM, (bf16*)(F.ws + WS_WFFO + l * WFFO_STRIDE), 0, scr, r - l * I6, F.lane); }
    }
    float* BT = (float*)(F.ws + WS_TAB); float* LB = (float*)(F.ws + WS_TAB + 65536);
    const int gt = blockIdx.x * (NWAVES * 64) + F.tid, NT = F.G * NWAVES * 64;
    for (int idx = gt; idx < 3 * 16 * 129; idx += NT) { const int g = idx / (16 * 129), rem = idx - g * 16 * 129, h = rem / 129, j = rem - h * 129;
        BT[idx] = F.rel_bias[t5_bucket(j << (2 * g)) * 48 + g * 16 + h]; }
    for (int c = gt; c < DM; c += NT) { const float l0 = F.lb_logits[c], l1 = F.lb_logits[DM + c]; LB[c] = 1.f / (1.f + expf(l0 - l1)); }
    norm_rows<false, ATT_I8 ? 2 : 1>(F, F.x, nullptr, nullptr, (bf16*)(F.ws + WS_XN), nullptr, F.gains, (float*)(F.ws + WS_SA));
}
__device__ __forceinline__ void attn_naive(Frame& F) {
    const int gw = F.vcu * NWAVES + F.wave, NGW = F.G * NWAVES;
    const bf16* QKV = (const bf16*)(F.ws + WS_QKV); bf16* MRG = (bf16*)(F.ws + WS_MRG); const float* BT = (const float*)(F.ws + WS_TAB);
    for (int item = gw; item < M * 16; item += NGW) {
        const int m = item >> 4, h = item & 15, t = m & (SEQ - 1);
        float mx = -1e30f, l = 0.f, a0 = 0.f, a1 = 0.f;
#pragma unroll 1
        for (int g = 0; g < 3; ++g) {
            const int sh = 2 * g;
            const unsigned qw = *(const GAS unsigned*)(QKV + (size_t)m * NQKV + g * 6144 + h * 128 + 2 * F.lane);
            const float q0 = bflo(qw) * QSCALE, q1 = bfhi(qw) * QSCALE;
            const int jmax = (t >> sh) < 128 ? (t >> sh) : 128;
            const float* bt = BT + (g * 16 + h) * 129;
#pragma unroll 1
            for (int j0 = 0; j0 <= jmax; j0 += 8) {
                unsigned kw[8], vw[8]; float bs[8];
#pragma unroll
                for (int u = 0; u < 8; ++u) { const int jj = (j0 + u) <= jmax ? (j0 + u) : jmax; const bf16* rp = QKV + (size_t)(m - (jj << sh)) * NQKV + g * 6144 + h * 128 + 2 * F.lane;
                    kw[u] = *(const GAS unsigned*)(rp + 2048); vw[u] = *(const GAS unsigned*)(rp + 4096); bs[u] = bt[jj]; }
                float s[8]; float cm = -INFINITY;
#pragma unroll
                for (int u = 0; u < 8; ++u) { s[u] = wave_sum(q0 * bflo(kw[u]) + q1 * bfhi(kw[u])) + bs[u]; if (j0 + u > jmax) s[u] = -INFINITY; cm = fmaxf(cm, s[u]); }
                const float mn = fmaxf(mx, cm), sc = __expf(mx - mn); l *= sc; a0 *= sc; a1 *= sc; mx = mn;
#pragma unroll
                for (int u = 0; u < 8; ++u) { const float p = __expf(s[u] - mn); l += p; a0 += p * bflo(vw[u]); a1 += p * bfhi(vw[u]); }
            }
        }
        const float inv = 1.f / l;
        *(GAS unsigned*)(MRG + (size_t)m * DATT + h * 128 + 2 * F.lane) = pk2(a0 * inv, a1 * inv);
    }
}
__device__ __forceinline__ void hgrn_naive(Frame& F) {
    if (blockIdx.x >= 64) return;
    const int b = blockIdx.x >> 5, h = blockIdx.x & 31;
    const bf16* HP = (const bf16*)(F.ws + WS_QKV); float* ORAW = (float*)(F.ws + WS_ACT); const float* LB = (const float*)(F.ws + WS_TAB + 65536);
    LAS f32x4* PRM = (LAS f32x4*)(F.lds);
    LAS float* VV = (LAS float*)(F.lds + 32768);
    LAS float* OP = (LAS float*)(F.lds + 32768 + 8192);
    const int e = F.tid & 127, qd = F.tid >> 7, ps = F.tid >> 6, pl = F.tid & 63;
    const float lb0 = LB[h * 128 + 2 * pl], lb1 = LB[h * 128 + 2 * pl + 1];
    float S[32];
#pragma unroll
    for (int d = 0; d < 32; ++d) S[d] = 0.f;
    unsigned qw, fw, iw;
#define HG_LOAD(n) do { const bf16* bp = HP + (size_t)(b * SEQ + (n) * 8 + ps) * NHG + h * 128 + 2 * pl; qw = *(const GAS unsigned*)bp; fw = *(const GAS unsigned*)(bp + 4096); iw = *(const GAS unsigned*)(bp + 8192); } while (0)
#define HG_WRITE(buf) do { const float f0 = bflo(fw), f1 = bfhi(fw), r0 = bflo(qw), r1 = bfhi(qw); \
        const float g0 = lb0 + (1.f - lb0) / (1.f + __expf(-f0)), g1 = lb1 + (1.f - lb1) / (1.f + __expf(-f1)); \
        const int o = ((buf) * 8 + ps) * 128 + 2 * pl; \
        PRM[o] = (f32x4){g0, 1.f - g0, r0 / (1.f + __expf(-r0)) * QSCALE, 0.f}; PRM[o + 1] = (f32x4){g1, 1.f - g1, r1 / (1.f + __expf(-r1)) * QSCALE, 0.f}; \
        VV[o] = bflo(iw); VV[o + 1] = bfhi(iw); } while (0)
    HG_LOAD(0); HG_WRITE(0); __syncthreads();
#pragma unroll 1
    for (int n = 0; n < SEQ / 8; ++n) {
        const int buf = n & 1;
        if (n + 1 < SEQ / 8) HG_LOAD(n + 1);
#pragma unroll 1
        for (int st = 0; st < 8; ++st) {
            const float v = VV[(buf * 8 + st) * 128 + e]; float o = 0.f;
#pragma unroll
            for (int dd = 0; dd < 32; ++dd) { const f32x4 P = PRM[(buf * 8 + st) * 128 + qd * 32 + dd]; S[dd] = P.x * S[dd] + P.y * v; o += P.z * S[dd]; }
            OP[(st * 4 + qd) * 128 + e] = o;
        }
        if (n + 1 < SEQ / 8) HG_WRITE(buf ^ 1);
        __syncthreads();
#pragma unroll
        for (int r = 0; r < 2; ++r) { const int idx = F.tid + 512 * r, st = idx >> 7, ee = idx & 127;
            const float sum = (OP[(st * 4 + 0) * 128 + ee] + OP[(st * 4 + 1) * 128 + ee]) + (OP[(st * 4 + 2) * 128 + ee] + OP[(st * 4 + 3) * 128 + ee]);
            ORAW[(size_t)(b * SEQ + n * 8 + st) * DM + h * 128 + ee] = sum; }
        __syncthreads();
    }
#undef HG_LOAD
#undef HG_WRITE
}
__device__ __forceinline__ void hgrn_gate(Frame& F) {
    const int gw = F.vcu * NWAVES + F.wave, NGW = F.G * NWAVES;
    const float* ORAW = (const float*)(F.ws + WS_ACT); const bf16* HP = (const bf16*)(F.ws + WS_QKV); bf16* OG = (bf16*)(F.ws + WS_OG);
    const f32x4 gn = *(const GAS f32x4*)(F.hg_gain + 4 * (F.lane & 31));
    for (int m = gw; m < M; m += NGW) {
        const GAS f32x4* orow = (const GAS f32x4*)(ORAW + (size_t)m * DM) + F.lane;
        const GAS v2u* grow = (const GAS v2u*)(HP + (size_t)m * NHG + 3 * DM) + F.lane;
        GAS v2u* o8 = (GAS v2u*)(OG + (size_t)m * DM) + F.lane;
#pragma unroll 4
        for (int j = 0; j < 16; ++j) {
            const f32x4 o = orow[64 * j]; const v2u gw2 = grow[64 * j];
            float ss = (o.x * o.x + o.y * o.y) + (o.z * o.z + o.w * o.w);
#pragma unroll
            for (int k = 1; k < 32; k <<= 1) ss += __shfl_xor(ss, k);
            const float rstd = 1.f / sqrtf(ss * (1.f / HD) + RMS_EPS);
            const float g0 = bflo(gw2.x), g1 = bfhi(gw2.x), g2 = bflo(gw2.y), g3 = bfhi(gw2.y);
            v2u w; w.x = pk2(o.x * rstd * gn.x * (g0 / (1.f + __expf(-g0))), o.y * rstd * gn.y * (g1 / (1.f + __expf(-g1))));
            w.y = pk2(o.z * rstd * gn.z * (g2 / (1.f + __expf(-g2))), o.w * rstd * gn.w * (g3 / (1.f + __expf(-g3))));
            o8[64 * j] = w;
        }
    }
}
typedef short v4i16_t __attribute__((ext_vector_type(4)));
constexpr int AT_K = 0, AT_KP = 128 * 272, AT_V = 2 * AT_KP, AT_VP = 128 * 288, AT_BT = AT_V + 2 * AT_VP, AT_END = AT_BT + 1024;
static_assert(AT_END <= LDSCTL_OFF, "attention LDS map");
constexpr size_t WS_AO = 2334 * MiB, WS_LSE = 2526 * MiB, WS_END2 = 2529 * MiB;
#define AT_ROW(row_, h_) (QKV_HM ? (size_t)(h_) * ((size_t)M * 128) + (size_t)(row_) * 128 : (size_t)(row_) * 2048 + (size_t)(h_) * 128)
__device__ __forceinline__ void attn_load_page(LAS unsigned char* L, int tid, const bf16* Kt, const bf16* Vt, int row0, int h, int slot) {
#pragma unroll
    for (int i = 0; i < 4; ++i) { const int chunk = tid + 512 * i, r = chunk >> 4, c = chunk & 15;
        const v4u kv = *(const GAS v4u*)(Kt + AT_ROW(row0 + r, h) + 8 * c); const v4u vv = *(const GAS v4u*)(Vt + AT_ROW(row0 + r, h) + 8 * c);
        *(LAS v4u*)(L + AT_K + slot * AT_KP + r * 272 + 16 * c) = kv; *(LAS v4u*)(L + AT_V + slot * AT_VP + r * 288 + 16 * c) = vv; }
}
__device__ __forceinline__ void attn_mfma(Frame& F) {
    const bf16* QKVp = (const bf16*)(F.ws + WS_QKV); bf16* AO = (bf16*)(F.ws + WS_AO); float* LSE = (float*)(F.ws + WS_LSE); const float* BT = (const float*)(F.ws + WS_TAB);
    LAS unsigned char* L = F.lds;
    const int w = F.wave, li = F.lane & 15, g4 = F.lane >> 4;
    const int per = (6144 + F.G - 1) / F.G, U0 = F.vcu * per, U1 = (U0 + per) < 6144 ? (U0 + per) : 6144;
    int prevU = -2;
    v4u pk[4], pv[4];
#define AT_DECODE(UU, gh_, qb_, g_, h_, q0_) const int gh_ = (UU) >> 7, qb_ = (UU) & 127, g_ = gh_ >> 4, h_ = gh_ & 15, q0_ = 128 * qb_
#define AT_PREFETCH(UU) do { AT_DECODE(UU, ghn, qbn, gn_, hn, q0n); (void)qbn; const bf16* Kn = QKVp + (size_t)(3 * gn_ + 1) * M * 2048; const bf16* Vn = Kn + (size_t)M * 2048; \
        _Pragma("unroll") for (int i = 0; i < 4; ++i) { const int chunk = F.tid + 512 * i, r = chunk >> 4, c = chunk & 15; \
            pk[i] = *(const GAS v4u*)(Kn + AT_ROW(q0n + r, hn) + 8 * c); pv[i] = *(const GAS v4u*)(Vn + AT_ROW(q0n + r, hn) + 8 * c); } \
        } while (0)
#define AT_QLOAD(UU) do { AT_DECODE(UU, ghq, qbq, gq_, hq, q0q); (void)qbq; const bf16* qp = QKVp + (size_t)(3 * gq_) * M * 2048 + AT_ROW(q0q + 16 * w + li, hq) + 8 * g4; \
        _Pragma("unroll") for (int ds = 0; ds < 4; ++ds) qf[ds] = *(const GAS bf16x8*)(qp + 32 * ds); } while (0)
    bf16x8 qf[4];
    if (U0 < U1) { AT_PREFETCH(U0); AT_QLOAD(U0); }
#pragma unroll 1
    for (int U = U0; U < U1; ++U) {
        const int gh = U >> 7, qb = U & 127, g = gh >> 4, h = gh & 15, sh = 2 * g, n = SEQ >> sh, q0 = 128 * qb, i0 = q0 & (n - 1);
        const bool first = (i0 == 0);
        const bf16* Qt = QKVp + (size_t)(3 * g) * M * 2048; const bf16* Kt = Qt + (size_t)M * 2048; const bf16* Vt = Kt + (size_t)M * 2048;
        __builtin_amdgcn_s_barrier(); asm volatile("" ::: "memory");
        if (U == U0 || qb == 0) { if (F.tid < 161) { const int rel = F.tid - 16; ((LAS float*)(L + AT_BT))[F.tid] = (rel >= 0 && rel <= 128) ? BT[gh * 129 + rel] : 0.f; } }
        if (first) { for (int i = F.tid; i < AT_VP / 16; i += NWAVES * 64) *(LAS v4u*)(L + AT_V + ((qb - 1) & 1) * AT_VP + 16 * i) = (v4u){0u, 0u, 0u, 0u}; }
        else if (prevU != U - 1) attn_load_page(L, F.tid, Kt, Vt, q0 - 128, h, (qb - 1) & 1);
#pragma unroll
        for (int i = 0; i < 4; ++i) { const int chunk = F.tid + 512 * i, r = chunk >> 4, c = chunk & 15;
            *(LAS v4u*)(L + AT_K + (qb & 1) * AT_KP + r * 272 + 16 * c) = pk[i]; *(LAS v4u*)(L + AT_V + (qb & 1) * AT_VP + r * 288 + 16 * c) = pv[i]; }
        prevU = U;
        LDS_WAIT(); __builtin_amdgcn_s_barrier(); asm volatile("" ::: "memory");
        { const int Un = (U + 1 < U1) ? U + 1 : U; AT_PREFETCH(Un); }
        f32x4 sc[9];
        __builtin_amdgcn_s_setprio(1);
#pragma unroll
        for (int blk = 0; blk < 9; ++blk) { const int kb = w + blk, slot = (qb - 1 + (kb >> 3)) & 1;
            const LAS unsigned char* kp = L + AT_K + slot * AT_KP + ((kb & 7) * 16 + li) * 272 + 16 * g4;
            f32x4 acc = (f32x4){0.f, 0.f, 0.f, 0.f};
#pragma unroll
            for (int ds = 0; ds < 4; ++ds) { const bf16x8 a = *(const LAS bf16x8*)(kp + 64 * ds); acc = __builtin_amdgcn_mfma_f32_16x16x32_bf16(a, qf[ds], acc, 0, 0, 0); }
            sc[blk] = acc; }
        __builtin_amdgcn_s_setprio(0);
        { const int Uq = (U + 1 < U1) ? U + 1 : U; AT_QLOAD(Uq); }
        const LAS float* bt = (const LAS float*)(L + AT_BT) + (16 + 128 + li - 4 * g4);
        const int ql = 16 * w + li, relmax = first ? (ql < 128 ? ql : 128) : 128;
        float mx = -INFINITY;
#pragma unroll
        for (int blk = 0; blk < 9; ++blk)
#pragma unroll
            for (int r = 0; r < 4; ++r) sc[blk][r] = sc[blk][r] * QSCALE + *(const volatile LAS float*)(bt - (16 * blk + r));
#pragma unroll
        for (int blk = 0; blk < 9; ++blk)
#pragma unroll
            for (int r = 0; r < 4; ++r) { const int rel = 128 + li - 16 * blk - 4 * g4 - r;
                const float s = (rel >= 0 && rel <= relmax) ? sc[blk][r] : -INFINITY; sc[blk][r] = s; mx = fmaxf(mx, s); }
        mx = fmaxf(mx, __shfl_xor(mx, 16)); mx = fmaxf(mx, __shfl_xor(mx, 32));
        float lsum = 0.f;
#pragma unroll
        for (int blk = 0; blk < 9; ++blk)
#pragma unroll
            for (int r = 0; r < 4; ++r) { const float p = __expf(sc[blk][r] - mx); sc[blk][r] = p; lsum += p; }
        lsum += __shfl_xor(lsum, 16); lsum += __shfl_xor(lsum, 32);
        f32x4 o[8];
#pragma unroll
        for (int db = 0; db < 8; ++db) o[db] = (f32x4){0.f, 0.f, 0.f, 0.f};
        __builtin_amdgcn_s_setprio(1);
#pragma unroll
        for (int st = 0; st < 5; ++st) {
            const int ba = 2 * st, bb = (2 * st + 1) < 9 ? (2 * st + 1) : 8;
            v4u pw; pw.x = cvtpk(sc[ba][0], sc[ba][1]); pw.y = cvtpk(sc[ba][2], sc[ba][3]);
            if (2 * st + 1 < 9) { pw.z = cvtpk(sc[bb][0], sc[bb][1]); pw.w = cvtpk(sc[bb][2], sc[bb][3]); } else { pw.z = 0u; pw.w = 0u; }
            const bf16x8 pf = __builtin_bit_cast(bf16x8, pw);
            const int kba = w + ba, kbb = w + bb;
            const LAS unsigned char* va = L + AT_V + ((qb - 1 + (kba >> 3)) & 1) * AT_VP + ((kba & 7) * 16 + 4 * g4 + (li >> 2)) * 288 + 8 * (li & 3);
            const LAS unsigned char* vb = L + AT_V + ((qb - 1 + (kbb >> 3)) & 1) * AT_VP + ((kbb & 7) * 16 + 4 * g4 + (li >> 2)) * 288 + 8 * (li & 3);
#pragma unroll
            for (int db = 0; db < 8; ++db) {
                const v4i16_t lo = __builtin_amdgcn_ds_read_tr16_b64_v4i16((LAS v4i16_t*)(va + 32 * db)), hi = __builtin_amdgcn_ds_read_tr16_b64_v4i16((LAS v4i16_t*)(vb + 32 * db));
                const bf16x8 a = __builtin_shufflevector(lo, hi, 0, 1, 2, 3, 4, 5, 6, 7);
                o[db] = __builtin_amdgcn_mfma_f32_16x16x32_bf16(a, pf, o[db], 0, 0, 0); }
        }
        __builtin_amdgcn_s_setprio(0);
        const float inv = 1.f / lsum;
        const size_t orow = (size_t)g * M + (size_t)(q0 + 16 * w + li);
        bf16* op = AO + orow * 2048 + h * 128 + 4 * g4;
#pragma unroll
        for (int db = 0; db < 8; ++db) *(GAS v2u*)(op + 16 * db) = (v2u){cvtpk(o[db][0] * inv, o[db][1] * inv), cvtpk(o[db][2] * inv, o[db][3] * inv)};
        if (g4 == 0) LSE[orow * 16 + h] = mx + __logf(lsum);
    }
#undef AT_PREFETCH
#undef AT_QLOAD
#undef AT_DECODE
}
__device__ __forceinline__ void attn_merge(Frame& F) {
    const int gw = F.vcu * NWAVES + F.wave, NGW = F.G * NWAVES;
    const bf16* AO = (const bf16*)(F.ws + WS_AO); const float* LSE = (const float*)(F.ws + WS_LSE); bf16* MRG = (bf16*)(F.ws + WS_MRG);
    for (int m = gw; m < M; m += NGW) {
        const int t = m & (SEQ - 1), bbase = m & ~(SEQ - 1);
        size_t rows[3];
#pragma unroll
        for (int g = 0; g < 3; ++g) { const int sh = 2 * g; rows[g] = (size_t)g * M + (size_t)(bbase + ((t & ((1 << sh) - 1)) << (13 - sh)) + (t >> sh)); }
#pragma unroll
        for (int k = 0; k < 4; ++k) {
            const int hd = (F.lane >> 4) + 4 * k, c = F.lane + 64 * k;
            const float l0 = LSE[rows[0] * 16 + hd], l1 = LSE[rows[1] * 16 + hd], l2 = LSE[rows[2] * 16 + hd];
            const float mx = fmaxf(l0, fmaxf(l1, l2)); float w0 = __expf(l0 - mx), w1 = __expf(l1 - mx), w2 = __expf(l2 - mx); const float inv = 1.f / (w0 + w1 + w2); w0 *= inv; w1 *= inv; w2 *= inv;
            const v4u a = *(const GAS v4u*)(AO + rows[0] * 2048 + 8 * c), b = *(const GAS v4u*)(AO + rows[1] * 2048 + 8 * c), d = *(const GAS v4u*)(AO + rows[2] * 2048 + 8 * c);
            v4u o;
#pragma unroll
            for (int j = 0; j < 4; ++j) o[j] = cvtpk(w0 * bflo(a[j]) + w1 * bflo(b[j]) + w2 * bflo(d[j]), w0 * bfhi(a[j]) + w1 * bfhi(b[j]) + w2 * bfhi(d[j]));
            *(GAS v4u*)(MRG + (size_t)m * DATT + 8 * c) = o;
        }
    }
}
typedef float f32x16 __attribute__((ext_vector_type(16)));
typedef short s16x4 __attribute__((ext_vector_type(4)));
constexpr int HG_QR = 0, HG_QD = 17408, HG_KR = 34816, HG_KRT = 52224, HG_VT = 70656, HG_ST0 = 75264, HG_ST1 = 83968, HG_SEG = 92672, HG_EL = 96768, HG_DEC = 97280, HG_END = 97792;
static_assert(HG_END <= RING_BYTES, "hgrn LDS map");
__device__ __forceinline__ void hgrn_mfma(Frame& F) {
    const bf16* HP = (const bf16*)(F.ws + WS_QKV); float* ORAW = (float*)(F.ws + WS_ACT); const float* LB = (const float*)(F.ws + WS_TAB + 65536);
    LAS unsigned char* L = F.lds;
    const int w = F.wave, cp = F.lane, l31 = F.lane & 31, hh = F.lane >> 5;
#pragma unroll 1
    for (int u = blockIdx.x; u < 256; u += F.G) {
        const int bh = u >> 2, e0 = (u & 3) * 32, b = bh >> 5, h = bh & 31;
        const float lb0 = LB[h * 128 + 2 * cp], lb1 = LB[h * 128 + 2 * cp + 1];
        const size_t rowbase = (size_t)b * SEQ;
        unsigned qraw[8], fraw[8], vraw[2];
#define HGM_LOAD(c) do { \
            _Pragma("unroll") for (int i = 0; i < 8; ++i) { const bf16* bp = HP + (rowbase + 64 * (c) + 8 * w + i) * NHG + h * 128 + 2 * cp; qraw[i] = *(const GAS unsigned*)bp; fraw[i] = *(const GAS unsigned*)(bp + 4096); } \
            _Pragma("unroll") for (int k = 0; k < 2; ++k) { const int vrow = (F.tid >> 4) + 32 * k; vraw[k] = *(const GAS unsigned*)(HP + (rowbase + 64 * (c) + vrow) * NHG + 8192 + h * 128 + e0 + 2 * (F.tid & 15)); } } while (0)
        f32x16 S;
#pragma unroll
        for (int i = 0; i < 16; ++i) S[i] = 0.f;
        for (int i = F.tid; i < 8704 / 4; i += NWAVES * 64) ((LAS unsigned*)(L + HG_ST0))[i] = 0u;
        HGM_LOAD(0);
#pragma unroll 1
        for (int c = 0; c < SEQ / 64; ++c) {
            float q[8][2], k[8][2], cs[8][2]; float run0 = 0.f, run1 = 0.f;
#pragma unroll
            for (int i = 0; i < 8; ++i) {
                const float f0 = bflo(fraw[i]), f1 = bfhi(fraw[i]), r0 = bflo(qraw[i]), r1 = bfhi(qraw[i]);
                const float g0 = lb0 + (1.f - lb0) * __builtin_amdgcn_rcpf(1.f + __expf(-f0)), g1 = lb1 + (1.f - lb1) * __builtin_amdgcn_rcpf(1.f + __expf(-f1));
                run0 += __logf(g0); run1 += __logf(g1); cs[i][0] = run0; cs[i][1] = run1;
                k[i][0] = 1.f - g0; k[i][1] = 1.f - g1;
                q[i][0] = r0 * __builtin_amdgcn_rcpf(1.f + __expf(-r0)) * QSCALE; q[i][1] = r1 * __builtin_amdgcn_rcpf(1.f + __expf(-r1)) * QSCALE;
            }
            { typedef float f32x2v __attribute__((ext_vector_type(2))); *(LAS f32x2v*)(L + HG_SEG + (w * 128 + 2 * cp) * 4) = (f32x2v){run0, run1}; }
            const unsigned v0 = vraw[0], v1 = vraw[1];
            LDS_WAIT(); __builtin_amdgcn_s_barrier(); asm volatile("" ::: "memory");
            float off0 = 0.f, off1 = 0.f, bref0 = 0.f, bref1 = 0.f, p0 = 0.f, p1 = 0.f;
#pragma unroll
            for (int s = 0; s < 8; ++s) { typedef float f32x2v __attribute__((ext_vector_type(2))); const f32x2v t = *(const LAS f32x2v*)(L + HG_SEG + (s * 128 + 2 * cp) * 4);
                if (s == w) { off0 = p0; off1 = p1; } p0 += t.x; p1 += t.y; if (s == 3) { bref0 = p0; bref1 = p1; } }
            const float er0 = __expf(bref0), er1 = __expf(bref1);
            unsigned krt0[4], krt1[4];
#pragma unroll
            for (int i = 0; i < 8; ++i) {
                const float e10 = __expf(cs[i][0] + off0 - bref0), e11 = __expf(cs[i][1] + off1 - bref1);
                const float qr0 = q[i][0] * e10, qr1 = q[i][1] * e11, kr0 = k[i][0] * __builtin_amdgcn_rcpf(e10), kr1 = k[i][1] * __builtin_amdgcn_rcpf(e11);
                const int ro = (8 * w + i) * 272 + 4 * cp;
                *(LAS unsigned*)(L + HG_QR + ro) = cvtpk(qr0, qr1);
                *(LAS unsigned*)(L + HG_QD + ro) = cvtpk(qr0 * er0, qr1 * er1);
                *(LAS unsigned*)(L + HG_KR + ro) = cvtpk(kr0, kr1);
                if (i & 1) { krt0[i >> 1] = cvtpk(k[i - 1][0] * __builtin_amdgcn_rcpf(__expf(cs[i - 1][0] + off0 - bref0)), kr0); krt1[i >> 1] = cvtpk(k[i - 1][1] * __builtin_amdgcn_rcpf(__expf(cs[i - 1][1] + off1 - bref1)), kr1); }
            }
            *(LAS v4u*)(L + HG_KRT + (2 * cp) * 144 + 16 * w) = (v4u){krt0[0], krt0[1], krt0[2], krt0[3]};
            *(LAS v4u*)(L + HG_KRT + (2 * cp + 1) * 144 + 16 * w) = (v4u){krt1[0], krt1[1], krt1[2], krt1[3]};
            if (w == 0) { typedef float f32x2v __attribute__((ext_vector_type(2)));
                *(LAS f32x2v*)(L + HG_EL + 8 * cp) = (f32x2v){__expf(p0 - bref0), __expf(p1 - bref1)}; *(LAS f32x2v*)(L + HG_DEC + 8 * cp) = (f32x2v){__expf(p0), __expf(p1)}; }
            { const int ee = 2 * (F.tid & 15), ss = F.tid >> 4;
                *(LAS unsigned short*)(L + HG_VT + ee * 144 + ss * 2) = (unsigned short)(v0 & 0xffffu); *(LAS unsigned short*)(L + HG_VT + (ee + 1) * 144 + ss * 2) = (unsigned short)(v0 >> 16);
                *(LAS unsigned short*)(L + HG_VT + ee * 144 + (ss + 32) * 2) = (unsigned short)(v1 & 0xffffu); *(LAS unsigned short*)(L + HG_VT + (ee + 1) * 144 + (ss + 32) * 2) = (unsigned short)(v1 >> 16); }
            if (c + 1 < SEQ / 64) HGM_LOAD(c + 1);
            LDS_WAIT(); __builtin_amdgcn_s_barrier(); asm volatile("" ::: "memory");
            const LAS unsigned char* stc = L + ((c & 1) ? HG_ST1 : HG_ST0);
            LAS unsigned char* stn = L + ((c & 1) ? HG_ST0 : HG_ST1);
            if (w < 2) {
                const int th = w;
                f32x16 Y;
#pragma unroll
                for (int i = 0; i < 16; ++i) Y[i] = 0.f;
#pragma unroll
                for (int kd = 0; kd < 8; ++kd) { const bf16x8 a = *(const LAS bf16x8*)(stc + l31 * 272 + (16 * kd + 8 * hh) * 2); const bf16x8 bq = *(const LAS bf16x8*)(L + HG_QD + (32 * th + l31) * 272 + (16 * kd + 8 * hh) * 2);
                    Y = __builtin_amdgcn_mfma_f32_32x32x16_bf16(a, bq, Y, 0, 0, 0); }
#pragma unroll
                for (int sb = 0; sb < 2; ++sb) { if (sb <= th) {
                    f32x16 X;
#pragma unroll
                    for (int i = 0; i < 16; ++i) X[i] = 0.f;
#pragma unroll
                    for (int kd = 0; kd < 8; ++kd) { const bf16x8 a = *(const LAS bf16x8*)(L + HG_KR + (32 * sb + l31) * 272 + (16 * kd + 8 * hh) * 2); const bf16x8 bq = *(const LAS bf16x8*)(L + HG_QR + (32 * th + l31) * 272 + (16 * kd + 8 * hh) * 2);
                        X = __builtin_amdgcn_mfma_f32_32x32x16_bf16(a, bq, X, 0, 0, 0); }
                    if (sb == th) {
#pragma unroll
                        for (int r = 0; r < 16; ++r) { const int s = (r & 3) + 8 * (r >> 2) + 4 * hh; if (s > l31) X[r] = 0.f; } }
#pragma unroll
                    for (int ks = 0; ks < 2; ++ks) {
                        const unsigned x0 = cvtpk(X[8 * ks + 0], X[8 * ks + 1]), x1 = cvtpk(X[8 * ks + 2], X[8 * ks + 3]), x2 = cvtpk(X[8 * ks + 4], X[8 * ks + 5]), x3 = cvtpk(X[8 * ks + 6], X[8 * ks + 7]);
                        const bf16x8 xb = __builtin_bit_cast(bf16x8, (v4u){x0, x1, x2, x3});
                        const v2u alo = *(const LAS v2u*)(L + HG_VT + l31 * 144 + (32 * sb + 16 * ks + 4 * hh) * 2), ahi = *(const LAS v2u*)(L + HG_VT + l31 * 144 + (32 * sb + 16 * ks + 8 + 4 * hh) * 2);
                        const bf16x8 a = __builtin_bit_cast(bf16x8, (v4u){alo.x, alo.y, ahi.x, ahi.y});
                        Y = __builtin_amdgcn_mfma_f32_32x32x16_bf16(a, xb, Y, 0, 0, 0); }
                } }
                float* orow = ORAW + (rowbase + 64 * c + 32 * th + l31) * DM + h * 128 + e0 + 4 * hh;
#pragma unroll
                for (int g = 0; g < 4; ++g) *(GAS f32x4*)(orow + 8 * g) = (f32x4){Y[4 * g], Y[4 * g + 1], Y[4 * g + 2], Y[4 * g + 3]};
            } else if (w >= 4) {
                const int dt = w - 4;
                f32x16 T;
#pragma unroll
                for (int i = 0; i < 16; ++i) T[i] = 0.f;
#pragma unroll
                for (int ks = 0; ks < 4; ++ks) { const bf16x8 a = *(const LAS bf16x8*)(L + HG_KRT + (32 * dt + l31) * 144 + (16 * ks + 8 * hh) * 2); const bf16x8 bv = *(const LAS bf16x8*)(L + HG_VT + l31 * 144 + (16 * ks + 8 * hh) * 2);
                    T = __builtin_amdgcn_mfma_f32_32x32x16_bf16(a, bv, T, 0, 0, 0); }
#pragma unroll
                for (int g = 0; g < 4; ++g) { const f32x4 dec = *(const LAS f32x4*)(L + HG_DEC + (32 * dt + 8 * g + 4 * hh) * 4), el = *(const LAS f32x4*)(L + HG_EL + (32 * dt + 8 * g + 4 * hh) * 4);
#pragma unroll
                    for (int i = 0; i < 4; ++i) S[4 * g + i] = dec[i] * S[4 * g + i] + el[i] * T[4 * g + i];
                    *(LAS v2u*)(stn + l31 * 272 + (32 * dt + 8 * g + 4 * hh) * 2) = (v2u){cvtpk(S[4 * g], S[4 * g + 1]), cvtpk(S[4 * g + 2], S[4 * g + 3])}; }
            }
        }
        LDS_WAIT(); __builtin_amdgcn_s_barrier(); asm volatile("" ::: "memory");
#undef HGM_LOAD
    }
}
__device__ __forceinline__ void hgrn_mfma2(Frame& F) {
    const bf16* QH = (const bf16*)(F.ws + WS_QKV); const bf16* FH = QH + (size_t)M * DM; const bf16* VH = FH + (size_t)M * DM; const bf16* KH = (const bf16*)(F.ws + WS_AO); bf16* ORAW = (bf16*)(F.ws + WS_ACT);
    LAS unsigned char* L = F.lds;
    const int w = F.wave, cp = F.lane, l31 = F.lane & 31, hh = F.lane >> 5, li = F.lane & 15, g4 = F.lane >> 4;
    typedef float f32x2v __attribute__((ext_vector_type(2)));
#pragma unroll 1
    for (int u = blockIdx.x; u < 256; u += F.G) {
        const int ux = u & 7, uy = u >> 3, bh = ux + 8 * (uy >> 2), e0 = (uy & 3) * 32, b = bh >> 5, h = bh & 31;
        const size_t rowbase = (size_t)b * SEQ;
        unsigned qn[8], fn[8], kn[8], vn[2];
        const bf16* pq = QH + ((size_t)bh * SEQ + 8 * w) * 128 + 2 * cp; const bf16* pf = FH + ((size_t)bh * SEQ + 8 * w) * 128 + 2 * cp; const bf16* pk = KH + ((size_t)bh * SEQ + 8 * w) * 128 + 2 * cp;
        const bf16* pv = VH + ((size_t)bh * SEQ + (F.tid >> 4)) * 128 + e0 + 2 * (F.tid & 15);
#define HG2_LOAD() do { \
            _Pragma("unroll") for (int i = 0; i < 8; ++i) { qn[i] = *(const GAS unsigned*)(pq + 128 * i); fn[i] = *(const GAS unsigned*)(pf + 128 * i); kn[i] = *(const GAS unsigned*)(pk + 128 * i); } \
            vn[0] = *(const GAS unsigned*)pv; vn[1] = *(const GAS unsigned*)(pv + 32 * 128); pq += 64 * 128; pf += 64 * 128; pk += 64 * 128; pv += 64 * 128; } while (0)
        f32x16 S;
#pragma unroll
        for (int i = 0; i < 16; ++i) S[i] = 0.f;
        for (int i = F.tid; i < 8704 / 4; i += NWAVES * 64) ((LAS unsigned*)(L + HG_ST0))[i] = 0u;
        HG2_LOAD();
#pragma unroll 1
        for (int c = 0; c < SEQ / 64; ++c) {
            float qf[8][2], kf[8][2], cs[8][2]; float run0 = 0.f, run1 = 0.f;
#pragma unroll
            for (int i = 0; i < 8; ++i) { qf[i][0] = bflo(qn[i]); qf[i][1] = bfhi(qn[i]); kf[i][0] = bflo(kn[i]); kf[i][1] = bfhi(kn[i]); run0 += bflo(fn[i]); run1 += bfhi(fn[i]); cs[i][0] = run0; cs[i][1] = run1; }
            const unsigned v0 = vn[0], v1 = vn[1];
            { const int back = (c + 1 < SEQ / 64) ? 0 : 64 * 128; pq -= back; pf -= back; pk -= back; pv -= back; }
            HG2_LOAD();
            *(LAS f32x2v*)(L + HG_SEG + (w * 128 + 2 * cp) * 4) = (f32x2v){run0, run1};
            LDS_WAIT(); __builtin_amdgcn_s_barrier(); asm volatile("" ::: "memory");
            float off0 = 0.f, off1 = 0.f, bref0 = 0.f, bref1 = 0.f, p0 = 0.f, p1 = 0.f;
#pragma unroll
            for (int s = 0; s < 8; ++s) { const f32x2v t = *(const LAS f32x2v*)(L + HG_SEG + (s * 128 + 2 * cp) * 4);
                if (s == w) { off0 = p0; off1 = p1; } p0 += t.x; p1 += t.y; if (s == 3) { bref0 = p0; bref1 = p1; } }
            const float er0 = __expf(bref0), er1 = __expf(bref1);
            off0 -= bref0; off1 -= bref1;
            float kr[8][2];
#pragma unroll
            for (int i = 0; i < 8; ++i) {
                const float e10 = __expf(cs[i][0] + off0), e11 = __expf(cs[i][1] + off1);
                const float qr0 = qf[i][0] * e10, qr1 = qf[i][1] * e11; kr[i][0] = kf[i][0] * __builtin_amdgcn_rcpf(e10); kr[i][1] = kf[i][1] * __builtin_amdgcn_rcpf(e11);
                const int ro = (8 * w + i) * 272 + 4 * cp;
                *(LAS unsigned*)(L + HG_QR + ro) = cvtpk(qr0, qr1);
                *(LAS unsigned*)(L + HG_QD + ro) = cvtpk(qr0 * er0, qr1 * er1);
                *(LAS unsigned*)(L + HG_KR + ro) = cvtpk(kr[i][0], kr[i][1]);
            }
            *(LAS v4u*)(L + HG_KRT + (2 * cp) * 144 + 16 * w) = (v4u){cvtpk(kr[0][0], kr[1][0]), cvtpk(kr[2][0], kr[3][0]), cvtpk(kr[4][0], kr[5][0]), cvtpk(kr[6][0], kr[7][0])};
            *(LAS v4u*)(L + HG_KRT + (2 * cp + 1) * 144 + 16 * w) = (v4u){cvtpk(kr[0][1], kr[1][1]), cvtpk(kr[2][1], kr[3][1]), cvtpk(kr[4][1], kr[5][1]), cvtpk(kr[6][1], kr[7][1])};
            if (w == 0) { *(LAS f32x2v*)(L + HG_EL + 8 * cp) = (f32x2v){__expf(p0 - bref0), __expf(p1 - bref1)}; *(LAS f32x2v*)(L + HG_DEC + 8 * cp) = (f32x2v){__expf(p0), __expf(p1)}; }
            { const int ee = 2 * (F.tid & 15), ss = F.tid >> 4;
                *(LAS unsigned short*)(L + HG_VT + ee * 144 + ss * 2) = (unsigned short)(v0 & 0xffffu); *(LAS unsigned short*)(L + HG_VT + (ee + 1) * 144 + ss * 2) = (unsigned short)(v0 >> 16);
                *(LAS unsigned short*)(L + HG_VT + ee * 144 + (ss + 32) * 2) = (unsigned short)(v1 & 0xffffu); *(LAS unsigned short*)(L + HG_VT + (ee + 1) * 144 + (ss + 32) * 2) = (unsigned short)(v1 >> 16); }
            LDS_WAIT(); __builtin_amdgcn_s_barrier(); asm volatile("" ::: "memory");
            const LAS unsigned char* stc = L + ((c & 1) ? HG_ST1 : HG_ST0);
            LAS unsigned char* stn = L + ((c & 1) ? HG_ST0 : HG_ST1);
            if (w < 4) {
                const int tq = w;
                f32x4 Y[2]; Y[0] = (f32x4){0.f, 0.f, 0.f, 0.f}; Y[1] = Y[0];
                bf16x8 bqr[4];
#pragma unroll
                for (int kd = 0; kd < 4; ++kd) { const bf16x8 bq = *(const LAS bf16x8*)(L + HG_QD + (16 * tq + li) * 272 + (32 * kd + 8 * g4) * 2); bqr[kd] = *(const LAS bf16x8*)(L + HG_QR + (16 * tq + li) * 272 + (32 * kd + 8 * g4) * 2);
#pragma unroll
                    for (int eb = 0; eb < 2; ++eb) { const bf16x8 a = *(const LAS bf16x8*)(stc + (16 * eb + li) * 272 + (32 * kd + 8 * g4) * 2); Y[eb] = __builtin_amdgcn_mfma_f32_16x16x32_bf16(a, bq, Y[eb], 0, 0, 0); } }
                f32x4 X[4];
#pragma unroll
                for (int sb = 0; sb < 4; ++sb) { f32x4 acc = (f32x4){0.f, 0.f, 0.f, 0.f};
                    if (sb <= tq) {
#pragma unroll
                        for (int kd = 0; kd < 4; ++kd) { const bf16x8 a = *(const LAS bf16x8*)(L + HG_KR + (16 * sb + li) * 272 + (32 * kd + 8 * g4) * 2); acc = __builtin_amdgcn_mfma_f32_16x16x32_bf16(a, bqr[kd], acc, 0, 0, 0); }
                        if (sb == tq) {
#pragma unroll
                            for (int r = 0; r < 4; ++r) if (4 * g4 + r > li) acc[r] = 0.f; } }
                    X[sb] = acc; }
#pragma unroll
                for (int pr = 0; pr < 2; ++pr) { if (2 * pr <= tq) {
                    const bf16x8 pf = __builtin_bit_cast(bf16x8, (v4u){cvtpk(X[2 * pr][0], X[2 * pr][1]), cvtpk(X[2 * pr][2], X[2 * pr][3]), cvtpk(X[2 * pr + 1][0], X[2 * pr + 1][1]), cvtpk(X[2 * pr + 1][2], X[2 * pr + 1][3])});
#pragma unroll
                    for (int eb = 0; eb < 2; ++eb) { const v2u alo = *(const LAS v2u*)(L + HG_VT + (16 * eb + li) * 144 + (32 * pr + 4 * g4) * 2), ahi = *(const LAS v2u*)(L + HG_VT + (16 * eb + li) * 144 + (32 * pr + 16 + 4 * g4) * 2);
                        const bf16x8 a = __builtin_bit_cast(bf16x8, (v4u){alo.x, alo.y, ahi.x, ahi.y}); Y[eb] = __builtin_amdgcn_mfma_f32_16x16x32_bf16(a, pf, Y[eb], 0, 0, 0); } } }
                bf16* orow = ORAW + (rowbase + 64 * c + 16 * tq + li) * DM + h * 128 + e0 + 4 * g4;
#pragma unroll
                for (int eb = 0; eb < 2; ++eb) *(GAS v2u*)(orow + 16 * eb) = (v2u){cvtpk(Y[eb][0], Y[eb][1]), cvtpk(Y[eb][2], Y[eb][3])};
            } else {
                const int dt = w - 4;
                f32x16 T;
#pragma unroll
                for (int i = 0; i < 16; ++i) T[i] = 0.f;
#pragma unroll
                for (int ks = 0; ks < 4; ++ks) { const bf16x8 a = *(const LAS bf16x8*)(L + HG_KRT + (32 * dt + l31) * 144 + (16 * ks + 8 * hh) * 2); const bf16x8 bv = *(const LAS bf16x8*)(L + HG_VT + l31 * 144 + (16 * ks + 8 * hh) * 2);
                    T = __builtin_amdgcn_mfma_f32_32x32x16_bf16(a, bv, T, 0, 0, 0); }
#pragma unroll
                for (int g = 0; g < 4; ++g) { const f32x4 dec = *(const LAS f32x4*)(L + HG_DEC + (32 * dt + 8 * g + 4 * hh) * 4), el = *(const LAS f32x4*)(L + HG_EL + (32 * dt + 8 * g + 4 * hh) * 4);
#pragma unroll
                    for (int i = 0; i < 4; ++i) S[4 * g + i] = dec[i] * S[4 * g + i] + el[i] * T[4 * g + i];
                    *(LAS v2u*)(stn + l31 * 272 + (32 * dt + 8 * g + 4 * hh) * 2) = (v2u){cvtpk(S[4 * g], S[4 * g + 1]), cvtpk(S[4 * g + 2], S[4 * g + 3])}; }
            }
        }
        LDS_WAIT(); __builtin_amdgcn_s_barrier(); asm volatile("" ::: "memory");
#undef HG2_LOAD
    }
}
__device__ __forceinline__ void hgrn_gate2(Frame& F) {
    const int gw = F.vcu * NWAVES + F.wave, NGW = F.G * NWAVES;
    const bf16* ORAW = (const bf16*)(F.ws + WS_ACT); const bf16* SG = (HG_FUSE == 2) ? (const bf16*)(F.ws + WS_AO) : (const bf16*)(F.ws + WS_QKV) + 3 * (size_t)M * DM; bf16* OG = (bf16*)(F.ws + WS_OG);
    const f32x4 gn = *(const GAS f32x4*)(F.hg_gain + 4 * (F.lane & 31));
    for (int m = gw; m < M; m += NGW) {
        const GAS v2u* orow = (const GAS v2u*)(ORAW + (size_t)m * DM) + F.lane;
        const GAS v2u* grow = (const GAS v2u*)(SG + (size_t)m * DM) + F.lane;
        GAS v2u* o8 = (GAS v2u*)(OG + (size_t)m * DM) + F.lane;
#pragma unroll 8
        for (int j = 0; j < 16; ++j) {
            const v2u ow = orow[64 * j], gw2 = grow[64 * j];
            const float o0 = bflo(ow.x), o1 = bfhi(ow.x), o2 = bflo(ow.y), o3 = bfhi(ow.y);
            float ss = (o0 * o0 + o1 * o1) + (o2 * o2 + o3 * o3);
#pragma unroll
            for (int k = 1; k < 32; k <<= 1) ss += __shfl_xor(ss, k);
            const float rstd = 1.f / sqrtf(ss * (1.f / HD) + RMS_EPS);
            float s0 = bflo(gw2.x), s1 = bfhi(gw2.x), s2 = bflo(gw2.y), s3 = bfhi(gw2.y);
            if (HG_FUSE == 2) { s0 *= __builtin_amdgcn_rcpf(1.f + __expf(-s0)); s1 *= __builtin_amdgcn_rcpf(1.f + __expf(-s1)); s2 *= __builtin_amdgcn_rcpf(1.f + __expf(-s2)); s3 *= __builtin_amdgcn_rcpf(1.f + __expf(-s3)); }
            v2u wv; wv.x = cvtpk(o0 * rstd * gn.x * s0, o1 * rstd * gn.y * s1); wv.y = cvtpk(o2 * rstd * gn.z * s2, o3 * rstd * gn.w * s3);
            o8[64 * j] = wv;
        }
    }
}

#define DPP_MOV(x, ctrl) __builtin_bit_cast(float, __builtin_amdgcn_update_dpp(0, __builtin_bit_cast(int, (x)), (ctrl), 0xf, 0xf, false))
__device__ __forceinline__ void hgrn_gate3(Frame& F) {
    const int gw = F.vcu * NWAVES + F.wave, NGW = F.G * NWAVES;
    const bf16* ORAW = (const bf16*)(F.ws + WS_ACT); const bf16* SG = (const bf16*)(F.ws + WS_AO); unsigned char* OG8 = (unsigned char*)(F.ws + WS_OG); float* sa3 = (float*)(F.ws + WS_SA3);
    const f32x4 gn = *(const GAS f32x4*)(F.hg_gain + 4 * (F.lane & 31));
    const float s1 = (F.lane & 1) ? -1.f : 1.f, s2 = (F.lane & 2) ? -1.f : 1.f, s4 = (F.lane & 4) ? -1.f : 1.f;
    for (int m = gw; m < M; m += NGW) {
        const GAS v2u* orow = (const GAS v2u*)(ORAW + (size_t)m * DM) + F.lane;
        const GAS v2u* grow = (const GAS v2u*)(SG + (size_t)m * DM) + F.lane;
        float v[16][4]; float am = 0.f;
#pragma unroll
        for (int j = 0; j < 16; ++j) {
            const v2u ow = orow[64 * j], gw2 = grow[64 * j];
            const float o0 = bflo(ow.x), o1 = bfhi(ow.x), o2 = bflo(ow.y), o3 = bfhi(ow.y);
            float ss = (o0 * o0 + o1 * o1) + (o2 * o2 + o3 * o3);
#pragma unroll
            for (int k = 1; k < 32; k <<= 1) ss += __shfl_xor(ss, k);
            const float rstd = 1.f / sqrtf(ss * (1.f / HD) + RMS_EPS);
            float g0 = bflo(gw2.x), g1 = bfhi(gw2.x), g2 = bflo(gw2.y), g3 = bfhi(gw2.y);
            g0 *= __builtin_amdgcn_rcpf(1.f + __expf(-g0)); g1 *= __builtin_amdgcn_rcpf(1.f + __expf(-g1)); g2 *= __builtin_amdgcn_rcpf(1.f + __expf(-g2)); g3 *= __builtin_amdgcn_rcpf(1.f + __expf(-g3));
            float x0 = o0 * rstd * gn.x * g0, x1 = o1 * rstd * gn.y * g1, x2 = o2 * rstd * gn.z * g2, x3 = o3 * rstd * gn.w * g3;
            { const unsigned a = cvtpk(x0, x1), b = cvtpk(x2, x3); x0 = bflo(a); x1 = bfhi(a); x2 = bflo(b); x3 = bfhi(b); }
            { const float a = x0 + x1, b = x0 - x1, c = x2 + x3, d = x2 - x3; x0 = a + c; x1 = b + d; x2 = a - c; x3 = b - d; }
            float x[4] = {x0, x1, x2, x3};
#pragma unroll
            for (int i = 0; i < 4; ++i) { const float p = DPP_QUAD(x[i], 0xB1); x[i] = p + s1 * x[i]; }
#pragma unroll
            for (int i = 0; i < 4; ++i) { const float p = DPP_QUAD(x[i], 0x4E); x[i] = p + s2 * x[i]; }
#pragma unroll
            for (int i = 0; i < 4; ++i) { const float pl = DPP_MOV(x[i], 0x104), pr = DPP_MOV(x[i], 0x114); const float p = (F.lane & 4) ? pr : pl; x[i] = (p + s4 * x[i]) * 0.17677669529663687f; }
#pragma unroll
            for (int i = 0; i < 4; ++i) { v[j][i] = x[i]; am = fmaxf(am, fabsf(x[i])); }
        }
#pragma unroll
        for (int o = 1; o < 64; o <<= 1) am = fmaxf(am, __shfl_xor(am, o));
        am = fmaxf(am, 1e-30f);
        const float qs = 127.f / am;
        GAS unsigned* o4 = (GAS unsigned*)(OG8 + (size_t)m * DM) + F.lane;
#pragma unroll
        for (int j = 0; j < 16; ++j) { const int q0 = (int)rintf(v[j][0] * qs), q1 = (int)rintf(v[j][1] * qs), q2 = (int)rintf(v[j][2] * qs), q3 = (int)rintf(v[j][3] * qs);
            o4[64 * j] = (unsigned)(q0 & 255) | ((unsigned)(q1 & 255) << 8) | ((unsigned)(q2 & 255) << 16) | ((unsigned)q3 << 24); }
        if (F.lane == 0) sa3[m] = am * (1.f / 127.f);
    }
}
constexpr int H4_OPB = 34816, H4_KR = 17408, H4_ED0 = 3 * H4_OPB, H4_EDB = 1536, H4_VS0 = H4_ED0 + 3 * H4_EDB, H4_VSB = 4096, H4_VT0 = H4_VS0 + 3 * H4_VSB, H4_VTB = 4608, H4_ST0 = H4_VT0 + 2 * H4_VTB, H4_STB = 8704, H4_END = H4_ST0 + 2 * H4_STB;
static_assert(H4_END <= LDSCTL_OFF, "hgrn4 LDS map");
constexpr size_t WS_H3QR = WS_QKV, WS_H3KR = WS_QKV + 136 * MiB, WS_H3VH = WS_QKV + 272 * MiB, WS_H3SG = WS_AO, WS_H3EL = WS_AO + 128 * MiB, WS_H3DEC = WS_AO + 132 * MiB, WS_H3ER = WS_AO + 136 * MiB;
static_assert(WS_H3VH + 128 * MiB <= WS_MRG && WS_H3ER + 4 * MiB + 512 <= WS_LSE, "hgrn4 workspace map");
__device__ __forceinline__ void hgrn_mfma3(Frame& F) {
    const char* TQR = (const char*)(F.ws + WS_H3QR); const char* TKR = (const char*)(F.ws + WS_H3KR);
    const bf16* VH = (const bf16*)(F.ws + WS_H3VH); const float* ELg = (const float*)(F.ws + WS_H3EL); const float* DECg = (const float*)(F.ws + WS_H3DEC); const float* ERg = (const float*)(F.ws + WS_H3ER);
    bf16* ORAW = (bf16*)(F.ws + WS_ACT);
    LAS unsigned char* L = F.lds;
    const int w = F.wave, li = F.lane & 15, g4 = F.lane >> 4;
#pragma unroll 1
    for (int u = blockIdx.x; u < 256; u += F.G) {
        const int ux = u & 7, uy = u >> 3, bh = ux + 8 * (uy >> 2), e0 = (uy & 3) * 32, b = bh >> 5, h = bh & 31;
        const size_t rowbase = (size_t)b * SEQ;
#define H4_DMA(cc, sl) do { const size_t cid_ = (size_t)bh * 128 + (cc); const size_t cidn_ = ((cc) + 1 < SEQ / 64) ? cid_ + 1 : cid_; LAS unsigned char* ob_ = L + (sl) * H4_OPB; LAS unsigned char* eb_ = L + H4_ED0 + (sl) * H4_EDB; \
            _Pragma("unroll") for (int i_ = 0; i_ < 5; ++i_) { const int k_ = 5 * w + i_; \
                if (k_ < 34) { const int t_ = (k_ >= 17) ? 1 : 0, q_ = k_ - 17 * t_; \
                    __builtin_amdgcn_global_load_lds((const unsigned*)((t_ ? TKR : TQR) + cid_ * 17408 + q_ * 1024 + F.lane * 16), (LAS unsigned*)(ob_ + t_ * H4_KR + q_ * 1024), 16, 0, 0); } \
                else { const int e_ = k_ - 34, ar_ = e_ >> 1; const float* sp_ = (ar_ == 0) ? (ELg + cid_ * 128) : (ar_ == 1) ? (DECg + cid_ * 128) : (ERg + cidn_ * 128); \
                    __builtin_amdgcn_global_load_lds((const unsigned*)(sp_ + (e_ & 1) * 64 + F.lane), (LAS unsigned*)(eb_ + ar_ * 512 + (e_ & 1) * 256), 4, 0, 0); } } \
            _Pragma("unroll") for (int i_ = 0; i_ < 2; ++i_) { const int p_ = 2 * w + i_; \
                __builtin_amdgcn_global_load_lds((const unsigned*)(VH + ((size_t)bh * SEQ + 64 * (cc) + 4 * p_ + (F.lane >> 4)) * 128 + e0 + 2 * (F.lane & 15)), (LAS unsigned*)(L + H4_VS0 + (sl) * H4_VSB + p_ * 256), 4, 0, 0); } } while (0)
        f32x4 S[2][2];
#pragma unroll
        for (int a = 0; a < 2; ++a)
#pragma unroll
            for (int c2 = 0; c2 < 2; ++c2) S[a][c2] = (f32x4){0.f, 0.f, 0.f, 0.f};
        for (int i = F.tid; i < H4_STB / 4; i += NWAVES * 64) ((LAS unsigned*)(L + H4_ST0))[i] = 0u;
        H4_DMA(0, 0); H4_DMA(1, 1);
        int sl = 0;
#pragma unroll 1
        for (int c = 0; c < SEQ / 64; ++c) {
            if (w < 4 && c >= 2) asm volatile("s_waitcnt vmcnt(11)" ::: "memory"); else asm volatile("s_waitcnt vmcnt(7)" ::: "memory");
            {
                const LAS unsigned char* vs = L + H4_VS0 + sl * H4_VSB; LAS unsigned char* vt = L + H4_VT0 + (c & 1) * H4_VTB;
                const int row = 8 * w + (F.lane >> 3), eq = 4 * (F.lane & 7);
                const v2u vv = *(const LAS v2u*)(vs + row * 64 + eq * 2);
                *(LAS unsigned short*)(vt + (eq + 0) * 144 + row * 2) = (unsigned short)(vv.x & 0xffffu); *(LAS unsigned short*)(vt + (eq + 1) * 144 + row * 2) = (unsigned short)(vv.x >> 16);
                *(LAS unsigned short*)(vt + (eq + 2) * 144 + row * 2) = (unsigned short)(vv.y & 0xffffu); *(LAS unsigned short*)(vt + (eq + 3) * 144 + row * 2) = (unsigned short)(vv.y >> 16); }
            LDS_WAIT(); __builtin_amdgcn_s_barrier(); asm volatile("" ::: "memory");
            { const int cn = (c + 2 < SEQ / 64) ? c + 2 : SEQ / 64 - 1; const int sn = (sl == 0) ? 2 : sl - 1;
              H4_DMA(cn, sn); }
            const LAS unsigned char* OB = L + sl * H4_OPB; const LAS unsigned char* VT = L + H4_VT0 + (c & 1) * H4_VTB;
            const LAS unsigned char* stc = L + H4_ST0 + (c & 1) * H4_STB;
            LAS unsigned char* stn = L + H4_ST0 + ((c + 1) & 1) * H4_STB;
            if (w < 4) {
                const int tq = w;
                f32x4 Y[2]; Y[0] = (f32x4){0.f, 0.f, 0.f, 0.f}; Y[1] = Y[0];
                bf16x8 bqr[4];
#pragma unroll
                for (int kd = 0; kd < 4; ++kd) { bqr[kd] = *(const LAS bf16x8*)(OB + (16 * tq + li) * 272 + (32 * kd + 8 * g4) * 2);
#pragma unroll
                    for (int eb = 0; eb < 2; ++eb) { const bf16x8 a = *(const LAS bf16x8*)(stc + (16 * eb + li) * 272 + (32 * kd + 8 * g4) * 2); Y[eb] = __builtin_amdgcn_mfma_f32_16x16x32_bf16(a, bqr[kd], Y[eb], 0, 0, 0); } }
                f32x4 X[4];
#pragma unroll
                for (int sb = 0; sb < 4; ++sb) { f32x4 acc = (f32x4){0.f, 0.f, 0.f, 0.f};
                    if (sb <= tq) {
#pragma unroll
                        for (int kd = 0; kd < 4; ++kd) { const bf16x8 a = *(const LAS bf16x8*)(OB + H4_KR + (16 * sb + li) * 272 + (32 * kd + 8 * g4) * 2); acc = __builtin_amdgcn_mfma_f32_16x16x32_bf16(a, bqr[kd], acc, 0, 0, 0); }
                        if (sb == tq) {
#pragma unroll
                            for (int r = 0; r < 4; ++r) if (4 * g4 + r > li) acc[r] = 0.f; } }
                    X[sb] = acc; }
#pragma unroll
                for (int pr = 0; pr < 2; ++pr) { if (2 * pr <= tq) {
                    const bf16x8 pf = __builtin_bit_cast(bf16x8, (v4u){cvtpk(X[2 * pr][0], X[2 * pr][1]), cvtpk(X[2 * pr][2], X[2 * pr][3]), cvtpk(X[2 * pr + 1][0], X[2 * pr + 1][1]), cvtpk(X[2 * pr + 1][2], X[2 * pr + 1][3])});
#pragma unroll
                    for (int eb = 0; eb < 2; ++eb) { const v2u alo = *(const LAS v2u*)(VT + (16 * eb + li) * 144 + (32 * pr + 4 * g4) * 2), ahi = *(const LAS v2u*)(VT + (16 * eb + li) * 144 + (32 * pr + 16 + 4 * g4) * 2);
                        const bf16x8 a = __builtin_bit_cast(bf16x8, (v4u){alo.x, alo.y, ahi.x, ahi.y}); Y[eb] = __builtin_amdgcn_mfma_f32_16x16x32_bf16(a, pf, Y[eb], 0, 0, 0); } } }
                bf16* orow = ORAW + (rowbase + 64 * c + 16 * tq + li) * DM + h * 128 + e0 + 4 * g4;
#pragma unroll
                for (int eb = 0; eb < 2; ++eb) *(GAS v2u*)(orow + 16 * eb) = (v2u){cvtpk(Y[eb][0], Y[eb][1]), cvtpk(Y[eb][2], Y[eb][3])};
            } else {
                const int dt = w - 4;
                const LAS float* ELs = (const LAS float*)(L + H4_ED0 + sl * H4_EDB); const LAS float* DECs = ELs + 128; const LAS float* ERs = ELs + 256;
#pragma unroll
                for (int dbl = 0; dbl < 2; ++dbl) { const int db = 2 * dt + dbl;
                    f32x4 T[2]; T[0] = (f32x4){0.f, 0.f, 0.f, 0.f}; T[1] = T[0];
#pragma unroll
                    for (int ks = 0; ks < 2; ++ks) {
                        const unsigned ka = (unsigned)(size_t)(OB + H4_KR + (32 * ks + 4 * g4 + (li >> 2)) * 272 + (16 * db + 4 * (li & 3)) * 2);
                        v2u lo, hi;
                        asm volatile("ds_read_b64_tr_b16 %0, %2\n\tds_read_b64_tr_b16 %1, %2 offset:4352\n\ts_waitcnt lgkmcnt(0)" : "=&v"(lo), "=&v"(hi) : "v"(ka) : "memory");
                        const bf16x8 a = __builtin_bit_cast(bf16x8, (v4u){lo.x, lo.y, hi.x, hi.y});
#pragma unroll
                        for (int eb = 0; eb < 2; ++eb) { const v2u blo = *(const LAS v2u*)(VT + (16 * eb + li) * 144 + (32 * ks + 4 * g4) * 2), bhi = *(const LAS v2u*)(VT + (16 * eb + li) * 144 + (32 * ks + 16 + 4 * g4) * 2);
                            const bf16x8 bv = __builtin_bit_cast(bf16x8, (v4u){blo.x, blo.y, bhi.x, bhi.y}); T[eb] = __builtin_amdgcn_mfma_f32_16x16x32_bf16(a, bv, T[eb], 0, 0, 0); } }
                    const f32x4 dec = *(const LAS f32x4*)(DECs + 16 * db + 4 * g4), el = *(const LAS f32x4*)(ELs + 16 * db + 4 * g4), er = *(const LAS f32x4*)(ERs + 16 * db + 4 * g4);
#pragma unroll
                    for (int eb = 0; eb < 2; ++eb) { S[dbl][eb] = dec * S[dbl][eb] + el * T[eb]; const f32x4 sv = S[dbl][eb] * er;
                        *(LAS v2u*)(stn + (16 * eb + li) * 272 + (16 * db + 4 * g4) * 2) = (v2u){cvtpk(sv[0], sv[1]), cvtpk(sv[2], sv[3])}; } }
            }
            sl = (sl == 2) ? 0 : sl + 1;
        }
        asm volatile("s_waitcnt vmcnt(0)" ::: "memory"); LDS_WAIT(); __builtin_amdgcn_s_barrier(); asm volatile("" ::: "memory");
#undef H4_DMA
    }
}
struct Args { const float* in[11]; float* out; unsigned char* ws; int ph_lo, ph_hi, li, pad; };
__global__ void __launch_bounds__(NWAVES * 64, 2) mega_fwd(Args args) {
    extern __shared__ __attribute__((aligned(16))) unsigned char lds[];
    Frame F;
    F.lds = (LAS unsigned char*)lds;
    F.MISC = (volatile LAS unsigned*)(F.lds + MISC_OFF);
    F.tid = threadIdx.x; F.lane = F.tid & 63; F.wave = __builtin_amdgcn_readfirstlane(F.tid >> 6);
    F.G = gridDim.x; { const int bx = blockIdx.x; F.vcu = (F.G % 8 == 0) ? (bx % 8) * (F.G / 8) + bx / 8 : bx; }
#define GRID_BAR(seam) do { if (N_LAUNCHES != 1) { if (F.tid == 0) __hip_atomic_store(F.ctl + CW_TMO, 0xBADBA0u | (unsigned)(seam), RLX_AGENT); } \
    else { xcd_barrier(bar); } } while (0)
    unsigned char* ws = args.ws; F.ws = ws;
    F.ctl = (gu32*)(ws + WS_CTL);
    F.x = args.in[0]; F.gains = args.in[1]; F.rel_bias = args.in[2]; F.w_att_in = args.in[3]; F.w_att_out = args.in[4]; F.w_hg_in = args.in[5];
    F.lb_logits = args.in[6]; F.hg_gain = args.in[7]; F.w_hg_out = args.in[8]; F.w_ff_in = args.in[9]; F.w_ff_out = args.in[10]; F.out = args.out;
    for (int u = F.tid; u < (LDS_BYTES - LDSCTL_OFF) / 4; u += NWAVES * 64) ((LAS unsigned*)(F.lds + LDSCTL_OFF))[u] = 0u;
    __syncthreads();
    XcdBarrier bar; bar.bar = (unsigned*)(F.ctl + CW_BAR); bar.x = 0; bar.st = nullptr;
    if (N_LAUNCHES == 1) bar = xcd_barrier_post((unsigned*)(F.ctl + CW_BAR), F.MISC + 8);

    const int lo = args.ph_lo, hi = args.ph_hi;
#define IN(k) (lo <= (k) && (k) < hi)
#define BOTH(k) (IN(k) && IN((k) + 1))
    bf16* const XN = (bf16*)(ws + WS_XN); bf16* const HB = (bf16*)(ws + WS_HB); bf16* const Y = (bf16*)(ws + WS_Y); bf16* const ACT = (bf16*)(ws + WS_ACT);

    if (IN(0)) { for (int rep_ = 0; rep_ < REP_P0; ++rep_) p0_prologue(F);
        if (FFN_I8 && !P0_STRIP) { GRID_BAR(18);
            for (int l = 0; l < 2; ++l) p0_quant_rows<TM_FFI>(F, (const bf16*)(ws + WS_WFFI + l * WFFI_STRIDE), ws + WS_W8 + l * W8_STRIDE, (float*)(ws + WS_SW) + l * 2 * DFF, 2 * DFF);
            if (HGO_I8) p0_quant_wout<DM>(F, (const bf16*)(ws + WS_WHGO), ws + WS_W8G, (float*)(ws + WS_SWG));
            if (FFO_I8) for (int l = 0; l < 2; ++l) p0_quant_wout<DFF>(F, (const bf16*)(ws + WS_WFFO + l * WFFO_STRIDE), ws + WS_W8O + l * W8O_STRIDE, (float*)(ws + WS_SWO) + l * DM);
            if (ATT_I8) p0_quant_rows<false>(F, (const bf16*)(ws + WS_WATTI), ws + WS_W8A, (float*)(ws + WS_SWA), NQKV);
            if (HG_I8) p0_quant_rows<false>(F, (const bf16*)(ws + WS_WHGI), ws + WS_W8H, (float*)(ws + WS_SWH), NHG); }
        if (BOTH(0)) GRID_BAR(0); }
    if (IN(1)) {
        pg8::StaticOrder S; S.init(M, NQKV, F.G, (int)blockIdx.x);
        pg8::Gemm g{XN, ATT_I8 ? (const bf16*)(ws + WS_W8A) : (const bf16*)(ws + WS_WATTI), M, NQKV, ATT_I8 ? DM / 2 : DM};
        pg8::EpiBf16T<ATT_I8> E{(bf16*)(ws + WS_QKV), ATTN_MFMA ? 2048 : NQKV, ATTN_MFMA ? 2048 : 0, ATTN_MFMA ? (size_t)M * 2048 : 0, ATTN_MFMA ? 1 : 0, (const float*)(ws + WS_SA), (const float*)(ws + WS_SWA), (ATTN_MFMA && QKV_HM) ? (size_t)M * 128 : (size_t)0};
        const bool ovl_first = ((int)blockIdx.x & 1) == 0;
        if (P0_STRIP && P0_OVL && ovl_first) run_strips<4>(F, F.vcu, F.G);
        pg8::gemm_phase<pg8::EpiBf16T<ATT_I8>, pg8::StaticOrder, PG8_ALIGN, PG8_SP2, ATT_I8>(F.lds + RING_OFF, g, S, E); if (REP_GEMM > 1) { pg8::gemm_phase<pg8::EpiBf16T<ATT_I8>, pg8::StaticOrder, PG8_ALIGN, PG8_SP2, ATT_I8>(F.lds + RING_OFF, g, S, E); }
        if (P0_STRIP && P0_OVL && !ovl_first) { asm volatile("s_waitcnt vmcnt(0)" ::: "memory"); __syncthreads(); run_strips<4>(F, F.vcu, F.G); }
        if (BOTH(1)) GRID_BAR(1);
    }
    if (IN(2)) { if (ATTN_MFMA) { for (int rep_ = 0; rep_ < REP_ATT; ++rep_) { attn_mfma(F); GRID_BAR(16); attn_merge(F); if (rep_ + 1 < REP_ATT) GRID_BAR(17); } } else attn_naive(F); if (BOTH(2)) GRID_BAR(2); }
    if (IN(3)) {
        pg8::Gemm g{(const bf16*)(ws + WS_MRG), (const bf16*)(ws + WS_WATTO), M, DM, DATT}; pg8::StaticOrder S; S.init(M, DM, F.G, (int)blockIdx.x);
        pg8::EpiBf16 E{Y, DM, 0, 0, 0, nullptr, nullptr};
        pg8::gemm_phase<pg8::EpiBf16, pg8::StaticOrder, PG8_ALIGN, PG8_SP2>(F.lds + RING_OFF, g, S, E); if (REP_GEMM > 1) { pg8::gemm_phase<pg8::EpiBf16, pg8::StaticOrder, PG8_ALIGN, PG8_SP2>(F.lds + RING_OFF, g, S, E); }
        if (BOTH(3)) GRID_BAR(3);
    }
    if (IN(4)) { for (int rep_ = 0; rep_ < REP_NORM; ++rep_) norm_rows<true, FFN_I8 ? (TM_FFI ? 3 : 2) : 1, false, true>(F, F.x, Y, HB, XN, F.gains + 1 * DM, F.gains + 2 * DM, (float*)(ws + WS_SA)); if (BOTH(4)) GRID_BAR(4); }
    if (IN(5)) {
        pg8::StaticOrder S; S.init(M, 2 * DFF, F.G, (int)blockIdx.x);
        if (FFN_I8) {
            pg8::Gemm g{XN, (const bf16*)(ws + WS_W8), M, 2 * DFF, DM / 2};
            if (FFO_I8) {
                pg8::EpiSwiGLU8R E{ACT, DFF, (const float*)(ws + WS_SA), (const float*)(ws + WS_SW) + 0, (unsigned*)(ws + WS_RMAX) + 0 * M};
                pg8::gemm_phase<pg8::EpiSwiGLU8R, pg8::StaticOrder, PG8_ALIGN, PG8_SP2, true, 1, 1, TM_FFI>(F.lds + RING_OFF, g, S, E);
                if (P0_STRIP) run_deferred_strips<1>(F, (M / 256) * (2 * DFF / 256));
            } else {
            pg8::EpiSwiGLU8 E{ACT, DFF, (const float*)(ws + WS_SA), (const float*)(ws + WS_SW) + 0, (bf16*)(ws + WS_QKV)};
                pg8::gemm_phase<pg8::EpiSwiGLU8, pg8::StaticOrder, PG8_ALIGN, PG8_SP2, true, KREP_FFI, EREP_FFI, TM_FFI, TCH_FFI, LT_FFI>(F.lds + RING_OFF, g, S, E); if (REP_GEMM > 1 || REP_FFI > 1) { pg8::gemm_phase<pg8::EpiSwiGLU8, pg8::StaticOrder, PG8_ALIGN, PG8_SP2, true, 1, 1, TM_FFI>(F.lds + RING_OFF, g, S, E); }
            }
        } else {
            pg8::Gemm g{XN, (const bf16*)(ws + WS_WFFI), M, 2 * DFF, DM};
            pg8::EpiSwiGLU E{ACT, DFF};
            pg8::gemm_phase<pg8::EpiSwiGLU, pg8::StaticOrder, PG8_ALIGN, PG8_SP2>(F.lds + RING_OFF, g, S, E); if (REP_GEMM > 1) { pg8::gemm_phase<pg8::EpiSwiGLU, pg8::StaticOrder, PG8_ALIGN, PG8_SP2>(F.lds + RING_OFF, g, S, E); }
        }
        if (BOTH(5)) GRID_BAR(5);
    }
    if (IN(6)) {
        pg8::StaticOrder S; S.init(M, DM, F.G, (int)blockIdx.x);
        if (FFO_I8) {
            act_quant_rows(F, ACT, ws + WS_ACT8, (const unsigned*)(ws + WS_RMAX) + 0 * M, (float*)(ws + WS_SA2));
            GRID_BAR(20);
            pg8::Gemm g{(const bf16*)(ws + WS_ACT8), (const bf16*)(ws + WS_W8O + 0 * W8O_STRIDE), M, DM, DFF / 2};
            pg8::EpiBf16T<true> E{Y, DM, 0, 0, 0, (const float*)(ws + WS_SA2), (const float*)(ws + WS_SWO) + 0 * DM};
            pg8::gemm_phase<pg8::EpiBf16T<true>, pg8::StaticOrder, PG8_ALIGN, PG8_SP2, true>(F.lds + RING_OFF, g, S, E);
        } else {
            pg8::Gemm g{ACT, (const bf16*)(ws + WS_WFFO), M, DM, DFF};
            pg8::EpiBf16 E{Y, DM, 0, 0, 0, nullptr, nullptr};
            pg8::gemm_phase<pg8::EpiBf16, pg8::StaticOrder, PG8_ALIGN, PG8_SP2>(F.lds + RING_OFF, g, S, E);
        }
        if (BOTH(6)) GRID_BAR(6);
    }
    if (IN(7)) { norm_rows<true, HG_I8 ? 2 : 1, true, true>(F, HB, Y, HB, XN, F.gains + 3 * DM, F.gains + 4 * DM, (float*)(ws + WS_SA)); if (BOTH(7)) GRID_BAR(7); }
    if (IN(8)) {
        pg8::StaticOrder S; S.init(M, NHG, F.G, (int)blockIdx.x);
        pg8::Gemm g{XN, HG_I8 ? (const bf16*)(ws + WS_W8H) : (const bf16*)(ws + WS_WHGI), M, NHG, HG_I8 ? DM / 2 : DM};
        if (HG_FUSE == 0) {
            pg8::EpiHgrn<HG_I8> E{(bf16*)(ws + WS_QKV), (bf16*)(ws + WS_AO), (const float*)(ws + WS_TAB + 65536), (const float*)(ws + WS_SA), (const float*)(ws + WS_SWH)};
            pg8::gemm_phase<pg8::EpiHgrn<HG_I8>, pg8::StaticOrder, PG8_ALIGN, PG8_SP2, HG_I8>(F.lds + RING_OFF, g, S, E);
        } else if (HG_FUSE == 1) {
            pg8::EpiHgrn2<HG_I8> E{(bf16*)(ws + WS_QKV), (bf16*)(ws + WS_AO), (const float*)(ws + WS_TAB + 65536), (const float*)(ws + WS_SA), (const float*)(ws + WS_SWH)};
            pg8::gemm_phase<pg8::EpiHgrn2<HG_I8>, pg8::StaticOrder, PG8_ALIGN, PG8_SP2, HG_I8>(F.lds + RING_OFF, g, S, E);
        } else {
            pg8::EpiHgrn3<HG_I8> E{(bf16*)(ws + WS_H3QR), (WS_H3KR - WS_H3QR) / 2, (WS_H3VH - WS_H3QR) / 2, (WS_H3SG - WS_H3QR) / 2, (float*)(ws + WS_H3EL), (float*)(ws + WS_H3DEC), (float*)(ws + WS_H3ER),
                                   (const float*)(ws + WS_TAB + 65536), (const float*)(ws + WS_SA), (const float*)(ws + WS_SWH)};
            pg8::gemm_phase<pg8::EpiHgrn3<HG_I8>, pg8::StaticOrder, PG8_ALIGN, PG8_SP2, HG_I8>(F.lds + RING_OFF, g, S, E);
            if (REP_P8 > 1) { pg8::gemm_phase<pg8::EpiHgrn3<HG_I8>, pg8::StaticOrder, PG8_ALIGN, PG8_SP2, HG_I8>(F.lds + RING_OFF, g, S, E); }
        }
        if (BOTH(8)) GRID_BAR(8);
    }
    if (IN(9)) { if (HG_FUSE == 2) { hgrn_mfma3(F); if (REP_HG > 1) hgrn_mfma3(F); } else { hgrn_mfma2(F); if (REP_HG > 1) hgrn_mfma2(F); } if (BOTH(9)) GRID_BAR(9); }
    if (IN(10)) { if (HGO_I8) hgrn_gate3(F); else { hgrn_gate2(F); if (REP_HG > 1) hgrn_gate2(F); } if (BOTH(10)) GRID_BAR(10); }
    if (IN(11)) {
        pg8::StaticOrder S; S.init(M, DM, F.G, (int)blockIdx.x);
        if (HGO_I8) {
            pg8::Gemm g{(const bf16*)(ws + WS_OG), (const bf16*)(ws + WS_W8G), M, DM, DM / 2};
            pg8::EpiBf16T<true> E{Y, DM, 0, 0, 0, (const float*)(ws + WS_SA3), (const float*)(ws + WS_SWG)};
            pg8::gemm_phase<pg8::EpiBf16T<true>, pg8::StaticOrder, PG8_ALIGN, PG8_SP2, true>(F.lds + RING_OFF, g, S, E);
        } else {
            pg8::Gemm g{(const bf16*)(ws + WS_OG), (const bf16*)(ws + WS_WHGO), M, DM, DM};
            pg8::EpiBf16 E{Y, DM, 0, 0, 0, nullptr, nullptr};
            pg8::gemm_phase<pg8::EpiBf16, pg8::StaticOrder, PG8_ALIGN, PG8_SP2>(F.lds + RING_OFF, g, S, E);
        }
        if (BOTH(11)) GRID_BAR(11);
    }
    if (IN(12)) { norm_rows<true, FFN_I8 ? (TM_FFI ? 3 : 2) : 1, true, true>(F, HB, Y, HB, XN, F.gains + 5 * DM, F.gains + 6 * DM, (float*)(ws + WS_SA)); if (BOTH(12)) GRID_BAR(12); }
    if (IN(13)) {
        pg8::StaticOrder S; S.init(M, 2 * DFF, F.G, (int)blockIdx.x);
        if (FFN_I8) {
            pg8::Gemm g{XN, (const bf16*)(ws + WS_W8 + W8_STRIDE), M, 2 * DFF, DM / 2};
            if (FFO_I8) {
                pg8::EpiSwiGLU8R E{ACT, DFF, (const float*)(ws + WS_SA), (const float*)(ws + WS_SW) + 2 * DFF, (unsigned*)(ws + WS_RMAX) + 1 * M};
                pg8::gemm_phase<pg8::EpiSwiGLU8R, pg8::StaticOrder, PG8_ALIGN, PG8_SP2, true, 1, 1, TM_FFI>(F.lds + RING_OFF, g, S, E);
                if (P0_STRIP) run_deferred_strips<2>(F, (M / 256) * (2 * DFF / 256));
            } else {
            pg8::EpiSwiGLU8 E{ACT, DFF, (const float*)(ws + WS_SA), (const float*)(ws + WS_SW) + 2 * DFF, (bf16*)(ws + WS_QKV)};
                pg8::gemm_phase<pg8::EpiSwiGLU8, pg8::StaticOrder, PG8_ALIGN, PG8_SP2, true, KREP_FFI, EREP_FFI, TM_FFI, TCH_FFI, LT_FFI>(F.lds + RING_OFF, g, S, E); if (REP_GEMM > 1 || REP_FFI > 1) { pg8::gemm_phase<pg8::EpiSwiGLU8, pg8::StaticOrder, PG8_ALIGN, PG8_SP2, true, 1, 1, TM_FFI>(F.lds + RING_OFF, g, S, E); }
            }
        } else {
            pg8::Gemm g{XN, (const bf16*)(ws + WS_WFFI + WFFI_STRIDE), M, 2 * DFF, DM};
            pg8::EpiSwiGLU E{ACT, DFF};
            pg8::gemm_phase<pg8::EpiSwiGLU, pg8::StaticOrder, PG8_ALIGN, PG8_SP2>(F.lds + RING_OFF, g, S, E); if (REP_GEMM > 1) { pg8::gemm_phase<pg8::EpiSwiGLU, pg8::StaticOrder, PG8_ALIGN, PG8_SP2>(F.lds + RING_OFF, g, S, E); }
        }
        if (BOTH(13)) GRID_BAR(13);
    }
    if (IN(14)) {
        pg8::StaticOrder S; S.init(M, DM, F.G, (int)blockIdx.x);
        if (FFO_I8) {
            act_quant_rows(F, ACT, ws + WS_ACT8, (const unsigned*)(ws + WS_RMAX) + 1 * M, (float*)(ws + WS_SA2));
            GRID_BAR(21);
            pg8::Gemm g{(const bf16*)(ws + WS_ACT8), (const bf16*)(ws + WS_W8O + 1 * W8O_STRIDE), M, DM, DFF / 2};
            pg8::EpiBf16T<true> E{Y, DM, 0, 0, 0, (const float*)(ws + WS_SA2), (const float*)(ws + WS_SWO) + 1 * DM};
            pg8::gemm_phase<pg8::EpiBf16T<true>, pg8::StaticOrder, PG8_ALIGN, PG8_SP2, true>(F.lds + RING_OFF, g, S, E);
        } else {
            pg8::Gemm g{ACT, (const bf16*)(ws + WS_WFFO + WFFO_STRIDE), M, DM, DFF};
            pg8::EpiBf16 E{Y, DM, 0, 0, 0, nullptr, nullptr};
            pg8::gemm_phase<pg8::EpiBf16, pg8::StaticOrder, PG8_ALIGN, PG8_SP2>(F.lds + RING_OFF, g, S, E);
        }
        if (BOTH(14)) GRID_BAR(14);
    }
    if (REP_BAR > 0) { for (int rb_ = 0; rb_ < REP_BAR; ++rb_) GRID_BAR(30); }
    if (IN(15)) { norm_rows<true, 0, true, false>(F, HB, Y, F.out, nullptr, F.gains + 7 * DM, nullptr); }
#undef IN
#undef BOTH
}

extern "C" void kernel_launch(void* const* d_in, const int* in_sizes, int n_in, void* d_out, int out_size, void* d_ws, size_t ws_size, hipStream_t stream) {
    static int grid = 0;
    if (grid == 0) {
        if (n_in != 11 || in_sizes[0] != M * DM || out_size != M * DM || ws_size < WS_END5) { fprintf(stderr, "kernel_launch: unexpected shapes (n_in %d, in0 %d, out %d, ws %zu, need %zu); nothing launched\n", n_in, n_in > 0 ? in_sizes[0] : -1, out_size, ws_size, (size_t)WS_END); grid = -1; return; }
        int dev = 0, cus = 0, per_cu = 0;
        if (hipGetDevice(&dev) != hipSuccess || hipDeviceGetAttribute(&cus, hipDeviceAttributeMultiprocessorCount, dev) != hipSuccess) { grid = -1; return; }
        if (hipFuncSetAttribute((const void*)mega_fwd, hipFuncAttributeMaxDynamicSharedMemorySize, LDS_BYTES) != hipSuccess) { fprintf(stderr, "kernel_launch: hipFuncSetAttribute failed\n"); grid = -1; return; }
        if (hipOccupancyMaxActiveBlocksPerMultiprocessor(&per_cu, (const void*)mega_fwd, NWAVES * 64, LDS_BYTES) != hipSuccess || per_cu < 1)
            fprintf(stderr, "kernel_launch: note: occupancy query reports %d workgroups per CU\n", per_cu);
        (void)hipGetLastError();
        grid = cus;
    }
    if (grid < 0) return;
    if (hipMemsetAsync((char*)d_ws + WS_CTL, 0, CTL_ZERO_BYTES, stream) != hipSuccess) { fprintf(stderr, "kernel_launch: hipMemsetAsync failed\n"); return; }
    Args a{};
    for (int i = 0; i < 11; ++i) a.in[i] = (const float*)d_in[i];
    a.out = (float*)d_out; a.ws = (unsigned char*)d_ws;
    for (int li = 0; li < N_LAUNCHES; ++li) {
        a.ph_lo = (N_LAUNCHES == 1) ? 0 : li; a.ph_hi = (N_LAUNCHES == 1) ? NPH : li + 1; a.li = li;
        hipLaunchKernelGGL(mega_fwd, dim3(grid), dim3(NWAVES * 64), LDS_BYTES, stream, a);
        const hipError_t le = hipPeekAtLastError();
        if (le != hipSuccess) { fprintf(stderr, "kernel_launch: launch %d failed: %s\n", li, hipGetErrorName(le)); break; }
    }
}
```

```cpp
#include <hip/hip_runtime.h>
#include <cstdio>
#include <cstdint>
#ifndef PG8_WGM
#define PG8_WGM 8
#endif
#ifndef MK_FFO_ROT
#define MK_FFO_ROT 1
#endif
namespace pg8 {
#define PG8_LAS __attribute__((address_space(3)))
typedef unsigned short bf16_t;
typedef short bf16x8 __attribute__((ext_vector_type(8)));
typedef float f32x4 __attribute__((ext_vector_type(4)));
typedef unsigned u32x4 __attribute__((ext_vector_type(4)));
constexpr int BM = 256, BK = 64, HALF = 128, HTB = HALF * BK * 2  , STAGE_BYTES = 8 * HTB, NXCD = 8, WGM = PG8_WGM;

__host__ __device__ __forceinline__ int lds_byte(int r, int c) { const int st = (r >> 4) * 2 + (c >> 5), rr = r & 15, cc = c & 31, ob = rr * 64 + cc * 2; return st * 1024 + (ob ^ (((ob >> 9) & 1) << 5)); }
__host__ __device__ __forceinline__ void stage_rc(int b, int& R, int& C) { const int st = b / 1024, sb = b % 1024, swz = sb ^ (((sb >> 9) & 1) << 5); R = (st >> 1) * 16 + swz / 64; C = (st & 1) * 32 + (swz % 64) / 2; }
__host__ __device__ __forceinline__ int perm32(int rho) { const int n = rho >> 4, i = rho & 15; return 8 * (i >> 2) + 4 * n + (i & 3); }

struct Unit { int pm, pn; };
struct Gemm { const bf16_t* A; const bf16_t* Bt; int M, N, K; };

struct StaticOrder {
    int nM, nN, nwg, G, c;
    __host__ __device__ void init(int M, int N, int G_, int c_) { nM = M / BM; nN = N / BM; nwg = nM * nN; G = G_; c = c_; }
    __host__ __device__ bool next(int i, Unit& u) const {
        const long L = (long)i * G + c; if (L >= nwg) return false;
        int wgid = (int)L; { const int q = nwg / NXCD, r = nwg % NXCD, xcd = wgid % NXCD, off = wgid / NXCD; wgid = (xcd < r ? xcd * (q + 1) : r * (q + 1) + (xcd - r) * q) + off; }
        const int nig = WGM * nN, gid = wgid / nig, fm = gid * WGM, gsz = (nM - fm) < WGM ? (nM - fm) : WGM;
        u.pm = fm + ((wgid % nig) % gsz); u.pn = (wgid % nig) / gsz; return true;
    }
    __device__ __forceinline__ void a_ready(const Unit&) const {}
    __device__ __forceinline__ void done(const Unit&) const {}
};

__device__ __forceinline__ unsigned cvt_pk_bf16(float lo, float hi) { unsigned r; asm volatile("v_cvt_pk_bf16_f32 %0, %1, %2" : "=v"(r) : "v"(lo), "v"(hi)); return r; }
typedef float f32x2 __attribute__((ext_vector_type(2)));
typedef int i32x4 __attribute__((ext_vector_type(4)));
template <bool I8> struct AccT { typedef f32x4 type; static __device__ __forceinline__ f32x4 zero() { return (f32x4){0.f, 0.f, 0.f, 0.f}; } };
template <> struct AccT<true> { typedef i32x4 type; static __device__ __forceinline__ i32x4 zero() { return (i32x4){0, 0, 0, 0}; } };
__device__ __forceinline__ f32x4 mma16(bf16x8 a, bf16x8 b, f32x4 c) { return __builtin_amdgcn_mfma_f32_16x16x32_bf16(a, b, c, 0, 0, 0); }
__device__ __forceinline__ i32x4 mma16(bf16x8 a, bf16x8 b, i32x4 c) { return __builtin_amdgcn_mfma_i32_16x16x64_i8(__builtin_bit_cast(i32x4, a), __builtin_bit_cast(i32x4, b), c, 0, 0, 0); }
__host__ __device__ __forceinline__ size_t tm_chunk_off(int r, int cb, int nt, bool perm) {
    const int p = r >> 8, rr = r & 255, half = rr >> 7; int R = rr & 127;
    if (perm) { const int x = R & 31; R = (R & ~31) + 16 * ((x >> 2) & 1) + 4 * (x >> 3) + (x & 3); }
    return ((size_t)(p * nt + (cb >> 7)) * 2 + half) * 16384 + (size_t)lds_byte(R, (cb & 127) >> 1) + (cb & 1);
}
#ifndef MK_ACT_NT
#define MK_ACT_NT 0
#endif
#ifndef MK_ST_SC1
#define MK_ST_SC1 0
#endif
__device__ __forceinline__ void st16nt(void* p, u32x4 v) {
#if MK_ACT_NT
    __builtin_nontemporal_store(v, (u32x4*)p);
#else
    *(u32x4*)p = v;
#endif
}
__device__ __forceinline__ void st16(void* p, u32x4 v) {
#if MK_ST_SC1
    asm volatile("global_store_dwordx4 %0, %1, off sc1\n\ts_nop 1" :: "v"(p), "v"(v) : "memory");
#else
    *(u32x4*)p = v;
#endif
}
__device__ __forceinline__ float silu_f(float x) { return x * __builtin_amdgcn_rcpf(1.0f + __expf(-x)); }
template <bool I8> struct EpiBf16T {
    static constexpr bool PERM = true, AFTER_DRAIN = false, LDS_SCALES = I8, LDS_EXTRA = false;
    __device__ __forceinline__ const float* scale_src(const Unit& u, int t) const { return (t < 256) ? sa + u.pm * BM + t : sw + u.pn * BM + (t - 256); }
    bf16_t* O; int ldc; int split_cols; size_t split_stride; int dil; const float* sa; const float* sw;
    size_t hm = 0;
    __device__ __forceinline__ void operator()(const typename AccT<I8>::type (&acc)[2][2][4][2], const Unit& u, int wr, int wc, int fr, int fq, const PG8_LAS float* sc = nullptr) const {
        const int row0 = u.pm * BM + wr * 64 + fr; int colt = u.pn * BM; bf16_t* base = O; int sh = 0;
        if (split_cols) { const int t = colt / split_cols; base += (size_t)t * split_stride; colt -= t * split_cols; if (dil) sh = 2 * (t / 3); }
        const int col0 = colt + wc * 32 + 8 * fq;
        f32x4 swv[2][2];
#pragma unroll
        for (int bj = 0; bj < 2; ++bj)
#pragma unroll
            for (int n = 0; n < 2; ++n) { if constexpr (I8) swv[bj][n] = *(const PG8_LAS f32x4*)(sc + 256 + wc * 32 + 8 * fq + bj * HALF + 4 * n); else swv[bj][n] = (f32x4){1.f, 1.f, 1.f, 1.f}; }
#pragma unroll
        for (int ai = 0; ai < 2; ++ai)
#pragma unroll
            for (int m = 0; m < 4; ++m) { int r = row0 + ai * HALF + m * 16; float sr = 1.f; if constexpr (I8) sr = sc[wr * 64 + fr + ai * HALF + m * 16];
                if (sh) { const int tt = r & 8191; r = (r & ~8191) + ((tt & ((1 << sh) - 1)) << (13 - sh)) + (tt >> sh); }
                bf16_t* rowp = hm ? base + (size_t)(colt >> 7) * hm + (size_t)r * 128 + (col0 & 127) : base + (size_t)r * ldc + col0;
#pragma unroll
                for (int bj = 0; bj < 2; ++bj) { f32x4 v0, v1;
                    { if constexpr (I8) { v0 = __builtin_convertvector(acc[ai][bj][m][0], f32x4) * (swv[bj][0] * sr); v1 = __builtin_convertvector(acc[ai][bj][m][1], f32x4) * (swv[bj][1] * sr); } else { v0 = acc[ai][bj][m][0]; v1 = acc[ai][bj][m][1]; } }
                    u32x4 w; w.x = cvt_pk_bf16(v0[0], v0[1]); w.y = cvt_pk_bf16(v0[2], v0[3]); w.z = cvt_pk_bf16(v1[0], v1[1]); w.w = cvt_pk_bf16(v1[2], v1[3]);
                    st16(rowp + (hm ? (size_t)bj * hm : (size_t)(bj * HALF)), w); } }
    }
};
typedef EpiBf16T<false> EpiBf16;
struct EpiF32 {
    static constexpr bool PERM = false, AFTER_DRAIN = false, LDS_SCALES = false, LDS_EXTRA = false;
    float* C; int ldc;
    __device__ __forceinline__ void operator()(const f32x4 (&acc)[2][2][4][2], const Unit& u, int wr, int wc, int fr, int fq) const {
        const int row0 = u.pm * BM + wr * 64 + fr, col0 = u.pn * BM + wc * 32 + 4 * fq;
#pragma unroll
        for (int ai = 0; ai < 2; ++ai)
#pragma unroll
            for (int m = 0; m < 4; ++m) { float* rowp = C + (size_t)(row0 + ai * HALF + m * 16) * ldc + col0;
#pragma unroll
                for (int bj = 0; bj < 2; ++bj)
#pragma unroll
                    for (int n = 0; n < 2; ++n) *(f32x4*)(rowp + bj * HALF + n * 16) = acc[ai][bj][m][n]; }
    }
};
struct EpiSwiGLU {
    static constexpr bool PERM = true, AFTER_DRAIN = false, LDS_SCALES = false, LDS_EXTRA = false;
    bf16_t* O; int ldc;
    __device__ __forceinline__ void operator()(const f32x4 (&acc)[2][2][4][2], const Unit& u, int wr, int wc, int fr, int fq) const {
        const int row0 = u.pm * BM + wr * 64 + fr, col0 = u.pn * HALF + wc * 32 + 8 * fq;
#pragma unroll
        for (int ai = 0; ai < 2; ++ai)
#pragma unroll
            for (int m = 0; m < 4; ++m) { bf16_t* rowp = O + (size_t)(row0 + ai * HALF + m * 16) * ldc + col0;
                const f32x4 g0 = acc[ai][0][m][0], g1 = acc[ai][0][m][1], u0 = acc[ai][1][m][0], u1 = acc[ai][1][m][1];
                f32x4 v0, v1;
#pragma unroll
                for (int j = 0; j < 4; ++j) { v0[j] = silu_f(g0[j]) * u0[j]; v1[j] = silu_f(g1[j]) * u1[j]; }
                u32x4 w; w.x = cvt_pk_bf16(v0[0], v0[1]); w.y = cvt_pk_bf16(v0[2], v0[3]); w.z = cvt_pk_bf16(v1[0], v1[1]); w.w = cvt_pk_bf16(v1[2], v1[3]);
                st16(rowp, w); }
    }
};

template <bool I8> struct EpiHgrn {
    static constexpr bool PERM = true, AFTER_DRAIN = false, LDS_SCALES = false, LDS_EXTRA = false;
    bf16_t* base; bf16_t* KH; const float* lb; const float* sa; const float* sw;
    __device__ __forceinline__ void operator()(const typename AccT<I8>::type (&acc)[2][2][4][2], const Unit& u, int wr, int wc, int fr, int fq) const {
        const int row0 = u.pm * BM + wr * 64 + fr, sec = u.pn >> 4, cs0 = (u.pn & 15) * BM + wc * 32 + 8 * fq;
        f32x4 lbv[2][2], swv[2][2];
#pragma unroll
        for (int bj = 0; bj < 2; ++bj)
#pragma unroll
            for (int n = 0; n < 2; ++n) { lbv[bj][n] = (sec == 1) ? *(const f32x4*)(lb + cs0 + bj * HALF + 4 * n) : (f32x4){0.f, 0.f, 0.f, 0.f};
                swv[bj][n] = I8 ? *(const f32x4*)(sw + u.pn * BM + wc * 32 + 8 * fq + bj * HALF + 4 * n) : (f32x4){1.f, 1.f, 1.f, 1.f}; }
        bf16_t* const hm = base + (size_t)sec * ((size_t)16384 * 4096);
#pragma unroll
        for (int ai = 0; ai < 2; ++ai)
#pragma unroll
            for (int m = 0; m < 4; ++m) { const int r = row0 + ai * HALF + m * 16, bb = r >> 13, tt = r & 8191; const float sr = I8 ? sa[r] : 1.f;
#pragma unroll
                for (int bj = 0; bj < 2; ++bj) { f32x4 v[2]; u32x4 w;
#pragma unroll
                    for (int n = 0; n < 2; ++n)
#pragma unroll
                        for (int j = 0; j < 4; ++j) v[n][j] = I8 ? (float)acc[ai][bj][m][n][j] * (sr * swv[bj][n][j]) : (float)acc[ai][bj][m][n][j];
                    const size_t hoff = ((size_t)(bb * 32 + (u.pn & 15) * 2 + bj) * 8192 + tt) * 128 + wc * 32 + 8 * fq;
                    if (sec == 1) { f32x4 kk[2];
#pragma unroll
                        for (int n = 0; n < 2; ++n)
#pragma unroll
                            for (int j = 0; j < 4; ++j) { const float fg = lbv[bj][n][j] + (1.f - lbv[bj][n][j]) * __builtin_amdgcn_rcpf(1.0f + __expf(-v[n][j])); kk[n][j] = 1.f - fg; v[n][j] = __logf(fg); }
                        u32x4 kw; kw.x = cvt_pk_bf16(kk[0][0], kk[0][1]); kw.y = cvt_pk_bf16(kk[0][2], kk[0][3]); kw.z = cvt_pk_bf16(kk[1][0], kk[1][1]); kw.w = cvt_pk_bf16(kk[1][2], kk[1][3]);
                        st16(KH + hoff, kw);
                    } else if (sec == 0) {
#pragma unroll
                        for (int n = 0; n < 2; ++n)
#pragma unroll
                            for (int j = 0; j < 4; ++j) v[n][j] = silu_f(v[n][j]) * 0.08838834764831845f;
                    } else if (sec == 3) {
#pragma unroll
                        for (int n = 0; n < 2; ++n)
#pragma unroll
                            for (int j = 0; j < 4; ++j) v[n][j] = silu_f(v[n][j]);
                    }
                    w.x = cvt_pk_bf16(v[0][0], v[0][1]); w.y = cvt_pk_bf16(v[0][2], v[0][3]); w.z = cvt_pk_bf16(v[1][0], v[1][1]); w.w = cvt_pk_bf16(v[1][2], v[1][3]);
                    st16(hm + ((sec == 3) ? ((size_t)r * 4096 + cs0 + bj * HALF) : hoff), w); } }
    }
};
struct EpiSwiGLU8 {
    static constexpr bool PERM = true, AFTER_DRAIN = false, LDS_SCALES = false, LDS_EXTRA = false;
    bf16_t* O; int ldc; const float* sa; const float* sw; bf16_t* O2;
    __device__ __forceinline__ EpiSwiGLU8 alt() const { EpiSwiGLU8 e = *this; e.O = O2; return e; }
    __device__ __forceinline__ void operator()(const i32x4 (&acc)[2][2][4][2], const Unit& u, int wr, int wc, int fr, int fq) const {
        const int row0 = u.pm * BM + wr * 64 + fr, col0 = u.pn * HALF + wc * 32 + 8 * fq, brow0 = u.pn * BM + wc * 32 + 8 * fq;
        f32x4 sg[2], su[2];
#pragma unroll
        for (int n = 0; n < 2; ++n) { sg[n] = *(const f32x4*)(sw + brow0 + 4 * n); su[n] = *(const f32x4*)(sw + brow0 + HALF + 4 * n); }
#pragma unroll
        for (int ai = 0; ai < 2; ++ai)
#pragma unroll
            for (int m = 0; m < 4; ++m) { const int r = row0 + ai * HALF + m * 16; const float sr = sa[r]; bf16_t* rowp = O + (size_t)r * ldc + col0;
                f32x4 v[2];
#pragma unroll
                for (int n = 0; n < 2; ++n)
#pragma unroll
                    for (int j = 0; j < 4; ++j) { const float gt = (float)acc[ai][0][m][n][j] * (sr * sg[n][j]), up = (float)acc[ai][1][m][n][j] * (sr * su[n][j]); v[n][j] = silu_f(gt) * up; }
                u32x4 w; w.x = cvt_pk_bf16(v[0][0], v[0][1]); w.y = cvt_pk_bf16(v[0][2], v[0][3]); w.z = cvt_pk_bf16(v[1][0], v[1][1]); w.w = cvt_pk_bf16(v[1][2], v[1][3]);
                st16(rowp, w); }
    }
};

template <bool I8> struct EpiHgrn2 {
    static constexpr bool PERM = true, AFTER_DRAIN = false, LDS_SCALES = false, LDS_EXTRA = false;
    bf16_t* base; bf16_t* KH; const float* lb; const float* sa; const float* sw;
    __device__ __forceinline__ void operator()(const typename AccT<I8>::type (&acc)[2][2][4][2], const Unit& u, int wr, int wc, int fr, int fq) const {
        typedef unsigned u32x2 __attribute__((ext_vector_type(2)));
        const int row0 = u.pm * BM + wr * 64 + fr, head = u.pn >> 1, ch0 = 64 * (u.pn & 1) + 16 * wc + 4 * fq;
        const f32x4 lbv = *(const f32x4*)(lb + head * 128 + ch0);
        f32x4 swv[2][2];
#pragma unroll
        for (int bj = 0; bj < 2; ++bj)
#pragma unroll
            for (int n = 0; n < 2; ++n) swv[bj][n] = I8 ? *(const f32x4*)(sw + u.pn * BM + wc * 32 + 8 * fq + bj * HALF + 4 * n) : (f32x4){1.f, 1.f, 1.f, 1.f};
        const size_t MD = (size_t)16384 * 4096;
#pragma unroll
        for (int ai = 0; ai < 2; ++ai)
#pragma unroll
            for (int m = 0; m < 4; ++m) { const int r = row0 + ai * HALF + m * 16, bb = r >> 13, tt = r & 8191; const float sr = I8 ? sa[r] : 1.f;
                f32x4 v[2][2];
#pragma unroll
                for (int bj = 0; bj < 2; ++bj)
#pragma unroll
                    for (int n = 0; n < 2; ++n)
#pragma unroll
                        for (int j = 0; j < 4; ++j) v[bj][n][j] = I8 ? (float)acc[ai][bj][m][n][j] * (sr * swv[bj][n][j]) : (float)acc[ai][bj][m][n][j];
                const size_t hoff = ((size_t)(bb * 32 + head) * 8192 + tt) * 128 + ch0;
                f32x4 qv, lf, kk, sg;
#pragma unroll
                for (int j = 0; j < 4; ++j) { qv[j] = silu_f(v[0][0][j]) * 0.08838834764831845f;
                    const float fg = lbv[j] + (1.f - lbv[j]) * __builtin_amdgcn_rcpf(1.0f + __expf(-v[0][1][j])); kk[j] = 1.f - fg; lf[j] = __logf(fg); sg[j] = silu_f(v[1][1][j]); }
                *(u32x2*)(base + hoff) = (u32x2){cvt_pk_bf16(qv[0], qv[1]), cvt_pk_bf16(qv[2], qv[3])};
                *(u32x2*)(base + MD + hoff) = (u32x2){cvt_pk_bf16(lf[0], lf[1]), cvt_pk_bf16(lf[2], lf[3])};
                *(u32x2*)(KH + hoff) = (u32x2){cvt_pk_bf16(kk[0], kk[1]), cvt_pk_bf16(kk[2], kk[3])};
                *(u32x2*)(base + 2 * MD + hoff) = (u32x2){cvt_pk_bf16(v[1][0][0], v[1][0][1]), cvt_pk_bf16(v[1][0][2], v[1][0][3])};
                *(u32x2*)(base + 3 * MD + (size_t)r * 4096 + head * 128 + ch0) = (u32x2){cvt_pk_bf16(sg[0], sg[1]), cvt_pk_bf16(sg[2], sg[3])}; }
    }
};

#define PG8_DPP_SHR(x, n) __builtin_bit_cast(float, __builtin_amdgcn_update_dpp(0, __builtin_bit_cast(int, (x)), 0x110 + (n), 0xf, 0xf, false))
#define PG8_DPP_PERM(x, ctrl) __builtin_bit_cast(float, __builtin_amdgcn_update_dpp(0, __builtin_bit_cast(int, (x)), (ctrl), 0xf, 0xf, true))
__device__ __forceinline__ float row_sum16(float x) { x += PG8_DPP_PERM(x, 0x140); x += PG8_DPP_PERM(x, 0x141); x += PG8_DPP_PERM(x, 0xB1); x += PG8_DPP_PERM(x, 0x4E); return x; }
__device__ __forceinline__ float row_scan16(float x) { x += PG8_DPP_SHR(x, 1); x += PG8_DPP_SHR(x, 2); x += PG8_DPP_SHR(x, 4); x += PG8_DPP_SHR(x, 8); return x; }
#define PG8_SCAN_STEP(n) "v_add_f32_dpp %0, %0, %0 row_shr:" #n " row_mask:0xf bank_mask:0xf bound_ctrl:1\n\tv_add_f32_dpp %1, %1, %1 row_shr:" #n " row_mask:0xf bank_mask:0xf bound_ctrl:1\n\t" \
                         "v_add_f32_dpp %2, %2, %2 row_shr:" #n " row_mask:0xf bank_mask:0xf bound_ctrl:1\n\tv_add_f32_dpp %3, %3, %3 row_shr:" #n " row_mask:0xf bank_mask:0xf bound_ctrl:1\n\t"
__device__ __forceinline__ void row_scan16x4(float& a, float& b, float& c, float& d) {
    asm volatile("s_nop 1\n\t" PG8_SCAN_STEP(1) PG8_SCAN_STEP(2) PG8_SCAN_STEP(4) PG8_SCAN_STEP(8) : "+v"(a), "+v"(b), "+v"(c), "+v"(d));
}
__device__ __forceinline__ void row_addlast16x4(float& r0, float& r1, float& r2, float& r3, float i0, float i1, float i2, float i3) {
    asm volatile("s_nop 1\n\t"
                 "v_add_f32_dpp %0, %4, %0 row_newbcast:15 row_mask:0xf bank_mask:0xf\n\tv_add_f32_dpp %1, %5, %1 row_newbcast:15 row_mask:0xf bank_mask:0xf\n\t"
                 "v_add_f32_dpp %2, %6, %2 row_newbcast:15 row_mask:0xf bank_mask:0xf\n\tv_add_f32_dpp %3, %7, %3 row_newbcast:15 row_mask:0xf bank_mask:0xf"
                 : "+v"(r0), "+v"(r1), "+v"(r2), "+v"(r3) : "v"(i0), "v"(i1), "v"(i2), "v"(i3));
}
template <bool I8> struct EpiHgrn3 {
    static constexpr bool PERM = true, AFTER_DRAIN = false, LDS_SCALES = I8, LDS_EXTRA = I8;
    bf16_t* QR; size_t dKR, dVH, dSG;     float* EL; float* DEC; float* ER; const float* lb; const float* sa; const float* sw;
    __device__ __forceinline__ const float* scale_src(const Unit& u, int t) const { return (t < 256) ? sa + u.pm * BM + t : sw + u.pn * BM + (t - 256); }
    __device__ __forceinline__ const float* extra_src(const Unit& u, int t) const { return lb + (u.pn >> 1) * 128 + 64 * (u.pn & 1) + t; }
    __device__ __forceinline__ void operator()(const typename AccT<I8>::type (&acc)[2][2][4][2], const Unit& u, int wr, int wc, int fr, int fq, const PG8_LAS float* sc = nullptr) const {
        typedef unsigned u32x2 __attribute__((ext_vector_type(2)));
        const int lane = fr + 16 * fq, row0 = u.pm * BM + wr * 64 + fr, head = u.pn >> 1, ch0 = 64 * (u.pn & 1) + 16 * wc + 4 * fq;
        f32x4 lbv; if constexpr (I8) lbv = *(const PG8_LAS f32x4*)(sc + 512 + 16 * wc + 4 * fq); else lbv = *(const f32x4*)(lb + head * 128 + ch0);
        f32x4 swv[2][2];
#pragma unroll
        for (int bj = 0; bj < 2; ++bj)
#pragma unroll
            for (int n = 0; n < 2; ++n) { if constexpr (I8) swv[bj][n] = *(const PG8_LAS f32x4*)(sc + 256 + wc * 32 + 8 * fq + bj * HALF + 4 * n); else swv[bj][n] = (f32x4){1.f, 1.f, 1.f, 1.f}; }
#pragma unroll
        for (int ai = 0; ai < 2; ++ai) {
            f32x4 qv[4], lf[4], kk[4];
#pragma unroll
            for (int m = 0; m < 4; ++m) { const int r = row0 + ai * HALF + m * 16, bb = r >> 13, tt = r & 8191; float sr = 1.f; if constexpr (I8) sr = sc[wr * 64 + fr + ai * HALF + m * 16];
                f32x4 v[2][2];
#pragma unroll
                for (int bj = 0; bj < 2; ++bj)
#pragma unroll
                    for (int n = 0; n < 2; ++n) { if constexpr (I8) v[bj][n] = __builtin_convertvector(acc[ai][bj][m][n], f32x4) * (swv[bj][n] * sr); else v[bj][n] = acc[ai][bj][m][n]; }
#pragma unroll
                for (int j = 0; j < 4; ++j) { qv[m][j] = silu_f(v[0][0][j]) * 0.08838834764831845f;
                    const float fg = lbv[j] + (1.f - lbv[j]) * __builtin_amdgcn_rcpf(1.0f + __expf(-v[0][1][j])); kk[m][j] = 1.f - fg; lf[m][j] = __builtin_amdgcn_logf(fg) * 0.6931471805599453f; }
                { const u32x2 p0 = __builtin_amdgcn_permlane16_swap(cvt_pk_bf16(v[1][0][0], v[1][0][1]), cvt_pk_bf16(v[1][1][0], v[1][1][1]), false, false);
                  const u32x2 p1 = __builtin_amdgcn_permlane16_swap(cvt_pk_bf16(v[1][0][2], v[1][0][3]), cvt_pk_bf16(v[1][1][2], v[1][1][3]), false, false);
                  const size_t doff = (fq & 1) ? (dSG + (size_t)r * 4096 + head * 128 + (ch0 - 4)) : (dVH + ((size_t)(bb * 32 + head) * 8192 + tt) * 128 + ch0);
                  *(u32x4*)(QR + doff) = (u32x4){p0.x, p1.x, p0.y, p1.y}; } }
            f32x4 bb[4], run = (f32x4){0.f, 0.f, 0.f, 0.f}, bref = run;
#pragma unroll
            for (int m = 0; m < 4; ++m) { float i0 = lf[m][0], i1 = lf[m][1], i2 = lf[m][2], i3 = lf[m][3];
                row_scan16x4(i0, i1, i2, i3);
                bb[m] = (f32x4){i0, i1, i2, i3} + run;
                { float r0 = run[0], r1 = run[1], r2 = run[2], r3 = run[3]; row_addlast16x4(r0, r1, r2, r3, i0, i1, i2, i3); run = (f32x4){r0, r1, r2, r3}; }
                if (m == 1) bref = run; }
            const int rb = u.pm * BM + ai * HALF + wr * 64; const size_t cid = (size_t)((rb >> 13) * 32 + head) * 128 + ((rb & 8191) >> 6);
#pragma unroll
            for (int m = 0; m < 4; ++m) { f32x4 qr, kr;
#pragma unroll
                for (int j = 0; j < 4; ++j) { const float e1 = __expf(bb[m][j] - bref[j]); qr[j] = qv[m][j] * e1; kr[j] = kk[m][j] * __builtin_amdgcn_rcpf(e1); }
                const size_t off = cid * 8704 + (size_t)(16 * m + fr) * 136 + (ch0 & ~7);
                const u32x2 p0 = __builtin_amdgcn_permlane16_swap(cvt_pk_bf16(qr[0], qr[1]), cvt_pk_bf16(kr[0], kr[1]), false, false);
                const u32x2 p1 = __builtin_amdgcn_permlane16_swap(cvt_pk_bf16(qr[2], qr[3]), cvt_pk_bf16(kr[2], kr[3]), false, false);
                *(u32x4*)(QR + off + ((fq & 1) ? dKR : (size_t)0)) = (u32x4){p0.x, p1.x, p0.y, p1.y}; }
            if (fr == 0) { f32x4 el, dc, er;
#pragma unroll
                for (int j = 0; j < 4; ++j) { el[j] = __expf(run[j] - bref[j]); dc[j] = __expf(run[j]); er[j] = __expf(bref[j]); }
                *(f32x4*)(EL + cid * 128 + ch0) = el; *(f32x4*)(DEC + cid * 128 + ch0) = dc; *(f32x4*)(ER + cid * 128 + ch0) = er; }
        }
    }
};

struct EpiSwiGLU8R {
    static constexpr bool PERM = true, AFTER_DRAIN = false, LDS_SCALES = true, LDS_EXTRA = false;
    bf16_t* O; int ldc; const float* sa; const float* sw; unsigned* rmax;
    __device__ __forceinline__ const float* scale_src(const Unit& u, int t) const { return (t < 256) ? sa + u.pm * BM + t : sw + u.pn * BM + (t - 256); }
    __device__ __forceinline__ void operator()(const i32x4 (&acc)[2][2][4][2], const Unit& u, int wr, int wc, int fr, int fq, const PG8_LAS float* sc) const {
        const int row0 = u.pm * BM + wr * 64 + fr, col0 = u.pn * HALF + wc * 32 + 8 * fq, brow0 = u.pn * BM + wc * 32 + 8 * fq;
        f32x4 sg[2], su[2];
#pragma unroll
        for (int n = 0; n < 2; ++n) { sg[n] = *(const PG8_LAS f32x4*)(sc + 256 + wc * 32 + 8 * fq + 4 * n); su[n] = *(const PG8_LAS f32x4*)(sc + 256 + HALF + wc * 32 + 8 * fq + 4 * n); }
#pragma unroll
        for (int ai = 0; ai < 2; ++ai)
#pragma unroll
            for (int m = 0; m < 4; ++m) { const int r = row0 + ai * HALF + m * 16; const float sr = sc[wr * 64 + fr + ai * HALF + m * 16], sru = MK_FFO_ROT ? sr * 0.17677669529663687f : sr; bf16_t* rowp = O + (size_t)r * ldc + col0;
                f32x2 X[4];
#pragma unroll
                for (int n = 0; n < 2; ++n)
#pragma unroll
                    for (int j = 0; j < 4; ++j) { const float gt = (float)acc[ai][0][m][n][j] * (sr * sg[n][j]), up = (float)acc[ai][1][m][n][j] * (sru * su[n][j]); X[2 * n + (j >> 1)][j & 1] = silu_f(gt) * up; }
#if MK_FFO_ROT
#pragma unroll
                for (int k = 0; k < 4; ++k) { const float a = X[k].x, b = X[k].y; X[k] = (f32x2){a + b, a - b}; }
                { f32x2 a = X[0], b = X[1]; X[0] = a + b; X[1] = a - b; a = X[2]; b = X[3]; X[2] = a + b; X[3] = a - b; }
                { f32x2 a = X[0], b = X[2]; X[0] = a + b; X[2] = a - b; a = X[1]; b = X[3]; X[1] = a + b; X[3] = a - b; }
                { float x0 = X[0].x, x1 = X[0].y, x2 = X[1].x, x3 = X[1].y, x4 = X[2].x, x5 = X[2].y, x6 = X[3].x, x7 = X[3].y;
                  asm volatile("v_nop\n\tv_nop\n\tv_permlane16_swap_b32 %0, %4\n\tv_permlane16_swap_b32 %1, %5\n\tv_permlane16_swap_b32 %2, %6\n\tv_permlane16_swap_b32 %3, %7\n\ts_nop 1"
                               : "+v"(x0), "+v"(x1), "+v"(x2), "+v"(x3), "+v"(x4), "+v"(x5), "+v"(x6), "+v"(x7));
                  { const f32x2 a = (f32x2){x0, x1}, b = (f32x2){x4, x5}, c = (f32x2){x2, x3}, d = (f32x2){x6, x7}; X[0] = a + b; X[2] = a - b; X[1] = c + d; X[3] = c - d; }
                  x0 = X[0].x; x1 = X[0].y; x2 = X[1].x; x3 = X[1].y; x4 = X[2].x; x5 = X[2].y; x6 = X[3].x; x7 = X[3].y;
                  asm volatile("v_nop\n\tv_nop\n\tv_permlane32_swap_b32 %0, %2\n\tv_permlane32_swap_b32 %1, %3\n\tv_permlane32_swap_b32 %4, %6\n\tv_permlane32_swap_b32 %5, %7\n\ts_nop 1"
                               : "+v"(x0), "+v"(x1), "+v"(x2), "+v"(x3), "+v"(x4), "+v"(x5), "+v"(x6), "+v"(x7));
                  { const f32x2 a = (f32x2){x0, x1}, b = (f32x2){x2, x3}, c = (f32x2){x4, x5}, d = (f32x2){x6, x7}; X[0] = a + b; X[1] = a - b; X[2] = c + d; X[3] = c - d; } }
#endif
                u32x4 w; w.x = cvt_pk_bf16(X[0].x, X[0].y); w.y = cvt_pk_bf16(X[1].x, X[1].y); w.z = cvt_pk_bf16(X[2].x, X[2].y); w.w = cvt_pk_bf16(X[3].x, X[3].y);
                st16nt(rowp, w);
                float am = fmaxf(fmaxf(fmaxf(fabsf(X[0].x), fabsf(X[0].y)), fmaxf(fabsf(X[1].x), fabsf(X[1].y))), fmaxf(fmaxf(fabsf(X[2].x), fabsf(X[2].y)), fmaxf(fabsf(X[3].x), fabsf(X[3].y))));
                { float lo = am, hi = am; asm volatile("v_nop\n\tv_nop\n\tv_permlane16_swap_b32 %0, %1" : "+v"(lo), "+v"(hi)); am = fmaxf(lo, hi); }
                { float lo = am, hi = am; asm volatile("v_nop\n\tv_nop\n\tv_permlane32_swap_b32 %0, %1" : "+v"(lo), "+v"(hi)); am = fmaxf(lo, hi); }
                if (fq == 0) __hip_atomic_fetch_max(rmax + r, cvt_pk_bf16(am, am) << 16, __ATOMIC_RELAXED, __HIP_MEMORY_SCOPE_AGENT); }
    }
};
template <class Epi, class Sched, bool ALIGN_EPI = false, bool SP2 = false, bool I8 = false, int KREP = 1, int EREP = 1, bool TM = false, int TCH = 0, int LT = 0>
__device__ __forceinline__ void gemm_phase(PG8_LAS unsigned char* lds, const Gemm g, const Sched& S, const Epi& E) {
    const int tid = threadIdx.x, wid = __builtin_amdgcn_readfirstlane(tid >> 6), lane = tid & 63, wr = wid >> 2, wc = wid & 3, fr = lane & 15, fq = lane >> 4;
    const int K = g.K, nt = K / BK;
    unsigned voffA[2], voffB[2];
#pragma unroll
    for (int i = 0; i < 2; ++i) { int R, C; stage_rc(tid * 16 + i * 8192, R, C); const int Rb = Epi::PERM ? ((R & ~31) + perm32(R & 31)) : R;
        voffA[i] = TM ? (unsigned)(tid * 16 + i * 8192) : (unsigned)(R * K + C) * 2u; voffB[i] = TM ? (unsigned)(tid * 16 + i * 8192) : (unsigned)(Rb * K + C) * 2u; }
    const size_t kstep = TM ? (size_t)32768 : (size_t)(BK * 2);
    const size_t hstep = TM ? (size_t)16384 : (size_t)HALF * K * 2;
    const size_t tstep = TM ? (size_t)nt * 32768 : 2 * hstep;
    const unsigned ldsw = (unsigned)wid * 1024u;
    const int aoff = lds_byte(wr * 64 + fr, fq * 8), boff = lds_byte(wc * 32 + fr, fq * 8);
#define PG8_SA(b, h) (((b) * 2 + (h)) * HTB)
#define PG8_SB(b, h) ((4 + (b) * 2 + (h)) * HTB)
#define PG8_STAGE(bufoff, gbase, voff) do { _Pragma("unroll") for (int _i = 0; _i < 2; ++_i) \
        __builtin_amdgcn_global_load_lds((const unsigned*)((const char*)(gbase) + (voff)[_i]), (PG8_LAS unsigned*)(lds + (bufoff) + ldsw + _i * 8192), 16, 0, 0); } while (0)
#ifndef MK_B_NT
#define MK_B_NT 0
#endif
#define PG8_STAGEB(bufoff, gbase, voff) do { _Pragma("unroll") for (int _i = 0; _i < 2; ++_i) \
        __builtin_amdgcn_global_load_lds((const unsigned*)((const char*)(gbase) + (voff)[_i]), (PG8_LAS unsigned*)(lds + (bufoff) + ldsw + _i * 8192), 16, 0, MK_B_NT ? 2 : 0); } while (0)
#define PG8_LDA(dst, b, h) do { _Pragma("unroll") for (int m = 0; m < 4; ++m) _Pragma("unroll") for (int k = 0; k < 2; ++k) dst[m][k] = *(const PG8_LAS bf16x8*)(lds + PG8_SA(b, h) + aoff + m * 2048 + k * 1024); } while (0)
#define PG8_LDB(dst, b, h) do { _Pragma("unroll") for (int n = 0; n < 2; ++n) _Pragma("unroll") for (int k = 0; k < 2; ++k) dst[n][k] = *(const PG8_LAS bf16x8*)(lds + PG8_SB(b, h) + boff + n * 2048 + k * 1024); } while (0)
#ifndef PG8_PRIO
#define PG8_PRIO 1
#endif
#define PG8_MMA(ai, bj, At, Bt) do { if (PG8_PRIO) __builtin_amdgcn_s_setprio(PG8_PRIO); _Pragma("unroll") for (int m = 0; m < 4; ++m) _Pragma("unroll") for (int n = 0; n < 2; ++n) _Pragma("unroll") for (int k = 0; k < 2; ++k) \
        acc[ai][bj][m][n] = mma16(Bt[n][k], At[m][k], acc[ai][bj][m][n]); if (PG8_PRIO) __builtin_amdgcn_s_setprio(0); } while (0)
#define PG8_WAIT_V(n) asm volatile("s_waitcnt vmcnt(" #n ")" ::: "memory")
#define PG8_WAIT_L(n) asm volatile("s_waitcnt lgkmcnt(" #n ")" ::: "memory")
#define PG8_BAR __builtin_amdgcn_s_barrier()
#define PG8_SCHED __builtin_amdgcn_sched_barrier(0)
#define PG8_TOUCH(uidx) do { if constexpr (TCH > 0) { Unit tu_; if (S.next((uidx), tu_)) { const char* tb_ = (const char*)g.Bt + (size_t)tu_.pn * tstep; const unsigned sh_ = (unsigned)cur.pm & 63u; \
        for (int l_ = tid; l_ < nt * 4; l_ += 512) { const size_t o_ = TM ? ((size_t)sh_ * (size_t)(nt * 512) + (size_t)l_ * 128) : ((size_t)(4 * sh_ + l_ / nt) * (size_t)(nt * 128) + (size_t)(l_ % nt) * 128); \
            __builtin_amdgcn_global_load_lds((const unsigned*)(tb_ + o_), (PG8_LAS unsigned*)(lds + STAGE_BYTES + wid * 256), 4, 0, 0); } } } } while (0)
    const unsigned ltoff = (lane < 8) ? (unsigned)(wid * 1024 + lane * 128) : (unsigned)(wid * 512 + (lane - 8) * 128);
#define PG8_LTOUCH(abase, bbase) do { if constexpr (LT > 0) { if (lane < 12) { const char* tp_ = (lane < 8) ? ((abase) + ltA) : ((bbase) + ltB); \
        __builtin_amdgcn_global_load_lds((const unsigned*)(tp_ + ltoff), (PG8_LAS unsigned*)(lds + STAGE_BYTES + wid * 256), 4, 0, 0); } } } while (0)
#define PG8_WAIT_VS() do { if constexpr (LT > 0) PG8_WAIT_V(9); else PG8_WAIT_V(8); } while (0)
    Unit cur, nxt; int ui = 0;
    if (!S.next(0, cur)) return;
    PG8_LAS float* const lsc = (PG8_LAS float*)(lds + 139264);
#define PG8_SCALE_DMA(uu, slot) do { if constexpr (Epi::LDS_SCALES) { const float* sp_ = E.scale_src((uu), wid * 64 + lane); \
        __builtin_amdgcn_global_load_lds((const unsigned*)sp_, (PG8_LAS unsigned*)(lsc + (slot) * 640 + wid * 64), 4, 0, 0); \
        if constexpr (Epi::LDS_EXTRA) { if (wid == 0) __builtin_amdgcn_global_load_lds((const unsigned*)E.extra_src((uu), lane), (PG8_LAS unsigned*)(lsc + (slot) * 640 + 512), 4, 0, 0); } } } while (0)
    PG8_SCALE_DMA(cur, 0);
    typedef typename AccT<I8>::type acc_t;
    acc_t acc[2][2][4][2];
#pragma unroll
    for (int a = 0; a < 2; ++a)
#pragma unroll
        for (int b = 0; b < 2; ++b)
#pragma unroll
            for (int m = 0; m < 4; ++m)
#pragma unroll
                for (int n = 0; n < 2; ++n) acc[a][b][m][n] = AccT<I8>::zero();
    bf16x8 At[4][2], B0[2][2], B1[2][2];
    const char* cA = (const char*)g.A + (size_t)cur.pm * tstep; const char* cB = (const char*)g.Bt + (size_t)cur.pn * tstep;
    unsigned ltA = (unsigned)(cur.pn & 3) * 8192u, ltB = (unsigned)(cur.pm & 7) * 4096u;
    S.a_ready(cur);
    if constexpr (TCH > 0) { PG8_TOUCH(1); if constexpr (TCH > 1) PG8_TOUCH(2); }
    if constexpr (SP2) {
        PG8_STAGEB(PG8_SB(0, 0), cB, voffB); PG8_STAGEB(PG8_SB(0, 1), cB + hstep, voffB); PG8_STAGE(PG8_SA(0, 0), cA, voffA); PG8_STAGE(PG8_SA(0, 1), cA + hstep, voffA);
        if (wr == 1) PG8_BAR;
        PG8_WAIT_V(2); PG8_BAR;
        PG8_STAGEB(PG8_SB(1, 0), cB + kstep, voffB); PG8_STAGE(PG8_SA(1, 0), cA + kstep, voffA); PG8_STAGEB(PG8_SB(1, 1), cB + hstep + kstep, voffB);
        PG8_WAIT_V(6); PG8_BAR;
    } else {
        PG8_STAGEB(PG8_SB(0, 0), cB, voffB); PG8_STAGE(PG8_SA(0, 0), cA, voffA); PG8_STAGEB(PG8_SB(0, 1), cB + hstep, voffB); PG8_STAGE(PG8_SA(0, 1), cA + hstep, voffA);
        if (wr == 1) PG8_BAR;
        PG8_WAIT_V(4); PG8_BAR;
        PG8_STAGEB(PG8_SB(1, 0), cB + kstep, voffB); PG8_STAGE(PG8_SA(1, 0), cA + kstep, voffA); PG8_STAGEB(PG8_SB(1, 1), cB + hstep + kstep, voffB);
        PG8_WAIT_V(6); PG8_BAR;
    }
    for (;;) {
        const bool has_next = S.next(ui + 1, nxt);
        const char* nA = has_next ? (const char*)g.A + (size_t)nxt.pm * tstep : cA; const char* nB = has_next ? (const char*)g.Bt + (size_t)nxt.pn * tstep : cB;
        for (int krep = 0; krep < KREP; ++krep) {
        if (KREP > 1 && krep == KREP - 1 && krep > 0) {
_Pragma("unroll") for (int a = 0; a < 2; ++a) _Pragma("unroll") for (int b = 0; b < 2; ++b) _Pragma("unroll") for (int m = 0; m < 4; ++m) _Pragma("unroll") for (int n = 0; n < 2; ++n) acc[a][b][m][n] = AccT<I8>::zero(); }
        const char* nA2 = (krep == KREP - 1) ? nA : cA; const char* nB2 = (krep == KREP - 1) ? nB : cB;
        for (int t = 0; t < nt; t += 2) {
            const bool last = (t == nt - 2);
            const char* a1 = cA + (size_t)(t + 1) * kstep;
            const char* a2 = last ? nA2 : cA + (size_t)(t + 2) * kstep; const char* b2 = last ? nB2 : cB + (size_t)(t + 2) * kstep;
            const char* a3 = a2 + kstep; const char* b3 = b2 + kstep;
            const char *ta0 = cA, *tb0 = cB, *ta1 = cA, *tb1 = cB;
            if constexpr (LT > 0) { const int q0 = t + LT, q1 = t + 1 + LT;
                if (q0 < nt) { ta0 = cA + (size_t)q0 * kstep; tb0 = cB + (size_t)q0 * kstep; } else if (krep == KREP - 1 && has_next && q0 - nt < nt) { ta0 = nA + (size_t)(q0 - nt) * kstep; tb0 = nB + (size_t)(q0 - nt) * kstep; }
                if (q1 < nt) { ta1 = cA + (size_t)q1 * kstep; tb1 = cB + (size_t)q1 * kstep; } else if (krep == KREP - 1 && has_next && q1 - nt < nt) { ta1 = nA + (size_t)(q1 - nt) * kstep; tb1 = nB + (size_t)(q1 - nt) * kstep; } }
            if (last && has_next && krep == KREP - 1) S.a_ready(nxt);
            if constexpr (SP2) {
            PG8_LDB(B0, 0, 0); PG8_LDB(B1, 0, 1); PG8_SCHED; PG8_LDA(At, 0, 0); PG8_STAGE(PG8_SA(1, 1), a1 + hstep, voffA);
            PG8_WAIT_VS(); PG8_WAIT_L(0); PG8_BAR; PG8_MMA(0, 0, At, B0); PG8_MMA(0, 1, At, B1); PG8_BAR; PG8_SCHED;
            PG8_LDA(At, 0, 1); PG8_LTOUCH(ta0, tb0); PG8_STAGEB(PG8_SB(0, 0), b2, voffB); PG8_STAGEB(PG8_SB(0, 1), b2 + hstep, voffB); PG8_STAGE(PG8_SA(0, 0), a2, voffA);
            PG8_WAIT_VS(); PG8_WAIT_L(0); PG8_BAR; PG8_MMA(1, 0, At, B0); PG8_MMA(1, 1, At, B1); PG8_BAR; PG8_SCHED;
            PG8_LDB(B0, 1, 0); PG8_LDB(B1, 1, 1); PG8_SCHED; PG8_LDA(At, 1, 0); PG8_STAGE(PG8_SA(0, 1), a2 + hstep, voffA);
            PG8_WAIT_VS(); PG8_WAIT_L(0); PG8_BAR; PG8_MMA(0, 0, At, B0); PG8_MMA(0, 1, At, B1); PG8_BAR; PG8_SCHED;
            PG8_LDA(At, 1, 1); PG8_LTOUCH(ta1, tb1); PG8_STAGEB(PG8_SB(1, 0), b3, voffB); PG8_STAGEB(PG8_SB(1, 1), b3 + hstep, voffB); PG8_STAGE(PG8_SA(1, 0), a3, voffA);
            PG8_WAIT_VS(); PG8_WAIT_L(0); PG8_BAR; PG8_MMA(1, 0, At, B0); PG8_MMA(1, 1, At, B1); PG8_BAR; PG8_SCHED;
            } else {
            PG8_LDB(B0, 0, 0); PG8_SCHED; PG8_LDA(At, 0, 0); PG8_STAGE(PG8_SA(1, 1), a1 + hstep, voffA);
            PG8_WAIT_L(8); PG8_BAR; PG8_WAIT_L(0); PG8_MMA(0, 0, At, B0); PG8_BAR; PG8_SCHED;
            PG8_LDB(B1, 0, 1); PG8_STAGEB(PG8_SB(0, 0), b2, voffB);
            PG8_BAR; PG8_WAIT_L(0); PG8_MMA(0, 1, At, B1); PG8_BAR;
            PG8_LDA(At, 0, 1); PG8_STAGE(PG8_SA(0, 0), a2, voffA);
            PG8_BAR; PG8_WAIT_L(0); PG8_MMA(1, 0, At, B0); PG8_BAR; PG8_SCHED;
            PG8_STAGEB(PG8_SB(0, 1), b2 + hstep, voffB);
            PG8_WAIT_V(6); PG8_BAR; PG8_MMA(1, 1, At, B1); PG8_BAR;
            PG8_LDB(B0, 1, 0); PG8_SCHED; PG8_LDA(At, 1, 0); PG8_STAGE(PG8_SA(0, 1), a2 + hstep, voffA);
            PG8_WAIT_L(8); PG8_BAR; PG8_WAIT_L(0); PG8_MMA(0, 0, At, B0); PG8_BAR; PG8_SCHED;
            PG8_LDB(B1, 1, 1); PG8_STAGEB(PG8_SB(1, 0), b3, voffB);
            PG8_BAR; PG8_WAIT_L(0); PG8_MMA(0, 1, At, B1); PG8_BAR;
            PG8_LDA(At, 1, 1); PG8_STAGE(PG8_SA(1, 0), a3, voffA);
            PG8_BAR; PG8_WAIT_L(0); PG8_MMA(1, 0, At, B0); PG8_BAR; PG8_SCHED;
            PG8_STAGEB(PG8_SB(1, 1), b3 + hstep, voffB);
            PG8_WAIT_V(6); PG8_BAR; PG8_MMA(1, 1, At, B1); PG8_BAR;
            }
        }
        }
        if constexpr (ALIGN_EPI) { if (wr == 0) PG8_BAR; }
        if constexpr (Epi::LDS_SCALES) { E(acc, cur, wr, wc, fr, fq, lsc + (ui & 1) * 640); S.done(cur); if (has_next) PG8_SCALE_DMA(nxt, (ui + 1) & 1); } else
        if constexpr (!Epi::AFTER_DRAIN) { E(acc, cur, wr, wc, fr, fq); if constexpr (EREP > 1) { asm volatile("" ::: "memory"); E.alt()(acc, cur, wr, wc, fr, fq); } S.done(cur); PG8_TOUCH(ui + 1 + TCH); }
        if (!has_next) break;
#pragma unroll
        for (int a = 0; a < 2; ++a)
#pragma unroll
            for (int b = 0; b < 2; ++b)
#pragma unroll
                for (int m = 0; m < 4; ++m)
#pragma unroll
                    for (int n = 0; n < 2; ++n) acc[a][b][m][n] = AccT<I8>::zero();
        cur = nxt; cA = nA; cB = nB; ++ui; ltA = (unsigned)(cur.pn & 3) * 8192u; ltB = (unsigned)(cur.pm & 7) * 4096u;
        if constexpr (ALIGN_EPI) { if (wr == 1) PG8_BAR; }
    }
    PG8_WAIT_V(0);
    if constexpr (!ALIGN_EPI) { if (wr == 0) PG8_BAR; }
    PG8_BAR;
    if constexpr (Epi::AFTER_DRAIN) { E.fused(acc, cur, wr, wc, fr, fq, lds, wid, lane); S.done(cur); }
#undef PG8_TOUCH
#undef PG8_LTOUCH
#undef PG8_WAIT_VS
#undef PG8_SA
#undef PG8_SB
#undef PG8_STAGE
#undef PG8_LDA
#undef PG8_LDB
#undef PG8_MMA
#undef PG8_WAIT_V
#undef PG8_WAIT_L
#undef PG8_BAR
#undef PG8_SCHED
}
}
#ifndef PG8_SP2
#define PG8_SP2 true
#endif
#ifndef PG8_ALIGN
#define PG8_ALIGN true
#endif
constexpr int NWAVES = 8;
#ifndef MK_N_LAUNCHES
#define MK_N_LAUNCHES 1
#endif
#ifndef MK_HGRN_MFMA
#define MK_HGRN_MFMA 1
#endif
#ifndef MK_ATTN_MFMA
#define MK_ATTN_MFMA 1
#endif
constexpr bool HGRN_MFMA = MK_HGRN_MFMA, ATTN_MFMA = MK_ATTN_MFMA;
#ifndef MK_REP_GEMM
#define MK_REP_GEMM 1
#endif
#ifndef MK_REP_P0
#define MK_REP_P0 1
#endif
#ifndef MK_REP_ATT
#define MK_REP_ATT 1
#endif
#ifndef MK_REP_HG
#define MK_REP_HG 1
#endif
#ifndef MK_REP_NORM
#define MK_REP_NORM 1
#endif
constexpr int REP_GEMM = MK_REP_GEMM, REP_P0 = MK_REP_P0, REP_ATT = MK_REP_ATT, REP_HG = MK_REP_HG, REP_NORM = MK_REP_NORM;
#ifndef MK_FFN_I8
#define MK_FFN_I8 1
#endif
static_assert(MK_FFN_I8 == 1, "the workspace map overlays ACT on the bf16 FFN-in weight copies: int8 FFN path only");
#ifndef MK_HG_I8
#define MK_HG_I8 1
#endif
constexpr bool HG_I8 = MK_HG_I8;
#ifndef MK_ATT_I8
#define MK_ATT_I8 0
#endif
constexpr bool ATT_I8 = MK_ATT_I8;
constexpr bool FFN_I8 = MK_FFN_I8;
#ifndef MK_KREP_FFI
#define MK_KREP_FFI 1
#endif
#ifndef MK_EREP_FFI
#define MK_EREP_FFI 1
#endif
constexpr int EREP_FFI = MK_EREP_FFI;
#ifndef MK_REP_FFI
#define MK_REP_FFI 1
#endif
constexpr int REP_FFI = MK_REP_FFI;
constexpr int KREP_FFI = MK_KREP_FFI;
#ifndef MK_TM_FFI
#define MK_TM_FFI 1
#endif
constexpr bool TM_FFI = MK_TM_FFI;
#ifndef MK_TCH_FFI
#define MK_TCH_FFI 0
#endif
#ifndef MK_TCH_ALL
#define MK_TCH_ALL 0
#endif
constexpr int TCH_FFI = MK_TCH_FFI, TCH_ALL = MK_TCH_ALL;
#ifndef MK_LT_FFI
#define MK_LT_FFI 0
#endif
constexpr int LT_FFI = MK_LT_FFI;
#ifndef MK_HG_FUSE
#define MK_HG_FUSE 2
#endif
constexpr int HG_FUSE = MK_HG_FUSE;
#ifndef MK_REP_P8
#define MK_REP_P8 1
#endif
constexpr int REP_P8 = MK_REP_P8;
#ifndef MK_FFO_I8
#define MK_FFO_I8 1
#endif
#ifndef MK_FFO_ROT
#define MK_FFO_ROT 1
#endif
constexpr bool FFO_I8 = MK_FFO_I8;
#ifndef MK_REP_BAR
#define MK_REP_BAR 0
#endif
constexpr int REP_BAR = MK_REP_BAR;
#ifndef MK_NT_W
#define MK_NT_W 0
#endif
#if MK_NT_W
#define MK_LD_W(p) __builtin_nontemporal_load(p)
#else
#define MK_LD_W(p) (*(p))
#endif
#ifndef MK_P0_OVL
#define MK_P0_OVL 0
#endif
constexpr bool P0_OVL = MK_P0_OVL;
#ifndef MK_QKV_HM
#define MK_QKV_HM 1
#endif
constexpr bool QKV_HM = MK_QKV_HM;
#ifndef MK_P0_STRIP
#define MK_P0_STRIP 1
#endif
constexpr bool P0_STRIP = MK_P0_STRIP;
#ifndef MK_HGO_I8
#define MK_HGO_I8 1
#endif
constexpr bool HGO_I8 = MK_HGO_I8;
constexpr int NPH = 16;
constexpr int N_LAUNCHES = MK_N_LAUNCHES;
static_assert(N_LAUNCHES == 1 || N_LAUNCHES == NPH, "MK_N_LAUNCHES is 1 or NPH");

constexpr int BATCH = 2, SEQ = 8192, DM = 4096, M = BATCH * SEQ, DFF = 11008, NQKV = 18432, NHG = 16384, DATT = 2048, HD = 128;
constexpr float RMS_EPS = 1e-6f;
constexpr float QSCALE = 0.08838834764831845f;

constexpr size_t MiB = 1u << 20;
constexpr size_t WS_CTL = 0, CTL_ZERO_BYTES = 1 * MiB;
constexpr size_t WS_TAB = 1 * MiB;
constexpr size_t WS_WATTI = 2 * MiB, WS_WATTO = 146 * MiB, WS_WHGI = 162 * MiB, WS_WHGO = 290 * MiB;
constexpr size_t WS_WFFI = 322 * MiB, WFFI_STRIDE = 172 * MiB, WS_WFFO = 666 * MiB, WFFO_STRIDE = 86 * MiB;
constexpr size_t WS_XN = 838 * MiB;
constexpr size_t WS_Y = 966 * MiB;
constexpr size_t WS_ACT = 322 * MiB;
constexpr size_t WS_ACT_OLD = 1222 * MiB;
constexpr size_t WS_QKV = 1566 * MiB;
constexpr size_t WS_MRG = 2142 * MiB;
constexpr size_t WS_OG = 2206 * MiB;
constexpr size_t WS_END = 2334 * MiB;
constexpr size_t WS_SA = WS_TAB + 128 * 1024, WS_SW = WS_TAB + 256 * 1024;
constexpr size_t WS_W8 = 1222 * MiB, W8_STRIDE = 86 * MiB, WS_W8H = 1394 * MiB, WS_END3 = 2529 * MiB;
constexpr size_t WS_SWH = WS_SW + 4 * 2 * 2 * DFF, WS_SWA = WS_SWH + 4 * NHG, WS_W8A = 1458 * MiB;
static_assert(WS_W8A + (size_t)NQKV * DM <= WS_QKV && WS_SWA + 4 * NQKV <= WS_WATTI, "int8 maps");
constexpr size_t WS_HB = 2529 * MiB, WS_END4 = 2657 * MiB;
constexpr size_t WS_W8O = 2657 * MiB, W8O_STRIDE = 43 * MiB, WS_END5 = 2743 * MiB, WS_SWO = WS_TAB + 640 * 1024, WS_SA2 = WS_TAB + 704 * 1024, WS_ACT8 = WS_QKV, WS_RMAX = WS_CTL + 512 * 1024;
constexpr size_t WS_W8G = 1530 * MiB, WS_SWG = WS_TAB + 768 * 1024, WS_SA3 = WS_TAB + 800 * 1024;
static_assert(WS_W8G + (size_t)DM * DM <= WS_QKV && WS_SA3 + 4 * M <= WS_WATTI, "HGO_I8 maps");
constexpr int CW_TMO = 0, CW_CODE = 1;
constexpr int CW_BAR = 4096;
constexpr int RING_OFF = 0, RING_BYTES = 131072;
constexpr int LDSCTL_OFF = 150528, MISC_OFF = LDSCTL_OFF + 320;
constexpr int LDS_BYTES = 152576;
static_assert(MISC_OFF + 128 <= LDS_BYTES, "LDS map");

#define GAS __attribute__((address_space(1)))
#define LAS __attribute__((address_space(3)))
typedef unsigned short bf16;
typedef unsigned v4u __attribute__((ext_vector_type(4)));
typedef unsigned v2u __attribute__((ext_vector_type(2)));
typedef float f32x4 __attribute__((ext_vector_type(4)));
typedef short bf16x8 __attribute__((ext_vector_type(8)));
typedef GAS unsigned gu32;
typedef GAS unsigned long long gu64;
#define RLX_AGENT __ATOMIC_RELAXED, __HIP_MEMORY_SCOPE_AGENT
#define LDS_WAIT() asm volatile("s_waitcnt lgkmcnt(0)" ::: "memory")
#define VM_WAIT() asm volatile("s_waitcnt vmcnt(0)" ::: "memory")
__device__ __forceinline__ unsigned f2bf(float f) { unsigned u = __builtin_bit_cast(unsigned, f); return (u + 0x7fffu + ((u >> 16) & 1u)) >> 16; }
__device__ __forceinline__ unsigned pk2(float lo, float hi) { return f2bf(lo) | (f2bf(hi) << 16); }
__device__ __forceinline__ unsigned cvtpk(float lo, float hi) { return pg8::cvt_pk_bf16(lo, hi); }
__device__ __forceinline__ float bflo(unsigned w) { return __builtin_bit_cast(float, w << 16); }
__device__ __forceinline__ float bfhi(unsigned w) { return __builtin_bit_cast(float, w & 0xffff0000u); }
#define XB_TMO      128
#define XB_XCNT(j)  (256  + 64 * (j))
#define XB_XSUB(j)  (1280 + 64 * (j))
#define XB_XGEN(j)  (2304 + 64 * (j))
#define XB_TOP      3328
#define XB_TOPGEN   3392
#define XCD_BAR_WORDS 3456
#define XB_SPIN_CAP (1u << 18)

__device__ __forceinline__ unsigned xb_ld(unsigned* p)              { return __hip_atomic_load(p, __ATOMIC_RELAXED, __HIP_MEMORY_SCOPE_AGENT); }
__device__ __forceinline__ unsigned xb_add(unsigned* p, unsigned v) { return __hip_atomic_fetch_add(p, v, __ATOMIC_RELAXED, __HIP_MEMORY_SCOPE_AGENT); }
__device__ __forceinline__ unsigned xb_xcc_id() { return (unsigned)__builtin_amdgcn_s_getreg((3 << 11) | 20) & 0xFu; }
#define XB_SPIN(cond, bar) do { unsigned _sp = 0; while (cond) { __builtin_amdgcn_s_sleep(1); \
    if ((++_sp & 255u) == 0u) { if (xb_ld(&(bar)[XB_TMO])) break; if (_sp > XB_SPIN_CAP) { atomicAdd(&(bar)[XB_TMO], 1u); break; } } } } while (0)

struct XcdBarrier {
    unsigned* bar; unsigned x;
    volatile LAS unsigned* st;
};

__device__ __forceinline__ XcdBarrier xcd_barrier_post(unsigned* bar, volatile LAS unsigned* st) {
    XcdBarrier b; b.bar = bar; b.x = xb_xcc_id(); b.st = st;
    if (threadIdx.x == 0) (void)xb_add(&bar[XB_XCNT(b.x)], 1u);
    return b;
}
__device__ __forceinline__ void xcd_barrier_complete(unsigned* bar, unsigned x, unsigned& nloc, unsigned& nx) {
    const unsigned G = gridDim.x * gridDim.y * gridDim.z;
    unsigned sum, cnt, mine, sp = 0u;
    for (;;) {
        sum = 0u; cnt = 0u; mine = 0u;
#pragma unroll
        for (unsigned j = 0; j < 16; ++j) { const unsigned c = xb_ld(&bar[XB_XCNT(j)]); sum += c; cnt += (c > 0u) ? 1u : 0u; mine = (j == x) ? c : mine; }
        if (sum == G) break;
        __builtin_amdgcn_s_sleep(1);
        if ((++sp & 255u) == 0u) { if (xb_ld(&bar[XB_TMO])) break; if (sp > XB_SPIN_CAP) { atomicAdd(&bar[XB_TMO], 1u); break; } }
    }
    nloc = mine > 0u ? mine : 1u; nx = cnt > 0u ? cnt : 1u;
}

__device__ __forceinline__ void xcd_barrier(const XcdBarrier& b) {
    asm volatile("s_waitcnt vmcnt(0)" ::: "memory");
    __syncthreads();
    if (threadIdx.x == 0) {
        unsigned* bar = b.bar;
        __builtin_amdgcn_s_waitcnt(0);
        unsigned nloc = b.st[0], nx = b.st[1];
        if (nloc == 0u) { xcd_barrier_complete(bar, b.x, nloc, nx); b.st[0] = nloc; b.st[1] = nx; }
        const unsigned old = xb_add(&bar[XB_XSUB(b.x)], 1u);
        const unsigned gen = old / nloc;
        if (old + 1u == (gen + 1u) * nloc) {
            __builtin_amdgcn_fence(__ATOMIC_RELEASE, "agent");
            asm volatile("s_waitcnt vmcnt(0)" ::: "memory");
            const unsigned og = xb_add(&bar[XB_TOP], 1u);
            const unsigned tg = og / nx;
            if (og + 1u == (tg + 1u) * nx) xb_add(&bar[XB_TOPGEN], 1u);
            else XB_SPIN(xb_ld(&bar[XB_TOPGEN]) == tg, bar);
            __builtin_amdgcn_fence(__ATOMIC_ACQUIRE, "agent");
            xb_add(&bar[XB_XGEN(b.x)], 1u);
            asm volatile("s_waitcnt vmcnt(0)" ::: "memory");
        } else {
            XB_SPIN(xb_ld(&bar[XB_XGEN(b.x)]) == gen, bar);
            __builtin_amdgcn_fence(__ATOMIC_ACQUIRE, "agent");
            asm volatile("s_waitcnt vmcnt(0)" ::: "memory");
        }
    }
    __syncthreads();
}
struct Frame {
    LAS unsigned char* lds;
    volatile LAS unsigned* MISC;
    gu32* ctl;
    int tid, lane, wave;
    int vcu, G;
    const float *x, *gains, *rel_bias, *w_att_in, *w_att_out, *w_hg_in, *lb_logits, *hg_gain, *w_hg_out, *w_ff_in, *w_ff_out;
    float* out;
    unsigned char* ws;
};
#define XL_DPP(x, ctrl) __builtin_bit_cast(float, __builtin_amdgcn_update_dpp(0, __builtin_bit_cast(int, (x)), (ctrl), 0xf, 0xf, true))
#define XL_SWAP(op, v) do { float lo_ = (v), hi_ = (v); asm volatile("v_nop\n\tv_nop\n\t" op " %0, %1" : "+v"(lo_), "+v"(hi_)); a_ = lo_; b_ = hi_; } while (0)
__device__ __forceinline__ float xl16_sum(float v) { float a_, b_; XL_SWAP("v_permlane16_swap_b32", v); return a_ + b_; }
__device__ __forceinline__ float xl32_sum(float v) { float a_, b_; XL_SWAP("v_permlane32_swap_b32", v); return a_ + b_; }
__device__ __forceinline__ float xl16_max(float v) { float a_, b_; XL_SWAP("v_permlane16_swap_b32", v); return fmaxf(a_, b_); }
__device__ __forceinline__ float xl32_max(float v) { float a_, b_; XL_SWAP("v_permlane32_swap_b32", v); return fmaxf(a_, b_); }
__device__ __forceinline__ float row16_sum(float v) { v += XL_DPP(v, 0xB1); v += XL_DPP(v, 0x4E); v += XL_DPP(v, 0x141); v += XL_DPP(v, 0x140); return v; }
__device__ __forceinline__ float row16_max(float v) { v = fmaxf(v, XL_DPP(v, 0xB1)); v = fmaxf(v, XL_DPP(v, 0x4E)); v = fmaxf(v, XL_DPP(v, 0x141)); v = fmaxf(v, XL_DPP(v, 0x140)); return v; }
__device__ __forceinline__ float half32_sum(float v) { return xl16_sum(row16_sum(v)); }
__device__ __forceinline__ float wave_sum(float v) { return xl32_sum(xl16_sum(row16_sum(v))); }
__device__ __forceinline__ float wave_max(float v) { return xl32_max(xl16_max(row16_max(v))); }
__device__ __forceinline__ unsigned q8bits(float x, float qs) { return __builtin_bit_cast(unsigned, fmaf(x, qs, 12582912.f)) & 255u; }
__device__ __forceinline__ void p0_transpose_item(const float* W, int K, int N, bf16* WT, int mode, LAS float* scr, int item, int lane) {
    const int nblk = N / 32, kb = item / nblk, nb = item % nblk, k0 = 64 * kb, n0 = 32 * nb;
    int r0 = n0;
    if (mode == 1) { const int c = (n0 < DFF) ? n0 : n0 - DFF; r0 = 256 * (c >> 7) + (c & 127) + ((n0 < DFF) ? 0 : 128); }
#pragma unroll
    for (int i = 0; i < 32; ++i) { const int kk = 2 * i + (lane >> 5); scr[kk * 33 + (lane & 31)] = MK_LD_W(W + (size_t)(k0 + kk) * N + n0 + (lane & 31)); }
    LDS_WAIT(); asm volatile("" ::: "memory");
    const int c = lane & 7;
#pragma unroll
    for (int j = 0; j < 4; ++j) { const int n = (lane >> 3) + 8 * j; const LAS float* s = scr + (8 * c) * 33 + n;
        v4u o; o.x = pk2(s[0 * 33], s[1 * 33]); o.y = pk2(s[2 * 33], s[3 * 33]); o.z = pk2(s[4 * 33], s[5 * 33]); o.w = pk2(s[6 * 33], s[7 * 33]);
        int row = r0 + n;
        if (mode == 2) { const int col = n0 + n, s = col >> 12, cc = col & 4095, c64 = cc & 63; row = 256 * (cc >> 6) + 128 * (s >> 1) + 32 * (c64 >> 4) + 8 * ((c64 >> 2) & 3) + 4 * (s & 1) + (c64 & 3); }
        *(GAS v4u*)(WT + (size_t)row * K + k0 + 8 * c) = o; }
    LDS_WAIT(); asm volatile("" ::: "memory");
}
__device__ __forceinline__ int t5_bucket(int dist) {
    if (dist < 16) return dist;
    int large = 16 + (int)(log((double)dist / 16.0) / log(128.0) * 16.0);
    return large < 31 ? large : 31;
}
template <bool HAS_Y, int XNM, bool HIB = false, bool HOB = false>
__device__ __forceinline__ void norm_rows(Frame& F, const void* hin, const bf16* y, void* hout, bf16* xn, const float* ga, const float* gb, float* sa = nullptr) {
    const int gw = F.vcu * NWAVES + F.wave, NGW = F.G * NWAVES;
    LAS f32x4* const lga = (LAS f32x4*)(F.lds + RING_OFF); LAS f32x4* const lgb = lga + DM / 4;
    __syncthreads();
    if (HAS_Y) for (int i = F.tid; i < DM / 4; i += NWAVES * 64) lga[i] = ((const GAS f32x4*)ga)[i];
    if (XNM != 0) for (int i = F.tid; i < DM / 4; i += NWAVES * 64) lgb[i] = ((const GAS f32x4*)gb)[i];
    __syncthreads();
    v2u hb[HIB ? 16 : 1]; v2u yb[HAS_Y ? 16 : 1]; f32x4 hf[(!HIB && !HAS_Y) ? 16 : 1]; (void)hb; (void)yb; (void)hf;
    if (gw < M) {
        if constexpr (!HIB && !HAS_Y) { const GAS f32x4* hr = (const GAS f32x4*)((const float*)hin + (size_t)gw * DM) + F.lane;
#pragma unroll
            for (int j = 0; j < 16; ++j) hf[j] = hr[64 * j]; }
        if constexpr (HIB) { const GAS v2u* hr = (const GAS v2u*)((const bf16*)hin + (size_t)gw * DM) + F.lane;
#pragma unroll
            for (int j = 0; j < 16; ++j) hb[j] = hr[64 * j]; }
        if constexpr (HAS_Y) { const GAS v2u* yr = (const GAS v2u*)(y + (size_t)gw * DM) + F.lane;
#pragma unroll
            for (int j = 0; j < 16; ++j) yb[j] = yr[64 * j]; }
    }
    for (int m = gw; m < M; m += NGW) {
        const int mn = (m + NGW < M) ? m + NGW : m;
        f32x4 h[16];
        if constexpr (HIB) {
#pragma unroll
            for (int j = 0; j < 16; ++j) { const v2u hw = hb[j]; h[j] = (f32x4){bflo(hw.x), bfhi(hw.x), bflo(hw.y), bfhi(hw.y)}; }
            const GAS v2u* hr = (const GAS v2u*)((const bf16*)hin + (size_t)mn * DM) + F.lane;
#pragma unroll
            for (int j = 0; j < 16; ++j) hb[j] = hr[64 * j];
        } else if constexpr (!HAS_Y) {
#pragma unroll
            for (int j = 0; j < 16; ++j) h[j] = hf[j];
            const GAS f32x4* hr = (const GAS f32x4*)((const float*)hin + (size_t)mn * DM) + F.lane;
#pragma unroll
            for (int j = 0; j < 16; ++j) hf[j] = hr[64 * j];
        } else { const GAS f32x4* hr = (const GAS f32x4*)((const float*)hin + (size_t)m * DM) + F.lane;
#pragma unroll
            for (int j = 0; j < 16; ++j) h[j] = hr[64 * j]; }
        if constexpr (HAS_Y) {
            float ss = 0.f;
#pragma unroll
            for (int j = 0; j < 16; ++j) { const v2u yw = yb[j]; const f32x4 yv = (f32x4){bflo(yw.x), bfhi(yw.x), bflo(yw.y), bfhi(yw.y)}; ss += (yv.x * yv.x + yv.y * yv.y) + (yv.z * yv.z + yv.w * yv.w); }
            const float rstd = 1.f / sqrtf(wave_sum(ss) * (1.f / DM) + RMS_EPS);
            GAS f32x4* ho = (GAS f32x4*)((float*)hout + (size_t)m * DM) + F.lane; GAS v2u* hob = (GAS v2u*)((bf16*)hout + (size_t)m * DM) + F.lane;
#pragma unroll
            for (int j = 0; j < 16; ++j) { const f32x4 g = lga[64 * j + F.lane]; const v2u yw = yb[j]; const f32x4 yv = (f32x4){bflo(yw.x), bfhi(yw.x), bflo(yw.y), bfhi(yw.y)};
                h[j] = h[j] + yv * rstd * g;
                if (HOB) { const v2u hw = (v2u){cvtpk(h[j].x, h[j].y), cvtpk(h[j].z, h[j].w)}; hob[64 * j] = hw; h[j] = (f32x4){bflo(hw.x), bfhi(hw.x), bflo(hw.y), bfhi(hw.y)}; }
                else ho[64 * j] = h[j]; }
            { const GAS v2u* yr = (const GAS v2u*)(y + (size_t)mn * DM) + F.lane;
#pragma unroll
              for (int j = 0; j < 16; ++j) yb[j] = yr[64 * j]; }
        }
        if (XNM != 0) {
            float s2 = 0.f;
#pragma unroll
            for (int j = 0; j < 16; ++j) s2 += (h[j].x * h[j].x + h[j].y * h[j].y) + (h[j].z * h[j].z + h[j].w * h[j].w);
            const float r2 = 1.f / sqrtf(wave_sum(s2) * (1.f / DM) + RMS_EPS);
            if (XNM == 1) {
                GAS v2u* o8 = (GAS v2u*)(xn + (size_t)m * DM) + F.lane;
#pragma unroll
                for (int j = 0; j < 16; ++j) { const f32x4 g = lgb[64 * j + F.lane]; const f32x4 v = h[j] * r2 * g;
                    v2u w; w.x = pk2(v.x, v.y); w.y = pk2(v.z, v.w); o8[64 * j] = w; }
            } else {
                float am = 0.f;
#pragma unroll
                for (int j = 0; j < 16; ++j) { const f32x4 g = lgb[64 * j + F.lane]; h[j] = h[j] * r2 * g;
                    am = fmaxf(fmaxf(am, fmaxf(fabsf(h[j].x), fabsf(h[j].y))), fmaxf(fabsf(h[j].z), fabsf(h[j].w))); }
                am = wave_max(am);
                am = fmaxf(am, 1e-20f);
                const float qs = 127.f / am;
                GAS unsigned char* o1 = (GAS unsigned char*)xn; GAS unsigned* o4 = (GAS unsigned*)(o1 + (size_t)m * DM) + F.lane;
#pragma unroll
                for (int j = 0; j < 16; ++j) { const unsigned qw = q8bits(h[j].x, qs) | (q8bits(h[j].y, qs) << 8) | (q8bits(h[j].z, qs) << 16) | (q8bits(h[j].w, qs) << 24);

                    if (XNM == 3) *(GAS unsigned*)(o1 + pg8::tm_chunk_off(m, 256 * j + 4 * F.lane, DM / 128, false)) = qw; else o4[64 * j] = qw; }
                if (F.lane == 0) sa[m] = am * (1.f / 127.f);
            }
        }
    }
}
template <bool TMW> __device__ __forceinline__ void p0_quant_rows(Frame& F, const bf16* WT, unsigned char* W8, float* sw, int rows) {
    const int gw = F.vcu * NWAVES + F.wave, NGW = F.G * NWAVES;
    for (int r = gw; r < rows; r += NGW) {
        const GAS v4u* src = (const GAS v4u*)(WT + (size_t)r * DM) + F.lane;
        v4u c[8]; float am = 0.f;
#pragma unroll
        for (int i = 0; i < 8; ++i) { c[i] = src[64 * i];
#pragma unroll
            for (int j = 0; j < 4; ++j) am = fmaxf(am, fmaxf(fabsf(bflo(c[i][j])), fabsf(bfhi(c[i][j])))); }
#pragma unroll
        for (int o = 1; o < 64; o <<= 1) am = fmaxf(am, __shfl_xor(am, o));
        am = fmaxf(am, 1e-30f);
        const float qs = 127.f / am;
        GAS v2u* dst = (GAS v2u*)(W8 + (size_t)r * DM) + F.lane;
#pragma unroll
        for (int i = 0; i < 8; ++i) { unsigned w[2];
#pragma unroll
            for (int hf = 0; hf < 2; ++hf) w[hf] = q8bits(bflo(c[i][2 * hf]), qs) | (q8bits(bfhi(c[i][2 * hf]), qs) << 8) | (q8bits(bflo(c[i][2 * hf + 1]), qs) << 16) | (q8bits(bfhi(c[i][2 * hf + 1]), qs) << 24);

            if (TMW) *(GAS v2u*)(W8 + pg8::tm_chunk_off(r, 8 * (F.lane + 64 * i), DM / 128, true)) = (v2u){w[0], w[1]}; else dst[64 * i] = (v2u){w[0], w[1]}; }
        if (F.lane == 0) sw[r] = am * (1.f / 127.f);
    }
}
#define DPP_QUAD(x, ctrl) __builtin_bit_cast(float, __builtin_amdgcn_update_dpp(0, __builtin_bit_cast(int, (x)), (ctrl), 0xf, 0xf, true))
__device__ __forceinline__ void fwht8(float (&x)[8]) {
#pragma unroll
    for (int s = 1; s < 8; s <<= 1)
#pragma unroll
        for (int i = 0; i < 8; ++i) if (!(i & s)) { const float a = x[i], b = x[i + s]; x[i] = a + b; x[i + s] = a - b; }
}
__device__ __forceinline__ void fwht32_quad(float (&x)[8], int lane) {
    fwht8(x);
    const float s1 = (lane & 1) ? -1.f : 1.f, s2 = (lane & 2) ? -1.f : 1.f;
#pragma unroll
    for (int i = 0; i < 8; ++i) { const float p = DPP_QUAD(x[i], 0xB1); x[i] = p + s1 * x[i]; }
#pragma unroll
    for (int i = 0; i < 8; ++i) { const float p = DPP_QUAD(x[i], 0x4E); x[i] = (p + s2 * x[i]) * 0.17677669529663687f; }
}
template <int KL> __device__ __forceinline__ void p0_quant_wout(Frame& F, const bf16* WT, unsigned char* W8, float* sw) {
    const int gw = F.vcu * NWAVES + F.wave, NGW = F.G * NWAVES;
    constexpr int NCH = KL / 8, NI = (NCH + 63) / 64;
    for (int r = gw; r < DM; r += NGW) {
        const GAS v4u* src = (const GAS v4u*)(WT + (size_t)r * KL);
        v4u c[NI]; float am = 0.f;
#pragma unroll
        for (int i = 0; i < NI; ++i) { const int ch = F.lane + 64 * i; c[i] = (ch < NCH) ? src[ch] : (v4u){0u, 0u, 0u, 0u}; }
#pragma unroll
        for (int i = 0; i < NI; ++i) { float x[8];
#pragma unroll
            for (int j = 0; j < 4; ++j) { x[2 * j] = bflo(c[i][j]); x[2 * j + 1] = bfhi(c[i][j]); }
#if MK_FFO_ROT
            fwht32_quad(x, F.lane);
#endif
#pragma unroll
            for (int j = 0; j < 4; ++j) { c[i][j] = cvtpk(x[2 * j], x[2 * j + 1]); am = fmaxf(am, fmaxf(fabsf(bflo(c[i][j])), fabsf(bfhi(c[i][j])))); } }
#pragma unroll
        for (int o = 1; o < 64; o <<= 1) am = fmaxf(am, __shfl_xor(am, o));
        am = fmaxf(am, 1e-30f);
        const float qs = 127.f / am;
#pragma unroll
        for (int i = 0; i < NI; ++i) { const int ch = F.lane + 64 * i; unsigned w[2];
#pragma unroll
            for (int hf = 0; hf < 2; ++hf) { const int q0 = (int)rintf(bflo(c[i][2 * hf]) * qs), q1 = (int)rintf(bfhi(c[i][2 * hf]) * qs), q2 = (int)rintf(bflo(c[i][2 * hf + 1]) * qs), q3 = (int)rintf(bfhi(c[i][2 * hf + 1]) * qs);
                w[hf] = (unsigned)(q0 & 255) | ((unsigned)(q1 & 255) << 8) | ((unsigned)(q2 & 255) << 16) | ((unsigned)q3 << 24); }
            if (ch < NCH) *(GAS v2u*)(W8 + (size_t)r * KL + 8 * ch) = (v2u){w[0], w[1]}; }
        if (F.lane == 0) sw[r] = am * (1.f / 127.f);
    }
}
__device__ __forceinline__ void act_quant_rows(Frame& F, const bf16* ACTp, unsigned char* A8, const unsigned* rmax, float* sa2) {
    const int gw = F.vcu * NWAVES + F.wave, NGW = F.G * NWAVES;
    constexpr int NCH = DFF / 8, NI = (NCH + 63) / 64;
    v4u cb[NI]; unsigned rmb = 0u;
    if (gw < M) { const GAS v4u* src = (const GAS v4u*)(ACTp + (size_t)gw * DFF); rmb = rmax[gw];
#pragma unroll
        for (int i = 0; i < NI; ++i) { const int ch = F.lane + 64 * i; cb[i] = src[ch < NCH ? ch : NCH - 1]; } }
    for (int m = gw; m < M; m += NGW) {
        const int mn = (m + NGW < M) ? m + NGW : m;
        v4u c[NI];
#pragma unroll
        for (int i = 0; i < NI; ++i) c[i] = cb[i];
        const float am = fmaxf(__builtin_bit_cast(float, rmb), 1e-30f), qs = 127.f / am;
        { const GAS v4u* srcn = (const GAS v4u*)(ACTp + (size_t)mn * DFF); rmb = rmax[mn];
#pragma unroll
          for (int i = 0; i < NI; ++i) { const int ch = F.lane + 64 * i; cb[i] = srcn[ch < NCH ? ch : NCH - 1]; } }
#pragma unroll
        for (int i = 0; i < NI; ++i) { const int ch = F.lane + 64 * i; unsigned w[2];
#pragma unroll
            for (int hf = 0; hf < 2; ++hf) { const int q0 = (int)rintf(bflo(c[i][2 * hf]) * qs), q1 = (int)rintf(bfhi(c[i][2 * hf]) * qs), q2 = (int)rintf(bflo(c[i][2 * hf + 1]) * qs), q3 = (int)rintf(bfhi(c[i][2 * hf + 1]) * qs);
                w[hf] = (unsigned)(q0 & 255) | ((unsigned)(q1 & 255) << 8) | ((unsigned)(q2 & 255) << 16) | ((unsigned)q3 << 24); }
            if (ch < NCH) *(GAS v2u*)(A8 + (size_t)m * DFF + 8 * ch) = (v2u){w[0], w[1]}; }
        if (F.lane == 0) sa2[m] = am * (1.f / 127.f);
    }
}
constexpr int ST_PITCH = 8200, ST_K = 4096, ST_CM_OFF = RING_OFF + 16 * ST_PITCH;
__device__ __forceinline__ void strip_rot4(float (&v)[32]) {
#pragma unroll
    for (int g = 0; g < 4; ++g)
#pragma unroll
        for (int st = 1; st < 8; st <<= 1)
#pragma unroll
            for (int a = 0; a < 8; ++a) if (!(a & st)) { const float x = v[8 * g + a], y = v[8 * g + a + st]; v[8 * g + a] = x + y; v[8 * g + a + st] = x - y; }
#pragma unroll
    for (int g = 0; g < 4; ++g) {
        asm volatile("v_nop\n\tv_nop\n\tv_permlane16_swap_b32 %0, %1\n\tv_permlane16_swap_b32 %2, %3\n\tv_permlane16_swap_b32 %4, %5\n\tv_permlane16_swap_b32 %6, %7\n\ts_nop 1"
                     : "+v"(v[8 * g + 0]), "+v"(v[8 * g + 1]), "+v"(v[8 * g + 2]), "+v"(v[8 * g + 3]), "+v"(v[8 * g + 4]), "+v"(v[8 * g + 5]), "+v"(v[8 * g + 6]), "+v"(v[8 * g + 7]));
#pragma unroll
        for (int a = 0; a < 8; a += 2) { const float x = v[8 * g + a], y = v[8 * g + a + 1]; v[8 * g + a] = x + y; v[8 * g + a + 1] = x - y; }
        asm volatile("v_nop\n\tv_nop\n\tv_permlane32_swap_b32 %0, %2\n\tv_permlane32_swap_b32 %1, %3\n\tv_permlane32_swap_b32 %4, %6\n\tv_permlane32_swap_b32 %5, %7\n\ts_nop 1"
                     : "+v"(v[8 * g + 0]), "+v"(v[8 * g + 1]), "+v"(v[8 * g + 2]), "+v"(v[8 * g + 3]), "+v"(v[8 * g + 4]), "+v"(v[8 * g + 5]), "+v"(v[8 * g + 6]), "+v"(v[8 * g + 7]));
#pragma unroll
        for (int a = 0; a < 8; ++a) if (!(a & 2)) { const float x = v[8 * g + a], y = v[8 * g + a + 2]; v[8 * g + a] = x + y; v[8 * g + a + 2] = x - y; }
    }
}
constexpr size_t WS_FOMAX = WS_CTL + 256 * 1024, WS_FOCNT = WS_FOMAX + 32 * 1024;
__device__ __forceinline__ void strip_desc(const Frame& F, int s, const float*& p, int& N, int& kind, int& l, int& c0, int& b0, int& nb, int& cgl) {
    constexpr int S_FO = 3 * (DM / 16), S_FI = 2 * DFF / 16, S_HI = NHG / 16;
    int r = s; b0 = 0; nb = 32; cgl = 0;
    if (r < 2 * S_FO) { cgl = r / 3; const int part = r - 3 * cgl; l = cgl / (DM / 16); kind = 0; N = DM; p = F.w_ff_out + (size_t)l * DFF * DM; c0 = 16 * (cgl - l * (DM / 16));
        b0 = 29 * part; nb = (part == 2) ? 28 : 29; return; } r -= 2 * S_FO;
    if (r < 2 * S_FI) { l = r / S_FI; r -= l * S_FI; kind = 1; N = 2 * DFF; p = F.w_ff_in + (size_t)l * DM * 2 * DFF; c0 = 16 * r; return; } r -= 2 * S_FI;
    if (r < S_HI) { l = 0; kind = 2; N = NHG; p = F.w_hg_in; c0 = 16 * r; return; } r -= S_HI;
    l = 0; kind = 3; N = DM; p = F.w_hg_out; c0 = 16 * r;
}
template <int KL, int N, bool ROT, bool TMW, int MODE, bool SYNC3, bool PERMK>
__device__ __forceinline__ void p0_strip(Frame& F, float (&v)[32], const float* src, const float* nsrc, int nN, int c0, int b0, int nb, int cgl, unsigned char* W8, float* sw, int par) {
    LAS unsigned char* st = F.lds + RING_OFF;
    LAS float* cm = (LAS float*)(F.lds + ST_CM_OFF) + par * 128;
    const int n = F.lane & 15, kq = F.lane >> 4;
    float mx = 0.f;
#pragma unroll 1
    for (int blk = b0 + F.wave; blk < b0 + nb; blk += NWAVES) {
        float x[32];
#pragma unroll
        for (int i = 0; i < 32; ++i) x[i] = v[i];
        const bool last = blk + NWAVES >= b0 + nb;
        const float* q = last ? nsrc : src + (size_t)(128 * (blk + NWAVES)) * N;
        const size_t step = (size_t)4 * (last ? nN : N);
#pragma unroll
        for (int i = 0; i < 32; ++i) v[i] = MK_LD_W(q + i * step);
        if (ROT) strip_rot4(x);
        LAS unsigned short* d = (LAS unsigned short*)(st + n * ST_PITCH + 256 * (blk - b0)) + (!ROT ? kq : PERMK ? 4 * (kq >> 1) + 8 * (kq & 1) : 4 * kq);
#pragma unroll
        for (int i = 0; i < 32; i += 2) { const unsigned w = cvtpk(x[i], x[i + 1]); mx = fmaxf(mx, fmaxf(fabsf(x[i]), fabsf(x[i + 1])));
            const int r3 = (i >> 1) & 1, r4 = (i >> 2) & 1;
            if (ROT) *(LAS unsigned*)(d + 32 * (i >> 3) + (PERMK ? 2 * r4 + 16 * r3 : 2 * r3 + 16 * r4)) = w;
            else { d[4 * i] = (unsigned short)w; d[4 * i + 4] = (unsigned short)(w >> 16); } }
    }
    mx = fmaxf(mx, __shfl_xor(mx, 16)); mx = fmaxf(mx, __shfl_xor(mx, 32));
    if (F.lane < 16) cm[F.wave * 16 + n] = mx;
    __syncthreads();
    float am = 1e-30f;
#pragma unroll
    for (int w = 0; w < NWAVES; ++w) am = fmaxf(am, cm[w * 16 + n]);
    am = bflo(cvtpk(am, am));
    if (SYNC3) {
        unsigned* gmax = (unsigned*)(F.ws + WS_FOMAX) + cgl * 16; unsigned* cnt = (unsigned*)(F.ws + WS_FOCNT) + cgl;
        if (F.tid < 16) am = fmaxf(am, __builtin_bit_cast(float, __hip_atomic_fetch_max(gmax + n, __builtin_bit_cast(unsigned, am), __ATOMIC_RELAXED, __HIP_MEMORY_SCOPE_AGENT)));
        if (F.wave == 0) { asm volatile("s_waitcnt vmcnt(0)" ::: "memory");
            if (F.tid == 0) { (void)xb_add(cnt, 1u); unsigned sp = 0; while (xb_ld(cnt) < 3u && ++sp < (1u << 22)) __builtin_amdgcn_s_sleep(1); } }
        __syncthreads();
        am = fmaxf(am, __builtin_bit_cast(float, xb_ld(gmax + n)));
    }
    const float qs = 127.f / am;
    const int col = c0 + n; int R = col;
    if (MODE == 1) { const int c = (col < DFF) ? col : col - DFF; R = 256 * (c >> 7) + (c & 127) + ((col < DFF) ? 0 : 128); }
    if (MODE == 2) { const int s = col >> 12, cc = col & 4095, c64 = cc & 63; R = 256 * (cc >> 6) + 128 * (s >> 1) + 32 * (c64 >> 4) + 8 * ((c64 >> 2) & 3) + 4 * (s & 1) + (c64 & 3); }
#pragma unroll 2
    for (int t = 0; t < 8; ++t) {
        const int c = 4 * (F.wave + NWAVES * t) + kq;
        if (c < 8 * nb) {
            const LAS v2u* s2 = (const LAS v2u*)(st + n * ST_PITCH + 32 * c);
            unsigned w[4];
#pragma unroll
            for (int j = 0; j < 4; ++j) { const v2u u = s2[j];
                w[j] = q8bits(bflo(u.x), qs) | (q8bits(bfhi(u.x), qs) << 8) | (q8bits(bflo(u.y), qs) << 16) | (q8bits(bfhi(u.y), qs) << 24); }
            const int kb = 128 * b0 + 16 * c;
            if (TMW) *(GAS v4u*)(W8 + pg8::tm_chunk_off(R, kb, KL / 128, true)) = (v4u){w[0], w[1], w[2], w[3]};
            else *(GAS v4u*)(W8 + (size_t)R * KL + kb) = (v4u){w[0], w[1], w[2], w[3]};
        }
    }
    if (F.tid < 16 && b0 == 0) sw[R] = am * (ROT ? 0.17677669529663687f / 127.f : 1.f / 127.f);
    __syncthreads();
}
#ifndef MK_P0_DEFER
#define MK_P0_DEFER 0
#endif
constexpr int SX_FO = 3 * (DM / 16), SX_FI = 2 * DFF / 16, SX_HI = NHG / 16, SX_HO = DM / 16, SX_ALL = 2 * SX_FO + 2 * SX_FI + SX_HI + SX_HO;
constexpr int DEF_FI = MK_P0_DEFER ? 640 : 0, DEF_FO = MK_P0_DEFER ? 213 : 0;
static_assert(DEF_FI <= SX_FI && 3 * DEF_FO <= SX_FO, "deferred strip counts");
__device__ __forceinline__ int strip_full_index(int lst, int j) {
    if (lst == 3) return j;
    if (lst == 4) return 2 * SX_FO + j;
    if (lst == 1) return 2 * SX_FO + SX_FI + j;
    if (lst == 2) return SX_FO + j;
    if (j < SX_FO) return j;
    j -= SX_FO; if (j < SX_FO - 3 * DEF_FO) return SX_FO + 3 * DEF_FO + j;
    j -= SX_FO - 3 * DEF_FO; if (j < SX_FI) return 2 * SX_FO + j;
    j -= SX_FI; if (j < SX_FI - DEF_FI) return 2 * SX_FO + SX_FI + DEF_FI + j;
    j -= SX_FI - DEF_FI; return 2 * SX_FO + 2 * SX_FI + j;
}
template <int LST> __device__ __forceinline__ void run_strips(Frame& F, int j0, int jstep) {
    constexpr int CNT = LST == 0 ? SX_ALL - 3 * DEF_FO - DEF_FI : LST == 1 ? DEF_FI : LST == 2 ? 3 * DEF_FO : LST == 3 ? 2 * SX_FO : SX_ALL - 2 * SX_FO;
    const int n = F.lane & 15, kq = F.lane >> 4;
    int j = j0, par = 0;
    if (j < 0 || j >= CNT) return;
    const float* p; int N, kind, l, c0, b0, nb, cgl;
    strip_desc(F, strip_full_index(LST, j), p, N, kind, l, c0, b0, nb, cgl);
    const float* src = p + (size_t)kq * N + c0 + n;
    float v[32];
    { const float* q = src + (size_t)(128 * (b0 + F.wave)) * N; const size_t step = (size_t)4 * N;
#pragma unroll
      for (int i = 0; i < 32; ++i) v[i] = MK_LD_W(q + i * step); }
#pragma unroll 1
    while (j < CNT) {
        const int jn = j + jstep;
        const float* pn; int Nn, kindn, ln, c0n, b0n, nbn, cgln;
        strip_desc(F, strip_full_index(LST, jn < CNT ? jn : j), pn, Nn, kindn, ln, c0n, b0n, nbn, cgln);
        const float* srcn = pn + (size_t)kq * Nn + c0n + n;
        const float* nsrc = srcn + (size_t)(128 * (b0n + F.wave)) * Nn;
        if (LST != 1 && LST != 4 && kind == 0) p0_strip<DFF, DM, true, false, 0, true, true>(F, v, src, nsrc, Nn, c0, b0, nb, cgl, F.ws + WS_W8O + l * W8O_STRIDE, (float*)(F.ws + WS_SWO) + l * DM, par);
        else if (LST != 2 && LST != 3 && kind == 1) p0_strip<DM, 2 * DFF, false, TM_FFI, 1, false, false>(F, v, src, nsrc, Nn, c0, 0, 32, 0, F.ws + WS_W8 + l * W8_STRIDE, (float*)(F.ws + WS_SW) + l * 2 * DFF, par);
        else if ((LST == 0 || LST == 4) && kind == 2) p0_strip<DM, NHG, false, false, 2, false, false>(F, v, src, nsrc, Nn, c0, 0, 32, 0, F.ws + WS_W8H, (float*)(F.ws + WS_SWH), par);
        else if (LST == 0 || LST == 4) p0_strip<DM, DM, true, false, 0, false, false>(F, v, src, nsrc, Nn, c0, 0, 32, 0, F.ws + WS_W8G, (float*)(F.ws + WS_SWG), par);
        j = jn; src = srcn; kind = kindn; l = ln; c0 = c0n; b0 = b0n; nb = nbn; cgl = cgln; par ^= 1;
    }
    asm volatile("s_waitcnt vmcnt(0)" ::: "memory");
    __syncthreads();
}
template <int LST> __device__ __forceinline__ void run_deferred_strips(Frame& F, int units) {
    if ((LST == 1 ? DEF_FI : 3 * DEF_FO) == 0) return;
    const int rem = units % F.G, bx = (int)blockIdx.x;
    asm volatile("s_waitcnt vmcnt(0)" ::: "memory"); __syncthreads();
    run_strips<LST>(F, rem == 0 ? bx : bx - rem, rem == 0 ? F.G : F.G - rem);
}
__device__ __forceinline__ void p0_prologue(Frame& F) {
    LAS float* scr = (LAS float*)(F.lds + RING_OFF + F.wave * 16384);
    const int gw = F.vcu * NWAVES + F.wave, NGW = F.G * NWAVES;
    constexpr int I0 = (DM / 64) * (NQKV / 32), I1 = (DATT / 64) * (DM / 32), I2 = (DM / 64) * (NHG / 32), I3 = (DM / 64) * (DM / 32), I4 = (DM / 64) * (2 * DFF / 32), I6 = (DFF / 64) * (DM / 32);
    constexpr int NITEMS = P0_STRIP ? I0 + I1 : I0 + I1 + I2 + I3 + 2 * I4 + 2 * I6;
    if (P0_STRIP) { if (P0_OVL) run_strips<3>(F, F.vcu, F.G); else run_strips<0>(F, F.vcu, F.G); }
    for (int it = gw; it < NITEMS; it += NGW) {
        int r = it;
        if (r < I0) { p0_transpose_item(F.w_att_in, DM, NQKV, (bf16*)(F.ws + WS_WATTI), 0, scr, r, F.lane); continue; } r -= I0;
        if (r < I1) { p0_transpose_item(F.w_att_out, DATT, DM, (bf16*)(F.ws + WS_WATTO), 0, scr, r, F.lane); continue; } r -= I1;
        if (r < I2) { p0_transpose_item(F.w_hg_in, DM, NHG, (bf16*)(F.ws + WS_WHGI), HG_FUSE ? 2 : 0, scr, r, F.lane); continue; } r -= I2;
        if (r < I3) { p0_transpose_item(F.w_hg_out, DM, DM, (bf16*)(F.ws + WS_WHGO), 0, scr, r, F.lane); continue; } r -= I3;
        if (r < 2 * I4) { const int l = r / I4; p0_transpose_item(F.w_ff_in + (size_t)l * DM * 2 * DFF, DM, 2 * DFF, (bf16*)(F.ws + WS_WFFI + l * WFFI_STRIDE), 1, scr, r - l * I4, F.lane); continue; } r -= 2 * I4;
        { const int l = r / I6; p0_transpose_item(F.w_ff_out + (size_t)l * DFF * DM, DFF, DM, (bf16*)(F.ws + WS_WFFO + l * WFFO_STRIDE), 0, scr, r - l * I6, F.lane); }
    }
    float* BT = (float*)(F.ws + WS_TAB); float* LB = (float*)(F.ws + WS_TAB + 65536);
    const int gt = blockIdx.x * (NWAVES * 64) + F.tid, NT = F.G * NWAVES * 64;
    for (int idx = gt; idx < 3 * 16 * 129; idx += NT) { const int g = idx / (16 * 129), rem = idx - g * 16 * 129, h = rem / 129, j = rem - h * 129;
        BT[idx] = F.rel_bias[t5_bucket(j << (2 * g)) * 48 + g * 16 + h]; }
    for (int c = gt; c < DM; c += NT) { const float l0 = F.lb_logits[c], l1 = F.lb_logits[DM + c]; LB[c] = 1.f / (1.f + expf(l0 - l1)); }
    norm_rows<false, ATT_I8 ? 2 : 1>(F, F.x, nullptr, nullptr, (bf16*)(F.ws + WS_XN), nullptr, F.gains, (float*)(F.ws + WS_SA));
}
__device__ __forceinline__ void attn_naive(Frame& F) {
    const int gw = F.vcu * NWAVES + F.wave, NGW = F.G * NWAVES;
    const bf16* QKV = (const bf16*)(F.ws + WS_QKV); bf16* MRG = (bf16*)(F.ws + WS_MRG); const float* BT = (const float*)(F.ws + WS_TAB);
    for (int item = gw; item < M * 16; item += NGW) {
        const int m = item >> 4, h = item & 15, t = m & (SEQ - 1);
        float mx = -1e30f, l = 0.f, a0 = 0.f, a1 = 0.f;
#pragma unroll 1
        for (int g = 0; g < 3; ++g) {
            const int sh = 2 * g;
            const unsigned qw = *(const GAS unsigned*)(QKV + (size_t)m * NQKV + g * 6144 + h * 128 + 2 * F.lane);
            const float q0 = bflo(qw) * QSCALE, q1 = bfhi(qw) * QSCALE;
            const int jmax = (t >> sh) < 128 ? (t >> sh) : 128;
            const float* bt = BT + (g * 16 + h) * 129;
#pragma unroll 1
            for (int j0 = 0; j0 <= jmax; j0 += 8) {
                unsigned kw[8], vw[8]; float bs[8];
#pragma unroll
                for (int u = 0; u < 8; ++u) { const int jj = (j0 + u) <= jmax ? (j0 + u) : jmax; const bf16* rp = QKV + (size_t)(m - (jj << sh)) * NQKV + g * 6144 + h * 128 + 2 * F.lane;
                    kw[u] = *(const GAS unsigned*)(rp + 2048); vw[u] = *(const GAS unsigned*)(rp + 4096); bs[u] = bt[jj]; }
                float s[8]; float cm = -INFINITY;
#pragma unroll
                for (int u = 0; u < 8; ++u) { s[u] = wave_sum(q0 * bflo(kw[u]) + q1 * bfhi(kw[u])) + bs[u]; if (j0 + u > jmax) s[u] = -INFINITY; cm = fmaxf(cm, s[u]); }
                const float mn = fmaxf(mx, cm), sc = __expf(mx - mn); l *= sc; a0 *= sc; a1 *= sc; mx = mn;
#pragma unroll
                for (int u = 0; u < 8; ++u) { const float p = __expf(s[u] - mn); l += p; a0 += p * bflo(vw[u]); a1 += p * bfhi(vw[u]); }
            }
        }
        const float inv = 1.f / l;
        *(GAS unsigned*)(MRG + (size_t)m * DATT + h * 128 + 2 * F.lane) = pk2(a0 * inv, a1 * inv);
    }
}
__device__ __forceinline__ void hgrn_naive(Frame& F) {
    if (blockIdx.x >= 64) return;
    const int b = blockIdx.x >> 5, h = blockIdx.x & 31;
    const bf16* HP = (const bf16*)(F.ws + WS_QKV); float* ORAW = (float*)(F.ws + WS_ACT); const float* LB = (const float*)(F.ws + WS_TAB + 65536);
    LAS f32x4* PRM = (LAS f32x4*)(F.lds);
    LAS float* VV = (LAS float*)(F.lds + 32768);
    LAS float* OP = (LAS float*)(F.lds + 32768 + 8192);
    const int e = F.tid & 127, qd = F.tid >> 7, ps = F.tid >> 6, pl = F.tid & 63;
    const float lb0 = LB[h * 128 + 2 * pl], lb1 = LB[h * 128 + 2 * pl + 1];
    float S[32];
#pragma unroll
    for (int d = 0; d < 32; ++d) S[d] = 0.f;
    unsigned qw, fw, iw;
#define HG_LOAD(n) do { const bf16* bp = HP + (size_t)(b * SEQ + (n) * 8 + ps) * NHG + h * 128 + 2 * pl; qw = *(const GAS unsigned*)bp; fw = *(const GAS unsigned*)(bp + 4096); iw = *(const GAS unsigned*)(bp + 8192); } while (0)
#define HG_WRITE(buf) do { const float f0 = bflo(fw), f1 = bfhi(fw), r0 = bflo(qw), r1 = bfhi(qw); \
        const float g0 = lb0 + (1.f - lb0) / (1.f + __expf(-f0)), g1 = lb1 + (1.f - lb1) / (1.f + __expf(-f1)); \
        const int o = ((buf) * 8 + ps) * 128 + 2 * pl; \
        PRM[o] = (f32x4){g0, 1.f - g0, r0 / (1.f + __expf(-r0)) * QSCALE, 0.f}; PRM[o + 1] = (f32x4){g1, 1.f - g1, r1 / (1.f + __expf(-r1)) * QSCALE, 0.f}; \
        VV[o] = bflo(iw); VV[o + 1] = bfhi(iw); } while (0)
    HG_LOAD(0); HG_WRITE(0); __syncthreads();
#pragma unroll 1
    for (int n = 0; n < SEQ / 8; ++n) {
        const int buf = n & 1;
        if (n + 1 < SEQ / 8) HG_LOAD(n + 1);
#pragma unroll 1
        for (int st = 0; st < 8; ++st) {
            const float v = VV[(buf * 8 + st) * 128 + e]; float o = 0.f;
#pragma unroll
            for (int dd = 0; dd < 32; ++dd) { const f32x4 P = PRM[(buf * 8 + st) * 128 + qd * 32 + dd]; S[dd] = P.x * S[dd] + P.y * v; o += P.z * S[dd]; }
            OP[(st * 4 + qd) * 128 + e] = o;
        }
        if (n + 1 < SEQ / 8) HG_WRITE(buf ^ 1);
        __syncthreads();
#pragma unroll
        for (int r = 0; r < 2; ++r) { const int idx = F.tid + 512 * r, st = idx >> 7, ee = idx & 127;
            const float sum = (OP[(st * 4 + 0) * 128 + ee] + OP[(st * 4 + 1) * 128 + ee]) + (OP[(st * 4 + 2) * 128 + ee] + OP[(st * 4 + 3) * 128 + ee]);
            ORAW[(size_t)(b * SEQ + n * 8 + st) * DM + h * 128 + ee] = sum; }
        __syncthreads();
    }
#undef HG_LOAD
#undef HG_WRITE
}
__device__ __forceinline__ void hgrn_gate(Frame& F) {
    const int gw = F.vcu * NWAVES + F.wave, NGW = F.G * NWAVES;
    const float* ORAW = (const float*)(F.ws + WS_ACT); const bf16* HP = (const bf16*)(F.ws + WS_QKV); bf16* OG = (bf16*)(F.ws + WS_OG);
    const f32x4 gn = *(const GAS f32x4*)(F.hg_gain + 4 * (F.lane & 31));
    for (int m = gw; m < M; m += NGW) {
        const GAS f32x4* orow = (const GAS f32x4*)(ORAW + (size_t)m * DM) + F.lane;
        const GAS v2u* grow = (const GAS v2u*)(HP + (size_t)m * NHG + 3 * DM) + F.lane;
        GAS v2u* o8 = (GAS v2u*)(OG + (size_t)m * DM) + F.lane;
#pragma unroll 4
        for (int j = 0; j < 16; ++j) {
            const f32x4 o = orow[64 * j]; const v2u gw2 = grow[64 * j];
            float ss = (o.x * o.x + o.y * o.y) + (o.z * o.z + o.w * o.w);
#pragma unroll
            for (int k = 1; k < 32; k <<= 1) ss += __shfl_xor(ss, k);
            const float rstd = 1.f / sqrtf(ss * (1.f / HD) + RMS_EPS);
            const float g0 = bflo(gw2.x), g1 = bfhi(gw2.x), g2 = bflo(gw2.y), g3 = bfhi(gw2.y);
            v2u w; w.x = pk2(o.x * rstd * gn.x * (g0 / (1.f + __expf(-g0))), o.y * rstd * gn.y * (g1 / (1.f + __expf(-g1))));
            w.y = pk2(o.z * rstd * gn.z * (g2 / (1.f + __expf(-g2))), o.w * rstd * gn.w * (g3 / (1.f + __expf(-g3))));
            o8[64 * j] = w;
        }
    }
}
typedef short v4i16_t __attribute__((ext_vector_type(4)));
constexpr int AT_K = 0, AT_KP = 128 * 272, AT_V = 2 * AT_KP, AT_VP = 128 * 288, AT_BT = AT_V + 2 * AT_VP, AT_END = AT_BT + 1024;
static_assert(AT_END <= LDSCTL_OFF, "attention LDS map");
constexpr size_t WS_AO = 2334 * MiB, WS_LSE = 2526 * MiB, WS_END2 = 2529 * MiB;
#define AT_ROW(row_, h_) (QKV_HM ? (size_t)(h_) * ((size_t)M * 128) + (size_t)(row_) * 128 : (size_t)(row_) * 2048 + (size_t)(h_) * 128)
__device__ __forceinline__ void attn_load_page(LAS unsigned char* L, int tid, const bf16* Kt, const bf16* Vt, int row0, int h, int slot) {
#pragma unroll
    for (int i = 0; i < 4; ++i) { const int chunk = tid + 512 * i, r = chunk >> 4, c = chunk & 15;
        const v4u kv = *(const GAS v4u*)(Kt + AT_ROW(row0 + r, h) + 8 * c); const v4u vv = *(const GAS v4u*)(Vt + AT_ROW(row0 + r, h) + 8 * c);
        *(LAS v4u*)(L + AT_K + slot * AT_KP + r * 272 + 16 * c) = kv; *(LAS v4u*)(L + AT_V + slot * AT_VP + r * 288 + 16 * c) = vv; }
}
__device__ __forceinline__ void attn_mfma(Frame& F) {
    const bf16* QKVp = (const bf16*)(F.ws + WS_QKV); bf16* AO = (bf16*)(F.ws + WS_AO); float* LSE = (float*)(F.ws + WS_LSE); const float* BT = (const float*)(F.ws + WS_TAB);
    LAS unsigned char* L = F.lds;
    const int w = F.wave, li = F.lane & 15, g4 = F.lane >> 4;
    const int per = (6144 + F.G - 1) / F.G, U0 = F.vcu * per, U1 = (U0 + per) < 6144 ? (U0 + per) : 6144;
    int prevU = -2;
    v4u pk[4], pv[4];
#define AT_DECODE(UU, gh_, qb_, g_, h_, q0_) const int gh_ = (UU) >> 7, qb_ = (UU) & 127, g_ = gh_ >> 4, h_ = gh_ & 15, q0_ = 128 * qb_
#define AT_PREFETCH(UU) do { AT_DECODE(UU, ghn, qbn, gn_, hn, q0n); (void)qbn; const bf16* Kn = QKVp + (size_t)(3 * gn_ + 1) * M * 2048; const bf16* Vn = Kn + (size_t)M * 2048; \
        _Pragma("unroll") for (int i = 0; i < 4; ++i) { const int chunk = F.tid + 512 * i, r = chunk >> 4, c = chunk & 15; \
            pk[i] = *(const GAS v4u*)(Kn + AT_ROW(q0n + r, hn) + 8 * c); pv[i] = *(const GAS v4u*)(Vn + AT_ROW(q0n + r, hn) + 8 * c); } \
        } while (0)
#define AT_QLOAD(UU) do { AT_DECODE(UU, ghq, qbq, gq_, hq, q0q); (void)qbq; const bf16* qp = QKVp + (size_t)(3 * gq_) * M * 2048 + AT_ROW(q0q + 16 * w + li, hq) + 8 * g4; \
        _Pragma("unroll") for (int ds = 0; ds < 4; ++ds) qf[ds] = *(const GAS bf16x8*)(qp + 32 * ds); } while (0)
    bf16x8 qf[4];
    if (U0 < U1) { AT_PREFETCH(U0); AT_QLOAD(U0); }
#pragma unroll 1
    for (int U = U0; U < U1; ++U) {
        const int gh = U >> 7, qb = U & 127, g = gh >> 4, h = gh & 15, sh = 2 * g, n = SEQ >> sh, q0 = 128 * qb, i0 = q0 & (n - 1);
        const bool first = (i0 == 0);
        const bf16* Qt = QKVp + (size_t)(3 * g) * M * 2048; const bf16* Kt = Qt + (size_t)M * 2048; const bf16* Vt = Kt + (size_t)M * 2048;
        __builtin_amdgcn_s_barrier(); asm volatile("" ::: "memory");
        if (U == U0 || qb == 0) { if (F.tid < 161) { const int rel = F.tid - 16; ((LAS float*)(L + AT_BT))[F.tid] = (rel >= 0 && rel <= 128) ? BT[gh * 129 + rel] : 0.f; } }
        if (first) { for (int i = F.tid; i < AT_VP / 16; i += NWAVES * 64) *(LAS v4u*)(L + AT_V + ((qb - 1) & 1) * AT_VP + 16 * i) = (v4u){0u, 0u, 0u, 0u}; }
        else if (prevU != U - 1) attn_load_page(L, F.tid, Kt, Vt, q0 - 128, h, (qb - 1) & 1);
#pragma unroll
        for (int i = 0; i < 4; ++i) { const int chunk = F.tid + 512 * i, r = chunk >> 4, c = chunk & 15;
            *(LAS v4u*)(L + AT_K + (qb & 1) * AT_KP + r * 272 + 16 * c) = pk[i]; *(LAS v4u*)(L + AT_V + (qb & 1) * AT_VP + r * 288 + 16 * c) = pv[i]; }
        prevU = U;
        LDS_WAIT(); __builtin_amdgcn_s_barrier(); asm volatile("" ::: "memory");
        { const int Un = (U + 1 < U1) ? U + 1 : U; AT_PREFETCH(Un); }
        f32x4 sc[9];
        __builtin_amdgcn_s_setprio(1);
#pragma unroll
        for (int blk = 0; blk < 9; ++blk) { const int kb = w + blk, slot = (qb - 1 + (kb >> 3)) & 1;
            const LAS unsigned char* kp = L + AT_K + slot * AT_KP + ((kb & 7) * 16 + li) * 272 + 16 * g4;
            f32x4 acc = (f32x4){0.f, 0.f, 0.f, 0.f};
#pragma unroll
            for (int ds = 0; ds < 4; ++ds) { const bf16x8 a = *(const LAS bf16x8*)(kp + 64 * ds); acc = __builtin_amdgcn_mfma_f32_16x16x32_bf16(a, qf[ds], acc, 0, 0, 0); }
            sc[blk] = acc; }
        __builtin_amdgcn_s_setprio(0);
        { const int Uq = (U + 1 < U1) ? U + 1 : U; AT_QLOAD(Uq); }
        const LAS float* bt = (const LAS float*)(L + AT_BT) + (16 + 128 + li - 4 * g4);
        const int ql = 16 * w + li, relmax = first ? (ql < 128 ? ql : 128) : 128;
        float mx = -INFINITY;
#pragma unroll
        for (int blk = 0; blk < 9; ++blk)
#pragma unroll
            for (int r = 0; r < 4; ++r) sc[blk][r] = sc[blk][r] * QSCALE + *(const volatile LAS float*)(bt - (16 * blk + r));
        if (!first) {
#pragma unroll
            for (int blk = 0; blk < 9; ++blk)
#pragma unroll
                for (int r = 0; r < 4; ++r) { const int rel = 128 + li - 16 * blk - 4 * g4 - r;
                    const float s = (blk == 0) ? ((rel <= 128) ? sc[blk][r] : -INFINITY) : (blk == 8) ? ((rel >= 0) ? sc[blk][r] : -INFINITY) : sc[blk][r]; sc[blk][r] = s; mx = fmaxf(mx, s); }
        } else {
#pragma unroll
            for (int blk = 0; blk < 9; ++blk)
#pragma unroll
                for (int r = 0; r < 4; ++r) { const int rel = 128 + li - 16 * blk - 4 * g4 - r;
                    const float s = (rel >= 0 && rel <= relmax) ? sc[blk][r] : -INFINITY; sc[blk][r] = s; mx = fmaxf(mx, s); }
        }
        mx = xl32_max(xl16_max(mx));
        float lsum = 0.f;
#pragma unroll
        for (int blk = 0; blk < 9; ++blk)
#pragma unroll
            for (int r = 0; r < 4; ++r) { const float p = __expf(sc[blk][r] - mx); sc[blk][r] = p; lsum += p; }
        lsum = xl32_sum(xl16_sum(lsum));
        f32x4 o[8];
#pragma unroll
        for (int db = 0; db < 8; ++db) o[db] = (f32x4){0.f, 0.f, 0.f, 0.f};
        __builtin_amdgcn_s_setprio(1);
#pragma unroll
        for (int st = 0; st < 5; ++st) {
            const int ba = 2 * st, bb = (2 * st + 1) < 9 ? (2 * st + 1) : 8;
            v4u pw; pw.x = cvtpk(sc[ba][0], sc[ba][1]); pw.y = cvtpk(sc[ba][2], sc[ba][3]);
            if (2 * st + 1 < 9) { pw.z = cvtpk(sc[bb][0], sc[bb][1]); pw.w = cvtpk(sc[bb][2], sc[bb][3]); } else { pw.z = 0u; pw.w = 0u; }
            const bf16x8 pf = __builtin_bit_cast(bf16x8, pw);
            const int kba = w + ba, kbb = w + bb;
            const LAS unsigned char* va = L + AT_V + ((qb - 1 + (kba >> 3)) & 1) * AT_VP + ((kba & 7) * 16 + 4 * g4 + (li >> 2)) * 288 + 8 * (li & 3);
            const LAS unsigned char* vb = L + AT_V + ((qb - 1 + (kbb >> 3)) & 1) * AT_VP + ((kbb & 7) * 16 + 4 * g4 + (li >> 2)) * 288 + 8 * (li & 3);
#pragma unroll
            for (int db = 0; db < 8; ++db) {
                const v4i16_t lo = __builtin_amdgcn_ds_read_tr16_b64_v4i16((LAS v4i16_t*)(va + 32 * db)), hi = __builtin_amdgcn_ds_read_tr16_b64_v4i16((LAS v4i16_t*)(vb + 32 * db));
                const bf16x8 a = __builtin_shufflevector(lo, hi, 0, 1, 2, 3, 4, 5, 6, 7);
                o[db] = __builtin_amdgcn_mfma_f32_16x16x32_bf16(a, pf, o[db], 0, 0, 0); }
        }
        __builtin_amdgcn_s_setprio(0);
        const float inv = 1.f / lsum;
        const size_t orow = (size_t)g * M + (size_t)(q0 + 16 * w + li);
        bf16* op = AO + orow * 2048 + h * 128 + 4 * g4;
#pragma unroll
        for (int db = 0; db < 8; ++db) *(GAS v2u*)(op + 16 * db) = (v2u){cvtpk(o[db][0] * inv, o[db][1] * inv), cvtpk(o[db][2] * inv, o[db][3] * inv)};
        if (g4 == 0) LSE[orow * 16 + h] = mx + __logf(lsum);
    }
#undef AT_PREFETCH
#undef AT_QLOAD
#undef AT_DECODE
}
__device__ __forceinline__ void attn_merge(Frame& F) {
    const int gw = F.vcu * NWAVES + F.wave, NGW = F.G * NWAVES;
    const bf16* AO = (const bf16*)(F.ws + WS_AO); const float* LSE = (const float*)(F.ws + WS_LSE); bf16* MRG = (bf16*)(F.ws + WS_MRG);
    v4u pa[4], pb[4], pd[4]; float pl0[4], pl1[4], pl2[4];
#define AM_LOAD(mm) do { const int t_ = (mm) & (SEQ - 1), bb_ = (mm) & ~(SEQ - 1); size_t r_[3]; \
        _Pragma("unroll") for (int g = 0; g < 3; ++g) { const int sh = 2 * g; r_[g] = (size_t)g * M + (size_t)(bb_ + ((t_ & ((1 << sh) - 1)) << (13 - sh)) + (t_ >> sh)); } \
        _Pragma("unroll") for (int k = 0; k < 4; ++k) { const int hd = (F.lane >> 4) + 4 * k, c = F.lane + 64 * k; \
            pl0[k] = LSE[r_[0] * 16 + hd]; pl1[k] = LSE[r_[1] * 16 + hd]; pl2[k] = LSE[r_[2] * 16 + hd]; \
            pa[k] = *(const GAS v4u*)(AO + r_[0] * 2048 + 8 * c); pb[k] = *(const GAS v4u*)(AO + r_[1] * 2048 + 8 * c); pd[k] = *(const GAS v4u*)(AO + r_[2] * 2048 + 8 * c); } } while (0)
    if (gw < M) AM_LOAD(gw);
    for (int m = gw; m < M; m += NGW) {
        const int mn = (m + NGW < M) ? m + NGW : m;
        v4u ca[4], cb[4], cd[4]; float l0v[4], l1v[4], l2v[4];
#pragma unroll
        for (int k = 0; k < 4; ++k) { ca[k] = pa[k]; cb[k] = pb[k]; cd[k] = pd[k]; l0v[k] = pl0[k]; l1v[k] = pl1[k]; l2v[k] = pl2[k]; }
        AM_LOAD(mn);
#pragma unroll
        for (int k = 0; k < 4; ++k) {
            const int c = F.lane + 64 * k;
            const float l0 = l0v[k], l1 = l1v[k], l2 = l2v[k];
            const float mx = fmaxf(l0, fmaxf(l1, l2)); float w0 = __expf(l0 - mx), w1 = __expf(l1 - mx), w2 = __expf(l2 - mx); const float inv = 1.f / (w0 + w1 + w2); w0 *= inv; w1 *= inv; w2 *= inv;
            const v4u a = ca[k], b = cb[k], d = cd[k];
            v4u o;
#pragma unroll
            for (int j = 0; j < 4; ++j) o[j] = cvtpk(w0 * bflo(a[j]) + w1 * bflo(b[j]) + w2 * bflo(d[j]), w0 * bfhi(a[j]) + w1 * bfhi(b[j]) + w2 * bfhi(d[j]));
            *(GAS v4u*)(MRG + (size_t)m * DATT + 8 * c) = o;
        }
    }
#undef AM_LOAD
}
typedef float f32x16 __attribute__((ext_vector_type(16)));
typedef short s16x4 __attribute__((ext_vector_type(4)));
constexpr int HG_QR = 0, HG_QD = 17408, HG_KR = 34816, HG_KRT = 52224, HG_VT = 70656, HG_ST0 = 75264, HG_ST1 = 83968, HG_SEG = 92672, HG_EL = 96768, HG_DEC = 97280, HG_END = 97792;
static_assert(HG_END <= RING_BYTES, "hgrn LDS map");
__device__ __forceinline__ void hgrn_mfma(Frame& F) {
    const bf16* HP = (const bf16*)(F.ws + WS_QKV); float* ORAW = (float*)(F.ws + WS_ACT); const float* LB = (const float*)(F.ws + WS_TAB + 65536);
    LAS unsigned char* L = F.lds;
    const int w = F.wave, cp = F.lane, l31 = F.lane & 31, hh = F.lane >> 5;
#pragma unroll 1
    for (int u = blockIdx.x; u < 256; u += F.G) {
        const int bh = u >> 2, e0 = (u & 3) * 32, b = bh >> 5, h = bh & 31;
        const float lb0 = LB[h * 128 + 2 * cp], lb1 = LB[h * 128 + 2 * cp + 1];
        const size_t rowbase = (size_t)b * SEQ;
        unsigned qraw[8], fraw[8], vraw[2];
#define HGM_LOAD(c) do { \
            _Pragma("unroll") for (int i = 0; i < 8; ++i) { const bf16* bp = HP + (rowbase + 64 * (c) + 8 * w + i) * NHG + h * 128 + 2 * cp; qraw[i] = *(const GAS unsigned*)bp; fraw[i] = *(const GAS unsigned*)(bp + 4096); } \
            _Pragma("unroll") for (int k = 0; k < 2; ++k) { const int vrow = (F.tid >> 4) + 32 * k; vraw[k] = *(const GAS unsigned*)(HP + (rowbase + 64 * (c) + vrow) * NHG + 8192 + h * 128 + e0 + 2 * (F.tid & 15)); } } while (0)
        f32x16 S;
#pragma unroll
        for (int i = 0; i < 16; ++i) S[i] = 0.f;
        for (int i = F.tid; i < 8704 / 4; i += NWAVES * 64) ((LAS unsigned*)(L + HG_ST0))[i] = 0u;
        HGM_LOAD(0);
#pragma unroll 1
        for (int c = 0; c < SEQ / 64; ++c) {
            float q[8][2], k[8][2], cs[8][2]; float run0 = 0.f, run1 = 0.f;
#pragma unroll
            for (int i = 0; i < 8; ++i) {
                const float f0 = bflo(fraw[i]), f1 = bfhi(fraw[i]), r0 = bflo(qraw[i]), r1 = bfhi(qraw[i]);
                const float g0 = lb0 + (1.f - lb0) * __builtin_amdgcn_rcpf(1.f + __expf(-f0)), g1 = lb1 + (1.f - lb1) * __builtin_amdgcn_rcpf(1.f + __expf(-f1));
                run0 += __logf(g0); run1 += __logf(g1); cs[i][0] = run0; cs[i][1] = run1;
                k[i][0] = 1.f - g0; k[i][1] = 1.f - g1;
                q[i][0] = r0 * __builtin_amdgcn_rcpf(1.f + __expf(-r0)) * QSCALE; q[i][1] = r1 * __builtin_amdgcn_rcpf(1.f + __expf(-r1)) * QSCALE;
            }
            { typedef float f32x2v __attribute__((ext_vector_type(2))); *(LAS f32x2v*)(L + HG_SEG + (w * 128 + 2 * cp) * 4) = (f32x2v){run0, run1}; }
            const unsigned v0 = vraw[0], v1 = vraw[1];
            LDS_WAIT(); __builtin_amdgcn_s_barrier(); asm volatile("" ::: "memory");
            float off0 = 0.f, off1 = 0.f, bref0 = 0.f, bref1 = 0.f, p0 = 0.f, p1 = 0.f;
#pragma unroll
            for (int s = 0; s < 8; ++s) { typedef float f32x2v __attribute__((ext_vector_type(2))); const f32x2v t = *(const LAS f32x2v*)(L + HG_SEG + (s * 128 + 2 * cp) * 4);
                if (s == w) { off0 = p0; off1 = p1; } p0 += t.x; p1 += t.y; if (s == 3) { bref0 = p0; bref1 = p1; } }
            const float er0 = __expf(bref0), er1 = __expf(bref1);
            unsigned krt0[4], krt1[4];
#pragma unroll
            for (int i = 0; i < 8; ++i) {
                const float e10 = __expf(cs[i][0] + off0 - bref0), e11 = __expf(cs[i][1] + off1 - bref1);
                const float qr0 = q[i][0] * e10, qr1 = q[i][1] * e11, kr0 = k[i][0] * __builtin_amdgcn_rcpf(e10), kr1 = k[i][1] * __builtin_amdgcn_rcpf(e11);
                const int ro = (8 * w + i) * 272 + 4 * cp;
                *(LAS unsigned*)(L + HG_QR + ro) = cvtpk(qr0, qr1);
                *(LAS unsigned*)(L + HG_QD + ro) = cvtpk(qr0 * er0, qr1 * er1);
                *(LAS unsigned*)(L + HG_KR + ro) = cvtpk(kr0, kr1);
                if (i & 1) { krt0[i >> 1] = cvtpk(k[i - 1][0] * __builtin_amdgcn_rcpf(__expf(cs[i - 1][0] + off0 - bref0)), kr0); krt1[i >> 1] = cvtpk(k[i - 1][1] * __builtin_amdgcn_rcpf(__expf(cs[i - 1][1] + off1 - bref1)), kr1); }
            }
            *(LAS v4u*)(L + HG_KRT + (2 * cp) * 144 + 16 * w) = (v4u){krt0[0], krt0[1], krt0[2], krt0[3]};
            *(LAS v4u*)(L + HG_KRT + (2 * cp + 1) * 144 + 16 * w) = (v4u){krt1[0], krt1[1], krt1[2], krt1[3]};
            if (w == 0) { typedef float f32x2v __attribute__((ext_vector_type(2)));
                *(LAS f32x2v*)(L + HG_EL + 8 * cp) = (f32x2v){__expf(p0 - bref0), __expf(p1 - bref1)}; *(LAS f32x2v*)(L + HG_DEC + 8 * cp) = (f32x2v){__expf(p0), __expf(p1)}; }
            { const int ee = 2 * (F.tid & 15), ss = F.tid >> 4;
                *(LAS unsigned short*)(L + HG_VT + ee * 144 + ss * 2) = (unsigned short)(v0 & 0xffffu); *(LAS unsigned short*)(L + HG_VT + (ee + 1) * 144 + ss * 2) = (unsigned short)(v0 >> 16);
                *(LAS unsigned short*)(L + HG_VT + ee * 144 + (ss + 32) * 2) = (unsigned short)(v1 & 0xffffu); *(LAS unsigned short*)(L + HG_VT + (ee + 1) * 144 + (ss + 32) * 2) = (unsigned short)(v1 >> 16); }
            if (c + 1 < SEQ / 64) HGM_LOAD(c + 1);
            LDS_WAIT(); __builtin_amdgcn_s_barrier(); asm volatile("" ::: "memory");
            const LAS unsigned char* stc = L + ((c & 1) ? HG_ST1 : HG_ST0);
            LAS unsigned char* stn = L + ((c & 1) ? HG_ST0 : HG_ST1);
            if (w < 2) {
                const int th = w;
                f32x16 Y;
#pragma unroll
                for (int i = 0; i < 16; ++i) Y[i] = 0.f;
#pragma unroll
                for (int kd = 0; kd < 8; ++kd) { const bf16x8 a = *(const LAS bf16x8*)(stc + l31 * 272 + (16 * kd + 8 * hh) * 2); const bf16x8 bq = *(const LAS bf16x8*)(L + HG_QD + (32 * th + l31) * 272 + (16 * kd + 8 * hh) * 2);
                    Y = __builtin_amdgcn_mfma_f32_32x32x16_bf16(a, bq, Y, 0, 0, 0); }
#pragma unroll
                for (int sb = 0; sb < 2; ++sb) { if (sb <= th) {
                    f32x16 X;
#pragma unroll
                    for (int i = 0; i < 16; ++i) X[i] = 0.f;
#pragma unroll
                    for (int kd = 0; kd < 8; ++kd) { const bf16x8 a = *(const LAS bf16x8*)(L + HG_KR + (32 * sb + l31) * 272 + (16 * kd + 8 * hh) * 2); const bf16x8 bq = *(const LAS bf16x8*)(L + HG_QR + (32 * th + l31) * 272 + (16 * kd + 8 * hh) * 2);
                        X = __builtin_amdgcn_mfma_f32_32x32x16_bf16(a, bq, X, 0, 0, 0); }
                    if (sb == th) {
#pragma unroll
                        for (int r = 0; r < 16; ++r) { const int s = (r & 3) + 8 * (r >> 2) + 4 * hh; if (s > l31) X[r] = 0.f; } }
#pragma unroll
                    for (int ks = 0; ks < 2; ++ks) {
                        const unsigned x0 = cvtpk(X[8 * ks + 0], X[8 * ks + 1]), x1 = cvtpk(X[8 * ks + 2], X[8 * ks + 3]), x2 = cvtpk(X[8 * ks + 4], X[8 * ks + 5]), x3 = cvtpk(X[8 * ks + 6], X[8 * ks + 7]);
                        const bf16x8 xb = __builtin_bit_cast(bf16x8, (v4u){x0, x1, x2, x3});
                        const v2u alo = *(const LAS v2u*)(L + HG_VT + l31 * 144 + (32 * sb + 16 * ks + 4 * hh) * 2), ahi = *(const LAS v2u*)(L + HG_VT + l31 * 144 + (32 * sb + 16 * ks + 8 + 4 * hh) * 2);
                        const bf16x8 a = __builtin_bit_cast(bf16x8, (v4u){alo.x, alo.y, ahi.x, ahi.y});
                        Y = __builtin_amdgcn_mfma_f32_32x32x16_bf16(a, xb, Y, 0, 0, 0); }
                } }
                float* orow = ORAW + (rowbase + 64 * c + 32 * th + l31) * DM + h * 128 + e0 + 4 * hh;
#pragma unroll
                for (int g = 0; g < 4; ++g) *(GAS f32x4*)(orow + 8 * g) = (f32x4){Y[4 * g], Y[4 * g + 1], Y[4 * g + 2], Y[4 * g + 3]};
            } else if (w >= 4) {
                const int dt = w - 4;
                f32x16 T;
#pragma unroll
                for (int i = 0; i < 16; ++i) T[i] = 0.f;
#pragma unroll
                for (int ks = 0; ks < 4; ++ks) { const bf16x8 a = *(const LAS bf16x8*)(L + HG_KRT + (32 * dt + l31) * 144 + (16 * ks + 8 * hh) * 2); const bf16x8 bv = *(const LAS bf16x8*)(L + HG_VT + l31 * 144 + (16 * ks + 8 * hh) * 2);
                    T = __builtin_amdgcn_mfma_f32_32x32x16_bf16(a, bv, T, 0, 0, 0); }
#pragma unroll
                for (int g = 0; g < 4; ++g) { const f32x4 dec = *(const LAS f32x4*)(L + HG_DEC + (32 * dt + 8 * g + 4 * hh) * 4), el = *(const LAS f32x4*)(L + HG_EL + (32 * dt + 8 * g + 4 * hh) * 4);
#pragma unroll
                    for (int i = 0; i < 4; ++i) S[4 * g + i] = dec[i] * S[4 * g + i] + el[i] * T[4 * g + i];
                    *(LAS v2u*)(stn + l31 * 272 + (32 * dt + 8 * g + 4 * hh) * 2) = (v2u){cvtpk(S[4 * g], S[4 * g + 1]), cvtpk(S[4 * g + 2], S[4 * g + 3])}; }
            }
        }
        LDS_WAIT(); __builtin_amdgcn_s_barrier(); asm volatile("" ::: "memory");
#undef HGM_LOAD
    }
}
__device__ __forceinline__ void hgrn_mfma2(Frame& F) {
    const bf16* QH = (const bf16*)(F.ws + WS_QKV); const bf16* FH = QH + (size_t)M * DM; const bf16* VH = FH + (size_t)M * DM; const bf16* KH = (const bf16*)(F.ws + WS_AO); bf16* ORAW = (bf16*)(F.ws + WS_ACT);
    LAS unsigned char* L = F.lds;
    const int w = F.wave, cp = F.lane, l31 = F.lane & 31, hh = F.lane >> 5, li = F.lane & 15, g4 = F.lane >> 4;
    typedef float f32x2v __attribute__((ext_vector_type(2)));
#pragma unroll 1
    for (int u = blockIdx.x; u < 256; u += F.G) {
        const int ux = u & 7, uy = u >> 3, bh = ux + 8 * (uy >> 2), e0 = (uy & 3) * 32, b = bh >> 5, h = bh & 31;
        const size_t rowbase = (size_t)b * SEQ;
        unsigned qn[8], fn[8], kn[8], vn[2];
        const bf16* pq = QH + ((size_t)bh * SEQ + 8 * w) * 128 + 2 * cp; const bf16* pf = FH + ((size_t)bh * SEQ + 8 * w) * 128 + 2 * cp; const bf16* pk = KH + ((size_t)bh * SEQ + 8 * w) * 128 + 2 * cp;
        const bf16* pv = VH + ((size_t)bh * SEQ + (F.tid >> 4)) * 128 + e0 + 2 * (F.tid & 15);
#define HG2_LOAD() do { \
            _Pragma("unroll") for (int i = 0; i < 8; ++i) { qn[i] = *(const GAS unsigned*)(pq + 128 * i); fn[i] = *(const GAS unsigned*)(pf + 128 * i); kn[i] = *(const GAS unsigned*)(pk + 128 * i); } \
            vn[0] = *(const GAS unsigned*)pv; vn[1] = *(const GAS unsigned*)(pv + 32 * 128); pq += 64 * 128; pf += 64 * 128; pk += 64 * 128; pv += 64 * 128; } while (0)
        f32x16 S;
#pragma unroll
        for (int i = 0; i < 16; ++i) S[i] = 0.f;
        for (int i = F.tid; i < 8704 / 4; i += NWAVES * 64) ((LAS unsigned*)(L + HG_ST0))[i] = 0u;
        HG2_LOAD();
#pragma unroll 1
        for (int c = 0; c < SEQ / 64; ++c) {
            float qf[8][2], kf[8][2], cs[8][2]; float run0 = 0.f, run1 = 0.f;
#pragma unroll
            for (int i = 0; i < 8; ++i) { qf[i][0] = bflo(qn[i]); qf[i][1] = bfhi(qn[i]); kf[i][0] = bflo(kn[i]); kf[i][1] = bfhi(kn[i]); run0 += bflo(fn[i]); run1 += bfhi(fn[i]); cs[i][0] = run0; cs[i][1] = run1; }
            const unsigned v0 = vn[0], v1 = vn[1];
            { const int back = (c + 1 < SEQ / 64) ? 0 : 64 * 128; pq -= back; pf -= back; pk -= back; pv -= back; }
            HG2_LOAD();
            *(LAS f32x2v*)(L + HG_SEG + (w * 128 + 2 * cp) * 4) = (f32x2v){run0, run1};
            LDS_WAIT(); __builtin_amdgcn_s_barrier(); asm volatile("" ::: "memory");
            float off0 = 0.f, off1 = 0.f, bref0 = 0.f, bref1 = 0.f, p0 = 0.f, p1 = 0.f;
#pragma unroll
            for (int s = 0; s < 8; ++s) { const f32x2v t = *(const LAS f32x2v*)(L + HG_SEG + (s * 128 + 2 * cp) * 4);
                if (s == w) { off0 = p0; off1 = p1; } p0 += t.x; p1 += t.y; if (s == 3) { bref0 = p0; bref1 = p1; } }
            const float er0 = __expf(bref0), er1 = __expf(bref1);
            off0 -= bref0; off1 -= bref1;
            float kr[8][2];
#pragma unroll
            for (int i = 0; i < 8; ++i) {
                const float e10 = __expf(cs[i][0] + off0), e11 = __expf(cs[i][1] + off1);
                const float qr0 = qf[i][0] * e10, qr1 = qf[i][1] * e11; kr[i][0] = kf[i][0] * __builtin_amdgcn_rcpf(e10); kr[i][1] = kf[i][1] * __builtin_amdgcn_rcpf(e11);
                const int ro = (8 * w + i) * 272 + 4 * cp;
                *(LAS unsigned*)(L + HG_QR + ro) = cvtpk(qr0, qr1);
                *(LAS unsigned*)(L + HG_QD + ro) = cvtpk(qr0 * er0, qr1 * er1);
                *(LAS unsigned*)(L + HG_KR + ro) = cvtpk(kr[i][0], kr[i][1]);
            }
            *(LAS v4u*)(L + HG_KRT + (2 * cp) * 144 + 16 * w) = (v4u){cvtpk(kr[0][0], kr[1][0]), cvtpk(kr[2][0], kr[3][0]), cvtpk(kr[4][0], kr[5][0]), cvtpk(kr[6][0], kr[7][0])};
            *(LAS v4u*)(L + HG_KRT + (2 * cp + 1) * 144 + 16 * w) = (v4u){cvtpk(kr[0][1], kr[1][1]), cvtpk(kr[2][1], kr[3][1]), cvtpk(kr[4][1], kr[5][1]), cvtpk(kr[6][1], kr[7][1])};
            if (w == 0) { *(LAS f32x2v*)(L + HG_EL + 8 * cp) = (f32x2v){__expf(p0 - bref0), __expf(p1 - bref1)}; *(LAS f32x2v*)(L + HG_DEC + 8 * cp) = (f32x2v){__expf(p0), __expf(p1)}; }
            { const int ee = 2 * (F.tid & 15), ss = F.tid >> 4;
                *(LAS unsigned short*)(L + HG_VT + ee * 144 + ss * 2) = (unsigned short)(v0 & 0xffffu); *(LAS unsigned short*)(L + HG_VT + (ee + 1) * 144 + ss * 2) = (unsigned short)(v0 >> 16);
                *(LAS unsigned short*)(L + HG_VT + ee * 144 + (ss + 32) * 2) = (unsigned short)(v1 & 0xffffu); *(LAS unsigned short*)(L + HG_VT + (ee + 1) * 144 + (ss + 32) * 2) = (unsigned short)(v1 >> 16); }
            LDS_WAIT(); __builtin_amdgcn_s_barrier(); asm volatile("" ::: "memory");
            const LAS unsigned char* stc = L + ((c & 1) ? HG_ST1 : HG_ST0);
            LAS unsigned char* stn = L + ((c & 1) ? HG_ST0 : HG_ST1);
            if (w < 4) {
                const int tq = w;
                f32x4 Y[2]; Y[0] = (f32x4){0.f, 0.f, 0.f, 0.f}; Y[1] = Y[0];
                bf16x8 bqr[4];
#pragma unroll
                for (int kd = 0; kd < 4; ++kd) { const bf16x8 bq = *(const LAS bf16x8*)(L + HG_QD + (16 * tq + li) * 272 + (32 * kd + 8 * g4) * 2); bqr[kd] = *(const LAS bf16x8*)(L + HG_QR + (16 * tq + li) * 272 + (32 * kd + 8 * g4) * 2);
#pragma unroll
                    for (int eb = 0; eb < 2; ++eb) { const bf16x8 a = *(const LAS bf16x8*)(stc + (16 * eb + li) * 272 + (32 * kd + 8 * g4) * 2); Y[eb] = __builtin_amdgcn_mfma_f32_16x16x32_bf16(a, bq, Y[eb], 0, 0, 0); } }
                f32x4 X[4];
#pragma unroll
                for (int sb = 0; sb < 4; ++sb) { f32x4 acc = (f32x4){0.f, 0.f, 0.f, 0.f};
                    if (sb <= tq) {
#pragma unroll
                        for (int kd = 0; kd < 4; ++kd) { const bf16x8 a = *(const LAS bf16x8*)(L + HG_KR + (16 * sb + li) * 272 + (32 * kd + 8 * g4) * 2); acc = __builtin_amdgcn_mfma_f32_16x16x32_bf16(a, bqr[kd], acc, 0, 0, 0); }
                        if (sb == tq) {
#pragma unroll
                            for (int r = 0; r < 4; ++r) if (4 * g4 + r > li) acc[r] = 0.f; } }
                    X[sb] = acc; }
#pragma unroll
                for (int pr = 0; pr < 2; ++pr) { if (2 * pr <= tq) {
                    const bf16x8 pf = __builtin_bit_cast(bf16x8, (v4u){cvtpk(X[2 * pr][0], X[2 * pr][1]), cvtpk(X[2 * pr][2], X[2 * pr][3]), cvtpk(X[2 * pr + 1][0], X[2 * pr + 1][1]), cvtpk(X[2 * pr + 1][2], X[2 * pr + 1][3])});
#pragma unroll
                    for (int eb = 0; eb < 2; ++eb) { const v2u alo = *(const LAS v2u*)(L + HG_VT + (16 * eb + li) * 144 + (32 * pr + 4 * g4) * 2), ahi = *(const LAS v2u*)(L + HG_VT + (16 * eb + li) * 144 + (32 * pr + 16 + 4 * g4) * 2);
                        const bf16x8 a = __builtin_bit_cast(bf16x8, (v4u){alo.x, alo.y, ahi.x, ahi.y}); Y[eb] = __builtin_amdgcn_mfma_f32_16x16x32_bf16(a, pf, Y[eb], 0, 0, 0); } } }
                bf16* orow = ORAW + (rowbase + 64 * c + 16 * tq + li) * DM + h * 128 + e0 + 4 * g4;
#pragma unroll
                for (int eb = 0; eb < 2; ++eb) *(GAS v2u*)(orow + 16 * eb) = (v2u){cvtpk(Y[eb][0], Y[eb][1]), cvtpk(Y[eb][2], Y[eb][3])};
            } else {
                const int dt = w - 4;
                f32x16 T;
#pragma unroll
                for (int i = 0; i < 16; ++i) T[i] = 0.f;
#pragma unroll
                for (int ks = 0; ks < 4; ++ks) { const bf16x8 a = *(const LAS bf16x8*)(L + HG_KRT + (32 * dt + l31) * 144 + (16 * ks + 8 * hh) * 2); const bf16x8 bv = *(const LAS bf16x8*)(L + HG_VT + l31 * 144 + (16 * ks + 8 * hh) * 2);
                    T = __builtin_amdgcn_mfma_f32_32x32x16_bf16(a, bv, T, 0, 0, 0); }
#pragma unroll
                for (int g = 0; g < 4; ++g) { const f32x4 dec = *(const LAS f32x4*)(L + HG_DEC + (32 * dt + 8 * g + 4 * hh) * 4), el = *(const LAS f32x4*)(L + HG_EL + (32 * dt + 8 * g + 4 * hh) * 4);
#pragma unroll
                    for (int i = 0; i < 4; ++i) S[4 * g + i] = dec[i] * S[4 * g + i] + el[i] * T[4 * g + i];
                    *(LAS v2u*)(stn + l31 * 272 + (32 * dt + 8 * g + 4 * hh) * 2) = (v2u){cvtpk(S[4 * g], S[4 * g + 1]), cvtpk(S[4 * g + 2], S[4 * g + 3])}; }
            }
        }
        LDS_WAIT(); __builtin_amdgcn_s_barrier(); asm volatile("" ::: "memory");
#undef HG2_LOAD
    }
}
__device__ __forceinline__ void hgrn_gate2(Frame& F) {
    const int gw = F.vcu * NWAVES + F.wave, NGW = F.G * NWAVES;
    const bf16* ORAW = (const bf16*)(F.ws + WS_ACT); const bf16* SG = (HG_FUSE == 2) ? (const bf16*)(F.ws + WS_AO) : (const bf16*)(F.ws + WS_QKV) + 3 * (size_t)M * DM; bf16* OG = (bf16*)(F.ws + WS_OG);
    const f32x4 gn = *(const GAS f32x4*)(F.hg_gain + 4 * (F.lane & 31));
    for (int m = gw; m < M; m += NGW) {
        const GAS v2u* orow = (const GAS v2u*)(ORAW + (size_t)m * DM) + F.lane;
        const GAS v2u* grow = (const GAS v2u*)(SG + (size_t)m * DM) + F.lane;
        GAS v2u* o8 = (GAS v2u*)(OG + (size_t)m * DM) + F.lane;
#pragma unroll 8
        for (int j = 0; j < 16; ++j) {
            const v2u ow = orow[64 * j], gw2 = grow[64 * j];
            const float o0 = bflo(ow.x), o1 = bfhi(ow.x), o2 = bflo(ow.y), o3 = bfhi(ow.y);
            float ss = (o0 * o0 + o1 * o1) + (o2 * o2 + o3 * o3);
#pragma unroll
            for (int k = 1; k < 32; k <<= 1) ss += __shfl_xor(ss, k);
            const float rstd = 1.f / sqrtf(ss * (1.f / HD) + RMS_EPS);
            float s0 = bflo(gw2.x), s1 = bfhi(gw2.x), s2 = bflo(gw2.y), s3 = bfhi(gw2.y);
            if (HG_FUSE == 2) { s0 *= __builtin_amdgcn_rcpf(1.f + __expf(-s0)); s1 *= __builtin_amdgcn_rcpf(1.f + __expf(-s1)); s2 *= __builtin_amdgcn_rcpf(1.f + __expf(-s2)); s3 *= __builtin_amdgcn_rcpf(1.f + __expf(-s3)); }
            v2u wv; wv.x = cvtpk(o0 * rstd * gn.x * s0, o1 * rstd * gn.y * s1); wv.y = cvtpk(o2 * rstd * gn.z * s2, o3 * rstd * gn.w * s3);
            o8[64 * j] = wv;
        }
    }
}

#define DPP_MOV(x, ctrl) __builtin_bit_cast(float, __builtin_amdgcn_update_dpp(0, __builtin_bit_cast(int, (x)), (ctrl), 0xf, 0xf, false))
__device__ __forceinline__ void hgrn_gate3(Frame& F) {
    const int gw = F.vcu * NWAVES + F.wave, NGW = F.G * NWAVES;
    const bf16* ORAW = (const bf16*)(F.ws + WS_ACT); const bf16* SG = (const bf16*)(F.ws + WS_AO); unsigned char* OG8 = (unsigned char*)(F.ws + WS_OG); float* sa3 = (float*)(F.ws + WS_SA3);
    const f32x4 gn = *(const GAS f32x4*)(F.hg_gain + 4 * (F.lane & 31));
    const float s1 = (F.lane & 1) ? -1.f : 1.f, s2 = (F.lane & 2) ? -1.f : 1.f, s4 = (F.lane & 4) ? -1.f : 1.f;
    v2u ob[16], gbw[16];
    if (gw < M) { const GAS v2u* orow = (const GAS v2u*)(ORAW + (size_t)gw * DM) + F.lane; const GAS v2u* grow = (const GAS v2u*)(SG + (size_t)gw * DM) + F.lane;
#pragma unroll
        for (int j = 0; j < 16; ++j) { ob[j] = orow[64 * j]; gbw[j] = grow[64 * j]; } }
    for (int m = gw; m < M; m += NGW) {
        const int mn = (m + NGW < M) ? m + NGW : m;
        v2u co[16], cg[16];
#pragma unroll
        for (int j = 0; j < 16; ++j) { co[j] = ob[j]; cg[j] = gbw[j]; }
        { const GAS v2u* orow = (const GAS v2u*)(ORAW + (size_t)mn * DM) + F.lane; const GAS v2u* grow = (const GAS v2u*)(SG + (size_t)mn * DM) + F.lane;
#pragma unroll
          for (int j = 0; j < 16; ++j) { ob[j] = orow[64 * j]; gbw[j] = grow[64 * j]; } }
        float v[16][4]; float am = 0.f;
#pragma unroll
        for (int j = 0; j < 16; ++j) {
            const v2u ow = co[j], gw2 = cg[j];
            const float o0 = bflo(ow.x), o1 = bfhi(ow.x), o2 = bflo(ow.y), o3 = bfhi(ow.y);
            float ss = (o0 * o0 + o1 * o1) + (o2 * o2 + o3 * o3);
            ss = half32_sum(ss);
            const float rstd = __builtin_amdgcn_rsqf(ss * (1.f / HD) + RMS_EPS);
            float g0 = bflo(gw2.x), g1 = bfhi(gw2.x), g2 = bflo(gw2.y), g3 = bfhi(gw2.y);
            g0 *= __builtin_amdgcn_rcpf(1.f + __expf(-g0)); g1 *= __builtin_amdgcn_rcpf(1.f + __expf(-g1)); g2 *= __builtin_amdgcn_rcpf(1.f + __expf(-g2)); g3 *= __builtin_amdgcn_rcpf(1.f + __expf(-g3));
            float x0 = o0 * rstd * gn.x * g0, x1 = o1 * rstd * gn.y * g1, x2 = o2 * rstd * gn.z * g2, x3 = o3 * rstd * gn.w * g3;
            { const unsigned a = cvtpk(x0, x1), b = cvtpk(x2, x3); x0 = bflo(a); x1 = bfhi(a); x2 = bflo(b); x3 = bfhi(b); }
            { const float a = x0 + x1, b = x0 - x1, c = x2 + x3, d = x2 - x3; x0 = a + c; x1 = b + d; x2 = a - c; x3 = b - d; }
            float x[4] = {x0, x1, x2, x3};
#pragma unroll
            for (int i = 0; i < 4; ++i) { const float p = DPP_QUAD(x[i], 0xB1); x[i] = p + s1 * x[i]; }
#pragma unroll
            for (int i = 0; i < 4; ++i) { const float p = DPP_QUAD(x[i], 0x4E); x[i] = p + s2 * x[i]; }
#pragma unroll
            for (int i = 0; i < 4; ++i) { const float pl = DPP_MOV(x[i], 0x104), pr = DPP_MOV(x[i], 0x114); const float p = (F.lane & 4) ? pr : pl; x[i] = (p + s4 * x[i]) * 0.17677669529663687f; }
#pragma unroll
            for (int i = 0; i < 4; ++i) { v[j][i] = x[i]; am = fmaxf(am, fabsf(x[i])); }
        }
        am = wave_max(am);
        am = fmaxf(am, 1e-30f);
        const float qs = 127.f / am;
        GAS unsigned* o4 = (GAS unsigned*)(OG8 + (size_t)m * DM) + F.lane;
#pragma unroll
        for (int j = 0; j < 16; ++j) o4[64 * j] = q8bits(v[j][0], qs) | (q8bits(v[j][1], qs) << 8) | (q8bits(v[j][2], qs) << 16) | (q8bits(v[j][3], qs) << 24);
        if (F.lane == 0) sa3[m] = am * (1.f / 127.f);
    }
}
constexpr int H4_OPB = 34816, H4_KR = 17408, H4_ED0 = 3 * H4_OPB, H4_EDB = 1536, H4_VS0 = H4_ED0 + 3 * H4_EDB, H4_VSB = 4096, H4_VT0 = H4_VS0 + 3 * H4_VSB, H4_VTB = 4608, H4_ST0 = H4_VT0 + 2 * H4_VTB, H4_STB = 8704, H4_END = H4_ST0 + 2 * H4_STB;
static_assert(H4_END <= LDSCTL_OFF, "hgrn4 LDS map");
constexpr size_t WS_H3QR = WS_QKV, WS_H3KR = WS_QKV + 136 * MiB, WS_H3VH = WS_QKV + 272 * MiB, WS_H3SG = WS_AO, WS_H3EL = WS_AO + 128 * MiB, WS_H3DEC = WS_AO + 132 * MiB, WS_H3ER = WS_AO + 136 * MiB;
static_assert(WS_H3VH + 128 * MiB <= WS_MRG && WS_H3ER + 4 * MiB + 512 <= WS_LSE, "hgrn4 workspace map");
__device__ __forceinline__ void hgrn_mfma3(Frame& F) {
    const char* TQR = (const char*)(F.ws + WS_H3QR); const char* TKR = (const char*)(F.ws + WS_H3KR);
    const bf16* VH = (const bf16*)(F.ws + WS_H3VH); const float* ELg = (const float*)(F.ws + WS_H3EL); const float* DECg = (const float*)(F.ws + WS_H3DEC); const float* ERg = (const float*)(F.ws + WS_H3ER);
    bf16* ORAW = (bf16*)(F.ws + WS_ACT);
    LAS unsigned char* L = F.lds;
    const int w = F.wave, li = F.lane & 15, g4 = F.lane >> 4;
#pragma unroll 1
    for (int u = blockIdx.x; u < 256; u += F.G) {
        const int ux = u & 7, uy = u >> 3, bh = ux + 8 * (uy >> 2), e0 = (uy & 3) * 32, b = bh >> 5, h = bh & 31;
        const size_t rowbase = (size_t)b * SEQ;
#define H4_DMA(cc, sl) do { const size_t cid_ = (size_t)bh * 128 + (cc); const size_t cidn_ = ((cc) + 1 < SEQ / 64) ? cid_ + 1 : cid_; LAS unsigned char* ob_ = L + (sl) * H4_OPB; LAS unsigned char* eb_ = L + H4_ED0 + (sl) * H4_EDB; \
            _Pragma("unroll") for (int i_ = 0; i_ < 5; ++i_) { const int k_ = 5 * w + i_; \
                if (k_ < 34) { const int t_ = (k_ >= 17) ? 1 : 0, q_ = k_ - 17 * t_; \
                    __builtin_amdgcn_global_load_lds((const unsigned*)((t_ ? TKR : TQR) + cid_ * 17408 + q_ * 1024 + F.lane * 16), (LAS unsigned*)(ob_ + t_ * H4_KR + q_ * 1024), 16, 0, 0); } \
                else { const int e_ = k_ - 34, ar_ = e_ >> 1; const float* sp_ = (ar_ == 0) ? (ELg + cid_ * 128) : (ar_ == 1) ? (DECg + cid_ * 128) : (ERg + cidn_ * 128); \
                    __builtin_amdgcn_global_load_lds((const unsigned*)(sp_ + (e_ & 1) * 64 + F.lane), (LAS unsigned*)(eb_ + ar_ * 512 + (e_ & 1) * 256), 4, 0, 0); } } \
            _Pragma("unroll") for (int i_ = 0; i_ < 2; ++i_) { const int p_ = 2 * w + i_; \
                __builtin_amdgcn_global_load_lds((const unsigned*)(VH + ((size_t)bh * SEQ + 64 * (cc) + 4 * p_ + (F.lane >> 4)) * 128 + e0 + 2 * (F.lane & 15)), (LAS unsigned*)(L + H4_VS0 + (sl) * H4_VSB + p_ * 256), 4, 0, 0); } } while (0)
        f32x4 S[2][2];
#pragma unroll
        for (int a = 0; a < 2; ++a)
#pragma unroll
            for (int c2 = 0; c2 < 2; ++c2) S[a][c2] = (f32x4){0.f, 0.f, 0.f, 0.f};
        for (int i = F.tid; i < H4_STB / 4; i += NWAVES * 64) ((LAS unsigned*)(L + H4_ST0))[i] = 0u;
        H4_DMA(0, 0); H4_DMA(1, 1);
        int sl = 0;
#pragma unroll 1
        for (int c = 0; c < SEQ / 64; ++c) {
            if (w < 4 && c >= 2) asm volatile("s_waitcnt vmcnt(11)" ::: "memory"); else asm volatile("s_waitcnt vmcnt(7)" ::: "memory");
            {
                const LAS unsigned char* vs = L + H4_VS0 + sl * H4_VSB; LAS unsigned char* vt = L + H4_VT0 + (c & 1) * H4_VTB;
                const int row = 8 * w + (F.lane >> 3), eq = 4 * (F.lane & 7);
                const v2u vv = *(const LAS v2u*)(vs + row * 64 + eq * 2);
                *(LAS unsigned short*)(vt + (eq + 0) * 144 + row * 2) = (unsigned short)(vv.x & 0xffffu); *(LAS unsigned short*)(vt + (eq + 1) * 144 + row * 2) = (unsigned short)(vv.x >> 16);
                *(LAS unsigned short*)(vt + (eq + 2) * 144 + row * 2) = (unsigned short)(vv.y & 0xffffu); *(LAS unsigned short*)(vt + (eq + 3) * 144 + row * 2) = (unsigned short)(vv.y >> 16); }
            LDS_WAIT(); __builtin_amdgcn_s_barrier(); asm volatile("" ::: "memory");
            { const int cn = (c + 2 < SEQ / 64) ? c + 2 : SEQ / 64 - 1; const int sn = (sl == 0) ? 2 : sl - 1;
              H4_DMA(cn, sn); }
            const LAS unsigned char* OB = L + sl * H4_OPB; const LAS unsigned char* VT = L + H4_VT0 + (c & 1) * H4_VTB;
            const LAS unsigned char* stc = L + H4_ST0 + (c & 1) * H4_STB;
            LAS unsigned char* stn = L + H4_ST0 + ((c + 1) & 1) * H4_STB;
            if (w < 4) {
                const int tq = w;
                f32x4 Y[2]; Y[0] = (f32x4){0.f, 0.f, 0.f, 0.f}; Y[1] = Y[0];
                bf16x8 bqr[4];
#pragma unroll
                for (int kd = 0; kd < 4; ++kd) { bqr[kd] = *(const LAS bf16x8*)(OB + (16 * tq + li) * 272 + (32 * kd + 8 * g4) * 2);
#pragma unroll
                    for (int eb = 0; eb < 2; ++eb) { const bf16x8 a = *(const LAS bf16x8*)(stc + (16 * eb + li) * 272 + (32 * kd + 8 * g4) * 2); Y[eb] = __builtin_amdgcn_mfma_f32_16x16x32_bf16(a, bqr[kd], Y[eb], 0, 0, 0); } }
                f32x4 X[4];
#pragma unroll
                for (int sb = 0; sb < 4; ++sb) { f32x4 acc = (f32x4){0.f, 0.f, 0.f, 0.f};
                    if (sb <= tq) {
#pragma unroll
                        for (int kd = 0; kd < 4; ++kd) { const bf16x8 a = *(const LAS bf16x8*)(OB + H4_KR + (16 * sb + li) * 272 + (32 * kd + 8 * g4) * 2); acc = __builtin_amdgcn_mfma_f32_16x16x32_bf16(a, bqr[kd], acc, 0, 0, 0); }
                        if (sb == tq) {
#pragma unroll
                            for (int r = 0; r < 4; ++r) if (4 * g4 + r > li) acc[r] = 0.f; } }
                    X[sb] = acc; }
#pragma unroll
                for (int pr = 0; pr < 2; ++pr) { if (2 * pr <= tq) {
                    const bf16x8 pf = __builtin_bit_cast(bf16x8, (v4u){cvtpk(X[2 * pr][0], X[2 * pr][1]), cvtpk(X[2 * pr][2], X[2 * pr][3]), cvtpk(X[2 * pr + 1][0], X[2 * pr + 1][1]), cvtpk(X[2 * pr + 1][2], X[2 * pr + 1][3])});
#pragma unroll
                    for (int eb = 0; eb < 2; ++eb) { const v2u alo = *(const LAS v2u*)(VT + (16 * eb + li) * 144 + (32 * pr + 4 * g4) * 2), ahi = *(const LAS v2u*)(VT + (16 * eb + li) * 144 + (32 * pr + 16 + 4 * g4) * 2);
                        const bf16x8 a = __builtin_bit_cast(bf16x8, (v4u){alo.x, alo.y, ahi.x, ahi.y}); Y[eb] = __builtin_amdgcn_mfma_f32_16x16x32_bf16(a, pf, Y[eb], 0, 0, 0); } } }
                bf16* orow = ORAW + (rowbase + 64 * c + 16 * tq + li) * DM + h * 128 + e0 + 4 * g4;
#pragma unroll
                for (int eb = 0; eb < 2; ++eb) *(GAS v2u*)(orow + 16 * eb) = (v2u){cvtpk(Y[eb][0], Y[eb][1]), cvtpk(Y[eb][2], Y[eb][3])};
            } else {
                const int dt = w - 4;
                const LAS float* ELs = (const LAS float*)(L + H4_ED0 + sl * H4_EDB); const LAS float* DECs = ELs + 128; const LAS float* ERs = ELs + 256;
#pragma unroll
                for (int dbl = 0; dbl < 2; ++dbl) { const int db = 2 * dt + dbl;
                    f32x4 T[2]; T[0] = (f32x4){0.f, 0.f, 0.f, 0.f}; T[1] = T[0];
#pragma unroll
                    for (int ks = 0; ks < 2; ++ks) {
                        const unsigned ka = (unsigned)(size_t)(OB + H4_KR + (32 * ks + 4 * g4 + (li >> 2)) * 272 + (16 * db + 4 * (li & 3)) * 2);
                        v2u lo, hi;
                        asm volatile("ds_read_b64_tr_b16 %0, %2\n\tds_read_b64_tr_b16 %1, %2 offset:4352\n\ts_waitcnt lgkmcnt(0)" : "=&v"(lo), "=&v"(hi) : "v"(ka) : "memory");
                        const bf16x8 a = __builtin_bit_cast(bf16x8, (v4u){lo.x, lo.y, hi.x, hi.y});
#pragma unroll
                        for (int eb = 0; eb < 2; ++eb) { const v2u blo = *(const LAS v2u*)(VT + (16 * eb + li) * 144 + (32 * ks + 4 * g4) * 2), bhi = *(const LAS v2u*)(VT + (16 * eb + li) * 144 + (32 * ks + 16 + 4 * g4) * 2);
                            const bf16x8 bv = __builtin_bit_cast(bf16x8, (v4u){blo.x, blo.y, bhi.x, bhi.y}); T[eb] = __builtin_amdgcn_mfma_f32_16x16x32_bf16(a, bv, T[eb], 0, 0, 0); } }
                    const f32x4 dec = *(const LAS f32x4*)(DECs + 16 * db + 4 * g4), el = *(const LAS f32x4*)(ELs + 16 * db + 4 * g4), er = *(const LAS f32x4*)(ERs + 16 * db + 4 * g4);
#pragma unroll
                    for (int eb = 0; eb < 2; ++eb) { S[dbl][eb] = dec * S[dbl][eb] + el * T[eb]; const f32x4 sv = S[dbl][eb] * er;
                        *(LAS v2u*)(stn + (16 * eb + li) * 272 + (16 * db + 4 * g4) * 2) = (v2u){cvtpk(sv[0], sv[1]), cvtpk(sv[2], sv[3])}; } }
            }
            sl = (sl == 2) ? 0 : sl + 1;
        }
        asm volatile("s_waitcnt vmcnt(0)" ::: "memory"); LDS_WAIT(); __builtin_amdgcn_s_barrier(); asm volatile("" ::: "memory");
#undef H4_DMA
    }
}
struct Args { const float* in[11]; float* out; unsigned char* ws; int ph_lo, ph_hi, li, pad; };
__global__ void __launch_bounds__(NWAVES * 64, 2) mega_fwd(Args args) {
    extern __shared__ __attribute__((aligned(16))) unsigned char lds[];
    Frame F;
    F.lds = (LAS unsigned char*)lds;
    F.MISC = (volatile LAS unsigned*)(F.lds + MISC_OFF);
    F.tid = threadIdx.x; F.lane = F.tid & 63; F.wave = __builtin_amdgcn_readfirstlane(F.tid >> 6);
    F.G = gridDim.x; { const int bx = blockIdx.x; F.vcu = (F.G % 8 == 0) ? (bx % 8) * (F.G / 8) + bx / 8 : bx; }
#define GRID_BAR(seam) do { if (N_LAUNCHES != 1) { if (F.tid == 0) __hip_atomic_store(F.ctl + CW_TMO, 0xBADBA0u | (unsigned)(seam), RLX_AGENT); } \
    else { xcd_barrier(bar); } } while (0)
    unsigned char* ws = args.ws; F.ws = ws;
    F.ctl = (gu32*)(ws + WS_CTL);
    F.x = args.in[0]; F.gains = args.in[1]; F.rel_bias = args.in[2]; F.w_att_in = args.in[3]; F.w_att_out = args.in[4]; F.w_hg_in = args.in[5];
    F.lb_logits = args.in[6]; F.hg_gain = args.in[7]; F.w_hg_out = args.in[8]; F.w_ff_in = args.in[9]; F.w_ff_out = args.in[10]; F.out = args.out;
    for (int u = F.tid; u < (LDS_BYTES - LDSCTL_OFF) / 4; u += NWAVES * 64) ((LAS unsigned*)(F.lds + LDSCTL_OFF))[u] = 0u;
    __syncthreads();
    XcdBarrier bar; bar.bar = (unsigned*)(F.ctl + CW_BAR); bar.x = 0; bar.st = nullptr;
    if (N_LAUNCHES == 1) bar = xcd_barrier_post((unsigned*)(F.ctl + CW_BAR), F.MISC + 8);

    const int lo = args.ph_lo, hi = args.ph_hi;
#define IN(k) (lo <= (k) && (k) < hi)
#define BOTH(k) (IN(k) && IN((k) + 1))
    bf16* const XN = (bf16*)(ws + WS_XN); bf16* const HB = (bf16*)(ws + WS_HB); bf16* const Y = (bf16*)(ws + WS_Y); bf16* const ACT = (bf16*)(ws + WS_ACT);

    if (IN(0)) { for (int rep_ = 0; rep_ < REP_P0; ++rep_) p0_prologue(F);
        if (FFN_I8 && !P0_STRIP) { GRID_BAR(18);
            for (int l = 0; l < 2; ++l) p0_quant_rows<TM_FFI>(F, (const bf16*)(ws + WS_WFFI + l * WFFI_STRIDE), ws + WS_W8 + l * W8_STRIDE, (float*)(ws + WS_SW) + l * 2 * DFF, 2 * DFF);
            if (HGO_I8) p0_quant_wout<DM>(F, (const bf16*)(ws + WS_WHGO), ws + WS_W8G, (float*)(ws + WS_SWG));
            if (FFO_I8) for (int l = 0; l < 2; ++l) p0_quant_wout<DFF>(F, (const bf16*)(ws + WS_WFFO + l * WFFO_STRIDE), ws + WS_W8O + l * W8O_STRIDE, (float*)(ws + WS_SWO) + l * DM);
            if (ATT_I8) p0_quant_rows<false>(F, (const bf16*)(ws + WS_WATTI), ws + WS_W8A, (float*)(ws + WS_SWA), NQKV);
            if (HG_I8) p0_quant_rows<false>(F, (const bf16*)(ws + WS_WHGI), ws + WS_W8H, (float*)(ws + WS_SWH), NHG); }
        if (BOTH(0)) GRID_BAR(0); }
    if (IN(1)) {
        pg8::StaticOrder S; S.init(M, NQKV, F.G, (int)blockIdx.x);
        pg8::Gemm g{XN, ATT_I8 ? (const bf16*)(ws + WS_W8A) : (const bf16*)(ws + WS_WATTI), M, NQKV, ATT_I8 ? DM / 2 : DM};
        pg8::EpiBf16T<ATT_I8> E{(bf16*)(ws + WS_QKV), ATTN_MFMA ? 2048 : NQKV, ATTN_MFMA ? 2048 : 0, ATTN_MFMA ? (size_t)M * 2048 : 0, ATTN_MFMA ? 1 : 0, (const float*)(ws + WS_SA), (const float*)(ws + WS_SWA), (ATTN_MFMA && QKV_HM) ? (size_t)M * 128 : (size_t)0};
        const bool ovl_first = ((int)blockIdx.x & 1) == 0;
        if (P0_STRIP && P0_OVL && ovl_first) run_strips<4>(F, F.vcu, F.G);
        pg8::gemm_phase<pg8::EpiBf16T<ATT_I8>, pg8::StaticOrder, PG8_ALIGN, PG8_SP2, ATT_I8>(F.lds + RING_OFF, g, S, E); if (REP_GEMM > 1) { pg8::gemm_phase<pg8::EpiBf16T<ATT_I8>, pg8::StaticOrder, PG8_ALIGN, PG8_SP2, ATT_I8>(F.lds + RING_OFF, g, S, E); }
        if (P0_STRIP && P0_OVL && !ovl_first) { asm volatile("s_waitcnt vmcnt(0)" ::: "memory"); __syncthreads(); run_strips<4>(F, F.vcu, F.G); }
        if (BOTH(1)) GRID_BAR(1);
    }
    if (IN(2)) { if (ATTN_MFMA) { for (int rep_ = 0; rep_ < REP_ATT; ++rep_) { attn_mfma(F); GRID_BAR(16); attn_merge(F); if (rep_ + 1 < REP_ATT) GRID_BAR(17); } } else attn_naive(F); if (BOTH(2)) GRID_BAR(2); }
    if (IN(3)) {
        pg8::Gemm g{(const bf16*)(ws + WS_MRG), (const bf16*)(ws + WS_WATTO), M, DM, DATT}; pg8::StaticOrder S; S.init(M, DM, F.G, (int)blockIdx.x);
        pg8::EpiBf16 E{Y, DM, 0, 0, 0, nullptr, nullptr};
        pg8::gemm_phase<pg8::EpiBf16, pg8::StaticOrder, PG8_ALIGN, PG8_SP2>(F.lds + RING_OFF, g, S, E); if (REP_GEMM > 1) { pg8::gemm_phase<pg8::EpiBf16, pg8::StaticOrder, PG8_ALIGN, PG8_SP2>(F.lds + RING_OFF, g, S, E); }
        if (BOTH(3)) GRID_BAR(3);
    }
    if (IN(4)) { for (int rep_ = 0; rep_ < REP_NORM; ++rep_) norm_rows<true, FFN_I8 ? (TM_FFI ? 3 : 2) : 1, false, true>(F, F.x, Y, HB, XN, F.gains + 1 * DM, F.gains + 2 * DM, (float*)(ws + WS_SA)); if (BOTH(4)) GRID_BAR(4); }
    if (IN(5)) {
        pg8::StaticOrder S; S.init(M, 2 * DFF, F.G, (int)blockIdx.x);
        if (FFN_I8) {
            pg8::Gemm g{XN, (const bf16*)(ws + WS_W8), M, 2 * DFF, DM / 2};
            if (FFO_I8) {
                pg8::EpiSwiGLU8R E{ACT, DFF, (const float*)(ws + WS_SA), (const float*)(ws + WS_SW) + 0, (unsigned*)(ws + WS_RMAX) + 0 * M};
                pg8::gemm_phase<pg8::EpiSwiGLU8R, pg8::StaticOrder, PG8_ALIGN, PG8_SP2, true, 1, 1, TM_FFI>(F.lds + RING_OFF, g, S, E);
                if (P0_STRIP) run_deferred_strips<1>(F, (M / 256) * (2 * DFF / 256));
            } else {
            pg8::EpiSwiGLU8 E{ACT, DFF, (const float*)(ws + WS_SA), (const float*)(ws + WS_SW) + 0, (bf16*)(ws + WS_QKV)};
                pg8::gemm_phase<pg8::EpiSwiGLU8, pg8::StaticOrder, PG8_ALIGN, PG8_SP2, true, KREP_FFI, EREP_FFI, TM_FFI, TCH_FFI, LT_FFI>(F.lds + RING_OFF, g, S, E); if (REP_GEMM > 1 || REP_FFI > 1) { pg8::gemm_phase<pg8::EpiSwiGLU8, pg8::StaticOrder, PG8_ALIGN, PG8_SP2, true, 1, 1, TM_FFI>(F.lds + RING_OFF, g, S, E); }
            }
        } else {
            pg8::Gemm g{XN, (const bf16*)(ws + WS_WFFI), M, 2 * DFF, DM};
            pg8::EpiSwiGLU E{ACT, DFF};
            pg8::gemm_phase<pg8::EpiSwiGLU, pg8::StaticOrder, PG8_ALIGN, PG8_SP2>(F.lds + RING_OFF, g, S, E); if (REP_GEMM > 1) { pg8::gemm_phase<pg8::EpiSwiGLU, pg8::StaticOrder, PG8_ALIGN, PG8_SP2>(F.lds + RING_OFF, g, S, E); }
        }
        if (BOTH(5)) GRID_BAR(5);
    }
    if (IN(6)) {
        pg8::StaticOrder S; S.init(M, DM, F.G, (int)blockIdx.x);
        if (FFO_I8) {
            act_quant_rows(F, ACT, ws + WS_ACT8, (const unsigned*)(ws + WS_RMAX) + 0 * M, (float*)(ws + WS_SA2));
            GRID_BAR(20);
            pg8::Gemm g{(const bf16*)(ws + WS_ACT8), (const bf16*)(ws + WS_W8O + 0 * W8O_STRIDE), M, DM, DFF / 2};
            pg8::EpiBf16T<true> E{Y, DM, 0, 0, 0, (const float*)(ws + WS_SA2), (const float*)(ws + WS_SWO) + 0 * DM};
            pg8::gemm_phase<pg8::EpiBf16T<true>, pg8::StaticOrder, PG8_ALIGN, PG8_SP2, true>(F.lds + RING_OFF, g, S, E);
        } else {
            pg8::Gemm g{ACT, (const bf16*)(ws + WS_WFFO), M, DM, DFF};
            pg8::EpiBf16 E{Y, DM, 0, 0, 0, nullptr, nullptr};
            pg8::gemm_phase<pg8::EpiBf16, pg8::StaticOrder, PG8_ALIGN, PG8_SP2>(F.lds + RING_OFF, g, S, E);
        }
        if (BOTH(6)) GRID_BAR(6);
    }
    if (IN(7)) { norm_rows<true, HG_I8 ? 2 : 1, true, true>(F, HB, Y, HB, XN, F.gains + 3 * DM, F.gains + 4 * DM, (float*)(ws + WS_SA)); if (BOTH(7)) GRID_BAR(7); }
    if (IN(8)) {
        pg8::StaticOrder S; S.init(M, NHG, F.G, (int)blockIdx.x);
        pg8::Gemm g{XN, HG_I8 ? (const bf16*)(ws + WS_W8H) : (const bf16*)(ws + WS_WHGI), M, NHG, HG_I8 ? DM / 2 : DM};
        if (HG_FUSE == 0) {
            pg8::EpiHgrn<HG_I8> E{(bf16*)(ws + WS_QKV), (bf16*)(ws + WS_AO), (const float*)(ws + WS_TAB + 65536), (const float*)(ws + WS_SA), (const float*)(ws + WS_SWH)};
            pg8::gemm_phase<pg8::EpiHgrn<HG_I8>, pg8::StaticOrder, PG8_ALIGN, PG8_SP2, HG_I8>(F.lds + RING_OFF, g, S, E);
        } else if (HG_FUSE == 1) {
            pg8::EpiHgrn2<HG_I8> E{(bf16*)(ws + WS_QKV), (bf16*)(ws + WS_AO), (const float*)(ws + WS_TAB + 65536), (const float*)(ws + WS_SA), (const float*)(ws + WS_SWH)};
            pg8::gemm_phase<pg8::EpiHgrn2<HG_I8>, pg8::StaticOrder, PG8_ALIGN, PG8_SP2, HG_I8>(F.lds + RING_OFF, g, S, E);
        } else {
            pg8::EpiHgrn3<HG_I8> E{(bf16*)(ws + WS_H3QR), (WS_H3KR - WS_H3QR) / 2, (WS_H3VH - WS_H3QR) / 2, (WS_H3SG - WS_H3QR) / 2, (float*)(ws + WS_H3EL), (float*)(ws + WS_H3DEC), (float*)(ws + WS_H3ER),
                                   (const float*)(ws + WS_TAB + 65536), (const float*)(ws + WS_SA), (const float*)(ws + WS_SWH)};
            pg8::gemm_phase<pg8::EpiHgrn3<HG_I8>, pg8::StaticOrder, PG8_ALIGN, PG8_SP2, HG_I8>(F.lds + RING_OFF, g, S, E);
            if (REP_P8 > 1) { pg8::gemm_phase<pg8::EpiHgrn3<HG_I8>, pg8::StaticOrder, PG8_ALIGN, PG8_SP2, HG_I8>(F.lds + RING_OFF, g, S, E); }
        }
        if (BOTH(8)) GRID_BAR(8);
    }
    if (IN(9)) { if (HG_FUSE == 2) { hgrn_mfma3(F); if (REP_HG > 1) hgrn_mfma3(F); } else { hgrn_mfma2(F); if (REP_HG > 1) hgrn_mfma2(F); } if (BOTH(9)) GRID_BAR(9); }
    if (IN(10)) { if (HGO_I8) hgrn_gate3(F); else { hgrn_gate2(F); if (REP_HG > 1) hgrn_gate2(F); } if (BOTH(10)) GRID_BAR(10); }
    if (IN(11)) {
        pg8::StaticOrder S; S.init(M, DM, F.G, (int)blockIdx.x);
        if (HGO_I8) {
            pg8::Gemm g{(const bf16*)(ws + WS_OG), (const bf16*)(ws + WS_W8G), M, DM, DM / 2};
            pg8::EpiBf16T<true> E{Y, DM, 0, 0, 0, (const float*)(ws + WS_SA3), (const float*)(ws + WS_SWG)};
            pg8::gemm_phase<pg8::EpiBf16T<true>, pg8::StaticOrder, PG8_ALIGN, PG8_SP2, true>(F.lds + RING_OFF, g, S, E);
        } else {
            pg8::Gemm g{(const bf16*)(ws + WS_OG), (const bf16*)(ws + WS_WHGO), M, DM, DM};
            pg8::EpiBf16 E{Y, DM, 0, 0, 0, nullptr, nullptr};
            pg8::gemm_phase<pg8::EpiBf16, pg8::StaticOrder, PG8_ALIGN, PG8_SP2>(F.lds + RING_OFF, g, S, E);
        }
        if (BOTH(11)) GRID_BAR(11);
    }
    if (IN(12)) { norm_rows<true, FFN_I8 ? (TM_FFI ? 3 : 2) : 1, true, true>(F, HB, Y, HB, XN, F.gains + 5 * DM, F.gains + 6 * DM, (float*)(ws + WS_SA)); if (BOTH(12)) GRID_BAR(12); }
    if (IN(13)) {
        pg8::StaticOrder S; S.init(M, 2 * DFF, F.G, (int)blockIdx.x);
        if (FFN_I8) {
            pg8::Gemm g{XN, (const bf16*)(ws + WS_W8 + W8_STRIDE), M, 2 * DFF, DM / 2};
            if (FFO_I8) {
                pg8::EpiSwiGLU8R E{ACT, DFF, (const float*)(ws + WS_SA), (const float*)(ws + WS_SW) + 2 * DFF, (unsigned*)(ws + WS_RMAX) + 1 * M};
                pg8::gemm_phase<pg8::EpiSwiGLU8R, pg8::StaticOrder, PG8_ALIGN, PG8_SP2, true, 1, 1, TM_FFI>(F.lds + RING_OFF, g, S, E);
                if (P0_STRIP) run_deferred_strips<2>(F, (M / 256) * (2 * DFF / 256));
            } else {
            pg8::EpiSwiGLU8 E{ACT, DFF, (const float*)(ws + WS_SA), (const float*)(ws + WS_SW) + 2 * DFF, (bf16*)(ws + WS_QKV)};
                pg8::gemm_phase<pg8::EpiSwiGLU8, pg8::StaticOrder, PG8_ALIGN, PG8_SP2, true, KREP_FFI, EREP_FFI, TM_FFI, TCH_FFI, LT_FFI>(F.lds + RING_OFF, g, S, E); if (REP_GEMM > 1 || REP_FFI > 1) { pg8::gemm_phase<pg8::EpiSwiGLU8, pg8::StaticOrder, PG8_ALIGN, PG8_SP2, true, 1, 1, TM_FFI>(F.lds + RING_OFF, g, S, E); }
            }
        } else {
            pg8::Gemm g{XN, (const bf16*)(ws + WS_WFFI + WFFI_STRIDE), M, 2 * DFF, DM};
            pg8::EpiSwiGLU E{ACT, DFF};
            pg8::gemm_phase<pg8::EpiSwiGLU, pg8::StaticOrder, PG8_ALIGN, PG8_SP2>(F.lds + RING_OFF, g, S, E); if (REP_GEMM > 1) { pg8::gemm_phase<pg8::EpiSwiGLU, pg8::StaticOrder, PG8_ALIGN, PG8_SP2>(F.lds + RING_OFF, g, S, E); }
        }
        if (BOTH(13)) GRID_BAR(13);
    }
    if (IN(14)) {
        pg8::StaticOrder S; S.init(M, DM, F.G, (int)blockIdx.x);
        if (FFO_I8) {
            act_quant_rows(F, ACT, ws + WS_ACT8, (const unsigned*)(ws + WS_RMAX) + 1 * M, (float*)(ws + WS_SA2));
            GRID_BAR(21);
            pg8::Gemm g{(const bf16*)(ws + WS_ACT8), (const bf16*)(ws + WS_W8O + 1 * W8O_STRIDE), M, DM, DFF / 2};
            pg8::EpiBf16T<true> E{Y, DM, 0, 0, 0, (const float*)(ws + WS_SA2), (const float*)(ws + WS_SWO) + 1 * DM};
            pg8::gemm_phase<pg8::EpiBf16T<true>, pg8::StaticOrder, PG8_ALIGN, PG8_SP2, true>(F.lds + RING_OFF, g, S, E);
        } else {
            pg8::Gemm g{ACT, (const bf16*)(ws + WS_WFFO + WFFO_STRIDE), M, DM, DFF};
            pg8::EpiBf16 E{Y, DM, 0, 0, 0, nullptr, nullptr};
            pg8::gemm_phase<pg8::EpiBf16, pg8::StaticOrder, PG8_ALIGN, PG8_SP2>(F.lds + RING_OFF, g, S, E);
        }
        if (BOTH(14)) GRID_BAR(14);
    }
    if (REP_BAR > 0) { for (int rb_ = 0; rb_ < REP_BAR; ++rb_) GRID_BAR(30); }
    if (IN(15)) { norm_rows<true, 0, true, false>(F, HB, Y, F.out, nullptr, F.gains + 7 * DM, nullptr); }
#undef IN
#undef BOTH
}

extern "C" void kernel_launch(void* const* d_in, const int* in_sizes, int n_in, void* d_out, int out_size, void* d_ws, size_t ws_size, hipStream_t stream) {
    static int grid = 0;
    if (grid == 0) {
        if (n_in != 11 || in_sizes[0] != M * DM || out_size != M * DM || ws_size < WS_END5) { fprintf(stderr, "kernel_launch: unexpected shapes (n_in %d, in0 %d, out %d, ws %zu, need %zu); nothing launched\n", n_in, n_in > 0 ? in_sizes[0] : -1, out_size, ws_size, (size_t)WS_END); grid = -1; return; }
        int dev = 0, cus = 0, per_cu = 0;
        if (hipGetDevice(&dev) != hipSuccess || hipDeviceGetAttribute(&cus, hipDeviceAttributeMultiprocessorCount, dev) != hipSuccess) { grid = -1; return; }
        if (hipFuncSetAttribute((const void*)mega_fwd, hipFuncAttributeMaxDynamicSharedMemorySize, LDS_BYTES) != hipSuccess) { fprintf(stderr, "kernel_launch: hipFuncSetAttribute failed\n"); grid = -1; return; }
        if (hipOccupancyMaxActiveBlocksPerMultiprocessor(&per_cu, (const void*)mega_fwd, NWAVES * 64, LDS_BYTES) != hipSuccess || per_cu < 1)
            fprintf(stderr, "kernel_launch: note: occupancy query reports %d workgroups per CU\n", per_cu);
        (void)hipGetLastError();
        grid = cus;
    }
    if (grid < 0) return;
    if (hipMemsetAsync((char*)d_ws + WS_CTL, 0, CTL_ZERO_BYTES, stream) != hipSuccess) { fprintf(stderr, "kernel_launch: hipMemsetAsync failed\n"); return; }
    Args a{};
    for (int i = 0; i < 11; ++i) a.in[i] = (const float*)d_in[i];
    a.out = (float*)d_out; a.ws = (unsigned char*)d_ws;
    for (int li = 0; li < N_LAUNCHES; ++li) {
        a.ph_lo = (N_LAUNCHES == 1) ? 0 : li; a.ph_hi = (N_LAUNCHES == 1) ? NPH : li + 1; a.li = li;
        hipLaunchKernelGGL(mega_fwd, dim3(grid), dim3(NWAVES * 64), LDS_BYTES, stream, a);
        const hipError_t le = hipPeekAtLastError();
        if (le != hipSuccess) { fprintf(stderr, "kernel_launch: launch %d failed: %s\n", li, hipGetErrorName(le)); break; }
    }
}
```

```cpp
#include <hip/hip_runtime.h>
#include <cstdio>
#include <cstdint>
#ifndef PG8_WGM
#define PG8_WGM 8
#endif
#ifndef MK_FFO_ROT
#define MK_FFO_ROT 1
#endif
namespace pg8 {
#define PG8_LAS __attribute__((address_space(3)))
typedef unsigned short bf16_t;
typedef short bf16x8 __attribute__((ext_vector_type(8)));
typedef float f32x4 __attribute__((ext_vector_type(4)));
typedef unsigned u32x4 __attribute__((ext_vector_type(4)));
constexpr int BM = 256, BK = 64, HALF = 128, HTB = HALF * BK * 2  , STAGE_BYTES = 8 * HTB, NXCD = 8, WGM = PG8_WGM;

__host__ __device__ __forceinline__ int lds_byte(int r, int c) { const int st = (r >> 4) * 2 + (c >> 5), rr = r & 15, cc = c & 31, ob = rr * 64 + cc * 2; return st * 1024 + (ob ^ (((ob >> 9) & 1) << 5)); }
__host__ __device__ __forceinline__ void stage_rc(int b, int& R, int& C) { const int st = b / 1024, sb = b % 1024, swz = sb ^ (((sb >> 9) & 1) << 5); R = (st >> 1) * 16 + swz / 64; C = (st & 1) * 32 + (swz % 64) / 2; }
__host__ __device__ __forceinline__ int perm32(int rho) { const int n = rho >> 4, i = rho & 15; return 8 * (i >> 2) + 4 * n + (i & 3); }

struct Unit { int pm, pn; };
struct Gemm { const bf16_t* A; const bf16_t* Bt; int M, N, K; };

struct StaticOrder {
    int nM, nN, nwg, G, c;
    __host__ __device__ void init(int M, int N, int G_, int c_) { nM = M / BM; nN = N / BM; nwg = nM * nN; G = G_; c = c_; }
    __host__ __device__ bool next(int i, Unit& u) const {
        const long L = (long)i * G + c; if (L >= nwg) return false;
        int wgid = (int)L; { const int q = nwg / NXCD, r = nwg % NXCD, xcd = wgid % NXCD, off = wgid / NXCD; wgid = (xcd < r ? xcd * (q + 1) : r * (q + 1) + (xcd - r) * q) + off; }
        const int nig = WGM * nN, gid = wgid / nig, fm = gid * WGM, gsz = (nM - fm) < WGM ? (nM - fm) : WGM;
        u.pm = fm + ((wgid % nig) % gsz); u.pn = (wgid % nig) / gsz; return true;
    }
    __device__ __forceinline__ void a_ready(const Unit&) const {}
    __device__ __forceinline__ void done(const Unit&) const {}
};

__device__ __forceinline__ unsigned cvt_pk_bf16(float lo, float hi) { unsigned r; asm volatile("v_cvt_pk_bf16_f32 %0, %1, %2" : "=v"(r) : "v"(lo), "v"(hi)); return r; }
typedef float f32x2 __attribute__((ext_vector_type(2)));
typedef int i32x4 __attribute__((ext_vector_type(4)));
template <bool I8> struct AccT { typedef f32x4 type; static __device__ __forceinline__ f32x4 zero() { return (f32x4){0.f, 0.f, 0.f, 0.f}; } };
template <> struct AccT<true> { typedef i32x4 type; static __device__ __forceinline__ i32x4 zero() { return (i32x4){0, 0, 0, 0}; } };
__device__ __forceinline__ f32x4 mma16(bf16x8 a, bf16x8 b, f32x4 c) { return __builtin_amdgcn_mfma_f32_16x16x32_bf16(a, b, c, 0, 0, 0); }
__device__ __forceinline__ i32x4 mma16(bf16x8 a, bf16x8 b, i32x4 c) { return __builtin_amdgcn_mfma_i32_16x16x64_i8(__builtin_bit_cast(i32x4, a), __builtin_bit_cast(i32x4, b), c, 0, 0, 0); }
__host__ __device__ __forceinline__ size_t tm_chunk_off(int r, int cb, int nt, bool perm) {
    const int p = r >> 8, rr = r & 255, half = rr >> 7; int R = rr & 127;
    if (perm) { const int x = R & 31; R = (R & ~31) + 16 * ((x >> 2) & 1) + 4 * (x >> 3) + (x & 3); }
    return ((size_t)(p * nt + (cb >> 7)) * 2 + half) * 16384 + (size_t)lds_byte(R, (cb & 127) >> 1) + (cb & 1);
}
#ifndef MK_ACT_NT
#define MK_ACT_NT 0
#endif
#ifndef MK_ST_SC1
#define MK_ST_SC1 0
#endif
__device__ __forceinline__ void st16nt(void* p, u32x4 v) {
#if MK_ACT_NT
    __builtin_nontemporal_store(v, (u32x4*)p);
#else
    *(u32x4*)p = v;
#endif
}
__device__ __forceinline__ void st16(void* p, u32x4 v) {
#if MK_ST_SC1
    asm volatile("global_store_dwordx4 %0, %1, off sc1\n\ts_nop 1" :: "v"(p), "v"(v) : "memory");
#else
    *(u32x4*)p = v;
#endif
}
__device__ __forceinline__ float silu_f(float x) { return x * __builtin_amdgcn_rcpf(1.0f + __expf(-x)); }
template <bool I8> struct EpiBf16T {
    static constexpr bool PERM = true, AFTER_DRAIN = false, LDS_SCALES = I8, LDS_EXTRA = false;
    __device__ __forceinline__ const float* scale_src(const Unit& u, int t) const { return (t < 256) ? sa + u.pm * BM + t : sw + u.pn * BM + (t - 256); }
    bf16_t* O; int ldc; int split_cols; size_t split_stride; int dil; const float* sa; const float* sw;
    size_t hm = 0;
    __device__ __forceinline__ void operator()(const typename AccT<I8>::type (&acc)[2][2][4][2], const Unit& u, int wr, int wc, int fr, int fq, const PG8_LAS float* sc = nullptr) const {
        const int row0 = u.pm * BM + wr * 64 + fr; int colt = u.pn * BM; bf16_t* base = O; int sh = 0;
        if (split_cols) { const int t = colt / split_cols; base += (size_t)t * split_stride; colt -= t * split_cols; if (dil) sh = 2 * (t / 3); }
        const int col0 = colt + wc * 32 + 8 * fq;
        f32x4 swv[2][2];
#pragma unroll
        for (int bj = 0; bj < 2; ++bj)
#pragma unroll
            for (int n = 0; n < 2; ++n) { if constexpr (I8) swv[bj][n] = *(const PG8_LAS f32x4*)(sc + 256 + wc * 32 + 8 * fq + bj * HALF + 4 * n); else swv[bj][n] = (f32x4){1.f, 1.f, 1.f, 1.f}; }
#pragma unroll
        for (int ai = 0; ai < 2; ++ai)
#pragma unroll
            for (int m = 0; m < 4; ++m) { int r = row0 + ai * HALF + m * 16; float sr = 1.f; if constexpr (I8) sr = sc[wr * 64 + fr + ai * HALF + m * 16];
                if (sh) { const int tt = r & 8191; r = (r & ~8191) + ((tt & ((1 << sh) - 1)) << (13 - sh)) + (tt >> sh); }
                bf16_t* rowp = hm ? base + (size_t)(colt >> 7) * hm + (size_t)r * 128 + (col0 & 127) : base + (size_t)r * ldc + col0;
#pragma unroll
                for (int bj = 0; bj < 2; ++bj) { f32x4 v0, v1;
                    { if constexpr (I8) { v0 = __builtin_convertvector(acc[ai][bj][m][0], f32x4) * (swv[bj][0] * sr); v1 = __builtin_convertvector(acc[ai][bj][m][1], f32x4) * (swv[bj][1] * sr); } else { v0 = acc[ai][bj][m][0]; v1 = acc[ai][bj][m][1]; } }
                    u32x4 w; w.x = cvt_pk_bf16(v0[0], v0[1]); w.y = cvt_pk_bf16(v0[2], v0[3]); w.z = cvt_pk_bf16(v1[0], v1[1]); w.w = cvt_pk_bf16(v1[2], v1[3]);
                    st16(rowp + (hm ? (size_t)bj * hm : (size_t)(bj * HALF)), w); } }
    }
};
typedef EpiBf16T<false> EpiBf16;
struct EpiF32 {
    static constexpr bool PERM = false, AFTER_DRAIN = false, LDS_SCALES = false, LDS_EXTRA = false;
    float* C; int ldc;
    __device__ __forceinline__ void operator()(const f32x4 (&acc)[2][2][4][2], const Unit& u, int wr, int wc, int fr, int fq) const {
        const int row0 = u.pm * BM + wr * 64 + fr, col0 = u.pn * BM + wc * 32 + 4 * fq;
#pragma unroll
        for (int ai = 0; ai < 2; ++ai)
#pragma unroll
            for (int m = 0; m < 4; ++m) { float* rowp = C + (size_t)(row0 + ai * HALF + m * 16) * ldc + col0;
#pragma unroll
                for (int bj = 0; bj < 2; ++bj)
#pragma unroll
                    for (int n = 0; n < 2; ++n) *(f32x4*)(rowp + bj * HALF + n * 16) = acc[ai][bj][m][n]; }
    }
};
struct EpiSwiGLU {
    static constexpr bool PERM = true, AFTER_DRAIN = false, LDS_SCALES = false, LDS_EXTRA = false;
    bf16_t* O; int ldc;
    __device__ __forceinline__ void operator()(const f32x4 (&acc)[2][2][4][2], const Unit& u, int wr, int wc, int fr, int fq) const {
        const int row0 = u.pm * BM + wr * 64 + fr, col0 = u.pn * HALF + wc * 32 + 8 * fq;
#pragma unroll
        for (int ai = 0; ai < 2; ++ai)
#pragma unroll
            for (int m = 0; m < 4; ++m) { bf16_t* rowp = O + (size_t)(row0 + ai * HALF + m * 16) * ldc + col0;
                const f32x4 g0 = acc[ai][0][m][0], g1 = acc[ai][0][m][1], u0 = acc[ai][1][m][0], u1 = acc[ai][1][m][1];
                f32x4 v0, v1;
#pragma unroll
                for (int j = 0; j < 4; ++j) { v0[j] = silu_f(g0[j]) * u0[j]; v1[j] = silu_f(g1[j]) * u1[j]; }
                u32x4 w; w.x = cvt_pk_bf16(v0[0], v0[1]); w.y = cvt_pk_bf16(v0[2], v0[3]); w.z = cvt_pk_bf16(v1[0], v1[1]); w.w = cvt_pk_bf16(v1[2], v1[3]);
                st16(rowp, w); }
    }
};

template <bool I8> struct EpiHgrn {
    static constexpr bool PERM = true, AFTER_DRAIN = false, LDS_SCALES = false, LDS_EXTRA = false;
    bf16_t* base; bf16_t* KH; const float* lb; const float* sa; const float* sw;
    __device__ __forceinline__ void operator()(const typename AccT<I8>::type (&acc)[2][2][4][2], const Unit& u, int wr, int wc, int fr, int fq) const {
        const int row0 = u.pm * BM + wr * 64 + fr, sec = u.pn >> 4, cs0 = (u.pn & 15) * BM + wc * 32 + 8 * fq;
        f32x4 lbv[2][2], swv[2][2];
#pragma unroll
        for (int bj = 0; bj < 2; ++bj)
#pragma unroll
            for (int n = 0; n < 2; ++n) { lbv[bj][n] = (sec == 1) ? *(const f32x4*)(lb + cs0 + bj * HALF + 4 * n) : (f32x4){0.f, 0.f, 0.f, 0.f};
                swv[bj][n] = I8 ? *(const f32x4*)(sw + u.pn * BM + wc * 32 + 8 * fq + bj * HALF + 4 * n) : (f32x4){1.f, 1.f, 1.f, 1.f}; }
        bf16_t* const hm = base + (size_t)sec * ((size_t)16384 * 4096);
#pragma unroll
        for (int ai = 0; ai < 2; ++ai)
#pragma unroll
            for (int m = 0; m < 4; ++m) { const int r = row0 + ai * HALF + m * 16, bb = r >> 13, tt = r & 8191; const float sr = I8 ? sa[r] : 1.f;
#pragma unroll
                for (int bj = 0; bj < 2; ++bj) { f32x4 v[2]; u32x4 w;
#pragma unroll
                    for (int n = 0; n < 2; ++n)
#pragma unroll
                        for (int j = 0; j < 4; ++j) v[n][j] = I8 ? (float)acc[ai][bj][m][n][j] * (sr * swv[bj][n][j]) : (float)acc[ai][bj][m][n][j];
                    const size_t hoff = ((size_t)(bb * 32 + (u.pn & 15) * 2 + bj) * 8192 + tt) * 128 + wc * 32 + 8 * fq;
                    if (sec == 1) { f32x4 kk[2];
#pragma unroll
                        for (int n = 0; n < 2; ++n)
#pragma unroll
                            for (int j = 0; j < 4; ++j) { const float fg = lbv[bj][n][j] + (1.f - lbv[bj][n][j]) * __builtin_amdgcn_rcpf(1.0f + __expf(-v[n][j])); kk[n][j] = 1.f - fg; v[n][j] = __logf(fg); }
                        u32x4 kw; kw.x = cvt_pk_bf16(kk[0][0], kk[0][1]); kw.y = cvt_pk_bf16(kk[0][2], kk[0][3]); kw.z = cvt_pk_bf16(kk[1][0], kk[1][1]); kw.w = cvt_pk_bf16(kk[1][2], kk[1][3]);
                        st16(KH + hoff, kw);
                    } else if (sec == 0) {
#pragma unroll
                        for (int n = 0; n < 2; ++n)
#pragma unroll
                            for (int j = 0; j < 4; ++j) v[n][j] = silu_f(v[n][j]) * 0.08838834764831845f;
                    } else if (sec == 3) {
#pragma unroll
                        for (int n = 0; n < 2; ++n)
#pragma unroll
                            for (int j = 0; j < 4; ++j) v[n][j] = silu_f(v[n][j]);
                    }
                    w.x = cvt_pk_bf16(v[0][0], v[0][1]); w.y = cvt_pk_bf16(v[0][2], v[0][3]); w.z = cvt_pk_bf16(v[1][0], v[1][1]); w.w = cvt_pk_bf16(v[1][2], v[1][3]);
                    st16(hm + ((sec == 3) ? ((size_t)r * 4096 + cs0 + bj * HALF) : hoff), w); } }
    }
};
struct EpiSwiGLU8 {
    static constexpr bool PERM = true, AFTER_DRAIN = false, LDS_SCALES = false, LDS_EXTRA = false;
    bf16_t* O; int ldc; const float* sa; const float* sw; bf16_t* O2;
    __device__ __forceinline__ EpiSwiGLU8 alt() const { EpiSwiGLU8 e = *this; e.O = O2; return e; }
    __device__ __forceinline__ void operator()(const i32x4 (&acc)[2][2][4][2], const Unit& u, int wr, int wc, int fr, int fq) const {
        const int row0 = u.pm * BM + wr * 64 + fr, col0 = u.pn * HALF + wc * 32 + 8 * fq, brow0 = u.pn * BM + wc * 32 + 8 * fq;
        f32x4 sg[2], su[2];
#pragma unroll
        for (int n = 0; n < 2; ++n) { sg[n] = *(const f32x4*)(sw + brow0 + 4 * n); su[n] = *(const f32x4*)(sw + brow0 + HALF + 4 * n); }
#pragma unroll
        for (int ai = 0; ai < 2; ++ai)
#pragma unroll
            for (int m = 0; m < 4; ++m) { const int r = row0 + ai * HALF + m * 16; const float sr = sa[r]; bf16_t* rowp = O + (size_t)r * ldc + col0;
                f32x4 v[2];
#pragma unroll
                for (int n = 0; n < 2; ++n)
#pragma unroll
                    for (int j = 0; j < 4; ++j) { const float gt = (float)acc[ai][0][m][n][j] * (sr * sg[n][j]), up = (float)acc[ai][1][m][n][j] * (sr * su[n][j]); v[n][j] = silu_f(gt) * up; }
                u32x4 w; w.x = cvt_pk_bf16(v[0][0], v[0][1]); w.y = cvt_pk_bf16(v[0][2], v[0][3]); w.z = cvt_pk_bf16(v[1][0], v[1][1]); w.w = cvt_pk_bf16(v[1][2], v[1][3]);
                st16(rowp, w); }
    }
};

template <bool I8> struct EpiHgrn2 {
    static constexpr bool PERM = true, AFTER_DRAIN = false, LDS_SCALES = false, LDS_EXTRA = false;
    bf16_t* base; bf16_t* KH; const float* lb; const float* sa; const float* sw;
    __device__ __forceinline__ void operator()(const typename AccT<I8>::type (&acc)[2][2][4][2], const Unit& u, int wr, int wc, int fr, int fq) const {
        typedef unsigned u32x2 __attribute__((ext_vector_type(2)));
        const int row0 = u.pm * BM + wr * 64 + fr, head = u.pn >> 1, ch0 = 64 * (u.pn & 1) + 16 * wc + 4 * fq;
        const f32x4 lbv = *(const f32x4*)(lb + head * 128 + ch0);
        f32x4 swv[2][2];
#pragma unroll
        for (int bj = 0; bj < 2; ++bj)
#pragma unroll
            for (int n = 0; n < 2; ++n) swv[bj][n] = I8 ? *(const f32x4*)(sw + u.pn * BM + wc * 32 + 8 * fq + bj * HALF + 4 * n) : (f32x4){1.f, 1.f, 1.f, 1.f};
        const size_t MD = (size_t)16384 * 4096;
#pragma unroll
        for (int ai = 0; ai < 2; ++ai)
#pragma unroll
            for (int m = 0; m < 4; ++m) { const int r = row0 + ai * HALF + m * 16, bb = r >> 13, tt = r & 8191; const float sr = I8 ? sa[r] : 1.f;
                f32x4 v[2][2];
#pragma unroll
                for (int bj = 0; bj < 2; ++bj)
#pragma unroll
                    for (int n = 0; n < 2; ++n)
#pragma unroll
                        for (int j = 0; j < 4; ++j) v[bj][n][j] = I8 ? (float)acc[ai][bj][m][n][j] * (sr * swv[bj][n][j]) : (float)acc[ai][bj][m][n][j];
                const size_t hoff = ((size_t)(bb * 32 + head) * 8192 + tt) * 128 + ch0;
                f32x4 qv, lf, kk, sg;
#pragma unroll
                for (int j = 0; j < 4; ++j) { qv[j] = silu_f(v[0][0][j]) * 0.08838834764831845f;
                    const float fg = lbv[j] + (1.f - lbv[j]) * __builtin_amdgcn_rcpf(1.0f + __expf(-v[0][1][j])); kk[j] = 1.f - fg; lf[j] = __logf(fg); sg[j] = silu_f(v[1][1][j]); }
                *(u32x2*)(base + hoff) = (u32x2){cvt_pk_bf16(qv[0], qv[1]), cvt_pk_bf16(qv[2], qv[3])};
                *(u32x2*)(base + MD + hoff) = (u32x2){cvt_pk_bf16(lf[0], lf[1]), cvt_pk_bf16(lf[2], lf[3])};
                *(u32x2*)(KH + hoff) = (u32x2){cvt_pk_bf16(kk[0], kk[1]), cvt_pk_bf16(kk[2], kk[3])};
                *(u32x2*)(base + 2 * MD + hoff) = (u32x2){cvt_pk_bf16(v[1][0][0], v[1][0][1]), cvt_pk_bf16(v[1][0][2], v[1][0][3])};
                *(u32x2*)(base + 3 * MD + (size_t)r * 4096 + head * 128 + ch0) = (u32x2){cvt_pk_bf16(sg[0], sg[1]), cvt_pk_bf16(sg[2], sg[3])}; }
    }
};

#define PG8_DPP_SHR(x, n) __builtin_bit_cast(float, __builtin_amdgcn_update_dpp(0, __builtin_bit_cast(int, (x)), 0x110 + (n), 0xf, 0xf, false))
#define PG8_DPP_PERM(x, ctrl) __builtin_bit_cast(float, __builtin_amdgcn_update_dpp(0, __builtin_bit_cast(int, (x)), (ctrl), 0xf, 0xf, true))
__device__ __forceinline__ float row_sum16(float x) { x += PG8_DPP_PERM(x, 0x140); x += PG8_DPP_PERM(x, 0x141); x += PG8_DPP_PERM(x, 0xB1); x += PG8_DPP_PERM(x, 0x4E); return x; }
__device__ __forceinline__ float row_scan16(float x) { x += PG8_DPP_SHR(x, 1); x += PG8_DPP_SHR(x, 2); x += PG8_DPP_SHR(x, 4); x += PG8_DPP_SHR(x, 8); return x; }
#define PG8_SCAN_STEP(n) "v_add_f32_dpp %0, %0, %0 row_shr:" #n " row_mask:0xf bank_mask:0xf bound_ctrl:1\n\tv_add_f32_dpp %1, %1, %1 row_shr:" #n " row_mask:0xf bank_mask:0xf bound_ctrl:1\n\t" \
                         "v_add_f32_dpp %2, %2, %2 row_shr:" #n " row_mask:0xf bank_mask:0xf bound_ctrl:1\n\tv_add_f32_dpp %3, %3, %3 row_shr:" #n " row_mask:0xf bank_mask:0xf bound_ctrl:1\n\t"
__device__ __forceinline__ void row_scan16x4(float& a, float& b, float& c, float& d) {
    asm volatile("s_nop 1\n\t" PG8_SCAN_STEP(1) PG8_SCAN_STEP(2) PG8_SCAN_STEP(4) PG8_SCAN_STEP(8) : "+v"(a), "+v"(b), "+v"(c), "+v"(d));
}
__device__ __forceinline__ void row_addlast16x4(float& r0, float& r1, float& r2, float& r3, float i0, float i1, float i2, float i3) {
    asm volatile("s_nop 1\n\t"
                 "v_add_f32_dpp %0, %4, %0 row_newbcast:15 row_mask:0xf bank_mask:0xf\n\tv_add_f32_dpp %1, %5, %1 row_newbcast:15 row_mask:0xf bank_mask:0xf\n\t"
                 "v_add_f32_dpp %2, %6, %2 row_newbcast:15 row_mask:0xf bank_mask:0xf\n\tv_add_f32_dpp %3, %7, %3 row_newbcast:15 row_mask:0xf bank_mask:0xf"
                 : "+v"(r0), "+v"(r1), "+v"(r2), "+v"(r3) : "v"(i0), "v"(i1), "v"(i2), "v"(i3));
}
template <bool I8> struct EpiHgrn3 {
    static constexpr bool PERM = true, AFTER_DRAIN = false, LDS_SCALES = I8, LDS_EXTRA = I8;
    bf16_t* QR; size_t dKR, dVH, dSG;     float* EL; float* DEC; float* ER; const float* lb; const float* sa; const float* sw;
    __device__ __forceinline__ const float* scale_src(const Unit& u, int t) const { return (t < 256) ? sa + u.pm * BM + t : sw + u.pn * BM + (t - 256); }
    __device__ __forceinline__ const float* extra_src(const Unit& u, int t) const { return lb + (u.pn >> 1) * 128 + 64 * (u.pn & 1) + t; }
    __device__ __forceinline__ void operator()(const typename AccT<I8>::type (&acc)[2][2][4][2], const Unit& u, int wr, int wc, int fr, int fq, const PG8_LAS float* sc = nullptr) const {
        typedef unsigned u32x2 __attribute__((ext_vector_type(2)));
        const int lane = fr + 16 * fq, row0 = u.pm * BM + wr * 64 + fr, head = u.pn >> 1, ch0 = 64 * (u.pn & 1) + 16 * wc + 4 * fq;
        f32x4 lbv; if constexpr (I8) lbv = *(const PG8_LAS f32x4*)(sc + 512 + 16 * wc + 4 * fq); else lbv = *(const f32x4*)(lb + head * 128 + ch0);
        f32x4 swv[2][2];
#pragma unroll
        for (int bj = 0; bj < 2; ++bj)
#pragma unroll
            for (int n = 0; n < 2; ++n) { if constexpr (I8) swv[bj][n] = *(const PG8_LAS f32x4*)(sc + 256 + wc * 32 + 8 * fq + bj * HALF + 4 * n); else swv[bj][n] = (f32x4){1.f, 1.f, 1.f, 1.f}; }
#pragma unroll
        for (int ai = 0; ai < 2; ++ai) {
            f32x4 qv[4], lf[4], kk[4];
#pragma unroll
            for (int m = 0; m < 4; ++m) { const int r = row0 + ai * HALF + m * 16, bb = r >> 13, tt = r & 8191; float sr = 1.f; if constexpr (I8) sr = sc[wr * 64 + fr + ai * HALF + m * 16];
                f32x4 v[2][2];
#pragma unroll
                for (int bj = 0; bj < 2; ++bj)
#pragma unroll
                    for (int n = 0; n < 2; ++n) { if constexpr (I8) v[bj][n] = __builtin_convertvector(acc[ai][bj][m][n], f32x4) * (swv[bj][n] * sr); else v[bj][n] = acc[ai][bj][m][n]; }
#pragma unroll
                for (int j = 0; j < 4; ++j) { qv[m][j] = silu_f(v[0][0][j]) * 0.08838834764831845f;
                    const float fg = lbv[j] + (1.f - lbv[j]) * __builtin_amdgcn_rcpf(1.0f + __expf(-v[0][1][j])); kk[m][j] = 1.f - fg; lf[m][j] = __builtin_amdgcn_logf(fg) * 0.6931471805599453f; }
                { const u32x2 p0 = __builtin_amdgcn_permlane16_swap(cvt_pk_bf16(v[1][0][0], v[1][0][1]), cvt_pk_bf16(v[1][1][0], v[1][1][1]), false, false);
                  const u32x2 p1 = __builtin_amdgcn_permlane16_swap(cvt_pk_bf16(v[1][0][2], v[1][0][3]), cvt_pk_bf16(v[1][1][2], v[1][1][3]), false, false);
                  const size_t doff = (fq & 1) ? (dSG + (size_t)r * 4096 + head * 128 + (ch0 - 4)) : (dVH + ((size_t)(bb * 32 + head) * 8192 + tt) * 128 + ch0);
                  *(u32x4*)(QR + doff) = (u32x4){p0.x, p1.x, p0.y, p1.y}; } }
            f32x4 bb[4], run = (f32x4){0.f, 0.f, 0.f, 0.f}, bref = run;
#pragma unroll
            for (int m = 0; m < 4; ++m) { float i0 = lf[m][0], i1 = lf[m][1], i2 = lf[m][2], i3 = lf[m][3];
                row_scan16x4(i0, i1, i2, i3);
                bb[m] = (f32x4){i0, i1, i2, i3} + run;
                { float r0 = run[0], r1 = run[1], r2 = run[2], r3 = run[3]; row_addlast16x4(r0, r1, r2, r3, i0, i1, i2, i3); run = (f32x4){r0, r1, r2, r3}; }
                if (m == 1) bref = run; }
            const int rb = u.pm * BM + ai * HALF + wr * 64; const size_t cid = (size_t)((rb >> 13) * 32 + head) * 128 + ((rb & 8191) >> 6);
#pragma unroll
            for (int m = 0; m < 4; ++m) { f32x4 qr, kr;
#pragma unroll
                for (int j = 0; j < 4; ++j) { const float e1 = __expf(bb[m][j] - bref[j]); qr[j] = qv[m][j] * e1; kr[j] = kk[m][j] * __builtin_amdgcn_rcpf(e1); }
                const size_t off = cid * 8704 + (size_t)(16 * m + fr) * 136 + (ch0 & ~7);
                const u32x2 p0 = __builtin_amdgcn_permlane16_swap(cvt_pk_bf16(qr[0], qr[1]), cvt_pk_bf16(kr[0], kr[1]), false, false);
                const u32x2 p1 = __builtin_amdgcn_permlane16_swap(cvt_pk_bf16(qr[2], qr[3]), cvt_pk_bf16(kr[2], kr[3]), false, false);
                *(u32x4*)(QR + off + ((fq & 1) ? dKR : (size_t)0)) = (u32x4){p0.x, p1.x, p0.y, p1.y}; }
            if (fr == 0) { f32x4 el, dc, er;
#pragma unroll
                for (int j = 0; j < 4; ++j) { el[j] = __expf(run[j] - bref[j]); dc[j] = __expf(run[j]); er[j] = __expf(bref[j]); }
                *(f32x4*)(EL + cid * 128 + ch0) = el; *(f32x4*)(DEC + cid * 128 + ch0) = dc; *(f32x4*)(ER + cid * 128 + ch0) = er; }
        }
    }
};

struct EpiSwiGLU8R {
    static constexpr bool PERM = true, AFTER_DRAIN = false, LDS_SCALES = true, LDS_EXTRA = false;
    bf16_t* O; int ldc; const float* sa; const float* sw; unsigned* rmax;
    __device__ __forceinline__ const float* scale_src(const Unit& u, int t) const { return (t < 256) ? sa + u.pm * BM + t : sw + u.pn * BM + (t - 256); }
    __device__ __forceinline__ void operator()(const i32x4 (&acc)[2][2][4][2], const Unit& u, int wr, int wc, int fr, int fq, const PG8_LAS float* sc) const {
        const int row0 = u.pm * BM + wr * 64 + fr, col0 = u.pn * HALF + wc * 32 + 8 * fq, brow0 = u.pn * BM + wc * 32 + 8 * fq;
        f32x4 sg[2], su[2];
#pragma unroll
        for (int n = 0; n < 2; ++n) { sg[n] = *(const PG8_LAS f32x4*)(sc + 256 + wc * 32 + 8 * fq + 4 * n); su[n] = *(const PG8_LAS f32x4*)(sc + 256 + HALF + wc * 32 + 8 * fq + 4 * n); }
#pragma unroll
        for (int ai = 0; ai < 2; ++ai)
#pragma unroll
            for (int m = 0; m < 4; ++m) { const int r = row0 + ai * HALF + m * 16; const float sr = sc[wr * 64 + fr + ai * HALF + m * 16], sru = MK_FFO_ROT ? sr * 0.17677669529663687f : sr; bf16_t* rowp = O + (size_t)r * ldc + col0;
                f32x2 X[4];
#pragma unroll
                for (int n = 0; n < 2; ++n)
#pragma unroll
                    for (int j = 0; j < 4; ++j) { const float gt = (float)acc[ai][0][m][n][j] * (sr * sg[n][j]), up = (float)acc[ai][1][m][n][j] * (sru * su[n][j]); X[2 * n + (j >> 1)][j & 1] = silu_f(gt) * up; }
#if MK_FFO_ROT
#pragma unroll
                for (int k = 0; k < 4; ++k) { const float a = X[k].x, b = X[k].y; X[k] = (f32x2){a + b, a - b}; }
                { f32x2 a = X[0], b = X[1]; X[0] = a + b; X[1] = a - b; a = X[2]; b = X[3]; X[2] = a + b; X[3] = a - b; }
                { f32x2 a = X[0], b = X[2]; X[0] = a + b; X[2] = a - b; a = X[1]; b = X[3]; X[1] = a + b; X[3] = a - b; }
                { float x0 = X[0].x, x1 = X[0].y, x2 = X[1].x, x3 = X[1].y, x4 = X[2].x, x5 = X[2].y, x6 = X[3].x, x7 = X[3].y;
                  asm volatile("v_nop\n\tv_nop\n\tv_permlane16_swap_b32 %0, %4\n\tv_permlane16_swap_b32 %1, %5\n\tv_permlane16_swap_b32 %2, %6\n\tv_permlane16_swap_b32 %3, %7\n\ts_nop 1"
                               : "+v"(x0), "+v"(x1), "+v"(x2), "+v"(x3), "+v"(x4), "+v"(x5), "+v"(x6), "+v"(x7));
                  { const f32x2 a = (f32x2){x0, x1}, b = (f32x2){x4, x5}, c = (f32x2){x2, x3}, d = (f32x2){x6, x7}; X[0] = a + b; X[2] = a - b; X[1] = c + d; X[3] = c - d; }
                  x0 = X[0].x; x1 = X[0].y; x2 = X[1].x; x3 = X[1].y; x4 = X[2].x; x5 = X[2].y; x6 = X[3].x; x7 = X[3].y;
                  asm volatile("v_nop\n\tv_nop\n\tv_permlane32_swap_b32 %0, %2\n\tv_permlane32_swap_b32 %1, %3\n\tv_permlane32_swap_b32 %4, %6\n\tv_permlane32_swap_b32 %5, %7\n\ts_nop 1"
                               : "+v"(x0), "+v"(x1), "+v"(x2), "+v"(x3), "+v"(x4), "+v"(x5), "+v"(x6), "+v"(x7));
                  { const f32x2 a = (f32x2){x0, x1}, b = (f32x2){x2, x3}, c = (f32x2){x4, x5}, d = (f32x2){x6, x7}; X[0] = a + b; X[1] = a - b; X[2] = c + d; X[3] = c - d; } }
#endif
                u32x4 w; w.x = cvt_pk_bf16(X[0].x, X[0].y); w.y = cvt_pk_bf16(X[1].x, X[1].y); w.z = cvt_pk_bf16(X[2].x, X[2].y); w.w = cvt_pk_bf16(X[3].x, X[3].y);
                st16nt(rowp, w);
                float am = fmaxf(fmaxf(fmaxf(fabsf(X[0].x), fabsf(X[0].y)), fmaxf(fabsf(X[1].x), fabsf(X[1].y))), fmaxf(fmaxf(fabsf(X[2].x), fabsf(X[2].y)), fmaxf(fabsf(X[3].x), fabsf(X[3].y))));
                { float lo = am, hi = am; asm volatile("v_nop\n\tv_nop\n\tv_permlane16_swap_b32 %0, %1" : "+v"(lo), "+v"(hi)); am = fmaxf(lo, hi); }
                { float lo = am, hi = am; asm volatile("v_nop\n\tv_nop\n\tv_permlane32_swap_b32 %0, %1" : "+v"(lo), "+v"(hi)); am = fmaxf(lo, hi); }
                if (fq == 0) __hip_atomic_fetch_max(rmax + r, cvt_pk_bf16(am, am) << 16, __ATOMIC_RELAXED, __HIP_MEMORY_SCOPE_AGENT); }
    }
};
template <class Epi, class Sched, bool ALIGN_EPI = false, bool SP2 = false, bool I8 = false, int KREP = 1, int EREP = 1, bool TM = false, int TCH = 0, int LT = 0>
__device__ __forceinline__ void gemm_phase(PG8_LAS unsigned char* lds, const Gemm g, const Sched& S, const Epi& E) {
    const int tid = threadIdx.x, wid = __builtin_amdgcn_readfirstlane(tid >> 6), lane = tid & 63, wr = wid >> 2, wc = wid & 3, fr = lane & 15, fq = lane >> 4;
    const int K = g.K, nt = K / BK;
    unsigned voffA[2], voffB[2];
#pragma unroll
    for (int i = 0; i < 2; ++i) { int R, C; stage_rc(tid * 16 + i * 8192, R, C); const int Rb = Epi::PERM ? ((R & ~31) + perm32(R & 31)) : R;
        voffA[i] = TM ? (unsigned)(tid * 16 + i * 8192) : (unsigned)(R * K + C) * 2u; voffB[i] = TM ? (unsigned)(tid * 16 + i * 8192) : (unsigned)(Rb * K + C) * 2u; }
    const size_t kstep = TM ? (size_t)32768 : (size_t)(BK * 2);
    const size_t hstep = TM ? (size_t)16384 : (size_t)HALF * K * 2;
    const size_t tstep = TM ? (size_t)nt * 32768 : 2 * hstep;
    const unsigned ldsw = (unsigned)wid * 1024u;
    const int aoff = lds_byte(wr * 64 + fr, fq * 8), boff = lds_byte(wc * 32 + fr, fq * 8);
#define PG8_SA(b, h) (((b) * 2 + (h)) * HTB)
#define PG8_SB(b, h) ((4 + (b) * 2 + (h)) * HTB)
#define PG8_STAGE(bufoff, gbase, voff) do { _Pragma("unroll") for (int _i = 0; _i < 2; ++_i) \
        __builtin_amdgcn_global_load_lds((const unsigned*)((const char*)(gbase) + (voff)[_i]), (PG8_LAS unsigned*)(lds + (bufoff) + ldsw + _i * 8192), 16, 0, 0); } while (0)
#ifndef MK_B_NT
#define MK_B_NT 0
#endif
#define PG8_STAGEB(bufoff, gbase, voff) do { _Pragma("unroll") for (int _i = 0; _i < 2; ++_i) \
        __builtin_amdgcn_global_load_lds((const unsigned*)((const char*)(gbase) + (voff)[_i]), (PG8_LAS unsigned*)(lds + (bufoff) + ldsw + _i * 8192), 16, 0, MK_B_NT ? 2 : 0); } while (0)
#define PG8_LDA(dst, b, h) do { _Pragma("unroll") for (int m = 0; m < 4; ++m) _Pragma("unroll") for (int k = 0; k < 2; ++k) dst[m][k] = *(const PG8_LAS bf16x8*)(lds + PG8_SA(b, h) + aoff + m * 2048 + k * 1024); } while (0)
#define PG8_LDB(dst, b, h) do { _Pragma("unroll") for (int n = 0; n < 2; ++n) _Pragma("unroll") for (int k = 0; k < 2; ++k) dst[n][k] = *(const PG8_LAS bf16x8*)(lds + PG8_SB(b, h) + boff + n * 2048 + k * 1024); } while (0)
#ifndef PG8_PRIO
#define PG8_PRIO 1
#endif
#define PG8_MMA(ai, bj, At, Bt) do { if (PG8_PRIO) __builtin_amdgcn_s_setprio(PG8_PRIO); _Pragma("unroll") for (int m = 0; m < 4; ++m) _Pragma("unroll") for (int n = 0; n < 2; ++n) _Pragma("unroll") for (int k = 0; k < 2; ++k) \
        acc[ai][bj][m][n] = mma16(Bt[n][k], At[m][k], acc[ai][bj][m][n]); if (PG8_PRIO) __builtin_amdgcn_s_setprio(0); } while (0)
#define PG8_WAIT_V(n) asm volatile("s_waitcnt vmcnt(" #n ")" ::: "memory")
#define PG8_WAIT_L(n) asm volatile("s_waitcnt lgkmcnt(" #n ")" ::: "memory")
#define PG8_BAR __builtin_amdgcn_s_barrier()
#define PG8_SCHED __builtin_amdgcn_sched_barrier(0)
#define PG8_TOUCH(uidx) do { if constexpr (TCH > 0) { Unit tu_; if (S.next((uidx), tu_)) { const char* tb_ = (const char*)g.Bt + (size_t)tu_.pn * tstep; const unsigned sh_ = (unsigned)cur.pm & 63u; \
        for (int l_ = tid; l_ < nt * 4; l_ += 512) { const size_t o_ = TM ? ((size_t)sh_ * (size_t)(nt * 512) + (size_t)l_ * 128) : ((size_t)(4 * sh_ + l_ / nt) * (size_t)(nt * 128) + (size_t)(l_ % nt) * 128); \
            __builtin_amdgcn_global_load_lds((const unsigned*)(tb_ + o_), (PG8_LAS unsigned*)(lds + STAGE_BYTES + wid * 256), 4, 0, 0); } } } } while (0)
    const unsigned ltoff = (lane < 8) ? (unsigned)(wid * 1024 + lane * 128) : (unsigned)(wid * 512 + (lane - 8) * 128);
#define PG8_LTOUCH(abase, bbase) do { if constexpr (LT > 0) { if (lane < 12) { const char* tp_ = (lane < 8) ? ((abase) + ltA) : ((bbase) + ltB); \
        __builtin_amdgcn_global_load_lds((const unsigned*)(tp_ + ltoff), (PG8_LAS unsigned*)(lds + STAGE_BYTES + wid * 256), 4, 0, 0); } } } while (0)
#define PG8_WAIT_VS() do { if constexpr (LT > 0) PG8_WAIT_V(9); else PG8_WAIT_V(8); } while (0)
    Unit cur, nxt; int ui = 0;
    unsigned utab_; { Unit tu_; utab_ = S.next(lane, tu_) ? (((unsigned)tu_.pm << 16) | (unsigned)tu_.pn) : 0xffffffffu; }
#define PG8_NEXT(i_, u_) ([&]() -> bool { if ((i_) >= 64) return false; const unsigned p_ = (unsigned)__builtin_amdgcn_readlane((int)utab_, (i_)); if (p_ == 0xffffffffu) return false; (u_).pm = (int)(p_ >> 16); (u_).pn = (int)(p_ & 0xffffu); return true; }())
    if (!PG8_NEXT(0, cur)) return;
    PG8_LAS float* const lsc = (PG8_LAS float*)(lds + 139264);
#define PG8_SCALE_DMA(uu, slot) do { if constexpr (Epi::LDS_SCALES) { const float* sp_ = E.scale_src((uu), wid * 64 + lane); \
        __builtin_amdgcn_global_load_lds((const unsigned*)sp_, (PG8_LAS unsigned*)(lsc + (slot) * 640 + wid * 64), 4, 0, 0); \
        if constexpr (Epi::LDS_EXTRA) { if (wid == 0) __builtin_amdgcn_global_load_lds((const unsigned*)E.extra_src((uu), lane), (PG8_LAS unsigned*)(lsc + (slot) * 640 + 512), 4, 0, 0); } } } while (0)
    PG8_SCALE_DMA(cur, 0);
    typedef typename AccT<I8>::type acc_t;
    acc_t acc[2][2][4][2];
#pragma unroll
    for (int a = 0; a < 2; ++a)
#pragma unroll
        for (int b = 0; b < 2; ++b)
#pragma unroll
            for (int m = 0; m < 4; ++m)
#pragma unroll
                for (int n = 0; n < 2; ++n) acc[a][b][m][n] = AccT<I8>::zero();
    bf16x8 At[4][2], B0[2][2], B1[2][2];
    const char* cA = (const char*)g.A + (size_t)cur.pm * tstep; const char* cB = (const char*)g.Bt + (size_t)cur.pn * tstep;
    unsigned ltA = (unsigned)(cur.pn & 3) * 8192u, ltB = (unsigned)(cur.pm & 7) * 4096u;
    S.a_ready(cur);
    if constexpr (TCH > 0) { PG8_TOUCH(1); if constexpr (TCH > 1) PG8_TOUCH(2); }
    if constexpr (SP2) {
        PG8_STAGEB(PG8_SB(0, 0), cB, voffB); PG8_STAGEB(PG8_SB(0, 1), cB + hstep, voffB); PG8_STAGE(PG8_SA(0, 0), cA, voffA); PG8_STAGE(PG8_SA(0, 1), cA + hstep, voffA);
        if (wr == 1) PG8_BAR;
        PG8_WAIT_V(2); PG8_BAR;
        PG8_STAGEB(PG8_SB(1, 0), cB + kstep, voffB); PG8_STAGE(PG8_SA(1, 0), cA + kstep, voffA); PG8_STAGEB(PG8_SB(1, 1), cB + hstep + kstep, voffB);
        PG8_WAIT_V(6); PG8_BAR;
    } else {
        PG8_STAGEB(PG8_SB(0, 0), cB, voffB); PG8_STAGE(PG8_SA(0, 0), cA, voffA); PG8_STAGEB(PG8_SB(0, 1), cB + hstep, voffB); PG8_STAGE(PG8_SA(0, 1), cA + hstep, voffA);
        if (wr == 1) PG8_BAR;
        PG8_WAIT_V(4); PG8_BAR;
        PG8_STAGEB(PG8_SB(1, 0), cB + kstep, voffB); PG8_STAGE(PG8_SA(1, 0), cA + kstep, voffA); PG8_STAGEB(PG8_SB(1, 1), cB + hstep + kstep, voffB);
        PG8_WAIT_V(6); PG8_BAR;
    }
    for (;;) {
        const bool has_next = PG8_NEXT(ui + 1, nxt);
        const char* nA = has_next ? (const char*)g.A + (size_t)nxt.pm * tstep : cA; const char* nB = has_next ? (const char*)g.Bt + (size_t)nxt.pn * tstep : cB;
        for (int krep = 0; krep < KREP; ++krep) {
        if (KREP > 1 && krep == KREP - 1 && krep > 0) {
_Pragma("unroll") for (int a = 0; a < 2; ++a) _Pragma("unroll") for (int b = 0; b < 2; ++b) _Pragma("unroll") for (int m = 0; m < 4; ++m) _Pragma("unroll") for (int n = 0; n < 2; ++n) acc[a][b][m][n] = AccT<I8>::zero(); }
        const char* nA2 = (krep == KREP - 1) ? nA : cA; const char* nB2 = (krep == KREP - 1) ? nB : cB;
        for (int t = 0; t < nt; t += 2) {
            const bool last = (t == nt - 2);
            const char* a1 = cA + (size_t)(t + 1) * kstep;
            const char* a2 = last ? nA2 : cA + (size_t)(t + 2) * kstep; const char* b2 = last ? nB2 : cB + (size_t)(t + 2) * kstep;
            const char* a3 = a2 + kstep; const char* b3 = b2 + kstep;
            const char *ta0 = cA, *tb0 = cB, *ta1 = cA, *tb1 = cB;
            if constexpr (LT > 0) { const int q0 = t + LT, q1 = t + 1 + LT;
                if (q0 < nt) { ta0 = cA + (size_t)q0 * kstep; tb0 = cB + (size_t)q0 * kstep; } else if (krep == KREP - 1 && has_next && q0 - nt < nt) { ta0 = nA + (size_t)(q0 - nt) * kstep; tb0 = nB + (size_t)(q0 - nt) * kstep; }
                if (q1 < nt) { ta1 = cA + (size_t)q1 * kstep; tb1 = cB + (size_t)q1 * kstep; } else if (krep == KREP - 1 && has_next && q1 - nt < nt) { ta1 = nA + (size_t)(q1 - nt) * kstep; tb1 = nB + (size_t)(q1 - nt) * kstep; } }
            if (last && has_next && krep == KREP - 1) S.a_ready(nxt);
            if constexpr (SP2) {
            PG8_LDB(B0, 0, 0); PG8_LDB(B1, 0, 1); PG8_SCHED; PG8_LDA(At, 0, 0); PG8_STAGE(PG8_SA(1, 1), a1 + hstep, voffA);
            PG8_WAIT_VS(); PG8_WAIT_L(0); PG8_BAR; PG8_MMA(0, 0, At, B0); PG8_MMA(0, 1, At, B1); PG8_BAR; PG8_SCHED;
            PG8_LDA(At, 0, 1); PG8_LTOUCH(ta0, tb0); PG8_STAGEB(PG8_SB(0, 0), b2, voffB); PG8_STAGEB(PG8_SB(0, 1), b2 + hstep, voffB); PG8_STAGE(PG8_SA(0, 0), a2, voffA);
            PG8_WAIT_VS(); PG8_WAIT_L(0); PG8_BAR; PG8_MMA(1, 0, At, B0); PG8_MMA(1, 1, At, B1); PG8_BAR; PG8_SCHED;
            PG8_LDB(B0, 1, 0); PG8_LDB(B1, 1, 1); PG8_SCHED; PG8_LDA(At, 1, 0); PG8_STAGE(PG8_SA(0, 1), a2 + hstep, voffA);
            PG8_WAIT_VS(); PG8_WAIT_L(0); PG8_BAR; PG8_MMA(0, 0, At, B0); PG8_MMA(0, 1, At, B1); PG8_BAR; PG8_SCHED;
            PG8_LDA(At, 1, 1); PG8_LTOUCH(ta1, tb1); PG8_STAGEB(PG8_SB(1, 0), b3, voffB); PG8_STAGEB(PG8_SB(1, 1), b3 + hstep, voffB); PG8_STAGE(PG8_SA(1, 0), a3, voffA);
            PG8_WAIT_VS(); PG8_WAIT_L(0); PG8_BAR; PG8_MMA(1, 0, At, B0); PG8_MMA(1, 1, At, B1); PG8_BAR; PG8_SCHED;
            } else {
            PG8_LDB(B0, 0, 0); PG8_SCHED; PG8_LDA(At, 0, 0); PG8_STAGE(PG8_SA(1, 1), a1 + hstep, voffA);
            PG8_WAIT_L(8); PG8_BAR; PG8_WAIT_L(0); PG8_MMA(0, 0, At, B0); PG8_BAR; PG8_SCHED;
            PG8_LDB(B1, 0, 1); PG8_STAGEB(PG8_SB(0, 0), b2, voffB);
            PG8_BAR; PG8_WAIT_L(0); PG8_MMA(0, 1, At, B1); PG8_BAR;
            PG8_LDA(At, 0, 1); PG8_STAGE(PG8_SA(0, 0), a2, voffA);
            PG8_BAR; PG8_WAIT_L(0); PG8_MMA(1, 0, At, B0); PG8_BAR; PG8_SCHED;
            PG8_STAGEB(PG8_SB(0, 1), b2 + hstep, voffB);
            PG8_WAIT_V(6); PG8_BAR; PG8_MMA(1, 1, At, B1); PG8_BAR;
            PG8_LDB(B0, 1, 0); PG8_SCHED; PG8_LDA(At, 1, 0); PG8_STAGE(PG8_SA(0, 1), a2 + hstep, voffA);
            PG8_WAIT_L(8); PG8_BAR; PG8_WAIT_L(0); PG8_MMA(0, 0, At, B0); PG8_BAR; PG8_SCHED;
            PG8_LDB(B1, 1, 1); PG8_STAGEB(PG8_SB(1, 0), b3, voffB);
            PG8_BAR; PG8_WAIT_L(0); PG8_MMA(0, 1, At, B1); PG8_BAR;
            PG8_LDA(At, 1, 1); PG8_STAGE(PG8_SA(1, 0), a3, voffA);
            PG8_BAR; PG8_WAIT_L(0); PG8_MMA(1, 0, At, B0); PG8_BAR; PG8_SCHED;
            PG8_STAGEB(PG8_SB(1, 1), b3 + hstep, voffB);
            PG8_WAIT_V(6); PG8_BAR; PG8_MMA(1, 1, At, B1); PG8_BAR;
            }
        }
        }
        if constexpr (ALIGN_EPI) { if (wr == 0) PG8_BAR; }
        if constexpr (Epi::LDS_SCALES) { E(acc, cur, wr, wc, fr, fq, lsc + (ui & 1) * 640); S.done(cur); if (has_next) PG8_SCALE_DMA(nxt, (ui + 1) & 1); } else
        if constexpr (!Epi::AFTER_DRAIN) { E(acc, cur, wr, wc, fr, fq); if constexpr (EREP > 1) { asm volatile("" ::: "memory"); E.alt()(acc, cur, wr, wc, fr, fq); } S.done(cur); PG8_TOUCH(ui + 1 + TCH); }
        if (!has_next) break;
#pragma unroll
        for (int a = 0; a < 2; ++a)
#pragma unroll
            for (int b = 0; b < 2; ++b)
#pragma unroll
                for (int m = 0; m < 4; ++m)
#pragma unroll
                    for (int n = 0; n < 2; ++n) acc[a][b][m][n] = AccT<I8>::zero();
        cur = nxt; cA = nA; cB = nB; ++ui; ltA = (unsigned)(cur.pn & 3) * 8192u; ltB = (unsigned)(cur.pm & 7) * 4096u;
        if constexpr (ALIGN_EPI) { if (wr == 1) PG8_BAR; }
    }
    PG8_WAIT_V(0);
    if constexpr (!ALIGN_EPI) { if (wr == 0) PG8_BAR; }
    PG8_BAR;
    if constexpr (Epi::AFTER_DRAIN) { E.fused(acc, cur, wr, wc, fr, fq, lds, wid, lane); S.done(cur); }
#undef PG8_TOUCH
#undef PG8_LTOUCH
#undef PG8_WAIT_VS
#undef PG8_SA
#undef PG8_SB
#undef PG8_STAGE
#undef PG8_LDA
#undef PG8_LDB
#undef PG8_MMA
#undef PG8_WAIT_V
#undef PG8_WAIT_L
#undef PG8_BAR
#undef PG8_SCHED
}
}
#ifndef PG8_SP2
#define PG8_SP2 true
#endif
#ifndef PG8_ALIGN
#define PG8_ALIGN true
#endif
constexpr int NWAVES = 8;
#ifndef MK_N_LAUNCHES
#define MK_N_LAUNCHES 1
#endif
#ifndef MK_HGRN_MFMA
#define MK_HGRN_MFMA 1
#endif
#ifndef MK_ATTN_MFMA
#define MK_ATTN_MFMA 1
#endif
constexpr bool HGRN_MFMA = MK_HGRN_MFMA, ATTN_MFMA = MK_ATTN_MFMA;
#ifndef MK_REP_GEMM
#define MK_REP_GEMM 1
#endif
#ifndef MK_REP_P0
#define MK_REP_P0 1
#endif
#ifndef MK_REP_ATT
#define MK_REP_ATT 1
#endif
#ifndef MK_REP_HG
#define MK_REP_HG 1
#endif
#ifndef MK_REP_NORM
#define MK_REP_NORM 1
#endif
constexpr int REP_GEMM = MK_REP_GEMM, REP_P0 = MK_REP_P0, REP_ATT = MK_REP_ATT, REP_HG = MK_REP_HG, REP_NORM = MK_REP_NORM;
#ifndef MK_FFN_I8
#define MK_FFN_I8 1
#endif
static_assert(MK_FFN_I8 == 1, "the workspace map overlays ACT on the bf16 FFN-in weight copies: int8 FFN path only");
#ifndef MK_HG_I8
#define MK_HG_I8 1
#endif
constexpr bool HG_I8 = MK_HG_I8;
#ifndef MK_ATT_I8
#define MK_ATT_I8 0
#endif
constexpr bool ATT_I8 = MK_ATT_I8;
constexpr bool FFN_I8 = MK_FFN_I8;
#ifndef MK_KREP_FFI
#define MK_KREP_FFI 1
#endif
#ifndef MK_EREP_FFI
#define MK_EREP_FFI 1
#endif
constexpr int EREP_FFI = MK_EREP_FFI;
#ifndef MK_REP_FFI
#define MK_REP_FFI 1
#endif
constexpr int REP_FFI = MK_REP_FFI;
constexpr int KREP_FFI = MK_KREP_FFI;
#ifndef MK_TM_FFI
#define MK_TM_FFI 1
#endif
constexpr bool TM_FFI = MK_TM_FFI;
#ifndef MK_TCH_FFI
#define MK_TCH_FFI 0
#endif
#ifndef MK_TCH_ALL
#define MK_TCH_ALL 0
#endif
constexpr int TCH_FFI = MK_TCH_FFI, TCH_ALL = MK_TCH_ALL;
#ifndef MK_LT_FFI
#define MK_LT_FFI 0
#endif
constexpr int LT_FFI = MK_LT_FFI;
#ifndef MK_HG_FUSE
#define MK_HG_FUSE 2
#endif
constexpr int HG_FUSE = MK_HG_FUSE;
#ifndef MK_REP_P8
#define MK_REP_P8 1
#endif
constexpr int REP_P8 = MK_REP_P8;
#ifndef MK_FFO_I8
#define MK_FFO_I8 1
#endif
#ifndef MK_FFO_ROT
#define MK_FFO_ROT 1
#endif
constexpr bool FFO_I8 = MK_FFO_I8;
#ifndef MK_REP_BAR
#define MK_REP_BAR 0
#endif
constexpr int REP_BAR = MK_REP_BAR;
#ifndef MK_NT_W
#define MK_NT_W 0
#endif
#if MK_NT_W
#define MK_LD_W(p) __builtin_nontemporal_load(p)
#else
#define MK_LD_W(p) (*(p))
#endif
#ifndef MK_P0_OVL
#define MK_P0_OVL 0
#endif
constexpr bool P0_OVL = MK_P0_OVL;
#ifndef MK_QKV_HM
#define MK_QKV_HM 1
#endif
constexpr bool QKV_HM = MK_QKV_HM;
#ifndef MK_P0_STRIP
#define MK_P0_STRIP 1
#endif
constexpr bool P0_STRIP = MK_P0_STRIP;
#ifndef MK_HGO_I8
#define MK_HGO_I8 1
#endif
constexpr bool HGO_I8 = MK_HGO_I8;
constexpr int NPH = 16;
constexpr int N_LAUNCHES = MK_N_LAUNCHES;
static_assert(N_LAUNCHES == 1 || N_LAUNCHES == NPH, "MK_N_LAUNCHES is 1 or NPH");

constexpr int BATCH = 2, SEQ = 8192, DM = 4096, M = BATCH * SEQ, DFF = 11008, NQKV = 18432, NHG = 16384, DATT = 2048, HD = 128;
constexpr float RMS_EPS = 1e-6f;
constexpr float QSCALE = 0.08838834764831845f;

constexpr size_t MiB = 1u << 20;
constexpr size_t WS_CTL = 0, CTL_ZERO_BYTES = 1 * MiB;
constexpr size_t WS_TAB = 1 * MiB;
constexpr size_t WS_WATTI = 2 * MiB, WS_WATTO = 146 * MiB, WS_WHGI = 162 * MiB, WS_WHGO = 290 * MiB;
constexpr size_t WS_WFFI = 322 * MiB, WFFI_STRIDE = 172 * MiB, WS_WFFO = 666 * MiB, WFFO_STRIDE = 86 * MiB;
constexpr size_t WS_XN = 838 * MiB;
constexpr size_t WS_Y = 966 * MiB;
constexpr size_t WS_ACT = 322 * MiB;
constexpr size_t WS_ACT_OLD = 1222 * MiB;
constexpr size_t WS_QKV = 1566 * MiB;
constexpr size_t WS_MRG = 2142 * MiB;
constexpr size_t WS_OG = 2206 * MiB;
constexpr size_t WS_END = 2334 * MiB;
constexpr size_t WS_SA = WS_TAB + 128 * 1024, WS_SW = WS_TAB + 256 * 1024;
constexpr size_t WS_W8 = 1222 * MiB, W8_STRIDE = 86 * MiB, WS_W8H = 1394 * MiB, WS_END3 = 2529 * MiB;
constexpr size_t WS_SWH = WS_SW + 4 * 2 * 2 * DFF, WS_SWA = WS_SWH + 4 * NHG, WS_W8A = 1458 * MiB;
static_assert(WS_W8A + (size_t)NQKV * DM <= WS_QKV && WS_SWA + 4 * NQKV <= WS_WATTI, "int8 maps");
constexpr size_t WS_HB = 2529 * MiB, WS_END4 = 2657 * MiB;
constexpr size_t WS_W8O = 2657 * MiB, W8O_STRIDE = 43 * MiB, WS_END5 = 2743 * MiB, WS_SWO = WS_TAB + 640 * 1024, WS_SA2 = WS_TAB + 704 * 1024, WS_ACT8 = WS_QKV, WS_RMAX = WS_CTL + 512 * 1024;
constexpr size_t WS_W8G = 1530 * MiB, WS_SWG = WS_TAB + 768 * 1024, WS_SA3 = WS_TAB + 800 * 1024;
static_assert(WS_W8G + (size_t)DM * DM <= WS_QKV && WS_SA3 + 4 * M <= WS_WATTI, "HGO_I8 maps");
constexpr int CW_TMO = 0, CW_CODE = 1;
constexpr int CW_BAR = 4096;
constexpr int RING_OFF = 0, RING_BYTES = 131072;
constexpr int LDSCTL_OFF = 150528, MISC_OFF = LDSCTL_OFF + 320;
constexpr int LDS_BYTES = 152576;
static_assert(MISC_OFF + 128 <= LDS_BYTES, "LDS map");

#define GAS __attribute__((address_space(1)))
#define LAS __attribute__((address_space(3)))
typedef unsigned short bf16;
typedef unsigned v4u __attribute__((ext_vector_type(4)));
typedef unsigned v2u __attribute__((ext_vector_type(2)));
typedef float f32x4 __attribute__((ext_vector_type(4)));
typedef short bf16x8 __attribute__((ext_vector_type(8)));
typedef GAS unsigned gu32;
typedef GAS unsigned long long gu64;
#define RLX_AGENT __ATOMIC_RELAXED, __HIP_MEMORY_SCOPE_AGENT
#define LDS_WAIT() asm volatile("s_waitcnt lgkmcnt(0)" ::: "memory")
#define VM_WAIT() asm volatile("s_waitcnt vmcnt(0)" ::: "memory")
__device__ __forceinline__ unsigned f2bf(float f) { unsigned u = __builtin_bit_cast(unsigned, f); return (u + 0x7fffu + ((u >> 16) & 1u)) >> 16; }
__device__ __forceinline__ unsigned pk2(float lo, float hi) { return f2bf(lo) | (f2bf(hi) << 16); }
__device__ __forceinline__ unsigned cvtpk(float lo, float hi) { return pg8::cvt_pk_bf16(lo, hi); }
__device__ __forceinline__ float bflo(unsigned w) { return __builtin_bit_cast(float, w << 16); }
__device__ __forceinline__ float bfhi(unsigned w) { return __builtin_bit_cast(float, w & 0xffff0000u); }
#define XB_TMO      128
#define XB_XCNT(j)  (256  + 64 * (j))
#define XB_XSUB(j)  (1280 + 64 * (j))
#define XB_XGEN(j)  (2304 + 64 * (j))
#define XB_TOP      3328
#define XB_TOPGEN   3392
#define XCD_BAR_WORDS 3456
#define XB_SPIN_CAP (1u << 18)

__device__ __forceinline__ unsigned xb_ld(unsigned* p)              { return __hip_atomic_load(p, __ATOMIC_RELAXED, __HIP_MEMORY_SCOPE_AGENT); }
__device__ __forceinline__ unsigned xb_add(unsigned* p, unsigned v) { return __hip_atomic_fetch_add(p, v, __ATOMIC_RELAXED, __HIP_MEMORY_SCOPE_AGENT); }
__device__ __forceinline__ unsigned xb_xcc_id() { return (unsigned)__builtin_amdgcn_s_getreg((3 << 11) | 20) & 0xFu; }
#define XB_SPIN(cond, bar) do { unsigned _sp = 0; while (cond) { __builtin_amdgcn_s_sleep(1); \
    if ((++_sp & 255u) == 0u) { if (xb_ld(&(bar)[XB_TMO])) break; if (_sp > XB_SPIN_CAP) { atomicAdd(&(bar)[XB_TMO], 1u); break; } } } } while (0)

struct XcdBarrier {
    unsigned* bar; unsigned x;
    volatile LAS unsigned* st;
};

__device__ __forceinline__ XcdBarrier xcd_barrier_post(unsigned* bar, volatile LAS unsigned* st) {
    XcdBarrier b; b.bar = bar; b.x = xb_xcc_id(); b.st = st;
    if (threadIdx.x == 0) (void)xb_add(&bar[XB_XCNT(b.x)], 1u);
    return b;
}
__device__ __forceinline__ void xcd_barrier_complete(unsigned* bar, unsigned x, unsigned& nloc, unsigned& nx) {
    const unsigned G = gridDim.x * gridDim.y * gridDim.z;
    unsigned sum, cnt, mine, sp = 0u;
    for (;;) {
        sum = 0u; cnt = 0u; mine = 0u;
#pragma unroll
        for (unsigned j = 0; j < 16; ++j) { const unsigned c = xb_ld(&bar[XB_XCNT(j)]); sum += c; cnt += (c > 0u) ? 1u : 0u; mine = (j == x) ? c : mine; }
        if (sum == G) break;
        __builtin_amdgcn_s_sleep(1);
        if ((++sp & 255u) == 0u) { if (xb_ld(&bar[XB_TMO])) break; if (sp > XB_SPIN_CAP) { atomicAdd(&bar[XB_TMO], 1u); break; } }
    }
    nloc = mine > 0u ? mine : 1u; nx = cnt > 0u ? cnt : 1u;
}

__device__ __forceinline__ void xcd_barrier(const XcdBarrier& b) {
    asm volatile("s_waitcnt vmcnt(0)" ::: "memory");
    __syncthreads();
    if (threadIdx.x == 0) {
        unsigned* bar = b.bar;
        __builtin_amdgcn_s_waitcnt(0);
        unsigned nloc = b.st[0], nx = b.st[1];
        if (nloc == 0u) { xcd_barrier_complete(bar, b.x, nloc, nx); b.st[0] = nloc; b.st[1] = nx; }
        const unsigned old = xb_add(&bar[XB_XSUB(b.x)], 1u);
        const unsigned gen = old / nloc;
        if (old + 1u == (gen + 1u) * nloc) {
            __builtin_amdgcn_fence(__ATOMIC_RELEASE, "agent");
            asm volatile("s_waitcnt vmcnt(0)" ::: "memory");
            const unsigned og = xb_add(&bar[XB_TOP], 1u);
            const unsigned tg = og / nx;
            if (og + 1u == (tg + 1u) * nx) xb_add(&bar[XB_TOPGEN], 1u);
            else XB_SPIN(xb_ld(&bar[XB_TOPGEN]) == tg, bar);
            __builtin_amdgcn_fence(__ATOMIC_ACQUIRE, "agent");
            xb_add(&bar[XB_XGEN(b.x)], 1u);
            asm volatile("s_waitcnt vmcnt(0)" ::: "memory");
        } else {
            XB_SPIN(xb_ld(&bar[XB_XGEN(b.x)]) == gen, bar);
            __builtin_amdgcn_fence(__ATOMIC_ACQUIRE, "agent");
            asm volatile("s_waitcnt vmcnt(0)" ::: "memory");
        }
    }
    __syncthreads();
}
struct Frame {
    LAS unsigned char* lds;
    volatile LAS unsigned* MISC;
    gu32* ctl;
    int tid, lane, wave;
    int vcu, G;
    const float *x, *gains, *rel_bias, *w_att_in, *w_att_out, *w_hg_in, *lb_logits, *hg_gain, *w_hg_out, *w_ff_in, *w_ff_out;
    float* out;
    unsigned char* ws;
};
#define XL_DPP(x, ctrl) __builtin_bit_cast(float, __builtin_amdgcn_update_dpp(0, __builtin_bit_cast(int, (x)), (ctrl), 0xf, 0xf, true))
#define XL_SWAP(op, v) do { float lo_ = (v), hi_ = (v); asm volatile("v_nop\n\tv_nop\n\t" op " %0, %1" : "+v"(lo_), "+v"(hi_)); a_ = lo_; b_ = hi_; } while (0)
__device__ __forceinline__ float xl16_sum(float v) { float a_, b_; XL_SWAP("v_permlane16_swap_b32", v); return a_ + b_; }
__device__ __forceinline__ float xl32_sum(float v) { float a_, b_; XL_SWAP("v_permlane32_swap_b32", v); return a_ + b_; }
__device__ __forceinline__ float xl16_max(float v) { float a_, b_; XL_SWAP("v_permlane16_swap_b32", v); return fmaxf(a_, b_); }
__device__ __forceinline__ float xl32_max(float v) { float a_, b_; XL_SWAP("v_permlane32_swap_b32", v); return fmaxf(a_, b_); }
__device__ __forceinline__ float row16_sum(float v) { v += XL_DPP(v, 0xB1); v += XL_DPP(v, 0x4E); v += XL_DPP(v, 0x141); v += XL_DPP(v, 0x140); return v; }
__device__ __forceinline__ float row16_max(float v) { v = fmaxf(v, XL_DPP(v, 0xB1)); v = fmaxf(v, XL_DPP(v, 0x4E)); v = fmaxf(v, XL_DPP(v, 0x141)); v = fmaxf(v, XL_DPP(v, 0x140)); return v; }
__device__ __forceinline__ float half32_sum(float v) { return xl16_sum(row16_sum(v)); }
__device__ __forceinline__ float wave_sum(float v) { return xl32_sum(xl16_sum(row16_sum(v))); }
__device__ __forceinline__ float wave_max(float v) { return xl32_max(xl16_max(row16_max(v))); }
__device__ __forceinline__ void p0_transpose_item(const float* W, int K, int N, bf16* WT, int mode, LAS float* scr, int item, int lane) {
    const int nblk = N / 32, kb = item / nblk, nb = item % nblk, k0 = 64 * kb, n0 = 32 * nb;
    int r0 = n0;
    if (mode == 1) { const int c = (n0 < DFF) ? n0 : n0 - DFF; r0 = 256 * (c >> 7) + (c & 127) + ((n0 < DFF) ? 0 : 128); }
#pragma unroll
    for (int i = 0; i < 32; ++i) { const int kk = 2 * i + (lane >> 5); scr[kk * 33 + (lane & 31)] = MK_LD_W(W + (size_t)(k0 + kk) * N + n0 + (lane & 31)); }
    LDS_WAIT(); asm volatile("" ::: "memory");
    const int c = lane & 7;
#pragma unroll
    for (int j = 0; j < 4; ++j) { const int n = (lane >> 3) + 8 * j; const LAS float* s = scr + (8 * c) * 33 + n;
        v4u o; o.x = pk2(s[0 * 33], s[1 * 33]); o.y = pk2(s[2 * 33], s[3 * 33]); o.z = pk2(s[4 * 33], s[5 * 33]); o.w = pk2(s[6 * 33], s[7 * 33]);
        int row = r0 + n;
        if (mode == 2) { const int col = n0 + n, s = col >> 12, cc = col & 4095, c64 = cc & 63; row = 256 * (cc >> 6) + 128 * (s >> 1) + 32 * (c64 >> 4) + 8 * ((c64 >> 2) & 3) + 4 * (s & 1) + (c64 & 3); }
        *(GAS v4u*)(WT + (size_t)row * K + k0 + 8 * c) = o; }
    LDS_WAIT(); asm volatile("" ::: "memory");
}
__device__ __forceinline__ int t5_bucket(int dist) {
    if (dist < 16) return dist;
    int large = 16 + (int)(log((double)dist / 16.0) / log(128.0) * 16.0);
    return large < 31 ? large : 31;
}
template <bool HAS_Y, int XNM, bool HIB = false, bool HOB = false>
__device__ __forceinline__ void norm_rows(Frame& F, const void* hin, const bf16* y, void* hout, bf16* xn, const float* ga, const float* gb, float* sa = nullptr) {
    const int gw = F.vcu * NWAVES + F.wave, NGW = F.G * NWAVES;
    LAS f32x4* const lga = (LAS f32x4*)(F.lds + RING_OFF); LAS f32x4* const lgb = lga + DM / 4;
    __syncthreads();
    if (HAS_Y) for (int i = F.tid; i < DM / 4; i += NWAVES * 64) lga[i] = ((const GAS f32x4*)ga)[i];
    if (XNM != 0) for (int i = F.tid; i < DM / 4; i += NWAVES * 64) lgb[i] = ((const GAS f32x4*)gb)[i];
    __syncthreads();
    v2u hb[HIB ? 16 : 1]; v2u yb[HAS_Y ? 16 : 1]; f32x4 hf[(!HIB && !HAS_Y) ? 16 : 1]; (void)hb; (void)yb; (void)hf;
    if (gw < M) {
        if constexpr (!HIB && !HAS_Y) { const GAS f32x4* hr = (const GAS f32x4*)((const float*)hin + (size_t)gw * DM) + F.lane;
#pragma unroll
            for (int j = 0; j < 16; ++j) hf[j] = hr[64 * j]; }
        if constexpr (HIB) { const GAS v2u* hr = (const GAS v2u*)((const bf16*)hin + (size_t)gw * DM) + F.lane;
#pragma unroll
            for (int j = 0; j < 16; ++j) hb[j] = hr[64 * j]; }
        if constexpr (HAS_Y) { const GAS v2u* yr = (const GAS v2u*)(y + (size_t)gw * DM) + F.lane;
#pragma unroll
            for (int j = 0; j < 16; ++j) yb[j] = yr[64 * j]; }
    }
    for (int m = gw; m < M; m += NGW) {
        const int mn = (m + NGW < M) ? m + NGW : m;
        f32x4 h[16];
        if constexpr (HIB) {
#pragma unroll
            for (int j = 0; j < 16; ++j) { const v2u hw = hb[j]; h[j] = (f32x4){bflo(hw.x), bfhi(hw.x), bflo(hw.y), bfhi(hw.y)}; }
            const GAS v2u* hr = (const GAS v2u*)((const bf16*)hin + (size_t)mn * DM) + F.lane;
#pragma unroll
            for (int j = 0; j < 16; ++j) hb[j] = hr[64 * j];
        } else if constexpr (!HAS_Y) {
#pragma unroll
            for (int j = 0; j < 16; ++j) h[j] = hf[j];
            const GAS f32x4* hr = (const GAS f32x4*)((const float*)hin + (size_t)mn * DM) + F.lane;
#pragma unroll
            for (int j = 0; j < 16; ++j) hf[j] = hr[64 * j];
        } else { const GAS f32x4* hr = (const GAS f32x4*)((const float*)hin + (size_t)m * DM) + F.lane;
#pragma unroll
            for (int j = 0; j < 16; ++j) h[j] = hr[64 * j]; }
        if constexpr (HAS_Y) {
            float ss = 0.f;
#pragma unroll
            for (int j = 0; j < 16; ++j) { const v2u yw = yb[j]; const f32x4 yv = (f32x4){bflo(yw.x), bfhi(yw.x), bflo(yw.y), bfhi(yw.y)}; ss += (yv.x * yv.x + yv.y * yv.y) + (yv.z * yv.z + yv.w * yv.w); }
            const float rstd = 1.f / sqrtf(wave_sum(ss) * (1.f / DM) + RMS_EPS);
            GAS f32x4* ho = (GAS f32x4*)((float*)hout + (size_t)m * DM) + F.lane; GAS v2u* hob = (GAS v2u*)((bf16*)hout + (size_t)m * DM) + F.lane;
#pragma unroll
            for (int j = 0; j < 16; ++j) { const f32x4 g = lga[64 * j + F.lane]; const v2u yw = yb[j]; const f32x4 yv = (f32x4){bflo(yw.x), bfhi(yw.x), bflo(yw.y), bfhi(yw.y)};
                h[j] = h[j] + yv * rstd * g;
                if (HOB) { const v2u hw = (v2u){cvtpk(h[j].x, h[j].y), cvtpk(h[j].z, h[j].w)}; hob[64 * j] = hw; h[j] = (f32x4){bflo(hw.x), bfhi(hw.x), bflo(hw.y), bfhi(hw.y)}; }
                else ho[64 * j] = h[j]; }
            { const GAS v2u* yr = (const GAS v2u*)(y + (size_t)mn * DM) + F.lane;
#pragma unroll
              for (int j = 0; j < 16; ++j) yb[j] = yr[64 * j]; }
        }
        if (XNM != 0) {
            float s2 = 0.f;
#pragma unroll
            for (int j = 0; j < 16; ++j) s2 += (h[j].x * h[j].x + h[j].y * h[j].y) + (h[j].z * h[j].z + h[j].w * h[j].w);
            const float r2 = 1.f / sqrtf(wave_sum(s2) * (1.f / DM) + RMS_EPS);
            if (XNM == 1) {
                GAS v2u* o8 = (GAS v2u*)(xn + (size_t)m * DM) + F.lane;
#pragma unroll
                for (int j = 0; j < 16; ++j) { const f32x4 g = lgb[64 * j + F.lane]; const f32x4 v = h[j] * r2 * g;
                    v2u w; w.x = pk2(v.x, v.y); w.y = pk2(v.z, v.w); o8[64 * j] = w; }
            } else {
                float am = 0.f;
#pragma unroll
                for (int j = 0; j < 16; ++j) { const f32x4 g = lgb[64 * j + F.lane]; h[j] = h[j] * r2 * g;
                    am = fmaxf(fmaxf(am, fmaxf(fabsf(h[j].x), fabsf(h[j].y))), fmaxf(fabsf(h[j].z), fabsf(h[j].w))); }
                am = wave_max(am);
                am = fmaxf(am, 1e-20f);
                const float qs = 127.f / am;
                GAS unsigned char* o1 = (GAS unsigned char*)xn; GAS unsigned* o4 = (GAS unsigned*)(o1 + (size_t)m * DM) + F.lane;
#pragma unroll
                for (int j = 0; j < 16; ++j) { const int q0 = (int)rintf(h[j].x * qs), q1 = (int)rintf(h[j].y * qs), q2 = (int)rintf(h[j].z * qs), q3 = (int)rintf(h[j].w * qs);
                    const unsigned qw = (unsigned)(q0 & 255) | ((unsigned)(q1 & 255) << 8) | ((unsigned)(q2 & 255) << 16) | ((unsigned)q3 << 24);
                    if (XNM == 3) *(GAS unsigned*)(o1 + pg8::tm_chunk_off(m, 256 * j + 4 * F.lane, DM / 128, false)) = qw; else o4[64 * j] = qw; }
                if (F.lane == 0) sa[m] = am * (1.f / 127.f);
            }
        }
    }
}
template <bool TMW> __device__ __forceinline__ void p0_quant_rows(Frame& F, const bf16* WT, unsigned char* W8, float* sw, int rows) {
    const int gw = F.vcu * NWAVES + F.wave, NGW = F.G * NWAVES;
    for (int r = gw; r < rows; r += NGW) {
        const GAS v4u* src = (const GAS v4u*)(WT + (size_t)r * DM) + F.lane;
        v4u c[8]; float am = 0.f;
#pragma unroll
        for (int i = 0; i < 8; ++i) { c[i] = src[64 * i];
#pragma unroll
            for (int j = 0; j < 4; ++j) am = fmaxf(am, fmaxf(fabsf(bflo(c[i][j])), fabsf(bfhi(c[i][j])))); }
#pragma unroll
        for (int o = 1; o < 64; o <<= 1) am = fmaxf(am, __shfl_xor(am, o));
        am = fmaxf(am, 1e-30f);
        const float qs = 127.f / am;
        GAS v2u* dst = (GAS v2u*)(W8 + (size_t)r * DM) + F.lane;
#pragma unroll
        for (int i = 0; i < 8; ++i) { unsigned w[2];
#pragma unroll
            for (int hf = 0; hf < 2; ++hf) { const int q0 = (int)rintf(bflo(c[i][2 * hf]) * qs), q1 = (int)rintf(bfhi(c[i][2 * hf]) * qs), q2 = (int)rintf(bflo(c[i][2 * hf + 1]) * qs), q3 = (int)rintf(bfhi(c[i][2 * hf + 1]) * qs);
                w[hf] = (unsigned)(q0 & 255) | ((unsigned)(q1 & 255) << 8) | ((unsigned)(q2 & 255) << 16) | ((unsigned)q3 << 24); }
            if (TMW) *(GAS v2u*)(W8 + pg8::tm_chunk_off(r, 8 * (F.lane + 64 * i), DM / 128, true)) = (v2u){w[0], w[1]}; else dst[64 * i] = (v2u){w[0], w[1]}; }
        if (F.lane == 0) sw[r] = am * (1.f / 127.f);
    }
}
#define DPP_QUAD(x, ctrl) __builtin_bit_cast(float, __builtin_amdgcn_update_dpp(0, __builtin_bit_cast(int, (x)), (ctrl), 0xf, 0xf, true))
__device__ __forceinline__ void fwht8(float (&x)[8]) {
#pragma unroll
    for (int s = 1; s < 8; s <<= 1)
#pragma unroll
        for (int i = 0; i < 8; ++i) if (!(i & s)) { const float a = x[i], b = x[i + s]; x[i] = a + b; x[i + s] = a - b; }
}
__device__ __forceinline__ void fwht32_quad(float (&x)[8], int lane) {
    fwht8(x);
    const float s1 = (lane & 1) ? -1.f : 1.f, s2 = (lane & 2) ? -1.f : 1.f;
#pragma unroll
    for (int i = 0; i < 8; ++i) { const float p = DPP_QUAD(x[i], 0xB1); x[i] = p + s1 * x[i]; }
#pragma unroll
    for (int i = 0; i < 8; ++i) { const float p = DPP_QUAD(x[i], 0x4E); x[i] = (p + s2 * x[i]) * 0.17677669529663687f; }
}
template <int KL> __device__ __forceinline__ void p0_quant_wout(Frame& F, const bf16* WT, unsigned char* W8, float* sw) {
    const int gw = F.vcu * NWAVES + F.wave, NGW = F.G * NWAVES;
    constexpr int NCH = KL / 8, NI = (NCH + 63) / 64;
    for (int r = gw; r < DM; r += NGW) {
        const GAS v4u* src = (const GAS v4u*)(WT + (size_t)r * KL);
        v4u c[NI]; float am = 0.f;
#pragma unroll
        for (int i = 0; i < NI; ++i) { const int ch = F.lane + 64 * i; c[i] = (ch < NCH) ? src[ch] : (v4u){0u, 0u, 0u, 0u}; }
#pragma unroll
        for (int i = 0; i < NI; ++i) { float x[8];
#pragma unroll
            for (int j = 0; j < 4; ++j) { x[2 * j] = bflo(c[i][j]); x[2 * j + 1] = bfhi(c[i][j]); }
#if MK_FFO_ROT
            fwht32_quad(x, F.lane);
#endif
#pragma unroll
            for (int j = 0; j < 4; ++j) { c[i][j] = cvtpk(x[2 * j], x[2 * j + 1]); am = fmaxf(am, fmaxf(fabsf(bflo(c[i][j])), fabsf(bfhi(c[i][j])))); } }
#pragma unroll
        for (int o = 1; o < 64; o <<= 1) am = fmaxf(am, __shfl_xor(am, o));
        am = fmaxf(am, 1e-30f);
        const float qs = 127.f / am;
#pragma unroll
        for (int i = 0; i < NI; ++i) { const int ch = F.lane + 64 * i; unsigned w[2];
#pragma unroll
            for (int hf = 0; hf < 2; ++hf) { const int q0 = (int)rintf(bflo(c[i][2 * hf]) * qs), q1 = (int)rintf(bfhi(c[i][2 * hf]) * qs), q2 = (int)rintf(bflo(c[i][2 * hf + 1]) * qs), q3 = (int)rintf(bfhi(c[i][2 * hf + 1]) * qs);
                w[hf] = (unsigned)(q0 & 255) | ((unsigned)(q1 & 255) << 8) | ((unsigned)(q2 & 255) << 16) | ((unsigned)q3 << 24); }
            if (ch < NCH) *(GAS v2u*)(W8 + (size_t)r * KL + 8 * ch) = (v2u){w[0], w[1]}; }
        if (F.lane == 0) sw[r] = am * (1.f / 127.f);
    }
}
__device__ __forceinline__ void act_quant_rows(Frame& F, const bf16* ACTp, unsigned char* A8, const unsigned* rmax, float* sa2) {
    const int gw = F.vcu * NWAVES + F.wave, NGW = F.G * NWAVES;
    constexpr int NCH = DFF / 8, NI = (NCH + 63) / 64;
    v4u cb[NI]; unsigned rmb = 0u;
    if (gw < M) { const GAS v4u* src = (const GAS v4u*)(ACTp + (size_t)gw * DFF); rmb = rmax[gw];
#pragma unroll
        for (int i = 0; i < NI; ++i) { const int ch = F.lane + 64 * i; cb[i] = src[ch < NCH ? ch : NCH - 1]; } }
    for (int m = gw; m < M; m += NGW) {
        const int mn = (m + NGW < M) ? m + NGW : m;
        v4u c[NI];
#pragma unroll
        for (int i = 0; i < NI; ++i) c[i] = cb[i];
        const float am = fmaxf(__builtin_bit_cast(float, rmb), 1e-30f), qs = 127.f / am;
        { const GAS v4u* srcn = (const GAS v4u*)(ACTp + (size_t)mn * DFF); rmb = rmax[mn];
#pragma unroll
          for (int i = 0; i < NI; ++i) { const int ch = F.lane + 64 * i; cb[i] = srcn[ch < NCH ? ch : NCH - 1]; } }
#pragma unroll
        for (int i = 0; i < NI; ++i) { const int ch = F.lane + 64 * i; unsigned w[2];
#pragma unroll
            for (int hf = 0; hf < 2; ++hf) { const int q0 = (int)rintf(bflo(c[i][2 * hf]) * qs), q1 = (int)rintf(bfhi(c[i][2 * hf]) * qs), q2 = (int)rintf(bflo(c[i][2 * hf + 1]) * qs), q3 = (int)rintf(bfhi(c[i][2 * hf + 1]) * qs);
                w[hf] = (unsigned)(q0 & 255) | ((unsigned)(q1 & 255) << 8) | ((unsigned)(q2 & 255) << 16) | ((unsigned)q3 << 24); }
            if (ch < NCH) *(GAS v2u*)(A8 + (size_t)m * DFF + 8 * ch) = (v2u){w[0], w[1]}; }
        if (F.lane == 0) sa2[m] = am * (1.f / 127.f);
    }
}
constexpr int ST_PITCH = 8200, ST_K = 4096, ST_CM_OFF = RING_OFF + 16 * ST_PITCH;
__device__ __forceinline__ void strip_rot4(float (&v)[32]) {
#pragma unroll
    for (int g = 0; g < 4; ++g)
#pragma unroll
        for (int st = 1; st < 8; st <<= 1)
#pragma unroll
            for (int a = 0; a < 8; ++a) if (!(a & st)) { const float x = v[8 * g + a], y = v[8 * g + a + st]; v[8 * g + a] = x + y; v[8 * g + a + st] = x - y; }
#pragma unroll
    for (int g = 0; g < 4; ++g) {
        asm volatile("v_nop\n\tv_nop\n\tv_permlane16_swap_b32 %0, %1\n\tv_permlane16_swap_b32 %2, %3\n\tv_permlane16_swap_b32 %4, %5\n\tv_permlane16_swap_b32 %6, %7\n\ts_nop 1"
                     : "+v"(v[8 * g + 0]), "+v"(v[8 * g + 1]), "+v"(v[8 * g + 2]), "+v"(v[8 * g + 3]), "+v"(v[8 * g + 4]), "+v"(v[8 * g + 5]), "+v"(v[8 * g + 6]), "+v"(v[8 * g + 7]));
#pragma unroll
        for (int a = 0; a < 8; a += 2) { const float x = v[8 * g + a], y = v[8 * g + a + 1]; v[8 * g + a] = x + y; v[8 * g + a + 1] = x - y; }
        asm volatile("v_nop\n\tv_nop\n\tv_permlane32_swap_b32 %0, %2\n\tv_permlane32_swap_b32 %1, %3\n\tv_permlane32_swap_b32 %4, %6\n\tv_permlane32_swap_b32 %5, %7\n\ts_nop 1"
                     : "+v"(v[8 * g + 0]), "+v"(v[8 * g + 1]), "+v"(v[8 * g + 2]), "+v"(v[8 * g + 3]), "+v"(v[8 * g + 4]), "+v"(v[8 * g + 5]), "+v"(v[8 * g + 6]), "+v"(v[8 * g + 7]));
#pragma unroll
        for (int a = 0; a < 8; ++a) if (!(a & 2)) { const float x = v[8 * g + a], y = v[8 * g + a + 2]; v[8 * g + a] = x + y; v[8 * g + a + 2] = x - y; }
    }
}
__device__ __forceinline__ unsigned q8bits(float x, float qs) { return __builtin_bit_cast(unsigned, fmaf(x, qs, 12582912.f)) & 255u; }
constexpr size_t WS_FOMAX = WS_CTL + 256 * 1024, WS_FOCNT = WS_FOMAX + 32 * 1024;
__device__ __forceinline__ void strip_desc(const Frame& F, int s, const float*& p, int& N, int& kind, int& l, int& c0, int& b0, int& nb, int& cgl) {
    constexpr int S_FO = 3 * (DM / 16), S_FI = 2 * DFF / 16, S_HI = NHG / 16;
    int r = s; b0 = 0; nb = 32; cgl = 0;
    if (r < 2 * S_FO) { cgl = r / 3; const int part = r - 3 * cgl; l = cgl / (DM / 16); kind = 0; N = DM; p = F.w_ff_out + (size_t)l * DFF * DM; c0 = 16 * (cgl - l * (DM / 16));
        b0 = 29 * part; nb = (part == 2) ? 28 : 29; return; } r -= 2 * S_FO;
    if (r < 2 * S_FI) { l = r / S_FI; r -= l * S_FI; kind = 1; N = 2 * DFF; p = F.w_ff_in + (size_t)l * DM * 2 * DFF; c0 = 16 * r; return; } r -= 2 * S_FI;
    if (r < S_HI) { l = 0; kind = 2; N = NHG; p = F.w_hg_in; c0 = 16 * r; return; } r -= S_HI;
    l = 0; kind = 3; N = DM; p = F.w_hg_out; c0 = 16 * r;
}
template <int KL, int N, bool ROT, bool TMW, int MODE, bool SYNC3, bool PERMK>
__device__ __forceinline__ void p0_strip(Frame& F, float (&v)[32], const float* src, const float* nsrc, int nN, int c0, int b0, int nb, int cgl, unsigned char* W8, float* sw, int par) {
    LAS unsigned char* st = F.lds + RING_OFF;
    LAS float* cm = (LAS float*)(F.lds + ST_CM_OFF) + par * 128;
    const int n = F.lane & 15, kq = F.lane >> 4;
    float mx = 0.f;
#pragma unroll 1
    for (int blk = b0 + F.wave; blk < b0 + nb; blk += NWAVES) {
        float x[32];
#pragma unroll
        for (int i = 0; i < 32; ++i) x[i] = v[i];
        const bool last = blk + NWAVES >= b0 + nb;
        const float* q = last ? nsrc : src + (size_t)(128 * (blk + NWAVES)) * N;
        const size_t step = (size_t)4 * (last ? nN : N);
#pragma unroll
        for (int i = 0; i < 32; ++i) v[i] = MK_LD_W(q + i * step);
        if (ROT) strip_rot4(x);
        LAS unsigned short* d = (LAS unsigned short*)(st + n * ST_PITCH + 256 * (blk - b0)) + (!ROT ? kq : PERMK ? 4 * (kq >> 1) + 8 * (kq & 1) : 4 * kq);
#pragma unroll
        for (int i = 0; i < 32; i += 2) { const unsigned w = cvtpk(x[i], x[i + 1]); mx = fmaxf(mx, fmaxf(fabsf(x[i]), fabsf(x[i + 1])));
            const int r3 = (i >> 1) & 1, r4 = (i >> 2) & 1;
            if (ROT) *(LAS unsigned*)(d + 32 * (i >> 3) + (PERMK ? 2 * r4 + 16 * r3 : 2 * r3 + 16 * r4)) = w;
            else { d[4 * i] = (unsigned short)w; d[4 * i + 4] = (unsigned short)(w >> 16); } }
    }
    mx = fmaxf(mx, __shfl_xor(mx, 16)); mx = fmaxf(mx, __shfl_xor(mx, 32));
    if (F.lane < 16) cm[F.wave * 16 + n] = mx;
    __syncthreads();
    float am = 1e-30f;
#pragma unroll
    for (int w = 0; w < NWAVES; ++w) am = fmaxf(am, cm[w * 16 + n]);
    am = bflo(cvtpk(am, am));
    if (SYNC3) {
        unsigned* gmax = (unsigned*)(F.ws + WS_FOMAX) + cgl * 16; unsigned* cnt = (unsigned*)(F.ws + WS_FOCNT) + cgl;
        if (F.tid < 16) am = fmaxf(am, __builtin_bit_cast(float, __hip_atomic_fetch_max(gmax + n, __builtin_bit_cast(unsigned, am), __ATOMIC_RELAXED, __HIP_MEMORY_SCOPE_AGENT)));
        if (F.wave == 0) { asm volatile("s_waitcnt vmcnt(0)" ::: "memory");
            if (F.tid == 0) { (void)xb_add(cnt, 1u); unsigned sp = 0; while (xb_ld(cnt) < 3u && ++sp < (1u << 22)) __builtin_amdgcn_s_sleep(1); } }
        __syncthreads();
        am = fmaxf(am, __builtin_bit_cast(float, xb_ld(gmax + n)));
    }
    const float qs = 127.f / am;
    const int col = c0 + n; int R = col;
    if (MODE == 1) { const int c = (col < DFF) ? col : col - DFF; R = 256 * (c >> 7) + (c & 127) + ((col < DFF) ? 0 : 128); }
    if (MODE == 2) { const int s = col >> 12, cc = col & 4095, c64 = cc & 63; R = 256 * (cc >> 6) + 128 * (s >> 1) + 32 * (c64 >> 4) + 8 * ((c64 >> 2) & 3) + 4 * (s & 1) + (c64 & 3); }
#pragma unroll 2
    for (int t = 0; t < 8; ++t) {
        const int c = 4 * (F.wave + NWAVES * t) + kq;
        if (c < 8 * nb) {
            const LAS v2u* s2 = (const LAS v2u*)(st + n * ST_PITCH + 32 * c);
            unsigned w[4];
#pragma unroll
            for (int j = 0; j < 4; ++j) { const v2u u = s2[j];
                w[j] = q8bits(bflo(u.x), qs) | (q8bits(bfhi(u.x), qs) << 8) | (q8bits(bflo(u.y), qs) << 16) | (q8bits(bfhi(u.y), qs) << 24); }
            const int kb = 128 * b0 + 16 * c;
            if (TMW) *(GAS v4u*)(W8 + pg8::tm_chunk_off(R, kb, KL / 128, true)) = (v4u){w[0], w[1], w[2], w[3]};
            else *(GAS v4u*)(W8 + (size_t)R * KL + kb) = (v4u){w[0], w[1], w[2], w[3]};
        }
    }
    if (F.tid < 16 && b0 == 0) sw[R] = am * (ROT ? 0.17677669529663687f / 127.f : 1.f / 127.f);
    __syncthreads();
}
#ifndef MK_P0_DEFER
#define MK_P0_DEFER 0
#endif
constexpr int SX_FO = 3 * (DM / 16), SX_FI = 2 * DFF / 16, SX_HI = NHG / 16, SX_HO = DM / 16, SX_ALL = 2 * SX_FO + 2 * SX_FI + SX_HI + SX_HO;
constexpr int DEF_FI = MK_P0_DEFER ? 640 : 0, DEF_FO = MK_P0_DEFER ? 213 : 0;
static_assert(DEF_FI <= SX_FI && 3 * DEF_FO <= SX_FO, "deferred strip counts");
__device__ __forceinline__ int strip_full_index(int lst, int j) {
    if (lst == 3) return j;
    if (lst == 4) return 2 * SX_FO + j;
    if (lst == 1) return 2 * SX_FO + SX_FI + j;
    if (lst == 2) return SX_FO + j;
    if (j < SX_FO) return j;
    j -= SX_FO; if (j < SX_FO - 3 * DEF_FO) return SX_FO + 3 * DEF_FO + j;
    j -= SX_FO - 3 * DEF_FO; if (j < SX_FI) return 2 * SX_FO + j;
    j -= SX_FI; if (j < SX_FI - DEF_FI) return 2 * SX_FO + SX_FI + DEF_FI + j;
    j -= SX_FI - DEF_FI; return 2 * SX_FO + 2 * SX_FI + j;
}
template <int LST> __device__ __forceinline__ void run_strips(Frame& F, int j0, int jstep) {
    constexpr int CNT = LST == 0 ? SX_ALL - 3 * DEF_FO - DEF_FI : LST == 1 ? DEF_FI : LST == 2 ? 3 * DEF_FO : LST == 3 ? 2 * SX_FO : SX_ALL - 2 * SX_FO;
    const int n = F.lane & 15, kq = F.lane >> 4;
    int j = j0, par = 0;
    if (j < 0 || j >= CNT) return;
    const float* p; int N, kind, l, c0, b0, nb, cgl;
    strip_desc(F, strip_full_index(LST, j), p, N, kind, l, c0, b0, nb, cgl);
    const float* src = p + (size_t)kq * N + c0 + n;
    float v[32];
    { const float* q = src + (size_t)(128 * (b0 + F.wave)) * N; const size_t step = (size_t)4 * N;
#pragma unroll
      for (int i = 0; i < 32; ++i) v[i] = MK_LD_W(q + i * step); }
#pragma unroll 1
    while (j < CNT) {
        const int jn = j + jstep;
        const float* pn; int Nn, kindn, ln, c0n, b0n, nbn, cgln;
        strip_desc(F, strip_full_index(LST, jn < CNT ? jn : j), pn, Nn, kindn, ln, c0n, b0n, nbn, cgln);
        const float* srcn = pn + (size_t)kq * Nn + c0n + n;
        const float* nsrc = srcn + (size_t)(128 * (b0n + F.wave)) * Nn;
        if (LST != 1 && LST != 4 && kind == 0) p0_strip<DFF, DM, true, false, 0, true, true>(F, v, src, nsrc, Nn, c0, b0, nb, cgl, F.ws + WS_W8O + l * W8O_STRIDE, (float*)(F.ws + WS_SWO) + l * DM, par);
        else if (LST != 2 && LST != 3 && kind == 1) p0_strip<DM, 2 * DFF, false, TM_FFI, 1, false, false>(F, v, src, nsrc, Nn, c0, 0, 32, 0, F.ws + WS_W8 + l * W8_STRIDE, (float*)(F.ws + WS_SW) + l * 2 * DFF, par);
        else if ((LST == 0 || LST == 4) && kind == 2) p0_strip<DM, NHG, false, false, 2, false, false>(F, v, src, nsrc, Nn, c0, 0, 32, 0, F.ws + WS_W8H, (float*)(F.ws + WS_SWH), par);
        else if (LST == 0 || LST == 4) p0_strip<DM, DM, true, false, 0, false, false>(F, v, src, nsrc, Nn, c0, 0, 32, 0, F.ws + WS_W8G, (float*)(F.ws + WS_SWG), par);
        j = jn; src = srcn; kind = kindn; l = ln; c0 = c0n; b0 = b0n; nb = nbn; cgl = cgln; par ^= 1;
    }
    asm volatile("s_waitcnt vmcnt(0)" ::: "memory");
    __syncthreads();
}
template <int LST> __device__ __forceinline__ void run_deferred_strips(Frame& F, int units) {
    if ((LST == 1 ? DEF_FI : 3 * DEF_FO) == 0) return;
    const int rem = units % F.G, bx = (int)blockIdx.x;
    asm volatile("s_waitcnt vmcnt(0)" ::: "memory"); __syncthreads();
    run_strips<LST>(F, rem == 0 ? bx : bx - rem, rem == 0 ? F.G : F.G - rem);
}
__device__ __forceinline__ void p0_prologue(Frame& F) {
    LAS float* scr = (LAS float*)(F.lds + RING_OFF + F.wave * 16384);
    const int gw = F.vcu * NWAVES + F.wave, NGW = F.G * NWAVES;
    constexpr int I0 = (DM / 64) * (NQKV / 32), I1 = (DATT / 64) * (DM / 32), I2 = (DM / 64) * (NHG / 32), I3 = (DM / 64) * (DM / 32), I4 = (DM / 64) * (2 * DFF / 32), I6 = (DFF / 64) * (DM / 32);
    constexpr int NITEMS = P0_STRIP ? I0 + I1 : I0 + I1 + I2 + I3 + 2 * I4 + 2 * I6;
    if (P0_STRIP) { if (P0_OVL) run_strips<3>(F, F.vcu, F.G); else run_strips<0>(F, F.vcu, F.G); }
    for (int it = gw; it < NITEMS; it += NGW) {
        int r = it;
        if (r < I0) { p0_transpose_item(F.w_att_in, DM, NQKV, (bf16*)(F.ws + WS_WATTI), 0, scr, r, F.lane); continue; } r -= I0;
        if (r < I1) { p0_transpose_item(F.w_att_out, DATT, DM, (bf16*)(F.ws + WS_WATTO), 0, scr, r, F.lane); continue; } r -= I1;
        if (r < I2) { p0_transpose_item(F.w_hg_in, DM, NHG, (bf16*)(F.ws + WS_WHGI), HG_FUSE ? 2 : 0, scr, r, F.lane); continue; } r -= I2;
        if (r < I3) { p0_transpose_item(F.w_hg_out, DM, DM, (bf16*)(F.ws + WS_WHGO), 0, scr, r, F.lane); continue; } r -= I3;
        if (r < 2 * I4) { const int l = r / I4; p0_transpose_item(F.w_ff_in + (size_t)l * DM * 2 * DFF, DM, 2 * DFF, (bf16*)(F.ws + WS_WFFI + l * WFFI_STRIDE), 1, scr, r - l * I4, F.lane); continue; } r -= 2 * I4;
        { const int l = r / I6; p0_transpose_item(F.w_ff_out + (size_t)l * DFF * DM, DFF, DM, (bf16*)(F.ws + WS_WFFO + l * WFFO_STRIDE), 0, scr, r - l * I6, F.lane); }
    }
    float* BT = (float*)(F.ws + WS_TAB); float* LB = (float*)(F.ws + WS_TAB + 65536);
    const int gt = blockIdx.x * (NWAVES * 64) + F.tid, NT = F.G * NWAVES * 64;
    for (int idx = gt; idx < 3 * 16 * 129; idx += NT) { const int g = idx / (16 * 129), rem = idx - g * 16 * 129, h = rem / 129, j = rem - h * 129;
        BT[idx] = F.rel_bias[t5_bucket(j << (2 * g)) * 48 + g * 16 + h]; }
    for (int c = gt; c < DM; c += NT) { const float l0 = F.lb_logits[c], l1 = F.lb_logits[DM + c]; LB[c] = 1.f / (1.f + expf(l0 - l1)); }
    norm_rows<false, ATT_I8 ? 2 : 1>(F, F.x, nullptr, nullptr, (bf16*)(F.ws + WS_XN), nullptr, F.gains, (float*)(F.ws + WS_SA));
}
__device__ __forceinline__ void attn_naive(Frame& F) {
    const int gw = F.vcu * NWAVES + F.wave, NGW = F.G * NWAVES;
    const bf16* QKV = (const bf16*)(F.ws + WS_QKV); bf16* MRG = (bf16*)(F.ws + WS_MRG); const float* BT = (const float*)(F.ws + WS_TAB);
    for (int item = gw; item < M * 16; item += NGW) {
        const int m = item >> 4, h = item & 15, t = m & (SEQ - 1);
        float mx = -1e30f, l = 0.f, a0 = 0.f, a1 = 0.f;
#pragma unroll 1
        for (int g = 0; g < 3; ++g) {
            const int sh = 2 * g;
            const unsigned qw = *(const GAS unsigned*)(QKV + (size_t)m * NQKV + g * 6144 + h * 128 + 2 * F.lane);
            const float q0 = bflo(qw) * QSCALE, q1 = bfhi(qw) * QSCALE;
            const int jmax = (t >> sh) < 128 ? (t >> sh) : 128;
            const float* bt = BT + (g * 16 + h) * 129;
#pragma unroll 1
            for (int j0 = 0; j0 <= jmax; j0 += 8) {
                unsigned kw[8], vw[8]; float bs[8];
#pragma unroll
                for (int u = 0; u < 8; ++u) { const int jj = (j0 + u) <= jmax ? (j0 + u) : jmax; const bf16* rp = QKV + (size_t)(m - (jj << sh)) * NQKV + g * 6144 + h * 128 + 2 * F.lane;
                    kw[u] = *(const GAS unsigned*)(rp + 2048); vw[u] = *(const GAS unsigned*)(rp + 4096); bs[u] = bt[jj]; }
                float s[8]; float cm = -INFINITY;
#pragma unroll
                for (int u = 0; u < 8; ++u) { s[u] = wave_sum(q0 * bflo(kw[u]) + q1 * bfhi(kw[u])) + bs[u]; if (j0 + u > jmax) s[u] = -INFINITY; cm = fmaxf(cm, s[u]); }
                const float mn = fmaxf(mx, cm), sc = __expf(mx - mn); l *= sc; a0 *= sc; a1 *= sc; mx = mn;
#pragma unroll
                for (int u = 0; u < 8; ++u) { const float p = __expf(s[u] - mn); l += p; a0 += p * bflo(vw[u]); a1 += p * bfhi(vw[u]); }
            }
        }
        const float inv = 1.f / l;
        *(GAS unsigned*)(MRG + (size_t)m * DATT + h * 128 + 2 * F.lane) = pk2(a0 * inv, a1 * inv);
    }
}
__device__ __forceinline__ void hgrn_naive(Frame& F) {
    if (blockIdx.x >= 64) return;
    const int b = blockIdx.x >> 5, h = blockIdx.x & 31;
    const bf16* HP = (const bf16*)(F.ws + WS_QKV); float* ORAW = (float*)(F.ws + WS_ACT); const float* LB = (const float*)(F.ws + WS_TAB + 65536);
    LAS f32x4* PRM = (LAS f32x4*)(F.lds);
    LAS float* VV = (LAS float*)(F.lds + 32768);
    LAS float* OP = (LAS float*)(F.lds + 32768 + 8192);
    const int e = F.tid & 127, qd = F.tid >> 7, ps = F.tid >> 6, pl = F.tid & 63;
    const float lb0 = LB[h * 128 + 2 * pl], lb1 = LB[h * 128 + 2 * pl + 1];
    float S[32];
#pragma unroll
    for (int d = 0; d < 32; ++d) S[d] = 0.f;
    unsigned qw, fw, iw;
#define HG_LOAD(n) do { const bf16* bp = HP + (size_t)(b * SEQ + (n) * 8 + ps) * NHG + h * 128 + 2 * pl; qw = *(const GAS unsigned*)bp; fw = *(const GAS unsigned*)(bp + 4096); iw = *(const GAS unsigned*)(bp + 8192); } while (0)
#define HG_WRITE(buf) do { const float f0 = bflo(fw), f1 = bfhi(fw), r0 = bflo(qw), r1 = bfhi(qw); \
        const float g0 = lb0 + (1.f - lb0) / (1.f + __expf(-f0)), g1 = lb1 + (1.f - lb1) / (1.f + __expf(-f1)); \
        const int o = ((buf) * 8 + ps) * 128 + 2 * pl; \
        PRM[o] = (f32x4){g0, 1.f - g0, r0 / (1.f + __expf(-r0)) * QSCALE, 0.f}; PRM[o + 1] = (f32x4){g1, 1.f - g1, r1 / (1.f + __expf(-r1)) * QSCALE, 0.f}; \
        VV[o] = bflo(iw); VV[o + 1] = bfhi(iw); } while (0)
    HG_LOAD(0); HG_WRITE(0); __syncthreads();
#pragma unroll 1
    for (int n = 0; n < SEQ / 8; ++n) {
        const int buf = n & 1;
        if (n + 1 < SEQ / 8) HG_LOAD(n + 1);
#pragma unroll 1
        for (int st = 0; st < 8; ++st) {
            const float v = VV[(buf * 8 + st) * 128 + e]; float o = 0.f;
#pragma unroll
            for (int dd = 0; dd < 32; ++dd) { const f32x4 P = PRM[(buf * 8 + st) * 128 + qd * 32 + dd]; S[dd] = P.x * S[dd] + P.y * v; o += P.z * S[dd]; }
            OP[(st * 4 + qd) * 128 + e] = o;
        }
        if (n + 1 < SEQ / 8) HG_WRITE(buf ^ 1);
        __syncthreads();
#pragma unroll
        for (int r = 0; r < 2; ++r) { const int idx = F.tid + 512 * r, st = idx >> 7, ee = idx & 127;
            const float sum = (OP[(st * 4 + 0) * 128 + ee] + OP[(st * 4 + 1) * 128 + ee]) + (OP[(st * 4 + 2) * 128 + ee] + OP[(st * 4 + 3) * 128 + ee]);
            ORAW[(size_t)(b * SEQ + n * 8 + st) * DM + h * 128 + ee] = sum; }
        __syncthreads();
    }
#undef HG_LOAD
#undef HG_WRITE
}
__device__ __forceinline__ void hgrn_gate(Frame& F) {
    const int gw = F.vcu * NWAVES + F.wave, NGW = F.G * NWAVES;
    const float* ORAW = (const float*)(F.ws + WS_ACT); const bf16* HP = (const bf16*)(F.ws + WS_QKV); bf16* OG = (bf16*)(F.ws + WS_OG);
    const f32x4 gn = *(const GAS f32x4*)(F.hg_gain + 4 * (F.lane & 31));
    for (int m = gw; m < M; m += NGW) {
        const GAS f32x4* orow = (const GAS f32x4*)(ORAW + (size_t)m * DM) + F.lane;
        const GAS v2u* grow = (const GAS v2u*)(HP + (size_t)m * NHG + 3 * DM) + F.lane;
        GAS v2u* o8 = (GAS v2u*)(OG + (size_t)m * DM) + F.lane;
#pragma unroll 4
        for (int j = 0; j < 16; ++j) {
            const f32x4 o = orow[64 * j]; const v2u gw2 = grow[64 * j];
            float ss = (o.x * o.x + o.y * o.y) + (o.z * o.z + o.w * o.w);
#pragma unroll
            for (int k = 1; k < 32; k <<= 1) ss += __shfl_xor(ss, k);
            const float rstd = 1.f / sqrtf(ss * (1.f / HD) + RMS_EPS);
            const float g0 = bflo(gw2.x), g1 = bfhi(gw2.x), g2 = bflo(gw2.y), g3 = bfhi(gw2.y);
            v2u w; w.x = pk2(o.x * rstd * gn.x * (g0 / (1.f + __expf(-g0))), o.y * rstd * gn.y * (g1 / (1.f + __expf(-g1))));
            w.y = pk2(o.z * rstd * gn.z * (g2 / (1.f + __expf(-g2))), o.w * rstd * gn.w * (g3 / (1.f + __expf(-g3))));
            o8[64 * j] = w;
        }
    }
}
typedef short v4i16_t __attribute__((ext_vector_type(4)));
constexpr int AT_K = 0, AT_KP = 128 * 272, AT_V = 2 * AT_KP, AT_VP = 128 * 288, AT_BT = AT_V + 2 * AT_VP, AT_END = AT_BT + 1024;
static_assert(AT_END <= LDSCTL_OFF, "attention LDS map");
constexpr size_t WS_AO = 2334 * MiB, WS_LSE = 2526 * MiB, WS_END2 = 2529 * MiB;
#define AT_ROW(row_, h_) (QKV_HM ? (size_t)(h_) * ((size_t)M * 128) + (size_t)(row_) * 128 : (size_t)(row_) * 2048 + (size_t)(h_) * 128)
__device__ __forceinline__ void attn_load_page(LAS unsigned char* L, int tid, const bf16* Kt, const bf16* Vt, int row0, int h, int slot) {
#pragma unroll
    for (int i = 0; i < 4; ++i) { const int chunk = tid + 512 * i, r = chunk >> 4, c = chunk & 15;
        const v4u kv = *(const GAS v4u*)(Kt + AT_ROW(row0 + r, h) + 8 * c); const v4u vv = *(const GAS v4u*)(Vt + AT_ROW(row0 + r, h) + 8 * c);
        *(LAS v4u*)(L + AT_K + slot * AT_KP + r * 272 + 16 * c) = kv; *(LAS v4u*)(L + AT_V + slot * AT_VP + r * 288 + 16 * c) = vv; }
}
__device__ __forceinline__ void attn_mfma(Frame& F) {
    const bf16* QKVp = (const bf16*)(F.ws + WS_QKV); bf16* AO = (bf16*)(F.ws + WS_AO); float* LSE = (float*)(F.ws + WS_LSE); const float* BT = (const float*)(F.ws + WS_TAB);
    LAS unsigned char* L = F.lds;
    const int w = F.wave, li = F.lane & 15, g4 = F.lane >> 4;
    const int per = (6144 + F.G - 1) / F.G, U0 = F.vcu * per, U1 = (U0 + per) < 6144 ? (U0 + per) : 6144;
    int prevU = -2;
    v4u pk[4], pv[4];
#define AT_DECODE(UU, gh_, qb_, g_, h_, q0_) const int gh_ = (UU) >> 7, qb_ = (UU) & 127, g_ = gh_ >> 4, h_ = gh_ & 15, q0_ = 128 * qb_
#define AT_PREFETCH(UU) do { AT_DECODE(UU, ghn, qbn, gn_, hn, q0n); (void)qbn; const bf16* Kn = QKVp + (size_t)(3 * gn_ + 1) * M * 2048; const bf16* Vn = Kn + (size_t)M * 2048; \
        _Pragma("unroll") for (int i = 0; i < 4; ++i) { const int chunk = F.tid + 512 * i, r = chunk >> 4, c = chunk & 15; \
            pk[i] = *(const GAS v4u*)(Kn + AT_ROW(q0n + r, hn) + 8 * c); pv[i] = *(const GAS v4u*)(Vn + AT_ROW(q0n + r, hn) + 8 * c); } \
        } while (0)
#define AT_QLOAD(UU) do { AT_DECODE(UU, ghq, qbq, gq_, hq, q0q); (void)qbq; const bf16* qp = QKVp + (size_t)(3 * gq_) * M * 2048 + AT_ROW(q0q + 16 * w + li, hq) + 8 * g4; \
        _Pragma("unroll") for (int ds = 0; ds < 4; ++ds) qf[ds] = *(const GAS bf16x8*)(qp + 32 * ds); } while (0)
    bf16x8 qf[4];
    if (U0 < U1) { AT_PREFETCH(U0); AT_QLOAD(U0); }
#pragma unroll 1
    for (int U = U0; U < U1; ++U) {
        const int gh = U >> 7, qb = U & 127, g = gh >> 4, h = gh & 15, sh = 2 * g, n = SEQ >> sh, q0 = 128 * qb, i0 = q0 & (n - 1);
        const bool first = (i0 == 0);
        const bf16* Qt = QKVp + (size_t)(3 * g) * M * 2048; const bf16* Kt = Qt + (size_t)M * 2048; const bf16* Vt = Kt + (size_t)M * 2048;
        __builtin_amdgcn_s_barrier(); asm volatile("" ::: "memory");
        if (U == U0 || qb == 0) { if (F.tid < 161) { const int rel = F.tid - 16; ((LAS float*)(L + AT_BT))[F.tid] = (rel >= 0 && rel <= 128) ? BT[gh * 129 + rel] : 0.f; } }
        if (first) { for (int i = F.tid; i < AT_VP / 16; i += NWAVES * 64) *(LAS v4u*)(L + AT_V + ((qb - 1) & 1) * AT_VP + 16 * i) = (v4u){0u, 0u, 0u, 0u}; }
        else if (prevU != U - 1) attn_load_page(L, F.tid, Kt, Vt, q0 - 128, h, (qb - 1) & 1);
#pragma unroll
        for (int i = 0; i < 4; ++i) { const int chunk = F.tid + 512 * i, r = chunk >> 4, c = chunk & 15;
            *(LAS v4u*)(L + AT_K + (qb & 1) * AT_KP + r * 272 + 16 * c) = pk[i]; *(LAS v4u*)(L + AT_V + (qb & 1) * AT_VP + r * 288 + 16 * c) = pv[i]; }
        prevU = U;
        LDS_WAIT(); __builtin_amdgcn_s_barrier(); asm volatile("" ::: "memory");
        { const int Un = (U + 1 < U1) ? U + 1 : U; AT_PREFETCH(Un); }
        f32x4 sc[9];
        __builtin_amdgcn_s_setprio(1);
#pragma unroll
        for (int blk = 0; blk < 9; ++blk) { const int kb = w + blk, slot = (qb - 1 + (kb >> 3)) & 1;
            const LAS unsigned char* kp = L + AT_K + slot * AT_KP + ((kb & 7) * 16 + li) * 272 + 16 * g4;
            f32x4 acc = (f32x4){0.f, 0.f, 0.f, 0.f};
#pragma unroll
            for (int ds = 0; ds < 4; ++ds) { const bf16x8 a = *(const LAS bf16x8*)(kp + 64 * ds); acc = __builtin_amdgcn_mfma_f32_16x16x32_bf16(a, qf[ds], acc, 0, 0, 0); }
            sc[blk] = acc; }
        __builtin_amdgcn_s_setprio(0);
        { const int Uq = (U + 1 < U1) ? U + 1 : U; AT_QLOAD(Uq); }
        const LAS float* bt = (const LAS float*)(L + AT_BT) + (16 + 128 + li - 4 * g4);
        const int ql = 16 * w + li, relmax = first ? (ql < 128 ? ql : 128) : 128;
        float mx = -INFINITY;
#pragma unroll
        for (int blk = 0; blk < 9; ++blk)
#pragma unroll
            for (int r = 0; r < 4; ++r) sc[blk][r] = sc[blk][r] * QSCALE + *(const volatile LAS float*)(bt - (16 * blk + r));
        if (!first) {
#pragma unroll
            for (int blk = 0; blk < 9; ++blk)
#pragma unroll
                for (int r = 0; r < 4; ++r) { const int rel = 128 + li - 16 * blk - 4 * g4 - r;
                    const float s = (blk == 0) ? ((rel <= 128) ? sc[blk][r] : -INFINITY) : (blk == 8) ? ((rel >= 0) ? sc[blk][r] : -INFINITY) : sc[blk][r]; sc[blk][r] = s; mx = fmaxf(mx, s); }
        } else {
#pragma unroll
            for (int blk = 0; blk < 9; ++blk)
#pragma unroll
                for (int r = 0; r < 4; ++r) { const int rel = 128 + li - 16 * blk - 4 * g4 - r;
                    const float s = (rel >= 0 && rel <= relmax) ? sc[blk][r] : -INFINITY; sc[blk][r] = s; mx = fmaxf(mx, s); }
        }
        mx = xl32_max(xl16_max(mx));
        float lsum = 0.f;
#pragma unroll
        for (int blk = 0; blk < 9; ++blk)
#pragma unroll
            for (int r = 0; r < 4; ++r) { const float p = __expf(sc[blk][r] - mx); sc[blk][r] = p; lsum += p; }
        lsum = xl32_sum(xl16_sum(lsum));
        f32x4 o[8];
#pragma unroll
        for (int db = 0; db < 8; ++db) o[db] = (f32x4){0.f, 0.f, 0.f, 0.f};
        __builtin_amdgcn_s_setprio(1);
#pragma unroll
        for (int st = 0; st < 5; ++st) {
            const int ba = 2 * st, bb = (2 * st + 1) < 9 ? (2 * st + 1) : 8;
            v4u pw; pw.x = cvtpk(sc[ba][0], sc[ba][1]); pw.y = cvtpk(sc[ba][2], sc[ba][3]);
            if (2 * st + 1 < 9) { pw.z = cvtpk(sc[bb][0], sc[bb][1]); pw.w = cvtpk(sc[bb][2], sc[bb][3]); } else { pw.z = 0u; pw.w = 0u; }
            const bf16x8 pf = __builtin_bit_cast(bf16x8, pw);
            const int kba = w + ba, kbb = w + bb;
            const LAS unsigned char* va = L + AT_V + ((qb - 1 + (kba >> 3)) & 1) * AT_VP + ((kba & 7) * 16 + 4 * g4 + (li >> 2)) * 288 + 8 * (li & 3);
            const LAS unsigned char* vb = L + AT_V + ((qb - 1 + (kbb >> 3)) & 1) * AT_VP + ((kbb & 7) * 16 + 4 * g4 + (li >> 2)) * 288 + 8 * (li & 3);
#pragma unroll
            for (int db = 0; db < 8; ++db) {
                const v4i16_t lo = __builtin_amdgcn_ds_read_tr16_b64_v4i16((LAS v4i16_t*)(va + 32 * db)), hi = __builtin_amdgcn_ds_read_tr16_b64_v4i16((LAS v4i16_t*)(vb + 32 * db));
                const bf16x8 a = __builtin_shufflevector(lo, hi, 0, 1, 2, 3, 4, 5, 6, 7);
                o[db] = __builtin_amdgcn_mfma_f32_16x16x32_bf16(a, pf, o[db], 0, 0, 0); }
        }
        __builtin_amdgcn_s_setprio(0);
        const float inv = 1.f / lsum;
        const size_t orow = (size_t)g * M + (size_t)(q0 + 16 * w + li);
        bf16* op = AO + orow * 2048 + h * 128 + 4 * g4;
#pragma unroll
        for (int db = 0; db < 8; ++db) *(GAS v2u*)(op + 16 * db) = (v2u){cvtpk(o[db][0] * inv, o[db][1] * inv), cvtpk(o[db][2] * inv, o[db][3] * inv)};
        if (g4 == 0) LSE[orow * 16 + h] = mx + __logf(lsum);
    }
#undef AT_PREFETCH
#undef AT_QLOAD
#undef AT_DECODE
}
__device__ __forceinline__ void attn_merge(Frame& F) {
    const int gw = F.vcu * NWAVES + F.wave, NGW = F.G * NWAVES;
    const bf16* AO = (const bf16*)(F.ws + WS_AO); const float* LSE = (const float*)(F.ws + WS_LSE); bf16* MRG = (bf16*)(F.ws + WS_MRG);
    v4u pa[4], pb[4], pd[4]; float pl0[4], pl1[4], pl2[4];
#define AM_LOAD(mm) do { const int t_ = (mm) & (SEQ - 1), bb_ = (mm) & ~(SEQ - 1); size_t r_[3]; \
        _Pragma("unroll") for (int g = 0; g < 3; ++g) { const int sh = 2 * g; r_[g] = (size_t)g * M + (size_t)(bb_ + ((t_ & ((1 << sh) - 1)) << (13 - sh)) + (t_ >> sh)); } \
        _Pragma("unroll") for (int k = 0; k < 4; ++k) { const int hd = (F.lane >> 4) + 4 * k, c = F.lane + 64 * k; \
            pl0[k] = LSE[r_[0] * 16 + hd]; pl1[k] = LSE[r_[1] * 16 + hd]; pl2[k] = LSE[r_[2] * 16 + hd]; \
            pa[k] = *(const GAS v4u*)(AO + r_[0] * 2048 + 8 * c); pb[k] = *(const GAS v4u*)(AO + r_[1] * 2048 + 8 * c); pd[k] = *(const GAS v4u*)(AO + r_[2] * 2048 + 8 * c); } } while (0)
    if (gw < M) AM_LOAD(gw);
    for (int m = gw; m < M; m += NGW) {
        const int mn = (m + NGW < M) ? m + NGW : m;
        v4u ca[4], cb[4], cd[4]; float l0v[4], l1v[4], l2v[4];
#pragma unroll
        for (int k = 0; k < 4; ++k) { ca[k] = pa[k]; cb[k] = pb[k]; cd[k] = pd[k]; l0v[k] = pl0[k]; l1v[k] = pl1[k]; l2v[k] = pl2[k]; }
        AM_LOAD(mn);
#pragma unroll
        for (int k = 0; k < 4; ++k) {
            const int c = F.lane + 64 * k;
            const float l0 = l0v[k], l1 = l1v[k], l2 = l2v[k];
            const float mx = fmaxf(l0, fmaxf(l1, l2)); float w0 = __expf(l0 - mx), w1 = __expf(l1 - mx), w2 = __expf(l2 - mx); const float inv = 1.f / (w0 + w1 + w2); w0 *= inv; w1 *= inv; w2 *= inv;
            const v4u a = ca[k], b = cb[k], d = cd[k];
            v4u o;
#pragma unroll
            for (int j = 0; j < 4; ++j) o[j] = cvtpk(w0 * bflo(a[j]) + w1 * bflo(b[j]) + w2 * bflo(d[j]), w0 * bfhi(a[j]) + w1 * bfhi(b[j]) + w2 * bfhi(d[j]));
            *(GAS v4u*)(MRG + (size_t)m * DATT + 8 * c) = o;
        }
    }
#undef AM_LOAD
}
typedef float f32x16 __attribute__((ext_vector_type(16)));
typedef short s16x4 __attribute__((ext_vector_type(4)));
constexpr int HG_QR = 0, HG_QD = 17408, HG_KR = 34816, HG_KRT = 52224, HG_VT = 70656, HG_ST0 = 75264, HG_ST1 = 83968, HG_SEG = 92672, HG_EL = 96768, HG_DEC = 97280, HG_END = 97792;
static_assert(HG_END <= RING_BYTES, "hgrn LDS map");
__device__ __forceinline__ void hgrn_mfma(Frame& F) {
    const bf16* HP = (const bf16*)(F.ws + WS_QKV); float* ORAW = (float*)(F.ws + WS_ACT); const float* LB = (const float*)(F.ws + WS_TAB + 65536);
    LAS unsigned char* L = F.lds;
    const int w = F.wave, cp = F.lane, l31 = F.lane & 31, hh = F.lane >> 5;
#pragma unroll 1
    for (int u = blockIdx.x; u < 256; u += F.G) {
        const int bh = u >> 2, e0 = (u & 3) * 32, b = bh >> 5, h = bh & 31;
        const float lb0 = LB[h * 128 + 2 * cp], lb1 = LB[h * 128 + 2 * cp + 1];
        const size_t rowbase = (size_t)b * SEQ;
        unsigned qraw[8], fraw[8], vraw[2];
#define HGM_LOAD(c) do { \
            _Pragma("unroll") for (int i = 0; i < 8; ++i) { const bf16* bp = HP + (rowbase + 64 * (c) + 8 * w + i) * NHG + h * 128 + 2 * cp; qraw[i] = *(const GAS unsigned*)bp; fraw[i] = *(const GAS unsigned*)(bp + 4096); } \
            _Pragma("unroll") for (int k = 0; k < 2; ++k) { const int vrow = (F.tid >> 4) + 32 * k; vraw[k] = *(const GAS unsigned*)(HP + (rowbase + 64 * (c) + vrow) * NHG + 8192 + h * 128 + e0 + 2 * (F.tid & 15)); } } while (0)
        f32x16 S;
#pragma unroll
        for (int i = 0; i < 16; ++i) S[i] = 0.f;
        for (int i = F.tid; i < 8704 / 4; i += NWAVES * 64) ((LAS unsigned*)(L + HG_ST0))[i] = 0u;
        HGM_LOAD(0);
#pragma unroll 1
        for (int c = 0; c < SEQ / 64; ++c) {
            float q[8][2], k[8][2], cs[8][2]; float run0 = 0.f, run1 = 0.f;
#pragma unroll
            for (int i = 0; i < 8; ++i) {
                const float f0 = bflo(fraw[i]), f1 = bfhi(fraw[i]), r0 = bflo(qraw[i]), r1 = bfhi(qraw[i]);
                const float g0 = lb0 + (1.f - lb0) * __builtin_amdgcn_rcpf(1.f + __expf(-f0)), g1 = lb1 + (1.f - lb1) * __builtin_amdgcn_rcpf(1.f + __expf(-f1));
                run0 += __logf(g0); run1 += __logf(g1); cs[i][0] = run0; cs[i][1] = run1;
                k[i][0] = 1.f - g0; k[i][1] = 1.f - g1;
                q[i][0] = r0 * __builtin_amdgcn_rcpf(1.f + __expf(-r0)) * QSCALE; q[i][1] = r1 * __builtin_amdgcn_rcpf(1.f + __expf(-r1)) * QSCALE;
            }
            { typedef float f32x2v __attribute__((ext_vector_type(2))); *(LAS f32x2v*)(L + HG_SEG + (w * 128 + 2 * cp) * 4) = (f32x2v){run0, run1}; }
            const unsigned v0 = vraw[0], v1 = vraw[1];
            LDS_WAIT(); __builtin_amdgcn_s_barrier(); asm volatile("" ::: "memory");
            float off0 = 0.f, off1 = 0.f, bref0 = 0.f, bref1 = 0.f, p0 = 0.f, p1 = 0.f;
#pragma unroll
            for (int s = 0; s < 8; ++s) { typedef float f32x2v __attribute__((ext_vector_type(2))); const f32x2v t = *(const LAS f32x2v*)(L + HG_SEG + (s * 128 + 2 * cp) * 4);
                if (s == w) { off0 = p0; off1 = p1; } p0 += t.x; p1 += t.y; if (s == 3) { bref0 = p0; bref1 = p1; } }
            const float er0 = __expf(bref0), er1 = __expf(bref1);
            unsigned krt0[4], krt1[4];
#pragma unroll
            for (int i = 0; i < 8; ++i) {
                const float e10 = __expf(cs[i][0] + off0 - bref0), e11 = __expf(cs[i][1] + off1 - bref1);
                const float qr0 = q[i][0] * e10, qr1 = q[i][1] * e11, kr0 = k[i][0] * __builtin_amdgcn_rcpf(e10), kr1 = k[i][1] * __builtin_amdgcn_rcpf(e11);
                const int ro = (8 * w + i) * 272 + 4 * cp;
                *(LAS unsigned*)(L + HG_QR + ro) = cvtpk(qr0, qr1);
                *(LAS unsigned*)(L + HG_QD + ro) = cvtpk(qr0 * er0, qr1 * er1);
                *(LAS unsigned*)(L + HG_KR + ro) = cvtpk(kr0, kr1);
                if (i & 1) { krt0[i >> 1] = cvtpk(k[i - 1][0] * __builtin_amdgcn_rcpf(__expf(cs[i - 1][0] + off0 - bref0)), kr0); krt1[i >> 1] = cvtpk(k[i - 1][1] * __builtin_amdgcn_rcpf(__expf(cs[i - 1][1] + off1 - bref1)), kr1); }
            }
            *(LAS v4u*)(L + HG_KRT + (2 * cp) * 144 + 16 * w) = (v4u){krt0[0], krt0[1], krt0[2], krt0[3]};
            *(LAS v4u*)(L + HG_KRT + (2 * cp + 1) * 144 + 16 * w) = (v4u){krt1[0], krt1[1], krt1[2], krt1[3]};
            if (w == 0) { typedef float f32x2v __attribute__((ext_vector_type(2)));
                *(LAS f32x2v*)(L + HG_EL + 8 * cp) = (f32x2v){__expf(p0 - bref0), __expf(p1 - bref1)}; *(LAS f32x2v*)(L + HG_DEC + 8 * cp) = (f32x2v){__expf(p0), __expf(p1)}; }
            { const int ee = 2 * (F.tid & 15), ss = F.tid >> 4;
                *(LAS unsigned short*)(L + HG_VT + ee * 144 + ss * 2) = (unsigned short)(v0 & 0xffffu); *(LAS unsigned short*)(L + HG_VT + (ee + 1) * 144 + ss * 2) = (unsigned short)(v0 >> 16);
                *(LAS unsigned short*)(L + HG_VT + ee * 144 + (ss + 32) * 2) = (unsigned short)(v1 & 0xffffu); *(LAS unsigned short*)(L + HG_VT + (ee + 1) * 144 + (ss + 32) * 2) = (unsigned short)(v1 >> 16); }
            if (c + 1 < SEQ / 64) HGM_LOAD(c + 1);
            LDS_WAIT(); __builtin_amdgcn_s_barrier(); asm volatile("" ::: "memory");
            const LAS unsigned char* stc = L + ((c & 1) ? HG_ST1 : HG_ST0);
            LAS unsigned char* stn = L + ((c & 1) ? HG_ST0 : HG_ST1);
            if (w < 2) {
                const int th = w;
                f32x16 Y;
#pragma unroll
                for (int i = 0; i < 16; ++i) Y[i] = 0.f;
#pragma unroll
                for (int kd = 0; kd < 8; ++kd) { const bf16x8 a = *(const LAS bf16x8*)(stc + l31 * 272 + (16 * kd + 8 * hh) * 2); const bf16x8 bq = *(const LAS bf16x8*)(L + HG_QD + (32 * th + l31) * 272 + (16 * kd + 8 * hh) * 2);
                    Y = __builtin_amdgcn_mfma_f32_32x32x16_bf16(a, bq, Y, 0, 0, 0); }
#pragma unroll
                for (int sb = 0; sb < 2; ++sb) { if (sb <= th) {
                    f32x16 X;
#pragma unroll
                    for (int i = 0; i < 16; ++i) X[i] = 0.f;
#pragma unroll
                    for (int kd = 0; kd < 8; ++kd) { const bf16x8 a = *(const LAS bf16x8*)(L + HG_KR + (32 * sb + l31) * 272 + (16 * kd + 8 * hh) * 2); const bf16x8 bq = *(const LAS bf16x8*)(L + HG_QR + (32 * th + l31) * 272 + (16 * kd + 8 * hh) * 2);
                        X = __builtin_amdgcn_mfma_f32_32x32x16_bf16(a, bq, X, 0, 0, 0); }
                    if (sb == th) {
#pragma unroll
                        for (int r = 0; r < 16; ++r) { const int s = (r & 3) + 8 * (r >> 2) + 4 * hh; if (s > l31) X[r] = 0.f; } }
#pragma unroll
                    for (int ks = 0; ks < 2; ++ks) {
                        const unsigned x0 = cvtpk(X[8 * ks + 0], X[8 * ks + 1]), x1 = cvtpk(X[8 * ks + 2], X[8 * ks + 3]), x2 = cvtpk(X[8 * ks + 4], X[8 * ks + 5]), x3 = cvtpk(X[8 * ks + 6], X[8 * ks + 7]);
                        const bf16x8 xb = __builtin_bit_cast(bf16x8, (v4u){x0, x1, x2, x3});
                        const v2u alo = *(const LAS v2u*)(L + HG_VT + l31 * 144 + (32 * sb + 16 * ks + 4 * hh) * 2), ahi = *(const LAS v2u*)(L + HG_VT + l31 * 144 + (32 * sb + 16 * ks + 8 + 4 * hh) * 2);
                        const bf16x8 a = __builtin_bit_cast(bf16x8, (v4u){alo.x, alo.y, ahi.x, ahi.y});
                        Y = __builtin_amdgcn_mfma_f32_32x32x16_bf16(a, xb, Y, 0, 0, 0); }
                } }
                float* orow = ORAW + (rowbase + 64 * c + 32 * th + l31) * DM + h * 128 + e0 + 4 * hh;
#pragma unroll
                for (int g = 0; g < 4; ++g) *(GAS f32x4*)(orow + 8 * g) = (f32x4){Y[4 * g], Y[4 * g + 1], Y[4 * g + 2], Y[4 * g + 3]};
            } else if (w >= 4) {
                const int dt = w - 4;
                f32x16 T;
#pragma unroll
                for (int i = 0; i < 16; ++i) T[i] = 0.f;
#pragma unroll
                for (int ks = 0; ks < 4; ++ks) { const bf16x8 a = *(const LAS bf16x8*)(L + HG_KRT + (32 * dt + l31) * 144 + (16 * ks + 8 * hh) * 2); const bf16x8 bv = *(const LAS bf16x8*)(L + HG_VT + l31 * 144 + (16 * ks + 8 * hh) * 2);
                    T = __builtin_amdgcn_mfma_f32_32x32x16_bf16(a, bv, T, 0, 0, 0); }
#pragma unroll
                for (int g = 0; g < 4; ++g) { const f32x4 dec = *(const LAS f32x4*)(L + HG_DEC + (32 * dt + 8 * g + 4 * hh) * 4), el = *(const LAS f32x4*)(L + HG_EL + (32 * dt + 8 * g + 4 * hh) * 4);
#pragma unroll
                    for (int i = 0; i < 4; ++i) S[4 * g + i] = dec[i] * S[4 * g + i] + el[i] * T[4 * g + i];
                    *(LAS v2u*)(stn + l31 * 272 + (32 * dt + 8 * g + 4 * hh) * 2) = (v2u){cvtpk(S[4 * g], S[4 * g + 1]), cvtpk(S[4 * g + 2], S[4 * g + 3])}; }
            }
        }
        LDS_WAIT(); __builtin_amdgcn_s_barrier(); asm volatile("" ::: "memory");
#undef HGM_LOAD
    }
}
__device__ __forceinline__ void hgrn_mfma2(Frame& F) {
    const bf16* QH = (const bf16*)(F.ws + WS_QKV); const bf16* FH = QH + (size_t)M * DM; const bf16* VH = FH + (size_t)M * DM; const bf16* KH = (const bf16*)(F.ws + WS_AO); bf16* ORAW = (bf16*)(F.ws + WS_ACT);
    LAS unsigned char* L = F.lds;
    const int w = F.wave, cp = F.lane, l31 = F.lane & 31, hh = F.lane >> 5, li = F.lane & 15, g4 = F.lane >> 4;
    typedef float f32x2v __attribute__((ext_vector_type(2)));
#pragma unroll 1
    for (int u = blockIdx.x; u < 256; u += F.G) {
        const int ux = u & 7, uy = u >> 3, bh = ux + 8 * (uy >> 2), e0 = (uy & 3) * 32, b = bh >> 5, h = bh & 31;
        const size_t rowbase = (size_t)b * SEQ;
        unsigned qn[8], fn[8], kn[8], vn[2];
        const bf16* pq = QH + ((size_t)bh * SEQ + 8 * w) * 128 + 2 * cp; const bf16* pf = FH + ((size_t)bh * SEQ + 8 * w) * 128 + 2 * cp; const bf16* pk = KH + ((size_t)bh * SEQ + 8 * w) * 128 + 2 * cp;
        const bf16* pv = VH + ((size_t)bh * SEQ + (F.tid >> 4)) * 128 + e0 + 2 * (F.tid & 15);
#define HG2_LOAD() do { \
            _Pragma("unroll") for (int i = 0; i < 8; ++i) { qn[i] = *(const GAS unsigned*)(pq + 128 * i); fn[i] = *(const GAS unsigned*)(pf + 128 * i); kn[i] = *(const GAS unsigned*)(pk + 128 * i); } \
            vn[0] = *(const GAS unsigned*)pv; vn[1] = *(const GAS unsigned*)(pv + 32 * 128); pq += 64 * 128; pf += 64 * 128; pk += 64 * 128; pv += 64 * 128; } while (0)
        f32x16 S;
#pragma unroll
        for (int i = 0; i < 16; ++i) S[i] = 0.f;
        for (int i = F.tid; i < 8704 / 4; i += NWAVES * 64) ((LAS unsigned*)(L + HG_ST0))[i] = 0u;
        HG2_LOAD();
#pragma unroll 1
        for (int c = 0; c < SEQ / 64; ++c) {
            float qf[8][2], kf[8][2], cs[8][2]; float run0 = 0.f, run1 = 0.f;
#pragma unroll
            for (int i = 0; i < 8; ++i) { qf[i][0] = bflo(qn[i]); qf[i][1] = bfhi(qn[i]); kf[i][0] = bflo(kn[i]); kf[i][1] = bfhi(kn[i]); run0 += bflo(fn[i]); run1 += bfhi(fn[i]); cs[i][0] = run0; cs[i][1] = run1; }
            const unsigned v0 = vn[0], v1 = vn[1];
            { const int back = (c + 1 < SEQ / 64) ? 0 : 64 * 128; pq -= back; pf -= back; pk -= back; pv -= back; }
            HG2_LOAD();
            *(LAS f32x2v*)(L + HG_SEG + (w * 128 + 2 * cp) * 4) = (f32x2v){run0, run1};
            LDS_WAIT(); __builtin_amdgcn_s_barrier(); asm volatile("" ::: "memory");
            float off0 = 0.f, off1 = 0.f, bref0 = 0.f, bref1 = 0.f, p0 = 0.f, p1 = 0.f;
#pragma unroll
            for (int s = 0; s < 8; ++s) { const f32x2v t = *(const LAS f32x2v*)(L + HG_SEG + (s * 128 + 2 * cp) * 4);
                if (s == w) { off0 = p0; off1 = p1; } p0 += t.x; p1 += t.y; if (s == 3) { bref0 = p0; bref1 = p1; } }
            const float er0 = __expf(bref0), er1 = __expf(bref1);
            off0 -= bref0; off1 -= bref1;
            float kr[8][2];
#pragma unroll
            for (int i = 0; i < 8; ++i) {
                const float e10 = __expf(cs[i][0] + off0), e11 = __expf(cs[i][1] + off1);
                const float qr0 = qf[i][0] * e10, qr1 = qf[i][1] * e11; kr[i][0] = kf[i][0] * __builtin_amdgcn_rcpf(e10); kr[i][1] = kf[i][1] * __builtin_amdgcn_rcpf(e11);
                const int ro = (8 * w + i) * 272 + 4 * cp;
                *(LAS unsigned*)(L + HG_QR + ro) = cvtpk(qr0, qr1);
                *(LAS unsigned*)(L + HG_QD + ro) = cvtpk(qr0 * er0, qr1 * er1);
                *(LAS unsigned*)(L + HG_KR + ro) = cvtpk(kr[i][0], kr[i][1]);
            }
            *(LAS v4u*)(L + HG_KRT + (2 * cp) * 144 + 16 * w) = (v4u){cvtpk(kr[0][0], kr[1][0]), cvtpk(kr[2][0], kr[3][0]), cvtpk(kr[4][0], kr[5][0]), cvtpk(kr[6][0], kr[7][0])};
            *(LAS v4u*)(L + HG_KRT + (2 * cp + 1) * 144 + 16 * w) = (v4u){cvtpk(kr[0][1], kr[1][1]), cvtpk(kr[2][1], kr[3][1]), cvtpk(kr[4][1], kr[5][1]), cvtpk(kr[6][1], kr[7][1])};
            if (w == 0) { *(LAS f32x2v*)(L + HG_EL + 8 * cp) = (f32x2v){__expf(p0 - bref0), __expf(p1 - bref1)}; *(LAS f32x2v*)(L + HG_DEC + 8 * cp) = (f32x2v){__expf(p0), __expf(p1)}; }
            { const int ee = 2 * (F.tid & 15), ss = F.tid >> 4;
                *(LAS unsigned short*)(L + HG_VT + ee * 144 + ss * 2) = (unsigned short)(v0 & 0xffffu); *(LAS unsigned short*)(L + HG_VT + (ee + 1) * 144 + ss * 2) = (unsigned short)(v0 >> 16);
                *(LAS unsigned short*)(L + HG_VT + ee * 144 + (ss + 32) * 2) = (unsigned short)(v1 & 0xffffu); *(LAS unsigned short*)(L + HG_VT + (ee + 1) * 144 + (ss + 32) * 2) = (unsigned short)(v1 >> 16); }
            LDS_WAIT(); __builtin_amdgcn_s_barrier(); asm volatile("" ::: "memory");
            const LAS unsigned char* stc = L + ((c & 1) ? HG_ST1 : HG_ST0);
            LAS unsigned char* stn = L + ((c & 1) ? HG_ST0 : HG_ST1);
            if (w < 4) {
                const int tq = w;
                f32x4 Y[2]; Y[0] = (f32x4){0.f, 0.f, 0.f, 0.f}; Y[1] = Y[0];
                bf16x8 bqr[4];
#pragma unroll
                for (int kd = 0; kd < 4; ++kd) { const bf16x8 bq = *(const LAS bf16x8*)(L + HG_QD + (16 * tq + li) * 272 + (32 * kd + 8 * g4) * 2); bqr[kd] = *(const LAS bf16x8*)(L + HG_QR + (16 * tq + li) * 272 + (32 * kd + 8 * g4) * 2);
#pragma unroll
                    for (int eb = 0; eb < 2; ++eb) { const bf16x8 a = *(const LAS bf16x8*)(stc + (16 * eb + li) * 272 + (32 * kd + 8 * g4) * 2); Y[eb] = __builtin_amdgcn_mfma_f32_16x16x32_bf16(a, bq, Y[eb], 0, 0, 0); } }
                f32x4 X[4];
#pragma unroll
                for (int sb = 0; sb < 4; ++sb) { f32x4 acc = (f32x4){0.f, 0.f, 0.f, 0.f};
                    if (sb <= tq) {
#pragma unroll
                        for (int kd = 0; kd < 4; ++kd) { const bf16x8 a = *(const LAS bf16x8*)(L + HG_KR + (16 * sb + li) * 272 + (32 * kd + 8 * g4) * 2); acc = __builtin_amdgcn_mfma_f32_16x16x32_bf16(a, bqr[kd], acc, 0, 0, 0); }
                        if (sb == tq) {
#pragma unroll
                            for (int r = 0; r < 4; ++r) if (4 * g4 + r > li) acc[r] = 0.f; } }
                    X[sb] = acc; }
#pragma unroll
                for (int pr = 0; pr < 2; ++pr) { if (2 * pr <= tq) {
                    const bf16x8 pf = __builtin_bit_cast(bf16x8, (v4u){cvtpk(X[2 * pr][0], X[2 * pr][1]), cvtpk(X[2 * pr][2], X[2 * pr][3]), cvtpk(X[2 * pr + 1][0], X[2 * pr + 1][1]), cvtpk(X[2 * pr + 1][2], X[2 * pr + 1][3])});
#pragma unroll
                    for (int eb = 0; eb < 2; ++eb) { const v2u alo = *(const LAS v2u*)(L + HG_VT + (16 * eb + li) * 144 + (32 * pr + 4 * g4) * 2), ahi = *(const LAS v2u*)(L + HG_VT + (16 * eb + li) * 144 + (32 * pr + 16 + 4 * g4) * 2);
                        const bf16x8 a = __builtin_bit_cast(bf16x8, (v4u){alo.x, alo.y, ahi.x, ahi.y}); Y[eb] = __builtin_amdgcn_mfma_f32_16x16x32_bf16(a, pf, Y[eb], 0, 0, 0); } } }
                bf16* orow = ORAW + (rowbase + 64 * c + 16 * tq + li) * DM + h * 128 + e0 + 4 * g4;
#pragma unroll
                for (int eb = 0; eb < 2; ++eb) *(GAS v2u*)(orow + 16 * eb) = (v2u){cvtpk(Y[eb][0], Y[eb][1]), cvtpk(Y[eb][2], Y[eb][3])};
            } else {
                const int dt = w - 4;
                f32x16 T;
#pragma unroll
                for (int i = 0; i < 16; ++i) T[i] = 0.f;
#pragma unroll
                for (int ks = 0; ks < 4; ++ks) { const bf16x8 a = *(const LAS bf16x8*)(L + HG_KRT + (32 * dt + l31) * 144 + (16 * ks + 8 * hh) * 2); const bf16x8 bv = *(const LAS bf16x8*)(L + HG_VT + l31 * 144 + (16 * ks + 8 * hh) * 2);
                    T = __builtin_amdgcn_mfma_f32_32x32x16_bf16(a, bv, T, 0, 0, 0); }
#pragma unroll
                for (int g = 0; g < 4; ++g) { const f32x4 dec = *(const LAS f32x4*)(L + HG_DEC + (32 * dt + 8 * g + 4 * hh) * 4), el = *(const LAS f32x4*)(L + HG_EL + (32 * dt + 8 * g + 4 * hh) * 4);
#pragma unroll
                    for (int i = 0; i < 4; ++i) S[4 * g + i] = dec[i] * S[4 * g + i] + el[i] * T[4 * g + i];
                    *(LAS v2u*)(stn + l31 * 272 + (32 * dt + 8 * g + 4 * hh) * 2) = (v2u){cvtpk(S[4 * g], S[4 * g + 1]), cvtpk(S[4 * g + 2], S[4 * g + 3])}; }
            }
        }
        LDS_WAIT(); __builtin_amdgcn_s_barrier(); asm volatile("" ::: "memory");
#undef HG2_LOAD
    }
}
__device__ __forceinline__ void hgrn_gate2(Frame& F) {
    const int gw = F.vcu * NWAVES + F.wave, NGW = F.G * NWAVES;
    const bf16* ORAW = (const bf16*)(F.ws + WS_ACT); const bf16* SG = (HG_FUSE == 2) ? (const bf16*)(F.ws + WS_AO) : (const bf16*)(F.ws + WS_QKV) + 3 * (size_t)M * DM; bf16* OG = (bf16*)(F.ws + WS_OG);
    const f32x4 gn = *(const GAS f32x4*)(F.hg_gain + 4 * (F.lane & 31));
    for (int m = gw; m < M; m += NGW) {
        const GAS v2u* orow = (const GAS v2u*)(ORAW + (size_t)m * DM) + F.lane;
        const GAS v2u* grow = (const GAS v2u*)(SG + (size_t)m * DM) + F.lane;
        GAS v2u* o8 = (GAS v2u*)(OG + (size_t)m * DM) + F.lane;
#pragma unroll 8
        for (int j = 0; j < 16; ++j) {
            const v2u ow = orow[64 * j], gw2 = grow[64 * j];
            const float o0 = bflo(ow.x), o1 = bfhi(ow.x), o2 = bflo(ow.y), o3 = bfhi(ow.y);
            float ss = (o0 * o0 + o1 * o1) + (o2 * o2 + o3 * o3);
#pragma unroll
            for (int k = 1; k < 32; k <<= 1) ss += __shfl_xor(ss, k);
            const float rstd = 1.f / sqrtf(ss * (1.f / HD) + RMS_EPS);
            float s0 = bflo(gw2.x), s1 = bfhi(gw2.x), s2 = bflo(gw2.y), s3 = bfhi(gw2.y);
            if (HG_FUSE == 2) { s0 *= __builtin_amdgcn_rcpf(1.f + __expf(-s0)); s1 *= __builtin_amdgcn_rcpf(1.f + __expf(-s1)); s2 *= __builtin_amdgcn_rcpf(1.f + __expf(-s2)); s3 *= __builtin_amdgcn_rcpf(1.f + __expf(-s3)); }
            v2u wv; wv.x = cvtpk(o0 * rstd * gn.x * s0, o1 * rstd * gn.y * s1); wv.y = cvtpk(o2 * rstd * gn.z * s2, o3 * rstd * gn.w * s3);
            o8[64 * j] = wv;
        }
    }
}

#define DPP_MOV(x, ctrl) __builtin_bit_cast(float, __builtin_amdgcn_update_dpp(0, __builtin_bit_cast(int, (x)), (ctrl), 0xf, 0xf, false))
__device__ __forceinline__ void hgrn_gate3(Frame& F) {
    const int gw = F.vcu * NWAVES + F.wave, NGW = F.G * NWAVES;
    const bf16* ORAW = (const bf16*)(F.ws + WS_ACT); const bf16* SG = (const bf16*)(F.ws + WS_AO); unsigned char* OG8 = (unsigned char*)(F.ws + WS_OG); float* sa3 = (float*)(F.ws + WS_SA3);
    const f32x4 gn = *(const GAS f32x4*)(F.hg_gain + 4 * (F.lane & 31));
    const float s1 = (F.lane & 1) ? -1.f : 1.f, s2 = (F.lane & 2) ? -1.f : 1.f, s4 = (F.lane & 4) ? -1.f : 1.f;
    v2u ob[16], gbw[16];
    if (gw < M) { const GAS v2u* orow = (const GAS v2u*)(ORAW + (size_t)gw * DM) + F.lane; const GAS v2u* grow = (const GAS v2u*)(SG + (size_t)gw * DM) + F.lane;
#pragma unroll
        for (int j = 0; j < 16; ++j) { ob[j] = orow[64 * j]; gbw[j] = grow[64 * j]; } }
    for (int m = gw; m < M; m += NGW) {
        const int mn = (m + NGW < M) ? m + NGW : m;
        v2u co[16], cg[16];
#pragma unroll
        for (int j = 0; j < 16; ++j) { co[j] = ob[j]; cg[j] = gbw[j]; }
        { const GAS v2u* orow = (const GAS v2u*)(ORAW + (size_t)mn * DM) + F.lane; const GAS v2u* grow = (const GAS v2u*)(SG + (size_t)mn * DM) + F.lane;
#pragma unroll
          for (int j = 0; j < 16; ++j) { ob[j] = orow[64 * j]; gbw[j] = grow[64 * j]; } }
        float v[16][4]; float am = 0.f;
#pragma unroll
        for (int j = 0; j < 16; ++j) {
            const v2u ow = co[j], gw2 = cg[j];
            const float o0 = bflo(ow.x), o1 = bfhi(ow.x), o2 = bflo(ow.y), o3 = bfhi(ow.y);
            float ss = (o0 * o0 + o1 * o1) + (o2 * o2 + o3 * o3);
            ss = half32_sum(ss);
            const float rstd = __builtin_amdgcn_rsqf(ss * (1.f / HD) + RMS_EPS);
            float g0 = bflo(gw2.x), g1 = bfhi(gw2.x), g2 = bflo(gw2.y), g3 = bfhi(gw2.y);
            g0 *= __builtin_amdgcn_rcpf(1.f + __expf(-g0)); g1 *= __builtin_amdgcn_rcpf(1.f + __expf(-g1)); g2 *= __builtin_amdgcn_rcpf(1.f + __expf(-g2)); g3 *= __builtin_amdgcn_rcpf(1.f + __expf(-g3));
            float x0 = o0 * rstd * gn.x * g0, x1 = o1 * rstd * gn.y * g1, x2 = o2 * rstd * gn.z * g2, x3 = o3 * rstd * gn.w * g3;
            { const unsigned a = cvtpk(x0, x1), b = cvtpk(x2, x3); x0 = bflo(a); x1 = bfhi(a); x2 = bflo(b); x3 = bfhi(b); }
            { const float a = x0 + x1, b = x0 - x1, c = x2 + x3, d = x2 - x3; x0 = a + c; x1 = b + d; x2 = a - c; x3 = b - d; }
            float x[4] = {x0, x1, x2, x3};
#pragma unroll
            for (int i = 0; i < 4; ++i) { const float p = DPP_QUAD(x[i], 0xB1); x[i] = p + s1 * x[i]; }
#pragma unroll
            for (int i = 0; i < 4; ++i) { const float p = DPP_QUAD(x[i], 0x4E); x[i] = p + s2 * x[i]; }
#pragma unroll
            for (int i = 0; i < 4; ++i) { const float pl = DPP_MOV(x[i], 0x104), pr = DPP_MOV(x[i], 0x114); const float p = (F.lane & 4) ? pr : pl; x[i] = (p + s4 * x[i]) * 0.17677669529663687f; }
#pragma unroll
            for (int i = 0; i < 4; ++i) { v[j][i] = x[i]; am = fmaxf(am, fabsf(x[i])); }
        }
        am = wave_max(am);
        am = fmaxf(am, 1e-30f);
        const float qs = 127.f / am;
        GAS unsigned* o4 = (GAS unsigned*)(OG8 + (size_t)m * DM) + F.lane;
#pragma unroll
        for (int j = 0; j < 16; ++j) o4[64 * j] = q8bits(v[j][0], qs) | (q8bits(v[j][1], qs) << 8) | (q8bits(v[j][2], qs) << 16) | (q8bits(v[j][3], qs) << 24);
        if (F.lane == 0) sa3[m] = am * (1.f / 127.f);
    }
}
constexpr int H4_OPB = 34816, H4_KR = 17408, H4_ED0 = 3 * H4_OPB, H4_EDB = 1536, H4_VS0 = H4_ED0 + 3 * H4_EDB, H4_VSB = 4096, H4_VT0 = H4_VS0 + 3 * H4_VSB, H4_VTB = 4608, H4_ST0 = H4_VT0 + 2 * H4_VTB, H4_STB = 8704, H4_END = H4_ST0 + 2 * H4_STB;
static_assert(H4_END <= LDSCTL_OFF, "hgrn4 LDS map");
constexpr size_t WS_H3QR = WS_QKV, WS_H3KR = WS_QKV + 136 * MiB, WS_H3VH = WS_QKV + 272 * MiB, WS_H3SG = WS_AO, WS_H3EL = WS_AO + 128 * MiB, WS_H3DEC = WS_AO + 132 * MiB, WS_H3ER = WS_AO + 136 * MiB;
static_assert(WS_H3VH + 128 * MiB <= WS_MRG && WS_H3ER + 4 * MiB + 512 <= WS_LSE, "hgrn4 workspace map");
__device__ __forceinline__ void hgrn_mfma3(Frame& F) {
    const char* TQR = (const char*)(F.ws + WS_H3QR); const char* TKR = (const char*)(F.ws + WS_H3KR);
    const bf16* VH = (const bf16*)(F.ws + WS_H3VH); const float* ELg = (const float*)(F.ws + WS_H3EL); const float* DECg = (const float*)(F.ws + WS_H3DEC); const float* ERg = (const float*)(F.ws + WS_H3ER);
    bf16* ORAW = (bf16*)(F.ws + WS_ACT);
    LAS unsigned char* L = F.lds;
    const int w = F.wave, li = F.lane & 15, g4 = F.lane >> 4;
#pragma unroll 1
    for (int u = blockIdx.x; u < 256; u += F.G) {
        const int ux = u & 7, uy = u >> 3, bh = ux + 8 * (uy >> 2), e0 = (uy & 3) * 32, b = bh >> 5, h = bh & 31;
        const size_t rowbase = (size_t)b * SEQ;
#define H4_DMA(cc, sl) do { const size_t cid_ = (size_t)bh * 128 + (cc); const size_t cidn_ = ((cc) + 1 < SEQ / 64) ? cid_ + 1 : cid_; LAS unsigned char* ob_ = L + (sl) * H4_OPB; LAS unsigned char* eb_ = L + H4_ED0 + (sl) * H4_EDB; \
            _Pragma("unroll") for (int i_ = 0; i_ < 5; ++i_) { const int k_ = 5 * w + i_; \
                if (k_ < 34) { const int t_ = (k_ >= 17) ? 1 : 0, q_ = k_ - 17 * t_; \
                    __builtin_amdgcn_global_load_lds((const unsigned*)((t_ ? TKR : TQR) + cid_ * 17408 + q_ * 1024 + F.lane * 16), (LAS unsigned*)(ob_ + t_ * H4_KR + q_ * 1024), 16, 0, 0); } \
                else { const int e_ = k_ - 34, ar_ = e_ >> 1; const float* sp_ = (ar_ == 0) ? (ELg + cid_ * 128) : (ar_ == 1) ? (DECg + cid_ * 128) : (ERg + cidn_ * 128); \
                    __builtin_amdgcn_global_load_lds((const unsigned*)(sp_ + (e_ & 1) * 64 + F.lane), (LAS unsigned*)(eb_ + ar_ * 512 + (e_ & 1) * 256), 4, 0, 0); } } \
            _Pragma("unroll") for (int i_ = 0; i_ < 2; ++i_) { const int p_ = 2 * w + i_; \
                __builtin_amdgcn_global_load_lds((const unsigned*)(VH + ((size_t)bh * SEQ + 64 * (cc) + 4 * p_ + (F.lane >> 4)) * 128 + e0 + 2 * (F.lane & 15)), (LAS unsigned*)(L + H4_VS0 + (sl) * H4_VSB + p_ * 256), 4, 0, 0); } } while (0)
        f32x4 S[2][2];
#pragma unroll
        for (int a = 0; a < 2; ++a)
#pragma unroll
            for (int c2 = 0; c2 < 2; ++c2) S[a][c2] = (f32x4){0.f, 0.f, 0.f, 0.f};
        for (int i = F.tid; i < H4_STB / 4; i += NWAVES * 64) ((LAS unsigned*)(L + H4_ST0))[i] = 0u;
        H4_DMA(0, 0); H4_DMA(1, 1);
        int sl = 0;
#pragma unroll 1
        for (int c = 0; c < SEQ / 64; ++c) {
            if (w < 4 && c >= 2) asm volatile("s_waitcnt vmcnt(11)" ::: "memory"); else asm volatile("s_waitcnt vmcnt(7)" ::: "memory");
            {
                const LAS unsigned char* vs = L + H4_VS0 + sl * H4_VSB; LAS unsigned char* vt = L + H4_VT0 + (c & 1) * H4_VTB;
                const int row = 8 * w + (F.lane >> 3), eq = 4 * (F.lane & 7);
                const v2u vv = *(const LAS v2u*)(vs + row * 64 + eq * 2);
                *(LAS unsigned short*)(vt + (eq + 0) * 144 + row * 2) = (unsigned short)(vv.x & 0xffffu); *(LAS unsigned short*)(vt + (eq + 1) * 144 + row * 2) = (unsigned short)(vv.x >> 16);
                *(LAS unsigned short*)(vt + (eq + 2) * 144 + row * 2) = (unsigned short)(vv.y & 0xffffu); *(LAS unsigned short*)(vt + (eq + 3) * 144 + row * 2) = (unsigned short)(vv.y >> 16); }
            LDS_WAIT(); __builtin_amdgcn_s_barrier(); asm volatile("" ::: "memory");
            { const int cn = (c + 2 < SEQ / 64) ? c + 2 : SEQ / 64 - 1; const int sn = (sl == 0) ? 2 : sl - 1;
              H4_DMA(cn, sn); }
            const LAS unsigned char* OB = L + sl * H4_OPB; const LAS unsigned char* VT = L + H4_VT0 + (c & 1) * H4_VTB;
            const LAS unsigned char* stc = L + H4_ST0 + (c & 1) * H4_STB;
            LAS unsigned char* stn = L + H4_ST0 + ((c + 1) & 1) * H4_STB;
            if (w < 4) {
                const int tq = w;
                f32x4 Y[2]; Y[0] = (f32x4){0.f, 0.f, 0.f, 0.f}; Y[1] = Y[0];
                bf16x8 bqr[4];
#pragma unroll
                for (int kd = 0; kd < 4; ++kd) { bqr[kd] = *(const LAS bf16x8*)(OB + (16 * tq + li) * 272 + (32 * kd + 8 * g4) * 2);
#pragma unroll
                    for (int eb = 0; eb < 2; ++eb) { const bf16x8 a = *(const LAS bf16x8*)(stc + (16 * eb + li) * 272 + (32 * kd + 8 * g4) * 2); Y[eb] = __builtin_amdgcn_mfma_f32_16x16x32_bf16(a, bqr[kd], Y[eb], 0, 0, 0); } }
                f32x4 X[4];
#pragma unroll
                for (int sb = 0; sb < 4; ++sb) { f32x4 acc = (f32x4){0.f, 0.f, 0.f, 0.f};
                    if (sb <= tq) {
#pragma unroll
                        for (int kd = 0; kd < 4; ++kd) { const bf16x8 a = *(const LAS bf16x8*)(OB + H4_KR + (16 * sb + li) * 272 + (32 * kd + 8 * g4) * 2); acc = __builtin_amdgcn_mfma_f32_16x16x32_bf16(a, bqr[kd], acc, 0, 0, 0); }
                        if (sb == tq) {
#pragma unroll
                            for (int r = 0; r < 4; ++r) if (4 * g4 + r > li) acc[r] = 0.f; } }
                    X[sb] = acc; }
#pragma unroll
                for (int pr = 0; pr < 2; ++pr) { if (2 * pr <= tq) {
                    const bf16x8 pf = __builtin_bit_cast(bf16x8, (v4u){cvtpk(X[2 * pr][0], X[2 * pr][1]), cvtpk(X[2 * pr][2], X[2 * pr][3]), cvtpk(X[2 * pr + 1][0], X[2 * pr + 1][1]), cvtpk(X[2 * pr + 1][2], X[2 * pr + 1][3])});
#pragma unroll
                    for (int eb = 0; eb < 2; ++eb) { const v2u alo = *(const LAS v2u*)(VT + (16 * eb + li) * 144 + (32 * pr + 4 * g4) * 2), ahi = *(const LAS v2u*)(VT + (16 * eb + li) * 144 + (32 * pr + 16 + 4 * g4) * 2);
                        const bf16x8 a = __builtin_bit_cast(bf16x8, (v4u){alo.x, alo.y, ahi.x, ahi.y}); Y[eb] = __builtin_amdgcn_mfma_f32_16x16x32_bf16(a, pf, Y[eb], 0, 0, 0); } } }
                bf16* orow = ORAW + (rowbase + 64 * c + 16 * tq + li) * DM + h * 128 + e0 + 4 * g4;
#pragma unroll
                for (int eb = 0; eb < 2; ++eb) *(GAS v2u*)(orow + 16 * eb) = (v2u){cvtpk(Y[eb][0], Y[eb][1]), cvtpk(Y[eb][2], Y[eb][3])};
            } else {
                const int dt = w - 4;
                const LAS float* ELs = (const LAS float*)(L + H4_ED0 + sl * H4_EDB); const LAS float* DECs = ELs + 128; const LAS float* ERs = ELs + 256;
#pragma unroll
                for (int dbl = 0; dbl < 2; ++dbl) { const int db = 2 * dt + dbl;
                    f32x4 T[2]; T[0] = (f32x4){0.f, 0.f, 0.f, 0.f}; T[1] = T[0];
#pragma unroll
                    for (int ks = 0; ks < 2; ++ks) {
                        const unsigned ka = (unsigned)(size_t)(OB + H4_KR + (32 * ks + 4 * g4 + (li >> 2)) * 272 + (16 * db + 4 * (li & 3)) * 2);
                        v2u lo, hi;
                        asm volatile("ds_read_b64_tr_b16 %0, %2\n\tds_read_b64_tr_b16 %1, %2 offset:4352\n\ts_waitcnt lgkmcnt(0)" : "=&v"(lo), "=&v"(hi) : "v"(ka) : "memory");
                        const bf16x8 a = __builtin_bit_cast(bf16x8, (v4u){lo.x, lo.y, hi.x, hi.y});
#pragma unroll
                        for (int eb = 0; eb < 2; ++eb) { const v2u blo = *(const LAS v2u*)(VT + (16 * eb + li) * 144 + (32 * ks + 4 * g4) * 2), bhi = *(const LAS v2u*)(VT + (16 * eb + li) * 144 + (32 * ks + 16 + 4 * g4) * 2);
                            const bf16x8 bv = __builtin_bit_cast(bf16x8, (v4u){blo.x, blo.y, bhi.x, bhi.y}); T[eb] = __builtin_amdgcn_mfma_f32_16x16x32_bf16(a, bv, T[eb], 0, 0, 0); } }
                    const f32x4 dec = *(const LAS f32x4*)(DECs + 16 * db + 4 * g4), el = *(const LAS f32x4*)(ELs + 16 * db + 4 * g4), er = *(const LAS f32x4*)(ERs + 16 * db + 4 * g4);
#pragma unroll
                    for (int eb = 0; eb < 2; ++eb) { S[dbl][eb] = dec * S[dbl][eb] + el * T[eb]; const f32x4 sv = S[dbl][eb] * er;
                        *(LAS v2u*)(stn + (16 * eb + li) * 272 + (16 * db + 4 * g4) * 2) = (v2u){cvtpk(sv[0], sv[1]), cvtpk(sv[2], sv[3])}; } }
            }
            sl = (sl == 2) ? 0 : sl + 1;
        }
        asm volatile("s_waitcnt vmcnt(0)" ::: "memory"); LDS_WAIT(); __builtin_amdgcn_s_barrier(); asm volatile("" ::: "memory");
#undef H4_DMA
    }
}
struct Args { const float* in[11]; float* out; unsigned char* ws; int ph_lo, ph_hi, li, pad; };
__global__ void __launch_bounds__(NWAVES * 64, 2) mega_fwd(Args args) {
    extern __shared__ __attribute__((aligned(16))) unsigned char lds[];
    Frame F;
    F.lds = (LAS unsigned char*)lds;
    F.MISC = (volatile LAS unsigned*)(F.lds + MISC_OFF);
    F.tid = threadIdx.x; F.lane = F.tid & 63; F.wave = __builtin_amdgcn_readfirstlane(F.tid >> 6);
    F.G = gridDim.x; { const int bx = blockIdx.x; F.vcu = (F.G % 8 == 0) ? (bx % 8) * (F.G / 8) + bx / 8 : bx; }
#define GRID_BAR(seam) do { if (N_LAUNCHES != 1) { if (F.tid == 0) __hip_atomic_store(F.ctl + CW_TMO, 0xBADBA0u | (unsigned)(seam), RLX_AGENT); } \
    else { xcd_barrier(bar); } } while (0)
    unsigned char* ws = args.ws; F.ws = ws;
    F.ctl = (gu32*)(ws + WS_CTL);
    F.x = args.in[0]; F.gains = args.in[1]; F.rel_bias = args.in[2]; F.w_att_in = args.in[3]; F.w_att_out = args.in[4]; F.w_hg_in = args.in[5];
    F.lb_logits = args.in[6]; F.hg_gain = args.in[7]; F.w_hg_out = args.in[8]; F.w_ff_in = args.in[9]; F.w_ff_out = args.in[10]; F.out = args.out;
    for (int u = F.tid; u < (LDS_BYTES - LDSCTL_OFF) / 4; u += NWAVES * 64) ((LAS unsigned*)(F.lds + LDSCTL_OFF))[u] = 0u;
    __syncthreads();
    XcdBarrier bar; bar.bar = (unsigned*)(F.ctl + CW_BAR); bar.x = 0; bar.st = nullptr;
    if (N_LAUNCHES == 1) bar = xcd_barrier_post((unsigned*)(F.ctl + CW_BAR), F.MISC + 8);

    const int lo = args.ph_lo, hi = args.ph_hi;
#define IN(k) (lo <= (k) && (k) < hi)
#define BOTH(k) (IN(k) && IN((k) + 1))
    bf16* const XN = (bf16*)(ws + WS_XN); bf16* const HB = (bf16*)(ws + WS_HB); bf16* const Y = (bf16*)(ws + WS_Y); bf16* const ACT = (bf16*)(ws + WS_ACT);

    if (IN(0)) { for (int rep_ = 0; rep_ < REP_P0; ++rep_) p0_prologue(F);
        if (FFN_I8 && !P0_STRIP) { GRID_BAR(18);
            for (int l = 0; l < 2; ++l) p0_quant_rows<TM_FFI>(F, (const bf16*)(ws + WS_WFFI + l * WFFI_STRIDE), ws + WS_W8 + l * W8_STRIDE, (float*)(ws + WS_SW) + l * 2 * DFF, 2 * DFF);
            if (HGO_I8) p0_quant_wout<DM>(F, (const bf16*)(ws + WS_WHGO), ws + WS_W8G, (float*)(ws + WS_SWG));
            if (FFO_I8) for (int l = 0; l < 2; ++l) p0_quant_wout<DFF>(F, (const bf16*)(ws + WS_WFFO + l * WFFO_STRIDE), ws + WS_W8O + l * W8O_STRIDE, (float*)(ws + WS_SWO) + l * DM);
            if (ATT_I8) p0_quant_rows<false>(F, (const bf16*)(ws + WS_WATTI), ws + WS_W8A, (float*)(ws + WS_SWA), NQKV);
            if (HG_I8) p0_quant_rows<false>(F, (const bf16*)(ws + WS_WHGI), ws + WS_W8H, (float*)(ws + WS_SWH), NHG); }
        if (BOTH(0)) GRID_BAR(0); }
    if (IN(1)) {
        pg8::StaticOrder S; S.init(M, NQKV, F.G, (int)blockIdx.x);
        pg8::Gemm g{XN, ATT_I8 ? (const bf16*)(ws + WS_W8A) : (const bf16*)(ws + WS_WATTI), M, NQKV, ATT_I8 ? DM / 2 : DM};
        pg8::EpiBf16T<ATT_I8> E{(bf16*)(ws + WS_QKV), ATTN_MFMA ? 2048 : NQKV, ATTN_MFMA ? 2048 : 0, ATTN_MFMA ? (size_t)M * 2048 : 0, ATTN_MFMA ? 1 : 0, (const float*)(ws + WS_SA), (const float*)(ws + WS_SWA), (ATTN_MFMA && QKV_HM) ? (size_t)M * 128 : (size_t)0};
        const bool ovl_first = ((int)blockIdx.x & 1) == 0;
        if (P0_STRIP && P0_OVL && ovl_first) run_strips<4>(F, F.vcu, F.G);
        pg8::gemm_phase<pg8::EpiBf16T<ATT_I8>, pg8::StaticOrder, PG8_ALIGN, PG8_SP2, ATT_I8>(F.lds + RING_OFF, g, S, E); if (REP_GEMM > 1) { pg8::gemm_phase<pg8::EpiBf16T<ATT_I8>, pg8::StaticOrder, PG8_ALIGN, PG8_SP2, ATT_I8>(F.lds + RING_OFF, g, S, E); }
        if (P0_STRIP && P0_OVL && !ovl_first) { asm volatile("s_waitcnt vmcnt(0)" ::: "memory"); __syncthreads(); run_strips<4>(F, F.vcu, F.G); }
        if (BOTH(1)) GRID_BAR(1);
    }
    if (IN(2)) { if (ATTN_MFMA) { for (int rep_ = 0; rep_ < REP_ATT; ++rep_) { attn_mfma(F); GRID_BAR(16); attn_merge(F); if (rep_ + 1 < REP_ATT) GRID_BAR(17); } } else attn_naive(F); if (BOTH(2)) GRID_BAR(2); }
    if (IN(3)) {
        pg8::Gemm g{(const bf16*)(ws + WS_MRG), (const bf16*)(ws + WS_WATTO), M, DM, DATT}; pg8::StaticOrder S; S.init(M, DM, F.G, (int)blockIdx.x);
        pg8::EpiBf16 E{Y, DM, 0, 0, 0, nullptr, nullptr};
        pg8::gemm_phase<pg8::EpiBf16, pg8::StaticOrder, PG8_ALIGN, PG8_SP2>(F.lds + RING_OFF, g, S, E); if (REP_GEMM > 1) { pg8::gemm_phase<pg8::EpiBf16, pg8::StaticOrder, PG8_ALIGN, PG8_SP2>(F.lds + RING_OFF, g, S, E); }
        if (BOTH(3)) GRID_BAR(3);
    }
    if (IN(4)) { for (int rep_ = 0; rep_ < REP_NORM; ++rep_) norm_rows<true, FFN_I8 ? (TM_FFI ? 3 : 2) : 1, false, true>(F, F.x, Y, HB, XN, F.gains + 1 * DM, F.gains + 2 * DM, (float*)(ws + WS_SA)); if (BOTH(4)) GRID_BAR(4); }
    if (IN(5)) {
        pg8::StaticOrder S; S.init(M, 2 * DFF, F.G, (int)blockIdx.x);
        if (FFN_I8) {
            pg8::Gemm g{XN, (const bf16*)(ws + WS_W8), M, 2 * DFF, DM / 2};
            if (FFO_I8) {
                pg8::EpiSwiGLU8R E{ACT, DFF, (const float*)(ws + WS_SA), (const float*)(ws + WS_SW) + 0, (unsigned*)(ws + WS_RMAX) + 0 * M};
                pg8::gemm_phase<pg8::EpiSwiGLU8R, pg8::StaticOrder, PG8_ALIGN, PG8_SP2, true, 1, 1, TM_FFI>(F.lds + RING_OFF, g, S, E);
                if (P0_STRIP) run_deferred_strips<1>(F, (M / 256) * (2 * DFF / 256));
            } else {
            pg8::EpiSwiGLU8 E{ACT, DFF, (const float*)(ws + WS_SA), (const float*)(ws + WS_SW) + 0, (bf16*)(ws + WS_QKV)};
                pg8::gemm_phase<pg8::EpiSwiGLU8, pg8::StaticOrder, PG8_ALIGN, PG8_SP2, true, KREP_FFI, EREP_FFI, TM_FFI, TCH_FFI, LT_FFI>(F.lds + RING_OFF, g, S, E); if (REP_GEMM > 1 || REP_FFI > 1) { pg8::gemm_phase<pg8::EpiSwiGLU8, pg8::StaticOrder, PG8_ALIGN, PG8_SP2, true, 1, 1, TM_FFI>(F.lds + RING_OFF, g, S, E); }
            }
        } else {
            pg8::Gemm g{XN, (const bf16*)(ws + WS_WFFI), M, 2 * DFF, DM};
            pg8::EpiSwiGLU E{ACT, DFF};
            pg8::gemm_phase<pg8::EpiSwiGLU, pg8::StaticOrder, PG8_ALIGN, PG8_SP2>(F.lds + RING_OFF, g, S, E); if (REP_GEMM > 1) { pg8::gemm_phase<pg8::EpiSwiGLU, pg8::StaticOrder, PG8_ALIGN, PG8_SP2>(F.lds + RING_OFF, g, S, E); }
        }
        if (BOTH(5)) GRID_BAR(5);
    }
    if (IN(6)) {
        pg8::StaticOrder S; S.init(M, DM, F.G, (int)blockIdx.x);
        if (FFO_I8) {
            act_quant_rows(F, ACT, ws + WS_ACT8, (const unsigned*)(ws + WS_RMAX) + 0 * M, (float*)(ws + WS_SA2));
            GRID_BAR(20);
            pg8::Gemm g{(const bf16*)(ws + WS_ACT8), (const bf16*)(ws + WS_W8O + 0 * W8O_STRIDE), M, DM, DFF / 2};
            pg8::EpiBf16T<true> E{Y, DM, 0, 0, 0, (const float*)(ws + WS_SA2), (const float*)(ws + WS_SWO) + 0 * DM};
            pg8::gemm_phase<pg8::EpiBf16T<true>, pg8::StaticOrder, PG8_ALIGN, PG8_SP2, true>(F.lds + RING_OFF, g, S, E);
        } else {
            pg8::Gemm g{ACT, (const bf16*)(ws + WS_WFFO), M, DM, DFF};
            pg8::EpiBf16 E{Y, DM, 0, 0, 0, nullptr, nullptr};
            pg8::gemm_phase<pg8::EpiBf16, pg8::StaticOrder, PG8_ALIGN, PG8_SP2>(F.lds + RING_OFF, g, S, E);
        }
        if (BOTH(6)) GRID_BAR(6);
    }
    if (IN(7)) { norm_rows<true, HG_I8 ? 2 : 1, true, true>(F, HB, Y, HB, XN, F.gains + 3 * DM, F.gains + 4 * DM, (float*)(ws + WS_SA)); if (BOTH(7)) GRID_BAR(7); }
    if (IN(8)) {
        pg8::StaticOrder S; S.init(M, NHG, F.G, (int)blockIdx.x);
        pg8::Gemm g{XN, HG_I8 ? (const bf16*)(ws + WS_W8H) : (const bf16*)(ws + WS_WHGI), M, NHG, HG_I8 ? DM / 2 : DM};
        if (HG_FUSE == 0) {
            pg8::EpiHgrn<HG_I8> E{(bf16*)(ws + WS_QKV), (bf16*)(ws + WS_AO), (const float*)(ws + WS_TAB + 65536), (const float*)(ws + WS_SA), (const float*)(ws + WS_SWH)};
            pg8::gemm_phase<pg8::EpiHgrn<HG_I8>, pg8::StaticOrder, PG8_ALIGN, PG8_SP2, HG_I8>(F.lds + RING_OFF, g, S, E);
        } else if (HG_FUSE == 1) {
            pg8::EpiHgrn2<HG_I8> E{(bf16*)(ws + WS_QKV), (bf16*)(ws + WS_AO), (const float*)(ws + WS_TAB + 65536), (const float*)(ws + WS_SA), (const float*)(ws + WS_SWH)};
            pg8::gemm_phase<pg8::EpiHgrn2<HG_I8>, pg8::StaticOrder, PG8_ALIGN, PG8_SP2, HG_I8>(F.lds + RING_OFF, g, S, E);
        } else {
            pg8::EpiHgrn3<HG_I8> E{(bf16*)(ws + WS_H3QR), (WS_H3KR - WS_H3QR) / 2, (WS_H3VH - WS_H3QR) / 2, (WS_H3SG - WS_H3QR) / 2, (float*)(ws + WS_H3EL), (float*)(ws + WS_H3DEC), (float*)(ws + WS_H3ER),
                                   (const float*)(ws + WS_TAB + 65536), (const float*)(ws + WS_SA), (const float*)(ws + WS_SWH)};
            pg8::gemm_phase<pg8::EpiHgrn3<HG_I8>, pg8::StaticOrder, PG8_ALIGN, PG8_SP2, HG_I8>(F.lds + RING_OFF, g, S, E);
            if (REP_P8 > 1) { pg8::gemm_phase<pg8::EpiHgrn3<HG_I8>, pg8::StaticOrder, PG8_ALIGN, PG8_SP2, HG_I8>(F.lds + RING_OFF, g, S, E); }
        }
        if (BOTH(8)) GRID_BAR(8);
    }
    if (IN(9)) { if (HG_FUSE == 2) { hgrn_mfma3(F); if (REP_HG > 1) hgrn_mfma3(F); } else { hgrn_mfma2(F); if (REP_HG > 1) hgrn_mfma2(F); } if (BOTH(9)) GRID_BAR(9); }
    if (IN(10)) { if (HGO_I8) hgrn_gate3(F); else { hgrn_gate2(F); if (REP_HG > 1) hgrn_gate2(F); } if (BOTH(10)) GRID_BAR(10); }
    if (IN(11)) {
        pg8::StaticOrder S; S.init(M, DM, F.G, (int)blockIdx.x);
        if (HGO_I8) {
            pg8::Gemm g{(const bf16*)(ws + WS_OG), (const bf16*)(ws + WS_W8G), M, DM, DM / 2};
            pg8::EpiBf16T<true> E{Y, DM, 0, 0, 0, (const float*)(ws + WS_SA3), (const float*)(ws + WS_SWG)};
            pg8::gemm_phase<pg8::EpiBf16T<true>, pg8::StaticOrder, PG8_ALIGN, PG8_SP2, true>(F.lds + RING_OFF, g, S, E);
        } else {
            pg8::Gemm g{(const bf16*)(ws + WS_OG), (const bf16*)(ws + WS_WHGO), M, DM, DM};
            pg8::EpiBf16 E{Y, DM, 0, 0, 0, nullptr, nullptr};
            pg8::gemm_phase<pg8::EpiBf16, pg8::StaticOrder, PG8_ALIGN, PG8_SP2>(F.lds + RING_OFF, g, S, E);
        }
        if (BOTH(11)) GRID_BAR(11);
    }
    if (IN(12)) { norm_rows<true, FFN_I8 ? (TM_FFI ? 3 : 2) : 1, true, true>(F, HB, Y, HB, XN, F.gains + 5 * DM, F.gains + 6 * DM, (float*)(ws + WS_SA)); if (BOTH(12)) GRID_BAR(12); }
    if (IN(13)) {
        pg8::StaticOrder S; S.init(M, 2 * DFF, F.G, (int)blockIdx.x);
        if (FFN_I8) {
            pg8::Gemm g{XN, (const bf16*)(ws + WS_W8 + W8_STRIDE), M, 2 * DFF, DM / 2};
            if (FFO_I8) {
                pg8::EpiSwiGLU8R E{ACT, DFF, (const float*)(ws + WS_SA), (const float*)(ws + WS_SW) + 2 * DFF, (unsigned*)(ws + WS_RMAX) + 1 * M};
                pg8::gemm_phase<pg8::EpiSwiGLU8R, pg8::StaticOrder, PG8_ALIGN, PG8_SP2, true, 1, 1, TM_FFI>(F.lds + RING_OFF, g, S, E);
                if (P0_STRIP) run_deferred_strips<2>(F, (M / 256) * (2 * DFF / 256));
            } else {
            pg8::EpiSwiGLU8 E{ACT, DFF, (const float*)(ws + WS_SA), (const float*)(ws + WS_SW) + 2 * DFF, (bf16*)(ws + WS_QKV)};
                pg8::gemm_phase<pg8::EpiSwiGLU8, pg8::StaticOrder, PG8_ALIGN, PG8_SP2, true, KREP_FFI, EREP_FFI, TM_FFI, TCH_FFI, LT_FFI>(F.lds + RING_OFF, g, S, E); if (REP_GEMM > 1 || REP_FFI > 1) { pg8::gemm_phase<pg8::EpiSwiGLU8, pg8::StaticOrder, PG8_ALIGN, PG8_SP2, true, 1, 1, TM_FFI>(F.lds + RING_OFF, g, S, E); }
            }
        } else {
            pg8::Gemm g{XN, (const bf16*)(ws + WS_WFFI + WFFI_STRIDE), M, 2 * DFF, DM};
            pg8::EpiSwiGLU E{ACT, DFF};
            pg8::gemm_phase<pg8::EpiSwiGLU, pg8::StaticOrder, PG8_ALIGN, PG8_SP2>(F.lds + RING_OFF, g, S, E); if (REP_GEMM > 1) { pg8::gemm_phase<pg8::EpiSwiGLU, pg8::StaticOrder, PG8_ALIGN, PG8_SP2>(F.lds + RING_OFF, g, S, E); }
        }
        if (BOTH(13)) GRID_BAR(13);
    }
    if (IN(14)) {
        pg8::StaticOrder S; S.init(M, DM, F.G, (int)blockIdx.x);
        if (FFO_I8) {
            act_quant_rows(F, ACT, ws + WS_ACT8, (const unsigned*)(ws + WS_RMAX) + 1 * M, (float*)(ws + WS_SA2));
            GRID_BAR(21);
            pg8::Gemm g{(const bf16*)(ws + WS_ACT8), (const bf16*)(ws + WS_W8O + 1 * W8O_STRIDE), M, DM, DFF / 2};
            pg8::EpiBf16T<true> E{Y, DM, 0, 0, 0, (const float*)(ws + WS_SA2), (const float*)(ws + WS_SWO) + 1 * DM};
            pg8::gemm_phase<pg8::EpiBf16T<true>, pg8::StaticOrder, PG8_ALIGN, PG8_SP2, true>(F.lds + RING_OFF, g, S, E);
        } else {
            pg8::Gemm g{ACT, (const bf16*)(ws + WS_WFFO + WFFO_STRIDE), M, DM, DFF};
            pg8::EpiBf16 E{Y, DM, 0, 0, 0, nullptr, nullptr};
            pg8::gemm_phase<pg8::EpiBf16, pg8::StaticOrder, PG8_ALIGN, PG8_SP2>(F.lds + RING_OFF, g, S, E);
        }
        if (BOTH(14)) GRID_BAR(14);
    }
    if (REP_BAR > 0) { for (int rb_ = 0; rb_ < REP_BAR; ++rb_) GRID_BAR(30); }
    if (IN(15)) { norm_rows<true, 0, true, false>(F, HB, Y, F.out, nullptr, F.gains + 7 * DM, nullptr); }
#undef IN
#undef BOTH
}

extern "C" void kernel_launch(void* const* d_in, const int* in_sizes, int n_in, void* d_out, int out_size, void* d_ws, size_t ws_size, hipStream_t stream) {
    static int grid = 0;
    if (grid == 0) {
        if (n_in != 11 || in_sizes[0] != M * DM || out_size != M * DM || ws_size < WS_END5) { fprintf(stderr, "kernel_launch: unexpected shapes (n_in %d, in0 %d, out %d, ws %zu, need %zu); nothing launched\n", n_in, n_in > 0 ? in_sizes[0] : -1, out_size, ws_size, (size_t)WS_END); grid = -1; return; }
        int dev = 0, cus = 0, per_cu = 0;
        if (hipGetDevice(&dev) != hipSuccess || hipDeviceGetAttribute(&cus, hipDeviceAttributeMultiprocessorCount, dev) != hipSuccess) { grid = -1; return; }
        if (hipFuncSetAttribute((const void*)mega_fwd, hipFuncAttributeMaxDynamicSharedMemorySize, LDS_BYTES) != hipSuccess) { fprintf(stderr, "kernel_launch: hipFuncSetAttribute failed\n"); grid = -1; return; }
        if (hipOccupancyMaxActiveBlocksPerMultiprocessor(&per_cu, (const void*)mega_fwd, NWAVES * 64, LDS_BYTES) != hipSuccess || per_cu < 1)
            fprintf(stderr, "kernel_launch: note: occupancy query reports %d workgroups per CU\n", per_cu);
        (void)hipGetLastError();
        grid = cus;
    }
    if (grid < 0) return;
    if (hipMemsetAsync((char*)d_ws + WS_CTL, 0, CTL_ZERO_BYTES, stream) != hipSuccess) { fprintf(stderr, "kernel_launch: hipMemsetAsync failed\n"); return; }
    Args a{};
    for (int i = 0; i < 11; ++i) a.in[i] = (const float*)d_in[i];
    a.out = (float*)d_out; a.ws = (unsigned char*)d_ws;
    for (int li = 0; li < N_LAUNCHES; ++li) {
        a.ph_lo = (N_LAUNCHES == 1) ? 0 : li; a.ph_hi = (N_LAUNCHES == 1) ? NPH : li + 1; a.li = li;
        hipLaunchKernelGGL(mega_fwd, dim3(grid), dim3(NWAVES * 64), LDS_BYTES, stream, a);
        const hipError_t le = hipPeekAtLastError();
        if (le != hipSuccess) { fprintf(stderr, "kernel_launch: launch %d failed: %s\n", li, hipGetErrorName(le)); break; }
    }
}
```
